# Optimizing an MI355X kernel written in HIP

```python
import math
import jax
import jax.numpy as jnp
from jax import lax
import numpy as np

D_MODEL = 1024
BATCH = 8
SEQ = 2048
DEPTH = 4
DEC_BATCH = 128
DEC_SEQ = 4
PAST_LEN = 16384
PAGE_SIZE = 128

N_MEM = 256
RW_HEADS = 12
RW_HEAD = 64
D_RW = RW_HEADS * RW_HEAD
W_LORA = 64
A_LORA = 64
V_LORA = 32
G_LORA = 128
RW_COLS = 3 * D_RW + W_LORA + A_LORA + G_LORA
GN_EPS = 64e-5
LRU_BLOCKS = 12
LRU_BW = 64
D_LRU = LRU_BLOCKS * LRU_BW
CONV_W = 4
LRU_C = 8.0
XA_HEADS = 4
XA_HEAD = 128
D_XA = XA_HEADS * XA_HEAD
N_BRANCH = 3
D_IN = RW_COLS + 2 * D_LRU + D_XA + N_BRANCH * D_MODEL
IN_SPLITS = (RW_COLS, RW_COLS + D_LRU, RW_COLS + 2 * D_LRU, RW_COLS + 2 * D_LRU + D_XA)
RW_SPLITS = (D_RW, 2 * D_RW, 3 * D_RW, 3 * D_RW + W_LORA, 3 * D_RW + W_LORA + A_LORA)
D_FF = ((-(-8 * D_MODEL // 3) + 255) // 256) * 256
ALPHA = (2 * DEPTH) ** 0.25
BETA = (8 * DEPTH) ** -0.25
LN_EPS = 1e-5

kernel_name = 'hybrid_rwkv7_rglru_memxattn_deepnorm_step'

f32 = jnp.float32


def _layer_norm(x, g, b, eps=LN_EPS):
    xf = x.astype(f32)
    mu = jnp.mean(xf, axis=-1, keepdims=True)
    var = jnp.mean(jnp.square(xf - mu), axis=-1, keepdims=True)
    return ((xf - mu) * lax.rsqrt(var + eps) * g.astype(f32) + b.astype(f32)).astype(x.dtype)


def _token_shift(p, prev, mu):
    p_prev = jnp.concatenate([prev[:, None].astype(p.dtype), p[:, :-1]], axis=1)
    return p + (p_prev - p) * mu


def _wkv7_scan(r, decay, k, v, kk, a, s0):
    def step(S, inp):
        r_t, w_t, k_t, v_t, kk_t, a_t = inp
        sa = jnp.einsum('bhvk,bhk->bhv', S, -kk_t)
        S = (S * w_t[:, :, None, :] + sa[..., None] * (kk_t * a_t)[:, :, None, :]
             + v_t[..., None] * k_t[:, :, None, :])
        y = jnp.einsum('bhvk,bhk->bhv', S, r_t)
        return S, y
    xs = tuple(jnp.moveaxis(t.astype(f32), 1, 0) for t in (r, decay, k, v, kk, a))
    S, ys = lax.scan(step, s0.astype(f32), xs)
    return jnp.moveaxis(ys, 0, 1), S


def _rwkv7_branch(l, p_rw, shift_prev, s0, v_first, P):
    B, T, _ = p_rw.shape
    xs = _token_shift(p_rw, shift_prev, P['rw_mu'][l])
    r, k, v, wd, ad, gd = jnp.split(xs, RW_SPLITS, axis=-1)
    w = -jax.nn.softplus(-(P['rw_w0'][l] + jnp.tanh(wd) @ P['rw_w2'][l])) - 0.5
    decay = jnp.exp(-jnp.exp(w.astype(f32)))
    a = jax.nn.sigmoid(P['rw_a0'][l] + ad @ P['rw_a2'][l])
    g = jax.nn.sigmoid(gd) @ P['rw_g2'][l]
    if l == 0:
        v_first = v
    else:
        j = l - 1
        v = v + (v_first - v) * jax.nn.sigmoid(P['rw_v0'][j] + (v @ P['rw_v1'][j]) @ P['rw_v2'][j])
    heads = lambda t: t.reshape(B, T, RW_HEADS, RW_HEAD)
    kk = heads(k * P['rw_kk'][l]).astype(f32)
    kk = kk / jnp.maximum(jnp.sqrt(jnp.sum(kk * kk, axis=-1, keepdims=True)), 1e-12)
    k = k * (1 + (a - 1) * P['rw_ka'][l])
    rh, kh, vh = heads(r), heads(k), heads(v)
    y, s_new = _wkv7_scan(rh, heads(decay), kh, vh, kk, heads(a), s0)
    y = _layer_norm(y.astype(p_rw.dtype), P['rw_gn_g'][l].reshape(RW_HEADS, RW_HEAD),
                    P['rw_gn_b'][l].reshape(RW_HEADS, RW_HEAD), GN_EPS)
    bonus = jnp.sum(rh * kh * P['rw_rk'][l], axis=-1, keepdims=True) * vh
    out = ((y + bonus).reshape(B, T, D_RW) * g) @ P['w_rw_out'][l]
    return out, v_first, s_new.astype(p_rw.dtype)


def _lin_combine(c1, c2):
    a1, u1 = c1
    a2, u2 = c2
    return a1 * a2, a2 * u1 + u2


def _rglru_branch(l, p_lx, p_lg, conv_buf, h0, P):
    B, T, _ = p_lx.shape
    xpad = jnp.concatenate([conv_buf.astype(p_lx.dtype), p_lx], axis=1)
    w = P['lru_conv_w'][l]
    xc = P['lru_conv_b'][l] + w[CONV_W - 1] * p_lx
    for j in range(CONV_W - 1):
        xc = xc + w[j] * xpad[:, j:j + T]
    xh = xc.reshape(B, T, LRU_BLOCKS, LRU_BW)
    rg = jax.nn.sigmoid(jnp.einsum('btni,nij->btnj', xh, P['lru_w_rg'][l])
                        + P['lru_b_rg'][l].reshape(LRU_BLOCKS, LRU_BW))
    ig = jax.nn.sigmoid(jnp.einsum('btni,nij->btnj', xh, P['lru_w_ig'][l])
                        + P['lru_b_ig'][l].reshape(LRU_BLOCKS, LRU_BW))
    log_a = -LRU_C * rg.astype(f32) * jax.nn.softplus(
        -P['lru_lambda'][l].astype(f32)).reshape(LRU_BLOCKS, LRU_BW)
    a = jnp.exp(log_a).reshape(B, T, D_LRU)
    u = (jnp.sqrt(-jnp.expm1(2.0 * log_a)) * (ig * xh).astype(f32)).reshape(B, T, D_LRU)
    a_cum, u_cum = lax.associative_scan(_lin_combine, (a, u), axis=1)
    h = a_cum * h0.astype(f32)[:, None] + u_cum
    out = (h.astype(p_lg.dtype) * jax.nn.gelu(p_lg)) @ P['w_lru_out'][l]
    return out, xpad[:, T:], h[:, -1].astype(p_lx.dtype)


def _memory_branch(l, q, mem_k, mem_v, P):
    B, T, _ = q.shape
    qh = q.reshape(B, T, XA_HEADS, XA_HEAD)
    s = jnp.einsum('bthd,bmhd->bhtm', qh, mem_k.astype(q.dtype)).astype(f32) * (XA_HEAD ** -0.5)
    p = jax.nn.softmax(s, axis=-1).astype(q.dtype)
    o = jnp.einsum('bhtm,bmhd->bthd', p, mem_v.astype(q.dtype)).reshape(B, T, D_XA)
    return o @ P['w_xa_out'][l]


def _layer(l, x, mem_k, mem_v, shift_prev, s0, conv_buf, h0, v_first, P):
    proj = x @ P['w_in'][l]
    p_rw, p_lx, p_lg, q, gates = jnp.split(proj, IN_SPLITS, axis=-1)
    o_rw, v_first, s_new = _rwkv7_branch(l, p_rw, shift_prev, s0, v_first, P)
    o_lru, conv_new, h_new = _rglru_branch(l, p_lx, p_lg, conv_buf, h0, P)
    o_xa = _memory_branch(l, q, mem_k, mem_v, P)
    g_rw, g_lru, g_xa = jnp.split(jax.nn.sigmoid(gates), N_BRANCH, axis=-1)
    mix = (g_rw * o_rw + g_lru * o_lru + g_xa * o_xa) @ P['w_o'][l]
    x = _layer_norm(ALPHA * x + mix, P['ln1_g'][l], P['ln1_b'][l])
    u, gt = jnp.split(x @ P['w_ffn_in'][l], 2, axis=-1)
    ffn = (jax.nn.silu(gt) * u) @ P['w_ffn_out'][l]
    x = _layer_norm(ALPHA * x + ffn, P['ln2_g'][l], P['ln2_b'][l])
    return x, v_first, p_rw[:, -1], s_new, conv_new, h_new


def _trunk(x, mem_k, mem_v, shift, wkv, conv, h, P):
    v_first = None
    n_sh, n_wkv, n_conv, n_h = [], [], [], []
    for l in range(DEPTH):
        x, v_first, s_sh, s_wkv, s_conv, s_h = _layer(
            l, x, mem_k[l], mem_v[l], shift[l], wkv[l], conv[l], h[l], v_first, P)
        n_sh.append(s_sh)
        n_wkv.append(s_wkv)
        n_conv.append(s_conv)
        n_h.append(s_h)
    return x, jnp.stack(n_sh), jnp.stack(n_wkv), jnp.stack(n_conv), jnp.stack(n_h)


def _nrm(k, shape, scale):
    return jax.random.normal(k, shape, f32) * scale


def setup_inputs(seed: int = 0) -> dict:
    key = jax.random.key(seed)
    ks = iter(jax.random.split(key, 48))
    nk = lambda: next(ks)
    u_lam = jax.random.uniform(nk(), (DEPTH, D_LRU), f32, 0.9, 0.999)
    s_lam = u_lam ** (1.0 / LRU_C)
    d = {}
    d['x_prompt'] = _nrm(nk(), (BATCH, SEQ, D_MODEL), 1.0)
    d['x_sample'] = _nrm(nk(), (DEC_BATCH, DEC_SEQ, D_MODEL), 1.0)
    d['mem_prompt'] = _nrm(nk(), (BATCH, N_MEM, D_MODEL), 1.0)
    d['state_rwkv_shift'] = _nrm(nk(), (DEPTH, DEC_BATCH, RW_COLS), 1.0)
    d['state_rwkv_wkv'] = _nrm(nk(), (DEPTH, DEC_BATCH, RW_HEADS, RW_HEAD, RW_HEAD), 0.3)
    d['state_lru_conv'] = _nrm(nk(), (DEPTH, DEC_BATCH, CONV_W - 1, D_LRU), 1.0)
    d['state_lru_h'] = _nrm(nk(), (DEPTH, DEC_BATCH, D_LRU), 0.5)
    d['cache_mem_k'] = _nrm(nk(), (DEPTH, DEC_BATCH, N_MEM, XA_HEADS, XA_HEAD), 1.0)
    d['cache_mem_v'] = _nrm(nk(), (DEPTH, DEC_BATCH, N_MEM, XA_HEADS, XA_HEAD), 1.0)
    d['w_in'] = _nrm(nk(), (DEPTH, D_MODEL, D_IN), D_MODEL ** -0.5)
    d['rw_mu'] = jax.random.uniform(nk(), (DEPTH, RW_COLS), f32, 0.0, 1.0)
    d['rw_w0'] = jax.random.uniform(nk(), (DEPTH, D_RW), f32, -4.0, 1.0)
    d['rw_w2'] = _nrm(nk(), (DEPTH, W_LORA, D_RW), 0.5 * W_LORA ** -0.5)
    d['rw_a0'] = _nrm(nk(), (DEPTH, D_RW), 0.5)
    d['rw_a2'] = _nrm(nk(), (DEPTH, A_LORA, D_RW), A_LORA ** -0.5)
    d['rw_g2'] = _nrm(nk(), (DEPTH, G_LORA, D_RW), G_LORA ** -0.5)
    d['rw_v0'] = _nrm(nk(), (DEPTH - 1, D_RW), 0.5)
    d['rw_v1'] = _nrm(nk(), (DEPTH - 1, D_RW, V_LORA), D_RW ** -0.5)
    d['rw_v2'] = _nrm(nk(), (DEPTH - 1, V_LORA, D_RW), V_LORA ** -0.5)
    d['rw_kk'] = 0.85 + _nrm(nk(), (DEPTH, D_RW), 0.05)
    d['rw_ka'] = 1.0 + _nrm(nk(), (DEPTH, D_RW), 0.05)
    d['rw_rk'] = _nrm(nk(), (DEPTH, RW_HEADS, RW_HEAD), 0.1)
    d['rw_gn_g'] = 1.0 + _nrm(nk(), (DEPTH, D_RW), 0.02)
    d['rw_gn_b'] = _nrm(nk(), (DEPTH, D_RW), 0.02)
    d['w_rw_out'] = _nrm(nk(), (DEPTH, D_RW, D_MODEL), D_RW ** -0.5)
    d['lru_conv_w'] = _nrm(nk(), (DEPTH, CONV_W, D_LRU), CONV_W ** -0.5)
    d['lru_conv_b'] = _nrm(nk(), (DEPTH, D_LRU), 0.02)
    d['lru_w_rg'] = _nrm(nk(), (DEPTH, LRU_BLOCKS, LRU_BW, LRU_BW), LRU_BW ** -0.5)
    d['lru_b_rg'] = _nrm(nk(), (DEPTH, D_LRU), 0.1)
    d['lru_w_ig'] = _nrm(nk(), (DEPTH, LRU_BLOCKS, LRU_BW, LRU_BW), LRU_BW ** -0.5)
    d['lru_b_ig'] = _nrm(nk(), (DEPTH, D_LRU), 0.1)
    d['lru_lambda'] = jnp.log(s_lam) - jnp.log1p(-s_lam)
    d['w_lru_out'] = _nrm(nk(), (DEPTH, D_LRU, D_MODEL), D_LRU ** -0.5)
    d['w_mem_kv'] = _nrm(nk(), (DEPTH, D_MODEL, 2 * D_XA), D_MODEL ** -0.5)
    d['w_xa_out'] = _nrm(nk(), (DEPTH, D_XA, D_MODEL), D_XA ** -0.5)
    d['w_o'] = _nrm(nk(), (DEPTH, D_MODEL, D_MODEL), BETA * D_MODEL ** -0.5)
    d['ln1_g'] = 1.0 + _nrm(nk(), (DEPTH, D_MODEL), 0.02)
    d['ln1_b'] = _nrm(nk(), (DEPTH, D_MODEL), 0.02)
    d['w_ffn_in'] = _nrm(nk(), (DEPTH, D_MODEL, 2 * D_FF), D_MODEL ** -0.5)
    d['w_ffn_out'] = _nrm(nk(), (DEPTH, D_FF, D_MODEL), BETA * D_FF ** -0.5)
    d['ln2_g'] = 1.0 + _nrm(nk(), (DEPTH, D_MODEL), 0.02)
    d['ln2_b'] = _nrm(nk(), (DEPTH, D_MODEL), 0.02)
    return d


def reference(x_prompt, x_sample, mem_prompt, state_rwkv_shift, state_rwkv_wkv, state_lru_conv,
              state_lru_h, cache_mem_k, cache_mem_v, w_in, rw_mu, rw_w0, rw_w2, rw_a0, rw_a2,
              rw_g2, rw_v0, rw_v1, rw_v2, rw_kk, rw_ka, rw_rk, rw_gn_g, rw_gn_b, w_rw_out,
              lru_conv_w, lru_conv_b, lru_w_rg, lru_b_rg, lru_w_ig, lru_b_ig, lru_lambda, w_lru_out,
              w_mem_kv, w_xa_out, w_o, ln1_g, ln1_b, w_ffn_in, w_ffn_out, ln2_g, ln2_b):
    P = {'w_in': w_in, 'rw_mu': rw_mu, 'rw_w0': rw_w0, 'rw_w2': rw_w2, 'rw_a0': rw_a0,
         'rw_a2': rw_a2, 'rw_g2': rw_g2, 'rw_v0': rw_v0, 'rw_v1': rw_v1, 'rw_v2': rw_v2,
         'rw_kk': rw_kk, 'rw_ka': rw_ka, 'rw_rk': rw_rk, 'rw_gn_g': rw_gn_g, 'rw_gn_b': rw_gn_b,
         'w_rw_out': w_rw_out, 'lru_conv_w': lru_conv_w, 'lru_conv_b': lru_conv_b,
         'lru_w_rg': lru_w_rg, 'lru_b_rg': lru_b_rg, 'lru_w_ig': lru_w_ig, 'lru_b_ig': lru_b_ig,
         'lru_lambda': lru_lambda, 'w_lru_out': w_lru_out, 'w_xa_out': w_xa_out, 'w_o': w_o,
         'ln1_g': ln1_g, 'ln1_b': ln1_b, 'w_ffn_in': w_ffn_in, 'w_ffn_out': w_ffn_out,
         'ln2_g': ln2_g, 'ln2_b': ln2_b}
    Bp = x_prompt.shape[0]
    mk, mv = [], []
    for l in range(DEPTH):
        k_, v_ = jnp.split(mem_prompt @ w_mem_kv[l], 2, axis=-1)
        mk.append(k_.reshape(Bp, N_MEM, XA_HEADS, XA_HEAD))
        mv.append(v_.reshape(Bp, N_MEM, XA_HEADS, XA_HEAD))
    new_mem_k_prompt = jnp.stack(mk)
    new_mem_v_prompt = jnp.stack(mv)
    dt = x_prompt.dtype
    z_shift = jnp.zeros((DEPTH, Bp, RW_COLS), dt)
    z_wkv = jnp.zeros((DEPTH, Bp, RW_HEADS, RW_HEAD, RW_HEAD), dt)
    z_conv = jnp.zeros((DEPTH, Bp, CONV_W - 1, D_LRU), dt)
    z_h = jnp.zeros((DEPTH, Bp, D_LRU), dt)
    y_prompt, sh_p, wkv_p, conv_p, h_p = _trunk(
        x_prompt, new_mem_k_prompt, new_mem_v_prompt, z_shift, z_wkv, z_conv, z_h, P)
    y_sample, sh_s, wkv_s, conv_s, h_s = _trunk(
        x_sample, cache_mem_k, cache_mem_v, state_rwkv_shift, state_rwkv_wkv,
        state_lru_conv, state_lru_h, P)
    return (y_prompt, y_sample, sh_p, wkv_p, conv_p, h_p, new_mem_k_prompt, new_mem_v_prompt,
            sh_s, wkv_s, conv_s, h_s)
```

```cpp
#include <hip/hip_runtime.h>
#include <hip/hip_cooperative_groups.h>
#include <cstdio>
namespace cg = cooperative_groups;

typedef unsigned short bf16_t;
typedef __attribute__((ext_vector_type(8))) short bf16x8;
typedef __attribute__((ext_vector_type(4))) float f32x4;

constexpr int D = 1024, MP = 16384, MS = 512, MT = 16896, NL = 4;
constexpr int DIN = 7680, DRW = 768, DLRU = 768, DXA = 512, DFF = 2816, RWC = 2560;
constexpr int C_LX = 2560, C_LG = 3328, C_Q = 4096, C_G = 4608;
constexpr int NSEQ = 136;
constexpr float ALPHA = 1.681792830507429f;

constexpr size_t O_Y = 0;
constexpr size_t O_SHP = O_Y + (size_t)MT * D;
constexpr size_t O_WKVP = O_SHP + (size_t)NL * 8 * RWC;
constexpr size_t O_CONVP = O_WKVP + (size_t)NL * 8 * 12 * 64 * 64;
constexpr size_t O_HP = O_CONVP + (size_t)NL * 8 * 3 * DLRU;
constexpr size_t O_MKP = O_HP + (size_t)NL * 8 * DLRU;
constexpr size_t O_MVP = O_MKP + (size_t)NL * 8 * 256 * 512;
constexpr size_t O_SHS = O_MVP + (size_t)NL * 8 * 256 * 512;
constexpr size_t O_WKVS = O_SHS + (size_t)NL * 128 * RWC;
constexpr size_t O_CONVS = O_WKVS + (size_t)NL * 128 * 12 * 64 * 64;
constexpr size_t O_HS = O_CONVS + (size_t)NL * 128 * 3 * DLRU;
constexpr size_t O_END = O_HS + (size_t)NL * 128 * DLRU;

constexpr size_t al256(size_t x) { return (x + 255) & ~(size_t)255; }
constexpr size_t W_IN = 0;
constexpr size_t W_RWOUT = W_IN + al256((size_t)NL * DIN * D * 2);
constexpr size_t W_LRUOUT = W_RWOUT + al256((size_t)NL * D * DRW * 2);
constexpr size_t W_XAOUT = W_LRUOUT + al256((size_t)NL * D * DLRU * 2);
constexpr size_t W_O = W_XAOUT + al256((size_t)NL * D * DXA * 2);
constexpr size_t W_FFNIN = W_O + al256((size_t)NL * D * D * 2);
constexpr size_t W_FFNOUT = W_FFNIN + al256((size_t)NL * 2 * DFF * D * 2);
constexpr size_t W_MEMKV = W_FFNOUT + al256((size_t)NL * D * DFF * 2);
constexpr size_t W_W2T = W_MEMKV + al256((size_t)NL * D * D * 2);
constexpr size_t W_A2T = W_W2T + al256((size_t)NL * DRW * 64 * 2);
constexpr size_t W_G2T = W_A2T + al256((size_t)NL * DRW * 64 * 2);
constexpr size_t W_V2T = W_G2T + al256((size_t)NL * DRW * 128 * 2);
constexpr size_t W_RGT = W_V2T + al256((size_t)3 * DRW * 32 * 2);
constexpr size_t W_IGT = W_RGT + al256((size_t)NL * 12 * 64 * 64 * 2);
constexpr size_t B_XF = W_IGT + al256((size_t)NL * 12 * 64 * 64 * 2);
constexpr size_t B_XB = B_XF + al256((size_t)MT * D * 4);
constexpr size_t B_MEMB = B_XB + al256((size_t)MT * D * 2);
constexpr size_t B_KB = B_MEMB + al256((size_t)2048 * D * 2);
constexpr size_t B_VTB = B_KB + al256((size_t)NL * 8 * 256 * 512 * 2);
constexpr size_t B_VFIRST = B_VTB + al256((size_t)NL * 8 * 256 * 512 * 2);
constexpr size_t B_PROJ = B_VFIRST + al256((size_t)MT * DRW * 2);
constexpr size_t B_SCAN = B_PROJ + al256((size_t)MT * DIN * 2);
constexpr size_t SCAN_BYTES = (size_t)MT * 12 * 896;
constexpr size_t B_MIXIN = B_SCAN;
constexpr size_t B_ACT = B_SCAN + al256((size_t)MT * D * 2);
constexpr size_t B_CBUF = B_SCAN + al256(SCAN_BYTES);
constexpr size_t B_YBUF = B_CBUF + al256((size_t)MT * 12 * 16);
constexpr size_t B_GBUF = B_YBUF + al256((size_t)MT * DRW * 4);
constexpr size_t B_ABUF = B_GBUF + al256((size_t)MT * DRW * 2);
constexpr size_t B_UBUF = B_ABUF + al256((size_t)MT * DLRU * 4);
constexpr size_t B_LBUF = B_UBUF + al256((size_t)MT * DLRU * 4);
constexpr size_t B_VMID = B_LBUF + al256((size_t)MT * 256 * 2);
constexpr size_t B_ARW = B_VMID + al256((size_t)MT * 32 * 2);
constexpr size_t B_ALRU = B_ARW + al256((size_t)MT * DRW * 2);
constexpr size_t B_AXA = B_ALRU + al256((size_t)MT * DLRU * 2);
constexpr size_t B_CNT = B_AXA + al256((size_t)MT * DXA * 2);
constexpr size_t WS_NEED = B_CNT + 256;
static_assert(al256((size_t)MT * D * 2) + (size_t)MT * DFF * 2 <= SCAN_BYTES, "alias overflow");

enum { I_XP = 0, I_XS, I_MEM, I_SSHIFT, I_SWKV, I_SCONV, I_SH, I_CK, I_CV, I_WIN, I_MU, I_W0, I_W2, I_A0, I_A2,
       I_G2, I_V0, I_V1, I_V2, I_KK, I_KA, I_RK, I_GNG, I_GNB, I_WRWOUT, I_CONVW, I_CONVB, I_WRG, I_BRG, I_WIG,
       I_BIG, I_LAMBDA, I_WLRUOUT, I_WMEMKV, I_WXAOUT, I_WO, I_LN1G, I_LN1B, I_WFFNIN, I_WFFNOUT, I_LN2G, I_LN2B };

struct Params {
  const float* in[42];
  float* out;
  char* ws;
};

constexpr int LDS_BYTES = 65536;

__device__ __forceinline__ bf16_t f2bf(float f) {
  unsigned u = __float_as_uint(f);
  u += 0x7fffu + ((u >> 16) & 1u);
  return (bf16_t)(u >> 16);
}
__device__ __forceinline__ float bf2f(bf16_t h) { return __uint_as_float(((unsigned)h) << 16); }
__device__ __forceinline__ float sigmoidf_(float x) { return 1.f / (1.f + __expf(-x)); }
__device__ __forceinline__ float softplusf_(float x) { return fmaxf(x, 0.f) + log1pf(__expf(-fabsf(x))); }
__device__ __forceinline__ int swz(int rr, int b) { int ob = rr * 64 + b; return ob ^ (((ob >> 9) & 1) << 5); }

__device__ __forceinline__ int tid_() {
  int t = threadIdx.x;
  asm volatile("" : "+v"(t));
  return t;
}
template <int CTRL>
__device__ __forceinline__ float dppf(float x) {
  return __int_as_float(__builtin_amdgcn_update_dpp(0, __float_as_int(x), CTRL, 0xf, 0xf, true));
}
__device__ __forceinline__ float red16_sum(float x) {
  x += dppf<0xB1>(x);
  x += dppf<0x4E>(x);
  x += dppf<0x141>(x);
  x += dppf<0x140>(x);
  return x;
}
__device__ __forceinline__ float red16_max(float x) {
  x = fmaxf(x, dppf<0xB1>(x));
  x = fmaxf(x, dppf<0x4E>(x));
  x = fmaxf(x, dppf<0x141>(x));
  x = fmaxf(x, dppf<0x140>(x));
  return x;
}
__device__ __forceinline__ float wave_sum(float x) {
#pragma unroll
  for (int m = 1; m < 64; m <<= 1) x += __shfl_xor(x, m, 64);
  return x;
}

__device__ __forceinline__ void tok_info(int tok, int& seq, int& t, int& T) {
  if (tok < MP) { seq = tok >> 11; t = tok & 2047; T = 2048; }
  else { int s = tok - MP; seq = 8 + (s >> 2); t = s & 3; T = 4; }
}
__device__ __forceinline__ int seq_tok0(int seq) { return seq < 8 ? seq * 2048 : MP + (seq - 8) * 4; }

#define MFMA(a, b, c) __builtin_amdgcn_mfma_f32_16x16x32_bf16((a), (b), (c), 0, 0, 0)

template <int MTW, int NTW>
__device__ __forceinline__ void gemm_main(const bf16_t* __restrict__ A, int lda, const bf16_t* __restrict__ Bt, int ldb,
                                          int K, int m0, int n0, char* lds, f32x4 (&acc)[MTW][NTW]) {
  constexpr int ABYTES = 4096 * MTW, BUFB = 4096 * (MTW + NTW);
  const int TX = tid_();
  const int tid = TX, lane = tid & 63, wv = tid >> 6;
  const int wr = wv >> 1, wc = wv & 1, fr = lane & 15, fq = lane >> 4;
  const int srow = tid >> 3, skc = tid & 7;
  const bf16_t* ga = A + (size_t)(m0 + srow) * lda + skc * 8;
  const bf16_t* gb = Bt + (size_t)(n0 + srow) * ldb + skc * 8;
  const int soff = ((srow >> 4) * 2 + (skc >> 2)) * 1024 + swz(srow & 15, (skc & 3) * 16);
  const int fo = swz(fr, fq * 16);
  uint4 ra[MTW], rb[NTW];
  const int nk = K >> 6;
#pragma unroll
  for (int j = 0; j < MTW; ++j) ra[j] = *(const uint4*)(ga + (size_t)(32 * j) * lda);
#pragma unroll
  for (int j = 0; j < NTW; ++j) rb[j] = *(const uint4*)(gb + (size_t)(32 * j) * ldb);
#pragma unroll
  for (int j = 0; j < MTW; ++j) *(uint4*)(lds + soff + j * 4096) = ra[j];
#pragma unroll
  for (int j = 0; j < NTW; ++j) *(uint4*)(lds + ABYTES + soff + j * 4096) = rb[j];
  __syncthreads();
  for (int kt = 0; kt < nk; ++kt) {
    const int cur = kt & 1;
    if (kt + 1 < nk) {
#pragma unroll
      for (int j = 0; j < MTW; ++j) ra[j] = *(const uint4*)(ga + (size_t)(32 * j) * lda + (kt + 1) * 64);
#pragma unroll
      for (int j = 0; j < NTW; ++j) rb[j] = *(const uint4*)(gb + (size_t)(32 * j) * ldb + (kt + 1) * 64);
    }
    const char* cA = lds + cur * BUFB;
    const char* cB = cA + ABYTES;
#pragma unroll
    for (int ks = 0; ks < 2; ++ks) {
      bf16x8 af[MTW], bfr[NTW];
#pragma unroll
      for (int mt = 0; mt < MTW; ++mt) af[mt] = *(const bf16x8*)(cA + ((wr * MTW + mt) * 2 + ks) * 1024 + fo);
#pragma unroll
      for (int nt = 0; nt < NTW; ++nt) bfr[nt] = *(const bf16x8*)(cB + ((wc * NTW + nt) * 2 + ks) * 1024 + fo);
#pragma unroll
      for (int mt = 0; mt < MTW; ++mt)
#pragma unroll
        for (int nt = 0; nt < NTW; ++nt) acc[mt][nt] = MFMA(af[mt], bfr[nt], acc[mt][nt]);
    }
    if (kt + 1 < nk) {
      char* nb = lds + (cur ^ 1) * BUFB;
#pragma unroll
      for (int j = 0; j < MTW; ++j) *(uint4*)(nb + soff + j * 4096) = ra[j];
#pragma unroll
      for (int j = 0; j < NTW; ++j) *(uint4*)(nb + ABYTES + soff + j * 4096) = rb[j];
    }
    __syncthreads();
  }
}

template <int MTW, int NTW>
__device__ __forceinline__ void zero_acc(f32x4 (&acc)[MTW][NTW]) {
#pragma unroll
  for (int a = 0; a < MTW; ++a)
#pragma unroll
    for (int b = 0; b < NTW; ++b) acc[a][b] = f32x4{0.f, 0.f, 0.f, 0.f};
}

__device__ void transpose_tile(const float* __restrict__ W, int ldw, bf16_t* __restrict__ Wt, int ldt, int k0, int n0,
                               int perm, char* lds) {
  const int TX = tid_();
  float* tile = (float*)lds;
  const int tid = TX;
  const int c = tid & 63, r0 = tid >> 6;
#pragma unroll
  for (int r = 0; r < 16; ++r) {
    int row = r * 4 + r0;
    tile[row * 65 + c] = W[(size_t)(k0 + row) * ldw + n0 + c];
  }
  __syncthreads();
#pragma unroll
  for (int r = 0; r < 16; ++r) {
    int n = n0 + r * 4 + r0;
    int np = n;
    if (perm) {
      if (n < DFF) np = (n >> 5) * 64 + (n & 31);
      else { int j = n - DFF; np = (j >> 5) * 64 + 32 + (j & 31); }
    }
    Wt[(size_t)np * ldt + k0 + c] = f2bf(tile[c * 65 + (r * 4 + r0)]);
  }
  __syncthreads();
}

__device__ __forceinline__ void convert_job(const float* __restrict__ src, bf16_t* __restrict__ dst, int K, int N, int nmat,
                                            int perm, int& start, char* lds) {
  const int tk = K / 64, tn = N / 64;
  const int ntiles = nmat * tk * tn;
  const int G = (int)gridDim.x;
  const int first = (((int)blockIdx.x - start) % G + G) % G;
  for (int i = first; i < ntiles; i += G) {
    const int mat = i / (tk * tn), r = i % (tk * tn);
    const int kt = r / tn, nt = r % tn;
    transpose_tile(src + (size_t)mat * K * N, N, dst + (size_t)mat * K * N, K, kt * 64, nt * 64, perm, lds);
  }
  start += ntiles;
}

__device__ void phase_convert(const Params& p, char* lds) {
  const int TX = tid_();
  char* ws = p.ws;
  int start = 0;
  convert_job(p.in[I_WIN], (bf16_t*)(ws + W_IN), 1024, 7680, NL, 0, start, lds);
  convert_job(p.in[I_WFFNIN], (bf16_t*)(ws + W_FFNIN), 1024, 5632, NL, 1, start, lds);
  convert_job(p.in[I_WFFNOUT], (bf16_t*)(ws + W_FFNOUT), 2816, 1024, NL, 0, start, lds);
  convert_job(p.in[I_WRWOUT], (bf16_t*)(ws + W_RWOUT), 768, 1024, NL, 0, start, lds);
  convert_job(p.in[I_WLRUOUT], (bf16_t*)(ws + W_LRUOUT), 768, 1024, NL, 0, start, lds);
  convert_job(p.in[I_WXAOUT], (bf16_t*)(ws + W_XAOUT), 512, 1024, NL, 0, start, lds);
  convert_job(p.in[I_WO], (bf16_t*)(ws + W_O), 1024, 1024, NL, 0, start, lds);
  convert_job(p.in[I_WMEMKV], (bf16_t*)(ws + W_MEMKV), 1024, 1024, NL, 0, start, lds);
  convert_job(p.in[I_W2], (bf16_t*)(ws + W_W2T), 64, 768, NL, 0, start, lds);
  convert_job(p.in[I_A2], (bf16_t*)(ws + W_A2T), 64, 768, NL, 0, start, lds);
  convert_job(p.in[I_G2], (bf16_t*)(ws + W_G2T), 128, 768, NL, 0, start, lds);
  convert_job(p.in[I_WRG], (bf16_t*)(ws + W_RGT), 64, 64, NL * 12, 0, start, lds);
  convert_job(p.in[I_WIG], (bf16_t*)(ws + W_IGT), 64, 64, NL * 12, 0, start, lds);
  const size_t gtid = (size_t)blockIdx.x * 256 + TX, gsz = (size_t)gridDim.x * 256;
  {
    float4* xf = (float4*)(ws + B_XF);
    uint2* xb = (uint2*)(ws + B_XB);
    const float4* xp = (const float4*)p.in[I_XP];
    const float4* xs = (const float4*)p.in[I_XS];
    const size_t np4 = (size_t)MP * D / 4, nt4 = (size_t)MT * D / 4;
    for (size_t i = gtid; i < nt4; i += gsz) {
      float4 v = (i < np4) ? xp[i] : xs[i - np4];
      xf[i] = v;
      uint2 o;
      o.x = (unsigned)f2bf(v.x) | ((unsigned)f2bf(v.y) << 16);
      o.y = (unsigned)f2bf(v.z) | ((unsigned)f2bf(v.w) << 16);
      xb[i] = o;
    }
  }
  {
    uint2* mb = (uint2*)(ws + B_MEMB);
    const float4* m = (const float4*)p.in[I_MEM];
    const size_t n4 = (size_t)2048 * D / 4;
    for (size_t i = gtid; i < n4; i += gsz) {
      float4 v = m[i];
      uint2 o;
      o.x = (unsigned)f2bf(v.x) | ((unsigned)f2bf(v.y) << 16);
      o.y = (unsigned)f2bf(v.z) | ((unsigned)f2bf(v.w) << 16);
      mb[i] = o;
    }
  }
  {
    bf16_t* v2t = (bf16_t*)(ws + W_V2T);
    const float* v2 = p.in[I_V2];
    for (size_t i = gtid; i < (size_t)3 * 768 * 32; i += gsz) {
      int j = (int)(i / (768 * 32)), r = (int)(i % (768 * 32));
      int n = r / 32, k = r % 32;
      v2t[i] = f2bf(v2[(size_t)j * 32 * 768 + (size_t)k * 768 + n]);
    }
  }
  if (blockIdx.x == 0 && TX < 64) ((int*)(ws + B_CNT))[TX] = 0;
}

__device__ void phase_proj(const Params& p, int l, char* lds) {
  const int TX = tid_();
  char* ws = p.ws;
  const bf16_t* xb = (const bf16_t*)(ws + B_XB);
  const bf16_t* wt = (const bf16_t*)(ws + W_IN) + (size_t)l * DIN * D;
  bf16_t* proj = (bf16_t*)(ws + B_PROJ);
  const int lane = TX & 63, wv = TX >> 6, wr = wv >> 1, wc = wv & 1, fr = lane & 15, fq = lane >> 4;
  const int nN = DIN / 128, ntiles = (MT / 128) * nN;
  const int nextra = (l == 0) ? NL * 16 * 8 : 0;
  for (int tile = blockIdx.x; tile < ntiles + nextra; tile += gridDim.x) {
    f32x4 acc[4][4];
    zero_acc(acc);
    if (tile < ntiles) {
      const int m0 = (tile / nN) * 128, n0 = (tile % nN) * 128;
      gemm_main<4, 4>(xb, D, wt, D, D, m0, n0, lds, acc);
#pragma unroll
      for (int mt = 0; mt < 4; ++mt)
#pragma unroll
        for (int nt = 0; nt < 4; ++nt)
#pragma unroll
          for (int i = 0; i < 4; ++i) {
            int row = m0 + wr * 64 + mt * 16 + fq * 4 + i, col = n0 + wc * 64 + nt * 16 + fr;
            proj[(size_t)row * DIN + col] = f2bf(acc[mt][nt][i]);
          }
    } else {
      const int e = tile - ntiles;
      const int ll = e / 128, r = e % 128;
      const int m0 = (r / 8) * 128, n0 = (r % 8) * 128;
      const bf16_t* memb = (const bf16_t*)(ws + B_MEMB);
      const bf16_t* wm = (const bf16_t*)(ws + W_MEMKV) + (size_t)ll * D * D;
      gemm_main<4, 4>(memb, D, wm, D, D, m0, n0, lds, acc);
      bf16_t* kb = (bf16_t*)(ws + B_KB);
      bf16_t* vtb = (bf16_t*)(ws + B_VTB);
#pragma unroll
      for (int mt = 0; mt < 4; ++mt)
#pragma unroll
        for (int nt = 0; nt < 4; ++nt)
#pragma unroll
          for (int i = 0; i < 4; ++i) {
            int row = m0 + wr * 64 + mt * 16 + fq * 4 + i, col = n0 + wc * 64 + nt * 16 + fr;
            int b = row >> 8, key = row & 255;
            float v = acc[mt][nt][i];
            if (col < 512) {
              p.out[O_MKP + ((size_t)(ll * 8 + b) * 256 + key) * 512 + col] = v;
              kb[((size_t)(ll * 8 + b) * 256 + key) * 512 + col] = f2bf(v);
            } else {
              int c2 = col - 512, h = c2 >> 7, d = c2 & 127;
              p.out[O_MVP + ((size_t)(ll * 8 + b) * 256 + key) * 512 + c2] = v;
              vtb[(((size_t)(ll * 8 + b) * 4 + h) * 128 + d) * 256 + key] = f2bf(v);
            }
          }
    }
  }
}

__device__ __forceinline__ float prw_prev(const Params& p, const bf16_t* proj, int l, int tok, int seq, int t, int c) {
  if (t > 0) return bf2f(proj[(size_t)(tok - 1) * DIN + c]);
  if (seq >= 8) return p.in[I_SSHIFT][((size_t)l * 128 + (seq - 8)) * RWC + c];
  return 0.f;
}
__device__ __forceinline__ float plx_back(const Params& p, const bf16_t* proj, int l, int tok, int seq, int t, int j, int ch) {
  if (t - j >= 0) return bf2f(proj[(size_t)(tok - j) * DIN + C_LX + ch]);
  if (seq >= 8) return p.in[I_SCONV][(((size_t)l * 128 + (seq - 8)) * 3 + (3 + t - j)) * DLRU + ch];
  return 0.f;
}

__device__ void phase_prep(const Params& p, int l, char* lds) {
  const int TX = tid_();
  char* ws = p.ws;
  const bf16_t* proj = (const bf16_t*)(ws + B_PROJ);
  bf16_t* L = (bf16_t*)(ws + B_LBUF);
  bf16_t* XC = (bf16_t*)(ws + B_ALRU);
  float* ubuf = (float*)(ws + B_UBUF);
  bf16_t* vmid = (bf16_t*)(ws + B_VMID);
  float* xsv = (float*)lds;
  const float* mu = p.in[I_MU] + (size_t)l * RWC;
  const float* cw = p.in[I_CONVW] + (size_t)l * 4 * DLRU;
  const float* cb = p.in[I_CONVB] + (size_t)l * DLRU;
  const int tid = TX;
  for (int item = blockIdx.x; item < MT / 8; item += gridDim.x) {
    const int tokb = item * 8;
    for (int tk = 0; tk < 8; ++tk) {
      const int tok = tokb + tk;
      int seq, t, T;
      tok_info(tok, seq, t, T);
      const bf16_t* pr = proj + (size_t)tok * DIN;
      {
        int c = 2304 + tid;
        float pc = bf2f(pr[c]);
        float pp = prw_prev(p, proj, l, tok, seq, t, c);
        float xs = pc + (pp - pc) * mu[c];
        float o = (tid < 64) ? tanhf(xs) : (tid < 128 ? xs : sigmoidf_(xs));
        L[(size_t)tok * 256 + tid] = f2bf(o);
      }
      if (l > 0) {
        for (int c = tid; c < DRW; c += 256) {
          float pc = bf2f(pr[1536 + c]);
          float pp = prw_prev(p, proj, l, tok, seq, t, 1536 + c);
          xsv[tk * DRW + c] = pc + (pp - pc) * mu[1536 + c];
        }
      }
      for (int ch = tid; ch < DLRU; ch += 256) {
        float x0 = bf2f(pr[C_LX + ch]);
        float x1 = plx_back(p, proj, l, tok, seq, t, 1, ch);
        float x2 = plx_back(p, proj, l, tok, seq, t, 2, ch);
        float x3 = plx_back(p, proj, l, tok, seq, t, 3, ch);
        float xc = cb[ch] + cw[3 * DLRU + ch] * x0 + cw[2 * DLRU + ch] * x1 + cw[1 * DLRU + ch] * x2 + cw[ch] * x3;
        ubuf[(size_t)tok * DLRU + ch] = xc;
        XC[(size_t)tok * DLRU + ch] = f2bf(xc);
        if (t >= T - 3) {
          size_t o = (seq < 8) ? O_CONVP + (((size_t)l * 8 + seq) * 3 + (t - (T - 3))) * DLRU
                               : O_CONVS + (((size_t)l * 128 + (seq - 8)) * 3 + (t - (T - 3))) * DLRU;
          p.out[o + ch] = x0;
        }
      }
      if (t == T - 1) {
        size_t o = (seq < 8) ? O_SHP + ((size_t)l * 8 + seq) * RWC : O_SHS + ((size_t)l * 128 + (seq - 8)) * RWC;
        for (int c = tid; c < RWC; c += 256) p.out[o + c] = bf2f(pr[c]);
      }
    }
    if (l > 0) {
      __syncthreads();
      const float* v1 = p.in[I_V1] + (size_t)(l - 1) * DRW * 32;
      const int tk = tid >> 5, j = tid & 31;
      float s = 0.f;
      const float* xr = xsv + tk * DRW;
#pragma unroll 8
      for (int i = 0; i < DRW; ++i) s += xr[i] * v1[i * 32 + j];
      vmid[(size_t)(tokb + tk) * 32 + j] = f2bf(s);
      __syncthreads();
    }
  }
}

__device__ void phase_lora(const Params& p, int l, char* lds) {
  const int TX = tid_();
  char* ws = p.ws;
  const bf16_t* proj = (const bf16_t*)(ws + B_PROJ);
  const bf16_t* L = (const bf16_t*)(ws + B_LBUF);
  const bf16_t* vmid = (const bf16_t*)(ws + B_VMID);
  const bf16_t* XC = (const bf16_t*)(ws + B_ALRU);
  const int lane = TX & 63, wv = TX >> 6, fr = lane & 15, fq = lane >> 4;
  const int NRW = (MT / 128) * 12;
  for (int item = blockIdx.x; item < 2 * NRW; item += gridDim.x) {
    if (item < NRW) {
      const int h = item % 12, tb = (item / 12) * 128 + wv * 32;
      const bf16_t* w2t = (const bf16_t*)(ws + W_W2T) + ((size_t)l * DRW + h * 64) * 64;
      const bf16_t* a2t = (const bf16_t*)(ws + W_A2T) + ((size_t)l * DRW + h * 64) * 64;
      const bf16_t* g2t = (const bf16_t*)(ws + W_G2T) + ((size_t)l * DRW + h * 64) * 128;
      bf16_t* gbuf = (bf16_t*)(ws + B_GBUF);
      {
        f32x4 ag[2][4];
#pragma unroll
        for (int a = 0; a < 2; ++a)
#pragma unroll
          for (int b = 0; b < 4; ++b) ag[a][b] = f32x4{0, 0, 0, 0};
#pragma unroll
        for (int ks = 0; ks < 4; ++ks) {
          bf16x8 af[2], bf_[4];
#pragma unroll
          for (int mt = 0; mt < 2; ++mt) af[mt] = *(const bf16x8*)(L + (size_t)(tb + mt * 16 + fr) * 256 + 128 + ks * 32 + fq * 8);
#pragma unroll
          for (int nt = 0; nt < 4; ++nt) bf_[nt] = *(const bf16x8*)(g2t + (size_t)(nt * 16 + fr) * 128 + ks * 32 + fq * 8);
#pragma unroll
          for (int mt = 0; mt < 2; ++mt)
#pragma unroll
            for (int nt = 0; nt < 4; ++nt) ag[mt][nt] = MFMA(af[mt], bf_[nt], ag[mt][nt]);
        }
#pragma unroll
        for (int mt = 0; mt < 2; ++mt)
#pragma unroll
          for (int nt = 0; nt < 4; ++nt)
#pragma unroll
            for (int i = 0; i < 4; ++i)
              gbuf[(size_t)(tb + mt * 16 + fq * 4 + i) * DRW + h * 64 + nt * 16 + fr] = f2bf(ag[mt][nt][i]);
      }
      f32x4 aw[2][4], aa[2][4], av[2][4];
#pragma unroll
      for (int a = 0; a < 2; ++a)
#pragma unroll
        for (int b = 0; b < 4; ++b) { aw[a][b] = f32x4{0, 0, 0, 0}; aa[a][b] = aw[a][b]; av[a][b] = aw[a][b]; }
#pragma unroll
      for (int ks = 0; ks < 2; ++ks) {
        bf16x8 af[2], bf_[4];
#pragma unroll
        for (int mt = 0; mt < 2; ++mt) af[mt] = *(const bf16x8*)(L + (size_t)(tb + mt * 16 + fr) * 256 + ks * 32 + fq * 8);
#pragma unroll
        for (int nt = 0; nt < 4; ++nt) bf_[nt] = *(const bf16x8*)(w2t + (size_t)(nt * 16 + fr) * 64 + ks * 32 + fq * 8);
#pragma unroll
        for (int mt = 0; mt < 2; ++mt)
#pragma unroll
          for (int nt = 0; nt < 4; ++nt) aw[mt][nt] = MFMA(af[mt], bf_[nt], aw[mt][nt]);
#pragma unroll
        for (int mt = 0; mt < 2; ++mt) af[mt] = *(const bf16x8*)(L + (size_t)(tb + mt * 16 + fr) * 256 + 64 + ks * 32 + fq * 8);
#pragma unroll
        for (int nt = 0; nt < 4; ++nt) bf_[nt] = *(const bf16x8*)(a2t + (size_t)(nt * 16 + fr) * 64 + ks * 32 + fq * 8);
#pragma unroll
        for (int mt = 0; mt < 2; ++mt)
#pragma unroll
          for (int nt = 0; nt < 4; ++nt) aa[mt][nt] = MFMA(af[mt], bf_[nt], aa[mt][nt]);
      }
      if (l > 0) {
        const bf16_t* v2t = (const bf16_t*)(ws + W_V2T) + ((size_t)(l - 1) * DRW + h * 64) * 32;
        bf16x8 af[2], bf_[4];
#pragma unroll
        for (int mt = 0; mt < 2; ++mt) af[mt] = *(const bf16x8*)(vmid + (size_t)(tb + mt * 16 + fr) * 32 + fq * 8);
#pragma unroll
        for (int nt = 0; nt < 4; ++nt) bf_[nt] = *(const bf16x8*)(v2t + (size_t)(nt * 16 + fr) * 32 + fq * 8);
#pragma unroll
        for (int mt = 0; mt < 2; ++mt)
#pragma unroll
          for (int nt = 0; nt < 4; ++nt) av[mt][nt] = MFMA(af[mt], bf_[nt], av[mt][nt]);
      }
      const float* mu = p.in[I_MU] + (size_t)l * RWC;
      float mur[4], muk[4], muv[4], w0[4], a0[4], v0[4], kkp[4], kap[4], rkp[4];
#pragma unroll
      for (int nt = 0; nt < 4; ++nt) {
        int c = h * 64 + nt * 16 + fr;
        mur[nt] = mu[c]; muk[nt] = mu[768 + c]; muv[nt] = mu[1536 + c];
        w0[nt] = p.in[I_W0][(size_t)l * DRW + c];
        a0[nt] = p.in[I_A0][(size_t)l * DRW + c];
        v0[nt] = (l > 0) ? p.in[I_V0][(size_t)(l - 1) * DRW + c] : 0.f;
        kkp[nt] = p.in[I_KK][(size_t)l * DRW + c];
        kap[nt] = p.in[I_KA][(size_t)l * DRW + c];
        rkp[nt] = p.in[I_RK][(size_t)l * DRW + c];
      }
      bf16_t* vfirst = (bf16_t*)(ws + B_VFIRST);
      float* cbuf = (float*)(ws + B_CBUF);
      char* scan = ws + B_SCAN;
#pragma unroll
      for (int mt = 0; mt < 2; ++mt)
#pragma unroll
        for (int i = 0; i < 4; ++i) {
          const int tok = tb + mt * 16 + fq * 4 + i;
          int seq, t, T;
          tok_info(tok, seq, t, T);
          const bf16_t* pr = proj + (size_t)tok * DIN;
          float rr[4], kx[4], vv[4], aval[4], dec[4], kkr[4], kmod[4];
          float ss = 0.f, s1 = 0.f, s2 = 0.f, s3 = 0.f;
#pragma unroll
          for (int nt = 0; nt < 4; ++nt) {
            const int cc = nt * 16 + fr, c = h * 64 + cc;
            float pc, pp;
            pc = bf2f(pr[c]); pp = prw_prev(p, proj, l, tok, seq, t, c);
            rr[nt] = pc + (pp - pc) * mur[nt];
            pc = bf2f(pr[768 + c]); pp = prw_prev(p, proj, l, tok, seq, t, 768 + c);
            kx[nt] = pc + (pp - pc) * muk[nt];
            pc = bf2f(pr[1536 + c]); pp = prw_prev(p, proj, l, tok, seq, t, 1536 + c);
            float vx = pc + (pp - pc) * muv[nt];
            float wraw = -softplusf_(-(w0[nt] + aw[mt][nt][i])) - 0.5f;
            dec[nt] = __expf(-__expf(wraw));
            aval[nt] = sigmoidf_(a0[nt] + aa[mt][nt][i]);
            if (l > 0) {
              float vf = bf2f(vfirst[(size_t)tok * DRW + c]);
              vv[nt] = vx + (vf - vx) * sigmoidf_(v0[nt] + av[mt][nt][i]);
            } else {
              vfirst[(size_t)tok * DRW + c] = f2bf(vx);
              vv[nt] = vx;
            }
            kkr[nt] = kx[nt] * kkp[nt];
            kmod[nt] = kx[nt] * (1.f + (aval[nt] - 1.f) * kap[nt]);
            ss += kkr[nt] * kkr[nt];
            s1 += kkr[nt] * aval[nt] * rr[nt];
            s2 += kmod[nt] * rr[nt];
            s3 += rr[nt] * kmod[nt] * rkp[nt];
          }
          ss = red16_sum(ss); s1 = red16_sum(s1); s2 = red16_sum(s2); s3 = red16_sum(s3);
          const float inv = 1.f / fmaxf(sqrtf(ss), 1e-12f);
          char* so = scan + ((size_t)tok * 12 + h) * 896;
#pragma unroll
          for (int nt = 0; nt < 4; ++nt) {
            const int cc = nt * 16 + fr;
            float kkn = kkr[nt] * inv;
            ((float*)so)[cc] = dec[nt];
            ((bf16_t*)(so + 256))[cc] = f2bf(dec[nt] * rr[nt]);
            ((bf16_t*)(so + 384))[cc] = f2bf(-kkn);
            ((bf16_t*)(so + 512))[cc] = f2bf(kkn * aval[nt]);
            ((bf16_t*)(so + 640))[cc] = f2bf(kmod[nt]);
            ((bf16_t*)(so + 768))[cc] = f2bf(vv[nt]);
          }
          if (fr == 0) {
            float4 cv = make_float4(s1 * inv, s2, s3, 0.f);
            *(float4*)(cbuf + ((size_t)tok * 12 + h) * 4) = cv;
          }
        }
    } else {
      const int it = item - NRW;
      const int nb = it % 12, tb = (it / 12) * 128 + wv * 32;
      const bf16_t* rgt = (const bf16_t*)(ws + W_RGT) + ((size_t)l * 12 + nb) * 4096;
      const bf16_t* igt = (const bf16_t*)(ws + W_IGT) + ((size_t)l * 12 + nb) * 4096;
      f32x4 ar[2][4], ai[2][4];
#pragma unroll
      for (int a = 0; a < 2; ++a)
#pragma unroll
        for (int b = 0; b < 4; ++b) { ar[a][b] = f32x4{0, 0, 0, 0}; ai[a][b] = ar[a][b]; }
#pragma unroll
      for (int ks = 0; ks < 2; ++ks) {
        bf16x8 af[2], b1[4], b2[4];
#pragma unroll
        for (int mt = 0; mt < 2; ++mt) af[mt] = *(const bf16x8*)(XC + (size_t)(tb + mt * 16 + fr) * DLRU + nb * 64 + ks * 32 + fq * 8);
#pragma unroll
        for (int nt = 0; nt < 4; ++nt) {
          b1[nt] = *(const bf16x8*)(rgt + (size_t)(nt * 16 + fr) * 64 + ks * 32 + fq * 8);
          b2[nt] = *(const bf16x8*)(igt + (size_t)(nt * 16 + fr) * 64 + ks * 32 + fq * 8);
        }
#pragma unroll
        for (int mt = 0; mt < 2; ++mt)
#pragma unroll
          for (int nt = 0; nt < 4; ++nt) {
            ar[mt][nt] = MFMA(af[mt], b1[nt], ar[mt][nt]);
            ai[mt][nt] = MFMA(af[mt], b2[nt], ai[mt][nt]);
          }
      }
      float* abuf = (float*)(ws + B_ABUF);
      float* ubuf = (float*)(ws + B_UBUF);
#pragma unroll
      for (int nt = 0; nt < 4; ++nt) {
        const int c = nb * 64 + nt * 16 + fr;
        const float brg = p.in[I_BRG][(size_t)l * DLRU + c], big = p.in[I_BIG][(size_t)l * DLRU + c];
        const float sp = softplusf_(-p.in[I_LAMBDA][(size_t)l * DLRU + c]);
#pragma unroll
        for (int mt = 0; mt < 2; ++mt)
#pragma unroll
          for (int i = 0; i < 4; ++i) {
            const int tok = tb + mt * 16 + fq * 4 + i;
            float rg = sigmoidf_(ar[mt][nt][i] + brg), ig = sigmoidf_(ai[mt][nt][i] + big);
            float la = -8.f * rg * sp;
            float a = __expf(la);
            float xc = ubuf[(size_t)tok * DLRU + c];
            float u = sqrtf(fmaxf(-expm1f(2.f * la), 0.f)) * (ig * xc);
            abuf[(size_t)tok * DLRU + c] = a;
            ubuf[(size_t)tok * DLRU + c] = u;
          }
      }
    }
  }
}

constexpr int STEP_B = 1360;
__device__ void wkv_scan_item(const Params& p, int l, int seq, int h, int qt, char* lds) {
  const int TX = tid_();
  char* ws = p.ws;
  const int tid = TX, lane = tid & 63, wv = tid >> 6;
  const int kq = lane & 15, rl = lane >> 4;
  const int row = qt * 16 + wv * 4 + rl;
  const int T = (seq < 8) ? 2048 : 4;
  const int tok0 = seq_tok0(seq);
  const char* scan = ws + B_SCAN;
  const float* cbuf = (const float*)(ws + B_CBUF);
  float* ybuf = (float*)(ws + B_YBUF);
  float S0 = 0.f, S1 = 0.f, S2 = 0.f, S3 = 0.f;
  if (seq >= 8) {
    const float4 s = *(const float4*)(p.in[I_SWKV] + ((((size_t)l * 128 + (seq - 8)) * 12 + h) * 64 + row) * 64 + kq * 4);
    S0 = s.x; S1 = s.y; S2 = s.z; S3 = s.w;
  }
  const int nch = (T + 15) >> 4;
  uint4 st[4];
  float4 cst;
  auto stage_load = [&](int c) {
    const int ns = min(16, T - c * 16);
#pragma unroll
    for (int j = 0; j < 4; ++j) {
      const int u = tid + 256 * j;
      if (u < ns * 56) {
        const int s = u / 56, q = u % 56;
        st[j] = *(const uint4*)(scan + ((size_t)(tok0 + c * 16 + s) * 12 + h) * 896 + q * 16);
      }
    }
    if (tid >= 128 && tid < 128 + ns) cst = *(const float4*)(cbuf + ((size_t)(tok0 + c * 16 + (tid - 128)) * 12 + h) * 4);
  };
  auto stage_write = [&](int c, char* buf) {
    const int ns = min(16, T - c * 16);
#pragma unroll
    for (int j = 0; j < 4; ++j) {
      const int u = tid + 256 * j;
      if (u < ns * 56) {
        const int s = u / 56, q = u % 56;
        char* base = buf + s * STEP_B;
        if (q < 16) {
          *(uint4*)(base + q * 16) = st[j];
        } else {
          float4 lo, hi;
          lo.x = __uint_as_float(st[j].x << 16); lo.y = __uint_as_float(st[j].x & 0xffff0000u);
          lo.z = __uint_as_float(st[j].y << 16); lo.w = __uint_as_float(st[j].y & 0xffff0000u);
          hi.x = __uint_as_float(st[j].z << 16); hi.y = __uint_as_float(st[j].z & 0xffff0000u);
          hi.z = __uint_as_float(st[j].w << 16); hi.w = __uint_as_float(st[j].w & 0xffff0000u);
          int off = -1;
          if (q < 48) off = 256 + (q - 16) * 32;
          else { int r8 = q - 48 - 2 * qt; if (r8 == 0 || r8 == 1) off = 1280 + r8 * 32; }
          if (off >= 0) { *(float4*)(base + off) = lo; *(float4*)(base + off + 16) = hi; }
        }
      }
    }
    if (tid >= 128 && tid < 128 + ns) *(float2*)(buf + (tid - 128) * STEP_B + 1344) = make_float2(cst.x, cst.y);
  };
  __syncthreads();
  stage_load(0);
  stage_write(0, lds);
  __syncthreads();
  for (int c = 0; c < nch; ++c) {
    const int ns = min(16, T - c * 16);
    if (c + 1 < nch) stage_load(c + 1);
    const char* buf = lds + (c & 1) * (16 * STEP_B);
#pragma unroll 2
    for (int s = 0; s < ns; ++s) {
      const char* b = buf + s * STEP_B;
      const float4 w4 = *(const float4*)(b + kq * 16);
      const float4 r4 = *(const float4*)(b + 256 + kq * 16);
      const float4 n4 = *(const float4*)(b + 512 + kq * 16);
      const float4 b4 = *(const float4*)(b + 768 + kq * 16);
      const float4 k4 = *(const float4*)(b + 1024 + kq * 16);
      const float v = *(const float*)(b + 1280 + (wv * 4 + rl) * 4);
      const float2 cc = *(const float2*)(b + 1344);
      float sa = S0 * n4.x + S1 * n4.y + S2 * n4.z + S3 * n4.w;
      float z = S0 * r4.x + S1 * r4.y + S2 * r4.z + S3 * r4.w;
      sa = red16_sum(sa);
      z = red16_sum(z);
      const float y = z + sa * cc.x + v * cc.y;
      S0 = S0 * w4.x + (sa * b4.x + v * k4.x);
      S1 = S1 * w4.y + (sa * b4.y + v * k4.y);
      S2 = S2 * w4.z + (sa * b4.z + v * k4.z);
      S3 = S3 * w4.w + (sa * b4.w + v * k4.w);
      if (kq == 0) ybuf[(size_t)(tok0 + c * 16 + s) * DRW + h * 64 + row] = y;
    }
    if (c + 1 < nch) stage_write(c + 1, lds + ((c + 1) & 1) * (16 * STEP_B));
    __syncthreads();
  }
  const size_t o = (seq < 8) ? O_WKVP + ((((size_t)l * 8 + seq) * 12 + h) * 64 + row) * 64
                             : O_WKVS + ((((size_t)l * 128 + (seq - 8)) * 12 + h) * 64 + row) * 64;
  *(float4*)(p.out + o + kq * 4) = make_float4(S0, S1, S2, S3);
}

__device__ void lru_scan_item(const Params& p, int l, int seq, int cg3) {
  const int TX = tid_();
  char* ws = p.ws;
  const int ch = cg3 * 256 + TX;
  const int T = (seq < 8) ? 2048 : 4;
  const int tok0 = seq_tok0(seq);
  const float* abuf = (const float*)(ws + B_ABUF);
  float* ubuf = (float*)(ws + B_UBUF);
  float h = (seq >= 8) ? p.in[I_SH][((size_t)l * 128 + (seq - 8)) * DLRU + ch] : 0.f;
  for (int t0 = 0; t0 < T; t0 += 4) {
    float a[4], u[4];
#pragma unroll
    for (int j = 0; j < 4; ++j) {
      a[j] = abuf[(size_t)(tok0 + t0 + j) * DLRU + ch];
      u[j] = ubuf[(size_t)(tok0 + t0 + j) * DLRU + ch];
    }
#pragma unroll
    for (int j = 0; j < 4; ++j) {
      h = a[j] * h + u[j];
      ubuf[(size_t)(tok0 + t0 + j) * DLRU + ch] = h;
    }
  }
  const size_t o = (seq < 8) ? O_HP + ((size_t)l * 8 + seq) * DLRU : O_HS + ((size_t)l * 128 + (seq - 8)) * DLRU;
  p.out[o + ch] = h;
}

__device__ void attn_prompt_item(const Params& p, int l, int b, int h, int qt, char* lds) {
  const int TX = tid_();
  char* ws = p.ws;
  const int lane = TX & 63, wv = TX >> 6, fr = lane & 15, fq = lane >> 4;
  const bf16_t* proj = (const bf16_t*)(ws + B_PROJ);
  const bf16_t* kb = (const bf16_t*)(ws + B_KB) + ((size_t)(l * 8 + b) * 256) * 512 + h * 128;
  const bf16_t* vt = (const bf16_t*)(ws + B_VTB) + (((size_t)(l * 8 + b) * 4 + h) * 128) * 256;
  bf16_t* axa = (bf16_t*)(ws + B_AXA);
  const int tok0 = b * 2048 + qt * 64 + wv * 16;
  bf16x8 aq[4];
#pragma unroll
  for (int ks = 0; ks < 4; ++ks) aq[ks] = *(const bf16x8*)(proj + (size_t)(tok0 + fr) * DIN + C_Q + h * 128 + ks * 32 + fq * 8);
  f32x4 s[16];
#pragma unroll
  for (int nt = 0; nt < 16; ++nt) {
    s[nt] = f32x4{0, 0, 0, 0};
#pragma unroll
    for (int ks = 0; ks < 4; ++ks) {
      bf16x8 bk = *(const bf16x8*)(kb + (size_t)(nt * 16 + fr) * 512 + ks * 32 + fq * 8);
      s[nt] = MFMA(aq[ks], bk, s[nt]);
    }
  }
  const float scale = 0.08838834764831845f;
  float rs[4];
  char* pl = lds + wv * 8192;
  __syncthreads();
#pragma unroll
  for (int i = 0; i < 4; ++i) {
    float m = s[0][i];
#pragma unroll
    for (int nt = 1; nt < 16; ++nt) m = fmaxf(m, s[nt][i]);
    m = red16_max(m);
    float sum = 0.f;
#pragma unroll
    for (int nt = 0; nt < 16; ++nt) {
      float e = __expf((s[nt][i] - m) * scale);
      sum += e;
      const int key = nt * 16 + fr, rr = fq * 4 + i;
      *(bf16_t*)(pl + (key >> 5) * 1024 + swz(rr, (key & 31) * 2)) = f2bf(e);
    }
    rs[i] = red16_sum(sum);
  }
  __syncthreads();
  f32x4 o[8];
#pragma unroll
  for (int nt = 0; nt < 8; ++nt) o[nt] = f32x4{0, 0, 0, 0};
  const int fo = swz(fr, fq * 16);
#pragma unroll
  for (int ks = 0; ks < 8; ++ks) {
    bf16x8 ap = *(const bf16x8*)(pl + ks * 1024 + fo);
#pragma unroll
    for (int nt = 0; nt < 8; ++nt) {
      bf16x8 bv = *(const bf16x8*)(vt + (size_t)(nt * 16 + fr) * 256 + ks * 32 + fq * 8);
      o[nt] = MFMA(ap, bv, o[nt]);
    }
  }
#pragma unroll
  for (int nt = 0; nt < 8; ++nt)
#pragma unroll
    for (int i = 0; i < 4; ++i)
      axa[(size_t)(tok0 + fq * 4 + i) * DXA + h * 128 + nt * 16 + fr] = f2bf(o[nt][i] / rs[i]);
  __syncthreads();
}

__device__ void attn_sample_item(const Params& p, int l, int b, int h, char* lds) {
  const int TX = tid_();
  char* ws = p.ws;
  const int tid = TX, lane = tid & 63, wv = tid >> 6;
  const bf16_t* proj = (const bf16_t*)(ws + B_PROJ);
  bf16_t* axa = (bf16_t*)(ws + B_AXA);
  const int tok0 = MP + b * 4;
  float* q = (float*)lds;
  float* pr = q + 512;
  float* red = pr + 1024;
  float* part = red + 32;
  __syncthreads();
  for (int i = tid; i < 512; i += 256) q[i] = bf2f(proj[(size_t)(tok0 + (i >> 7)) * DIN + C_Q + h * 128 + (i & 127)]);
  __syncthreads();
  const float* kc = p.in[I_CK] + (((size_t)l * 128 + b) * 256 + tid) * 512 + h * 128;
  float s0 = 0.f, s1 = 0.f, s2 = 0.f, s3 = 0.f;
#pragma unroll 4
  for (int d = 0; d < 128; d += 4) {
    const float4 kv = *(const float4*)(kc + d);
    const float4 q0 = *(const float4*)(q + d), q1 = *(const float4*)(q + 128 + d), q2 = *(const float4*)(q + 256 + d),
                 q3 = *(const float4*)(q + 384 + d);
    s0 += kv.x * q0.x + kv.y * q0.y + kv.z * q0.z + kv.w * q0.w;
    s1 += kv.x * q1.x + kv.y * q1.y + kv.z * q1.z + kv.w * q1.w;
    s2 += kv.x * q2.x + kv.y * q2.y + kv.z * q2.z + kv.w * q2.w;
    s3 += kv.x * q3.x + kv.y * q3.y + kv.z * q3.z + kv.w * q3.w;
  }
  const float scale = 0.08838834764831845f;
  s0 *= scale; s1 *= scale; s2 *= scale; s3 *= scale;
  float m0 = s0, m1 = s1, m2 = s2, m3 = s3;
#pragma unroll
  for (int m = 1; m < 64; m <<= 1) {
    m0 = fmaxf(m0, __shfl_xor(m0, m, 64)); m1 = fmaxf(m1, __shfl_xor(m1, m, 64));
    m2 = fmaxf(m2, __shfl_xor(m2, m, 64)); m3 = fmaxf(m3, __shfl_xor(m3, m, 64));
  }
  if (lane == 0) { red[wv * 4 + 0] = m0; red[wv * 4 + 1] = m1; red[wv * 4 + 2] = m2; red[wv * 4 + 3] = m3; }
  __syncthreads();
  m0 = fmaxf(fmaxf(red[0], red[4]), fmaxf(red[8], red[12]));
  m1 = fmaxf(fmaxf(red[1], red[5]), fmaxf(red[9], red[13]));
  m2 = fmaxf(fmaxf(red[2], red[6]), fmaxf(red[10], red[14]));
  m3 = fmaxf(fmaxf(red[3], red[7]), fmaxf(red[11], red[15]));
  const float e0 = __expf(s0 - m0), e1 = __expf(s1 - m1), e2 = __expf(s2 - m2), e3 = __expf(s3 - m3);
  pr[tid] = e0; pr[256 + tid] = e1; pr[512 + tid] = e2; pr[768 + tid] = e3;
  float t0 = wave_sum(e0), t1 = wave_sum(e1), t2 = wave_sum(e2), t3 = wave_sum(e3);
  if (lane == 0) { red[16 + wv * 4 + 0] = t0; red[16 + wv * 4 + 1] = t1; red[16 + wv * 4 + 2] = t2; red[16 + wv * 4 + 3] = t3; }
  __syncthreads();
  const float z0 = red[16] + red[20] + red[24] + red[28], z1 = red[17] + red[21] + red[25] + red[29];
  const float z2 = red[18] + red[22] + red[26] + red[30], z3 = red[19] + red[23] + red[27] + red[31];
  const int d = tid & 127, half = tid >> 7;
  const float* vc = p.in[I_CV] + (((size_t)l * 128 + b) * 256 + half * 128) * 512 + h * 128 + d;
  float o0 = 0.f, o1 = 0.f, o2 = 0.f, o3 = 0.f;
#pragma unroll 8
  for (int k = 0; k < 128; ++k) {
    const float vv = vc[(size_t)k * 512];
    const int key = half * 128 + k;
    o0 += pr[key] * vv; o1 += pr[256 + key] * vv; o2 += pr[512 + key] * vv; o3 += pr[768 + key] * vv;
  }
  if (half == 1) { part[d] = o0; part[128 + d] = o1; part[256 + d] = o2; part[384 + d] = o3; }
  __syncthreads();
  if (half == 0) {
    o0 += part[d]; o1 += part[128 + d]; o2 += part[256 + d]; o3 += part[384 + d];
    axa[(size_t)(tok0 + 0) * DXA + h * 128 + d] = f2bf(o0 / z0);
    axa[(size_t)(tok0 + 1) * DXA + h * 128 + d] = f2bf(o1 / z1);
    axa[(size_t)(tok0 + 2) * DXA + h * 128 + d] = f2bf(o2 / z2);
    axa[(size_t)(tok0 + 3) * DXA + h * 128 + d] = f2bf(o3 / z3);
  }
  __syncthreads();
}

__device__ void phase_mix(const Params& p, int l, char* lds, int* s_item) {
  const int TX = tid_();
  int* cnt = (int*)(p.ws + B_CNT) + l;
  constexpr int N_WKVP = 96 * 4, N_LRUP = 24, N_ATTP = 1024, N_WKVS = 128 * 12 * 4, N_LRUS = 384, N_ATTS = 512;
  constexpr int E1 = N_WKVP, E2 = E1 + N_LRUP, E3 = E2 + N_ATTP, E4 = E3 + N_WKVS, E5 = E4 + N_LRUS, E6 = E5 + N_ATTS;
  for (;;) {
    __syncthreads();
    if (TX == 0) *s_item = atomicAdd(cnt, 1);
    __syncthreads();
    const int it = *s_item;
    if (it >= E6) break;
    if (it < E1) {
      const int qt = it & 3, bh = it >> 2;
      wkv_scan_item(p, l, bh / 12, bh % 12, qt, lds);
    } else if (it < E2) {
      const int j = it - E1;
      lru_scan_item(p, l, j / 3, j % 3);
    } else if (it < E3) {
      const int j = it - E2;
      attn_prompt_item(p, l, j >> 7, (j >> 5) & 3, j & 31, lds);
    } else if (it < E4) {
      const int j = it - E3;
      const int qt = j & 3, bh = j >> 2;
      wkv_scan_item(p, l, 8 + bh / 12, bh % 12, qt, lds);
    } else if (it < E5) {
      const int j = it - E4;
      lru_scan_item(p, l, 8 + j / 3, j % 3);
    } else {
      const int j = it - E5;
      attn_sample_item(p, l, j >> 2, j & 3, lds);
    }
  }
}

__device__ void phase_post(const Params& p, int l) {
  const int TX = tid_();
  char* ws = p.ws;
  const int tid = TX, lane = tid & 63, wv = tid >> 6;
  const float* ybuf = (const float*)(ws + B_YBUF);
  const float* cbuf = (const float*)(ws + B_CBUF);
  const bf16_t* gbuf = (const bf16_t*)(ws + B_GBUF);
  const char* scan = ws + B_SCAN;
  const float* hbuf = (const float*)(ws + B_UBUF);
  const bf16_t* proj = (const bf16_t*)(ws + B_PROJ);
  bf16_t* arw = (bf16_t*)(ws + B_ARW);
  bf16_t* alru = (bf16_t*)(ws + B_ALRU);
  const float* gng = p.in[I_GNG] + (size_t)l * DRW;
  const float* gnb = p.in[I_GNB] + (size_t)l * DRW;
  for (int tok = blockIdx.x; tok < MT; tok += gridDim.x) {
#pragma unroll
    for (int hh = 0; hh < 3; ++hh) {
      const int h = wv + hh * 4, c = h * 64 + lane;
      const float y = ybuf[(size_t)tok * DRW + c];
      const float mean = wave_sum(y) * (1.f / 64.f);
      const float d = y - mean;
      const float var = wave_sum(d * d) * (1.f / 64.f);
      const float yn = d * rsqrtf(var + 64e-5f) * gng[c] + gnb[c];
      const float c3 = cbuf[((size_t)tok * 12 + h) * 4 + 2];
      const float v = bf2f(((const bf16_t*)(scan + ((size_t)tok * 12 + h) * 896 + 768))[lane]);
      const float g = bf2f(gbuf[(size_t)tok * DRW + c]);
      arw[(size_t)tok * DRW + c] = f2bf((yn + c3 * v) * g);
    }
    for (int c = tid; c < DLRU; c += 256) {
      const float hv = hbuf[(size_t)tok * DLRU + c];
      const float x = bf2f(proj[(size_t)tok * DIN + C_LG + c]);
      const float ge = 0.5f * x * (1.f + tanhf(0.7978845608028654f * (x + 0.044715f * x * x * x)));
      alru[(size_t)tok * DLRU + c] = f2bf(hv * ge);
    }
  }
}

__device__ void phase_merge(const Params& p, int l, char* lds) {
  const int TX = tid_();
  char* ws = p.ws;
  const bf16_t* proj = (const bf16_t*)(ws + B_PROJ);
  bf16_t* mixin = (bf16_t*)(ws + B_MIXIN);
  const int lane = TX & 63, wv = TX >> 6, wr = wv >> 1, wc = wv & 1, fr = lane & 15, fq = lane >> 4;
  const int ntiles = (MT / 128) * 16;
  for (int tile = blockIdx.x; tile < ntiles; tile += gridDim.x) {
    const int m0 = (tile / 16) * 128, n0 = (tile % 16) * 64;
    f32x4 sum[4][2], acc[4][2];
    zero_acc(sum);
#pragma unroll 1
    for (int br = 0; br < 3; ++br) {
      zero_acc(acc);
      const bf16_t* A; const bf16_t* Bt; int K;
      if (br == 0) { A = (const bf16_t*)(ws + B_ARW); Bt = (const bf16_t*)(ws + W_RWOUT) + (size_t)l * D * DRW; K = DRW; }
      else if (br == 1) { A = (const bf16_t*)(ws + B_ALRU); Bt = (const bf16_t*)(ws + W_LRUOUT) + (size_t)l * D * DLRU; K = DLRU; }
      else { A = (const bf16_t*)(ws + B_AXA); Bt = (const bf16_t*)(ws + W_XAOUT) + (size_t)l * D * DXA; K = DXA; }
      gemm_main<4, 2>(A, K, Bt, K, K, m0, n0, lds, acc);
#pragma unroll
      for (int mt = 0; mt < 4; ++mt)
#pragma unroll
        for (int nt = 0; nt < 2; ++nt)
#pragma unroll
          for (int i = 0; i < 4; ++i) {
            int row = m0 + wr * 64 + mt * 16 + fq * 4 + i, col = n0 + wc * 32 + nt * 16 + fr;
            float g = sigmoidf_(bf2f(proj[(size_t)row * DIN + C_G + br * D + col]));
            sum[mt][nt][i] += g * acc[mt][nt][i];
          }
    }
#pragma unroll
    for (int mt = 0; mt < 4; ++mt)
#pragma unroll
      for (int nt = 0; nt < 2; ++nt)
#pragma unroll
        for (int i = 0; i < 4; ++i) {
          int row = m0 + wr * 64 + mt * 16 + fq * 4 + i, col = n0 + wc * 32 + nt * 16 + fr;
          mixin[(size_t)row * D + col] = f2bf(sum[mt][nt][i]);
        }
  }
}

__device__ void phase_resid_gemm(const Params& p, const bf16_t* A, const bf16_t* Bt, int K, char* lds) {
  const int TX = tid_();
  char* ws = p.ws;
  const float* xf = (const float*)(ws + B_XF);
  float* t = p.out + O_Y;
  const int lane = TX & 63, wv = TX >> 6, wr = wv >> 1, wc = wv & 1, fr = lane & 15, fq = lane >> 4;
  const int ntiles = (MT / 128) * 8;
  for (int tile = blockIdx.x; tile < ntiles; tile += gridDim.x) {
    const int m0 = (tile / 8) * 128, n0 = (tile % 8) * 128;
    f32x4 acc[4][4];
    zero_acc(acc);
    gemm_main<4, 4>(A, K, Bt, K, K, m0, n0, lds, acc);
#pragma unroll
    for (int mt = 0; mt < 4; ++mt)
#pragma unroll
      for (int nt = 0; nt < 4; ++nt)
#pragma unroll
        for (int i = 0; i < 4; ++i) {
          int row = m0 + wr * 64 + mt * 16 + fq * 4 + i, col = n0 + wc * 64 + nt * 16 + fr;
          t[(size_t)row * D + col] = ALPHA * xf[(size_t)row * D + col] + acc[mt][nt][i];
        }
  }
}

__device__ void phase_ln(const Params& p, const float* g, const float* bta, bool final_out) {
  const int TX = tid_();
  char* ws = p.ws;
  const int lane = TX & 63, wv = TX >> 6;
  float* t = p.out + O_Y;
  float* xf = (float*)(ws + B_XF);
  bf16_t* xb = (bf16_t*)(ws + B_XB);
  for (int r4 = blockIdx.x; r4 < MT / 4; r4 += gridDim.x) {
    const int row = r4 * 4 + wv;
    float4 v[4];
    float s = 0.f;
#pragma unroll
    for (int j = 0; j < 4; ++j) {
      v[j] = *(const float4*)(t + (size_t)row * D + j * 256 + lane * 4);
      s += v[j].x + v[j].y + v[j].z + v[j].w;
    }
    const float mean = wave_sum(s) * (1.f / 1024.f);
    float q = 0.f;
#pragma unroll
    for (int j = 0; j < 4; ++j) {
      v[j].x -= mean; v[j].y -= mean; v[j].z -= mean; v[j].w -= mean;
      q += v[j].x * v[j].x + v[j].y * v[j].y + v[j].z * v[j].z + v[j].w * v[j].w;
    }
    const float rstd = rsqrtf(wave_sum(q) * (1.f / 1024.f) + 1e-5f);
#pragma unroll
    for (int j = 0; j < 4; ++j) {
      const int c = j * 256 + lane * 4;
      const float4 gg = *(const float4*)(g + c), bb = *(const float4*)(bta + c);
      float4 o;
      o.x = v[j].x * rstd * gg.x + bb.x; o.y = v[j].y * rstd * gg.y + bb.y;
      o.z = v[j].z * rstd * gg.z + bb.z; o.w = v[j].w * rstd * gg.w + bb.w;
      if (final_out) {
        *(float4*)(t + (size_t)row * D + c) = o;
      } else {
        *(float4*)(xf + (size_t)row * D + c) = o;
        uint2 ob;
        ob.x = (unsigned)f2bf(o.x) | ((unsigned)f2bf(o.y) << 16);
        ob.y = (unsigned)f2bf(o.z) | ((unsigned)f2bf(o.w) << 16);
        *(uint2*)(xb + (size_t)row * D + c) = ob;
      }
    }
  }
}

__device__ void phase_ffn_in(const Params& p, int l, char* lds) {
  const int TX = tid_();
  char* ws = p.ws;
  const bf16_t* xb = (const bf16_t*)(ws + B_XB);
  const bf16_t* wt = (const bf16_t*)(ws + W_FFNIN) + (size_t)l * 2 * DFF * D;
  bf16_t* act = (bf16_t*)(ws + B_ACT);
  const int lane = TX & 63, wv = TX >> 6, wr = wv >> 1, wc = wv & 1, fr = lane & 15, fq = lane >> 4;
  const int nN = 2 * DFF / 128, ntiles = (MT / 128) * nN;
  for (int tile = blockIdx.x; tile < ntiles; tile += gridDim.x) {
    const int m0 = (tile / nN) * 128, n0 = (tile % nN) * 128;
    f32x4 acc[4][4];
    zero_acc(acc);
    gemm_main<4, 4>(xb, D, wt, D, D, m0, n0, lds, acc);
    const int jb = (n0 + wc * 64) / 2;
#pragma unroll
    for (int mt = 0; mt < 4; ++mt)
#pragma unroll
      for (int nt = 0; nt < 2; ++nt)
#pragma unroll
        for (int i = 0; i < 4; ++i) {
          int row = m0 + wr * 64 + mt * 16 + fq * 4 + i;
          float u = acc[mt][nt][i], gt = acc[mt][nt + 2][i];
          act[(size_t)row * DFF + jb + nt * 16 + fr] = f2bf(gt * sigmoidf_(gt) * u);
        }
  }
}

__global__ void __launch_bounds__(256, 2) fwd_megakernel(Params p) {
  cg::grid_group grid = cg::this_grid();
  __shared__ __attribute__((aligned(16))) char lds[LDS_BYTES];
  __shared__ int s_item;
  char* ws = p.ws;
  constexpr int NPH = 1 + NL * 11;
#pragma unroll 1
  for (int ph = 0; ph < NPH; ++ph) {
    int phl = ph;
    asm volatile("" : "+s"(phl));
    if (phl == 0) {
      phase_convert(p, lds);
    } else {
      const int l = (phl - 1) / 11, k = (phl - 1) % 11;
      switch (k) {
        case 0: phase_proj(p, l, lds); break;
        case 1: phase_prep(p, l, lds); break;
        case 2: phase_lora(p, l, lds); break;
        case 3: phase_mix(p, l, lds, &s_item); break;
        case 4: phase_post(p, l); break;
        case 5: phase_merge(p, l, lds); break;
        case 6: phase_resid_gemm(p, (const bf16_t*)(ws + B_MIXIN), (const bf16_t*)(ws + W_O) + (size_t)l * D * D, D, lds); break;
        case 7: phase_ln(p, p.in[I_LN1G] + (size_t)l * D, p.in[I_LN1B] + (size_t)l * D, false); break;
        case 8: phase_ffn_in(p, l, lds); break;
        case 9: phase_resid_gemm(p, (const bf16_t*)(ws + B_ACT), (const bf16_t*)(ws + W_FFNOUT) + (size_t)l * D * DFF, DFF, lds); break;
        default: phase_ln(p, p.in[I_LN2G] + (size_t)l * D, p.in[I_LN2B] + (size_t)l * D, l == NL - 1); break;
      }
    }
    if (ph + 1 < NPH) grid.sync();
  }
}

extern "C" void kernel_launch(void* const* d_in, const int* in_sizes, int n_in, void* d_out, int out_size, void* d_ws,
                              size_t ws_size, hipStream_t stream) {
  static int grid_blocks = 0;
  if (!grid_blocks) {
    int dev = 0, cus = 0, per_cu = 0;
    (void)hipGetDevice(&dev);
    (void)hipDeviceGetAttribute(&cus, hipDeviceAttributeMultiprocessorCount, dev);
    (void)hipOccupancyMaxActiveBlocksPerMultiprocessor(&per_cu, fwd_megakernel, 256, 0);
    if (per_cu > 2) per_cu = 2;
    if (per_cu < 1) per_cu = 1;
    grid_blocks = cus * per_cu;
  }
  if (ws_size < WS_NEED || n_in < 42) {
    fprintf(stderr, "workspace too small: %zu < %zu\n", ws_size, (size_t)WS_NEED);
    return;
  }
  Params p{};
  for (int i = 0; i < 42; ++i) p.in[i] = (const float*)d_in[i];
  p.out = (float*)d_out;
  p.ws = (char*)d_ws;
  void* args[] = {&p};
  hipError_t e = hipLaunchCooperativeKernel((void*)fwd_megakernel, dim3(grid_blocks), dim3(256), args, 0, stream);
  if (e != hipSuccess) fprintf(stderr, "cooperative launch failed: %s (grid %d)\n", hipGetErrorString(e), grid_blocks);
}
```

```cpp
#include <hip/hip_runtime.h>
#include <hip/hip_cooperative_groups.h>
#include <cstdio>
namespace cg = cooperative_groups;

typedef unsigned short bf16_t;
typedef __attribute__((ext_vector_type(8))) short bf16x8;
typedef __attribute__((ext_vector_type(4))) float f32x4;

constexpr int D = 1024, MP = 16384, MS = 512, MT = 16896, NL = 4;
constexpr int DIN = 7680, DRW = 768, DLRU = 768, DXA = 512, DFF = 2816, RWC = 2560;
constexpr int C_LX = 2560, C_LG = 3328, C_Q = 4096, C_G = 4608;
constexpr int NSEQ = 136;
constexpr float ALPHA = 1.681792830507429f;

constexpr size_t O_Y = 0;
constexpr size_t O_SHP = O_Y + (size_t)MT * D;
constexpr size_t O_WKVP = O_SHP + (size_t)NL * 8 * RWC;
constexpr size_t O_CONVP = O_WKVP + (size_t)NL * 8 * 12 * 64 * 64;
constexpr size_t O_HP = O_CONVP + (size_t)NL * 8 * 3 * DLRU;
constexpr size_t O_MKP = O_HP + (size_t)NL * 8 * DLRU;
constexpr size_t O_MVP = O_MKP + (size_t)NL * 8 * 256 * 512;
constexpr size_t O_SHS = O_MVP + (size_t)NL * 8 * 256 * 512;
constexpr size_t O_WKVS = O_SHS + (size_t)NL * 128 * RWC;
constexpr size_t O_CONVS = O_WKVS + (size_t)NL * 128 * 12 * 64 * 64;
constexpr size_t O_HS = O_CONVS + (size_t)NL * 128 * 3 * DLRU;
constexpr size_t O_END = O_HS + (size_t)NL * 128 * DLRU;

constexpr size_t al256(size_t x) { return (x + 255) & ~(size_t)255; }
constexpr size_t W_IN = 0;
constexpr size_t W_RWOUT = W_IN + al256((size_t)NL * DIN * D * 2);
constexpr size_t W_LRUOUT = W_RWOUT + al256((size_t)NL * D * DRW * 2);
constexpr size_t W_XAOUT = W_LRUOUT + al256((size_t)NL * D * DLRU * 2);
constexpr size_t W_O = W_XAOUT + al256((size_t)NL * D * DXA * 2);
constexpr size_t W_FFNIN = W_O + al256((size_t)NL * D * D * 2);
constexpr size_t W_FFNOUT = W_FFNIN + al256((size_t)NL * 2 * DFF * D * 2);
constexpr size_t W_MEMKV = W_FFNOUT + al256((size_t)NL * D * DFF * 2);
constexpr size_t W_W2T = W_MEMKV + al256((size_t)NL * D * D * 2);
constexpr size_t W_A2T = W_W2T + al256((size_t)NL * DRW * 64 * 2);
constexpr size_t W_G2T = W_A2T + al256((size_t)NL * DRW * 64 * 2);
constexpr size_t W_V2T = W_G2T + al256((size_t)NL * DRW * 128 * 2);
constexpr size_t W_RGT = W_V2T + al256((size_t)3 * DRW * 32 * 2);
constexpr size_t W_IGT = W_RGT + al256((size_t)NL * 12 * 64 * 64 * 2);
constexpr size_t B_XF = W_IGT + al256((size_t)NL * 12 * 64 * 64 * 2);
constexpr size_t B_XB = B_XF + al256((size_t)MT * D * 4);
constexpr size_t B_MEMB = B_XB + al256((size_t)MT * D * 2);
constexpr size_t B_KB = B_MEMB + al256((size_t)2048 * D * 2);
constexpr size_t B_VTB = B_KB + al256((size_t)NL * 8 * 256 * 512 * 2);
constexpr size_t B_VFIRST = B_VTB + al256((size_t)NL * 8 * 256 * 512 * 2);
constexpr size_t B_PROJ = B_VFIRST + al256((size_t)MT * DRW * 2);
constexpr size_t B_SCAN = B_PROJ + al256((size_t)MT * DIN * 2);
constexpr size_t SCAN_BYTES = (size_t)MT * 12 * 896;
constexpr size_t B_MIXIN = B_SCAN;
constexpr size_t B_ACT = B_SCAN + al256((size_t)MT * D * 2);
constexpr size_t B_CBUF = B_SCAN + al256(SCAN_BYTES);
constexpr size_t B_YBUF = B_CBUF + al256((size_t)MT * 12 * 16);
constexpr size_t B_GBUF = B_YBUF + al256((size_t)MT * DRW * 4);
constexpr size_t B_ABUF = B_GBUF + al256((size_t)MT * DRW * 2);
constexpr size_t B_UBUF = B_ABUF + al256((size_t)MT * DLRU * 4);
constexpr size_t B_LBUF = B_UBUF + al256((size_t)MT * DLRU * 4);
constexpr size_t B_VMID = B_LBUF + al256((size_t)MT * 256 * 2);
constexpr size_t B_ARW = B_VMID + al256((size_t)MT * 32 * 2);
constexpr size_t B_ALRU = B_ARW + al256((size_t)MT * DRW * 2);
constexpr size_t B_AXA = B_ALRU + al256((size_t)MT * DLRU * 2);
constexpr size_t B_CNT = B_AXA + al256((size_t)MT * DXA * 2);
constexpr size_t B_BAR = B_CNT + 256;
constexpr size_t BAR_BYTES = 16384;
constexpr size_t W_V1T = B_BAR + BAR_BYTES;
constexpr size_t WS_NEED = W_V1T + al256((size_t)3 * 32 * DRW * 2);
static_assert(al256((size_t)MT * D * 2) + (size_t)MT * DFF * 2 <= SCAN_BYTES, "alias overflow");

enum { I_XP = 0, I_XS, I_MEM, I_SSHIFT, I_SWKV, I_SCONV, I_SH, I_CK, I_CV, I_WIN, I_MU, I_W0, I_W2, I_A0, I_A2,
       I_G2, I_V0, I_V1, I_V2, I_KK, I_KA, I_RK, I_GNG, I_GNB, I_WRWOUT, I_CONVW, I_CONVB, I_WRG, I_BRG, I_WIG,
       I_BIG, I_LAMBDA, I_WLRUOUT, I_WMEMKV, I_WXAOUT, I_WO, I_LN1G, I_LN1B, I_WFFNIN, I_WFFNOUT, I_LN2G, I_LN2B };

struct Params {
  const float* in[42];
  float* out;
  char* ws;
};

constexpr int LDS_BYTES = 65536;

__device__ __forceinline__ bf16_t f2bf(float f) {
  unsigned u = __float_as_uint(f);
  u += 0x7fffu + ((u >> 16) & 1u);
  return (bf16_t)(u >> 16);
}
__device__ __forceinline__ float bf2f(bf16_t h) { return __uint_as_float(((unsigned)h) << 16); }
__device__ __forceinline__ float sigmoidf_(float x) { return 1.f / (1.f + __expf(-x)); }
__device__ __forceinline__ float softplusf_(float x) { return fmaxf(x, 0.f) + log1pf(__expf(-fabsf(x))); }
__device__ __forceinline__ int swz(int rr, int b) { int ob = rr * 64 + b; return ob ^ (((ob >> 9) & 1) << 5); }

__device__ __forceinline__ int tid_() {
  int t = threadIdx.x;
  asm volatile("" : "+v"(t));
  return t;
}
template <int CTRL>
__device__ __forceinline__ float dppf(float x) {
  return __int_as_float(__builtin_amdgcn_update_dpp(0, __float_as_int(x), CTRL, 0xf, 0xf, true));
}
__device__ __forceinline__ float red16_sum(float x) {
  x += dppf<0xB1>(x);
  x += dppf<0x4E>(x);
  x += dppf<0x141>(x);
  x += dppf<0x140>(x);
  return x;
}
__device__ __forceinline__ float red16_max(float x) {
  x = fmaxf(x, dppf<0xB1>(x));
  x = fmaxf(x, dppf<0x4E>(x));
  x = fmaxf(x, dppf<0x141>(x));
  x = fmaxf(x, dppf<0x140>(x));
  return x;
}
__device__ __forceinline__ float wave_sum(float x) {
#pragma unroll
  for (int m = 1; m < 64; m <<= 1) x += __shfl_xor(x, m, 64);
  return x;
}

__device__ __forceinline__ void tok_info(int tok, int& seq, int& t, int& T) {
  if (tok < MP) { seq = tok >> 11; t = tok & 2047; T = 2048; }
  else { int s = tok - MP; seq = 8 + (s >> 2); t = s & 3; T = 4; }
}
__device__ __forceinline__ int seq_tok0(int seq) { return seq < 8 ? seq * 2048 : MP + (seq - 8) * 4; }


#define XB_TMO      128
#define XB_XCNT(j)  (256  + 64 * (j))
#define XB_XSUB(j)  (1280 + 64 * (j))
#define XB_XGEN(j)  (2304 + 64 * (j))
#define XB_TOP      3328
#define XB_TOPGEN   3392
#define XCD_BAR_WORDS 3456
#define XB_SPIN_CAP (1u << 22)
#define LAS __attribute__((address_space(3)))
__device__ __forceinline__ unsigned xb_ld(unsigned* p) { return __hip_atomic_load(p, __ATOMIC_RELAXED, __HIP_MEMORY_SCOPE_AGENT); }
__device__ __forceinline__ unsigned xb_add(unsigned* p, unsigned v) { return __hip_atomic_fetch_add(p, v, __ATOMIC_RELAXED, __HIP_MEMORY_SCOPE_AGENT); }
__device__ __forceinline__ unsigned xb_xcc_id() { return (unsigned)__builtin_amdgcn_s_getreg((3 << 11) | 20) & 0xFu; }
#define XB_SPIN(cond, bar) do { unsigned _sp = 0; while (cond) { __builtin_amdgcn_s_sleep(1); \
    if ((++_sp & 255u) == 0u) { if (xb_ld(&(bar)[XB_TMO])) break; if (_sp > XB_SPIN_CAP) { atomicAdd(&(bar)[XB_TMO], 1u); break; } } } } while (0)
struct XcdBarrier { unsigned* bar; unsigned x; volatile LAS unsigned* st; };
__device__ __forceinline__ XcdBarrier xcd_barrier_post(unsigned* bar, volatile LAS unsigned* st) {
  XcdBarrier b; b.bar = bar; b.x = xb_xcc_id(); b.st = st;
  if (threadIdx.x == 0) (void)xb_add(&bar[XB_XCNT(b.x)], 1u);
  return b;
}
__device__ __forceinline__ void xcd_barrier_complete(unsigned* bar, unsigned x, unsigned& nloc, unsigned& nx) {
  const unsigned G = gridDim.x * gridDim.y * gridDim.z;
  unsigned sum, cnt, mine, sp = 0u;
  for (;;) {
    sum = 0u; cnt = 0u; mine = 0u;
#pragma unroll
    for (unsigned j = 0; j < 16; ++j) { const unsigned c = xb_ld(&bar[XB_XCNT(j)]); sum += c; cnt += (c > 0u) ? 1u : 0u; mine = (j == x) ? c : mine; }
    if (sum == G) break;
    __builtin_amdgcn_s_sleep(1);
    if ((++sp & 255u) == 0u) { if (xb_ld(&bar[XB_TMO])) break; if (sp > XB_SPIN_CAP) { atomicAdd(&bar[XB_TMO], 1u); break; } }
  }
  nloc = mine > 0u ? mine : 1u; nx = cnt > 0u ? cnt : 1u;
}
__device__ __forceinline__ void xcd_barrier(const XcdBarrier& b) {
  asm volatile("s_waitcnt vmcnt(0)" ::: "memory");
  __syncthreads();
  if (threadIdx.x == 0) {
    unsigned* bar = b.bar;
    __builtin_amdgcn_s_waitcnt(0);
    unsigned nloc = b.st[0], nx = b.st[1];
    if (nloc == 0u) { xcd_barrier_complete(bar, b.x, nloc, nx); b.st[0] = nloc; b.st[1] = nx; }
    const unsigned old = xb_add(&bar[XB_XSUB(b.x)], 1u);
    const unsigned gen = old / nloc;
    if (old + 1u == (gen + 1u) * nloc) {
      __builtin_amdgcn_fence(__ATOMIC_RELEASE, "agent");
      asm volatile("s_waitcnt vmcnt(0)" ::: "memory");
      const unsigned og = xb_add(&bar[XB_TOP], 1u);
      const unsigned tg = og / nx;
      if (og + 1u == (tg + 1u) * nx) xb_add(&bar[XB_TOPGEN], 1u);
      else XB_SPIN(xb_ld(&bar[XB_TOPGEN]) == tg, bar);
      __builtin_amdgcn_fence(__ATOMIC_ACQUIRE, "agent");
      xb_add(&bar[XB_XGEN(b.x)], 1u);
      asm volatile("s_waitcnt vmcnt(0)" ::: "memory");
    } else {
      XB_SPIN(xb_ld(&bar[XB_XGEN(b.x)]) == gen, bar);
      __builtin_amdgcn_fence(__ATOMIC_ACQUIRE, "agent");
      asm volatile("s_waitcnt vmcnt(0)" ::: "memory");
    }
  }
  __syncthreads();
}

#define MFMA(a, b, c) __builtin_amdgcn_mfma_f32_16x16x32_bf16((a), (b), (c), 0, 0, 0)

template <int MTW, int NTW>
__device__ __forceinline__ void gemm_main(const bf16_t* __restrict__ A, int lda, const bf16_t* __restrict__ Bt, int ldb,
                                          int K, int m0, int n0, char* lds, f32x4 (&acc)[MTW][NTW]) {
  constexpr int ABYTES = 4096 * MTW, BUFB = 4096 * (MTW + NTW);
  const int TX = tid_();
  const int tid = TX, lane = tid & 63, wv = tid >> 6;
  const int wr = wv >> 1, wc = wv & 1, fr = lane & 15, fq = lane >> 4;
  const int obs = lane * 16;
  const int ob = obs ^ (((obs >> 9) & 1) << 5);
  const int srow = (wv >> 1) * 16 + (ob >> 6), scol = (wv & 1) * 32 + ((ob & 63) >> 1);
  const bf16_t* ga = A + (size_t)(m0 + srow) * lda + scol;
  const bf16_t* gb = Bt + (size_t)(n0 + srow) * ldb + scol;
  const int fo = swz(fr, fq * 16);
  const int nk = K >> 6;
  char* wbase = lds + wv * 1024;
#pragma unroll
  for (int j = 0; j < MTW; ++j)
    __builtin_amdgcn_global_load_lds((const unsigned*)(ga + (size_t)(32 * j) * lda), (unsigned*)(wbase + j * 4096), 16, 0, 0);
#pragma unroll
  for (int j = 0; j < NTW; ++j)
    __builtin_amdgcn_global_load_lds((const unsigned*)(gb + (size_t)(32 * j) * ldb), (unsigned*)(wbase + ABYTES + j * 4096), 16, 0, 0);
  for (int kt = 0; kt < nk; ++kt) {
    const int cur = kt & 1;
    asm volatile("s_waitcnt vmcnt(0)" ::: "memory");
    __syncthreads();
    if (kt + 1 < nk) {
      char* nb = wbase + (cur ^ 1) * BUFB;
#pragma unroll
      for (int j = 0; j < MTW; ++j)
        __builtin_amdgcn_global_load_lds((const unsigned*)(ga + (size_t)(32 * j) * lda + (kt + 1) * 64), (unsigned*)(nb + j * 4096), 16, 0, 0);
#pragma unroll
      for (int j = 0; j < NTW; ++j)
        __builtin_amdgcn_global_load_lds((const unsigned*)(gb + (size_t)(32 * j) * ldb + (kt + 1) * 64), (unsigned*)(nb + ABYTES + j * 4096), 16, 0, 0);
    }
    const char* cA = lds + cur * BUFB;
    const char* cB = cA + ABYTES;
#pragma unroll
    for (int ks = 0; ks < 2; ++ks) {
      bf16x8 af[MTW], bfr[NTW];
#pragma unroll
      for (int mt = 0; mt < MTW; ++mt) af[mt] = *(const bf16x8*)(cA + ((wr * MTW + mt) * 2 + ks) * 1024 + fo);
#pragma unroll
      for (int nt = 0; nt < NTW; ++nt) bfr[nt] = *(const bf16x8*)(cB + ((wc * NTW + nt) * 2 + ks) * 1024 + fo);
#pragma unroll
      for (int mt = 0; mt < MTW; ++mt)
#pragma unroll
        for (int nt = 0; nt < NTW; ++nt) acc[mt][nt] = MFMA(af[mt], bfr[nt], acc[mt][nt]);
    }
  }
  __syncthreads();
}

struct TileIter {
  int L, Lend, step;
};
__device__ __forceinline__ TileIter tile_iter(int ntiles) {
  const int G = (int)gridDim.x, b = (int)blockIdx.x;
  TileIter it;
  if ((G & 7) == 0) {
    const int tpx = (ntiles + 7) >> 3, x = b & 7;
    it.L = x * tpx + (b >> 3);
    it.Lend = min(ntiles, (x + 1) * tpx);
    it.step = G >> 3;
  } else {
    it.L = b; it.Lend = ntiles; it.step = G;
  }
  return it;
}
__device__ __forceinline__ void tile_mn(int L, int nM, int nN, int& m, int& n) {
  const int full = (nM >> 3) * 8 * nN;
  if (L < full) {
    const int band = L / (8 * nN), r = L % (8 * nN);
    n = r >> 3; m = band * 8 + (r & 7);
  } else {
    const int rem = nM & 7, r = L - full;
    n = r / rem; m = (nM >> 3) * 8 + r % rem;
  }
}

template <int MTW, int NTW>
__device__ __forceinline__ void zero_acc(f32x4 (&acc)[MTW][NTW]) {
#pragma unroll
  for (int a = 0; a < MTW; ++a)
#pragma unroll
    for (int b = 0; b < NTW; ++b) acc[a][b] = f32x4{0.f, 0.f, 0.f, 0.f};
}

__device__ void transpose_tile(const float* __restrict__ W, int ldw, bf16_t* __restrict__ Wt, int ldt, int k0, int n0,
                               int perm, char* lds) {
  const int TX = tid_();
  float* tile = (float*)lds;
  const int tid = TX;
  const int c = tid & 63, r0 = tid >> 6;
#pragma unroll
  for (int r = 0; r < 16; ++r) {
    int row = r * 4 + r0;
    tile[row * 65 + c] = W[(size_t)(k0 + row) * ldw + n0 + c];
  }
  __syncthreads();
#pragma unroll
  for (int r = 0; r < 16; ++r) {
    int n = n0 + r * 4 + r0;
    int np = n;
    if (perm) {
      if (n < DFF) np = (n >> 5) * 64 + (n & 31);
      else { int j = n - DFF; np = (j >> 5) * 64 + 32 + (j & 31); }
    }
    Wt[(size_t)np * ldt + k0 + c] = f2bf(tile[c * 65 + (r * 4 + r0)]);
  }
  __syncthreads();
}

__device__ __forceinline__ void convert_job(const float* __restrict__ src, bf16_t* __restrict__ dst, int K, int N, int nmat,
                                            int perm, int& start, char* lds) {
  const int tk = K / 64, tn = N / 64;
  const int ntiles = nmat * tk * tn;
  const int G = (int)gridDim.x;
  const int first = (((int)blockIdx.x - start) % G + G) % G;
  for (int i = first; i < ntiles; i += G) {
    const int mat = i / (tk * tn), r = i % (tk * tn);
    const int kt = r / tn, nt = r % tn;
    transpose_tile(src + (size_t)mat * K * N, N, dst + (size_t)mat * K * N, K, kt * 64, nt * 64, perm, lds);
  }
  start += ntiles;
}

__device__ void phase_convert(const Params& p, char* lds) {
  const int TX = tid_();
  char* ws = p.ws;
  int start = 0;
  convert_job(p.in[I_WIN], (bf16_t*)(ws + W_IN), 1024, 7680, NL, 0, start, lds);
  convert_job(p.in[I_WFFNIN], (bf16_t*)(ws + W_FFNIN), 1024, 5632, NL, 1, start, lds);
  convert_job(p.in[I_WFFNOUT], (bf16_t*)(ws + W_FFNOUT), 2816, 1024, NL, 0, start, lds);
  convert_job(p.in[I_WRWOUT], (bf16_t*)(ws + W_RWOUT), 768, 1024, NL, 0, start, lds);
  convert_job(p.in[I_WLRUOUT], (bf16_t*)(ws + W_LRUOUT), 768, 1024, NL, 0, start, lds);
  convert_job(p.in[I_WXAOUT], (bf16_t*)(ws + W_XAOUT), 512, 1024, NL, 0, start, lds);
  convert_job(p.in[I_WO], (bf16_t*)(ws + W_O), 1024, 1024, NL, 0, start, lds);
  convert_job(p.in[I_WMEMKV], (bf16_t*)(ws + W_MEMKV), 1024, 1024, NL, 0, start, lds);
  convert_job(p.in[I_W2], (bf16_t*)(ws + W_W2T), 64, 768, NL, 0, start, lds);
  convert_job(p.in[I_A2], (bf16_t*)(ws + W_A2T), 64, 768, NL, 0, start, lds);
  convert_job(p.in[I_G2], (bf16_t*)(ws + W_G2T), 128, 768, NL, 0, start, lds);
  convert_job(p.in[I_WRG], (bf16_t*)(ws + W_RGT), 64, 64, NL * 12, 0, start, lds);
  convert_job(p.in[I_WIG], (bf16_t*)(ws + W_IGT), 64, 64, NL * 12, 0, start, lds);
  const size_t gtid = (size_t)blockIdx.x * 256 + TX, gsz = (size_t)gridDim.x * 256;
  {
    float4* xf = (float4*)(ws + B_XF);
    uint2* xb = (uint2*)(ws + B_XB);
    const float4* xp = (const float4*)p.in[I_XP];
    const float4* xs = (const float4*)p.in[I_XS];
    const size_t np4 = (size_t)MP * D / 4, nt4 = (size_t)MT * D / 4;
    for (size_t i = gtid; i < nt4; i += gsz) {
      float4 v = (i < np4) ? xp[i] : xs[i - np4];
      xf[i] = v;
      uint2 o;
      o.x = (unsigned)f2bf(v.x) | ((unsigned)f2bf(v.y) << 16);
      o.y = (unsigned)f2bf(v.z) | ((unsigned)f2bf(v.w) << 16);
      xb[i] = o;
    }
  }
  {
    uint2* mb = (uint2*)(ws + B_MEMB);
    const float4* m = (const float4*)p.in[I_MEM];
    const size_t n4 = (size_t)2048 * D / 4;
    for (size_t i = gtid; i < n4; i += gsz) {
      float4 v = m[i];
      uint2 o;
      o.x = (unsigned)f2bf(v.x) | ((unsigned)f2bf(v.y) << 16);
      o.y = (unsigned)f2bf(v.z) | ((unsigned)f2bf(v.w) << 16);
      mb[i] = o;
    }
  }
  {
    bf16_t* v1t = (bf16_t*)(ws + W_V1T);
    const float* v1 = p.in[I_V1];
    for (size_t i = gtid; i < (size_t)3 * 768 * 32; i += gsz) {
      int j = (int)(i / (768 * 32)), r = (int)(i % (768 * 32));
      int n = r / 768, k = r % 768;
      v1t[i] = f2bf(v1[(size_t)j * 768 * 32 + (size_t)k * 32 + n]);
    }
  }
  {
    bf16_t* v2t = (bf16_t*)(ws + W_V2T);
    const float* v2 = p.in[I_V2];
    for (size_t i = gtid; i < (size_t)3 * 768 * 32; i += gsz) {
      int j = (int)(i / (768 * 32)), r = (int)(i % (768 * 32));
      int n = r / 32, k = r % 32;
      v2t[i] = f2bf(v2[(size_t)j * 32 * 768 + (size_t)k * 768 + n]);
    }
  }
}

__device__ void phase_proj(const Params& p, int l, char* lds) {
  const int TX = tid_();
  char* ws = p.ws;
  const bf16_t* xb = (const bf16_t*)(ws + B_XB);
  const bf16_t* wt = (const bf16_t*)(ws + W_IN) + (size_t)l * DIN * D;
  bf16_t* proj = (bf16_t*)(ws + B_PROJ);
  const int lane = TX & 63, wv = TX >> 6, wr = wv >> 1, wc = wv & 1, fr = lane & 15, fq = lane >> 4;
  const int nN = DIN / 128, ntiles = (MT / 128) * nN;
  const int nextra = (l == 0) ? NL * 16 * 8 : 0;
  for (TileIter it = tile_iter(ntiles + nextra); it.L < it.Lend; it.L += it.step) {
    const int tile = it.L;
    f32x4 acc[4][4];
    zero_acc(acc);
    if (tile >= nextra) {
      int tm, tn;
      tile_mn(tile - nextra, MT / 128, nN, tm, tn);
      const int m0 = tm * 128, n0 = tn * 128;
      gemm_main<4, 4>(xb, D, wt, D, D, m0, n0, lds, acc);
#pragma unroll
      for (int mt = 0; mt < 4; ++mt)
#pragma unroll
        for (int nt = 0; nt < 4; ++nt)
#pragma unroll
          for (int i = 0; i < 4; ++i) {
            int row = m0 + wr * 64 + mt * 16 + fq * 4 + i, col = n0 + wc * 64 + nt * 16 + fr;
            proj[(size_t)row * DIN + col] = f2bf(acc[mt][nt][i]);
          }
    } else {
      const int e = tile;
      const int ll = e / 128, r = e % 128;
      const int m0 = (r / 8) * 128, n0 = (r % 8) * 128;
      const bf16_t* memb = (const bf16_t*)(ws + B_MEMB);
      const bf16_t* wm = (const bf16_t*)(ws + W_MEMKV) + (size_t)ll * D * D;
      gemm_main<4, 4>(memb, D, wm, D, D, m0, n0, lds, acc);
      bf16_t* kb = (bf16_t*)(ws + B_KB);
      bf16_t* vtb = (bf16_t*)(ws + B_VTB);
#pragma unroll
      for (int mt = 0; mt < 4; ++mt)
#pragma unroll
        for (int nt = 0; nt < 4; ++nt)
#pragma unroll
          for (int i = 0; i < 4; ++i) {
            int row = m0 + wr * 64 + mt * 16 + fq * 4 + i, col = n0 + wc * 64 + nt * 16 + fr;
            int b = row >> 8, key = row & 255;
            float v = acc[mt][nt][i];
            if (col < 512) {
              p.out[O_MKP + ((size_t)(ll * 8 + b) * 256 + key) * 512 + col] = v;
              kb[((size_t)(ll * 8 + b) * 256 + key) * 512 + col] = f2bf(v);
            } else {
              int c2 = col - 512, h = c2 >> 7, d = c2 & 127;
              p.out[O_MVP + ((size_t)(ll * 8 + b) * 256 + key) * 512 + c2] = v;
              vtb[(((size_t)(ll * 8 + b) * 4 + h) * 128 + d) * 256 + key] = f2bf(v);
            }
          }
    }
  }
}

__device__ __forceinline__ float prw_prev(const Params& p, const bf16_t* proj, int l, int tok, int seq, int t, int c) {
  if (t > 0) return bf2f(proj[(size_t)(tok - 1) * DIN + c]);
  if (seq >= 8) return p.in[I_SSHIFT][((size_t)l * 128 + (seq - 8)) * RWC + c];
  return 0.f;
}
__device__ __forceinline__ float plx_back(const Params& p, const bf16_t* proj, int l, int tok, int seq, int t, int j, int ch) {
  if (t - j >= 0) return bf2f(proj[(size_t)(tok - j) * DIN + C_LX + ch]);
  if (seq >= 8) return p.in[I_SCONV][(((size_t)l * 128 + (seq - 8)) * 3 + (3 + t - j)) * DLRU + ch];
  return 0.f;
}

__device__ __forceinline__ float2 ld_bf2(const bf16_t* p) {
  const unsigned u = *(const unsigned*)p;
  return make_float2(__uint_as_float(u << 16), __uint_as_float(u & 0xffff0000u));
}
__device__ __forceinline__ unsigned pk_bf2(float a, float b) { return (unsigned)f2bf(a) | ((unsigned)f2bf(b) << 16); }
__device__ __forceinline__ float2 prw_prev2(const Params& p, const bf16_t* proj, int l, int tok, int seq, int t, int c) {
  if (t > 0) return ld_bf2(proj + (size_t)(tok - 1) * DIN + c);
  if (seq >= 8) return *(const float2*)(p.in[I_SSHIFT] + ((size_t)l * 128 + (seq - 8)) * RWC + c);
  return make_float2(0.f, 0.f);
}
__device__ __forceinline__ float2 plx_back2(const Params& p, const bf16_t* proj, int l, int tok, int seq, int t, int j, int ch) {
  if (t - j >= 0) return ld_bf2(proj + (size_t)(tok - j) * DIN + C_LX + ch);
  if (seq >= 8) return *(const float2*)(p.in[I_SCONV] + (((size_t)l * 128 + (seq - 8)) * 3 + (3 + t - j)) * DLRU + ch);
  return make_float2(0.f, 0.f);
}

__device__ void phase_prep(const Params& p, int l, char* lds) {
  const int TX = tid_();
  char* ws = p.ws;
  const bf16_t* proj = (const bf16_t*)(ws + B_PROJ);
  bf16_t* L = (bf16_t*)(ws + B_LBUF);
  bf16_t* XC = (bf16_t*)(ws + B_ALRU);
  float* ubuf = (float*)(ws + B_UBUF);
  bf16_t* vmid = (bf16_t*)(ws + B_VMID);
  const float* mu = p.in[I_MU] + (size_t)l * RWC;
  const float* cw = p.in[I_CONVW] + (size_t)l * 4 * DLRU;
  const float* cb = p.in[I_CONVB] + (size_t)l * DLRU;
  const int tid = TX, lane = tid & 63, wv = tid >> 6, fr = lane & 15, fq = lane >> 4;
  for (int item = blockIdx.x; item < MT / 16; item += gridDim.x) {
    const int tokb = item * 16;
#pragma unroll 4
    for (int u = tid; u < 16 * 128; u += 256) {
      const int tk = u >> 7, cp = (u & 127) * 2, tok = tokb + tk, c = 2304 + cp;
      int seq, t, T;
      tok_info(tok, seq, t, T);
      const float2 pc = ld_bf2(proj + (size_t)tok * DIN + c);
      const float2 pp = prw_prev2(p, proj, l, tok, seq, t, c);
      const float2 m2 = *(const float2*)(mu + c);
      const float x0 = pc.x + (pp.x - pc.x) * m2.x, x1 = pc.y + (pp.y - pc.y) * m2.y;
      float o0, o1;
      if (cp < 64) { o0 = tanhf(x0); o1 = tanhf(x1); }
      else if (cp < 128) { o0 = x0; o1 = x1; }
      else { o0 = sigmoidf_(x0); o1 = sigmoidf_(x1); }
      *(unsigned*)(L + (size_t)tok * 256 + cp) = pk_bf2(o0, o1);
    }
#pragma unroll 2
    for (int u = tid; u < 16 * 384; u += 256) {
      const int tk = u / 384, ch = (u % 384) * 2, tok = tokb + tk;
      int seq, t, T;
      tok_info(tok, seq, t, T);
      const float2 x0 = ld_bf2(proj + (size_t)tok * DIN + C_LX + ch);
      const float2 x1 = plx_back2(p, proj, l, tok, seq, t, 1, ch);
      const float2 x2 = plx_back2(p, proj, l, tok, seq, t, 2, ch);
      const float2 x3 = plx_back2(p, proj, l, tok, seq, t, 3, ch);
      const float2 b2 = *(const float2*)(cb + ch), w3 = *(const float2*)(cw + 3 * DLRU + ch), w2 = *(const float2*)(cw + 2 * DLRU + ch),
                   w1 = *(const float2*)(cw + DLRU + ch), w0 = *(const float2*)(cw + ch);
      const float xa = b2.x + w3.x * x0.x + w2.x * x1.x + w1.x * x2.x + w0.x * x3.x;
      const float xb_ = b2.y + w3.y * x0.y + w2.y * x1.y + w1.y * x2.y + w0.y * x3.y;
      *(float2*)(ubuf + (size_t)tok * DLRU + ch) = make_float2(xa, xb_);
      *(unsigned*)(XC + (size_t)tok * DLRU + ch) = pk_bf2(xa, xb_);
      if (t >= T - 3) {
        const size_t o = (seq < 8) ? O_CONVP + (((size_t)l * 8 + seq) * 3 + (t - (T - 3))) * DLRU
                                   : O_CONVS + (((size_t)l * 128 + (seq - 8)) * 3 + (t - (T - 3))) * DLRU;
        *(float2*)(p.out + o + ch) = x0;
      }
      if (l > 0) {
        const int c = 1536 + ch;
        const float2 pc = ld_bf2(proj + (size_t)tok * DIN + c);
        const float2 pp = prw_prev2(p, proj, l, tok, seq, t, c);
        const float2 m2 = *(const float2*)(mu + c);
        const float v0 = pc.x + (pp.x - pc.x) * m2.x, v1 = pc.y + (pp.y - pc.y) * m2.y;
        *(unsigned*)(lds + (ch >> 5) * 1024 + swz(tk, (ch & 31) * 2)) = pk_bf2(v0, v1);
      }
    }
    for (int tk = 0; tk < 16; ++tk) {
      const int tok = tokb + tk;
      int seq, t, T;
      tok_info(tok, seq, t, T);
      if (t == T - 1) {
        const size_t o = (seq < 8) ? O_SHP + ((size_t)l * 8 + seq) * RWC : O_SHS + ((size_t)l * 128 + (seq - 8)) * RWC;
        for (int c = tid * 2; c < RWC; c += 512) *(float2*)(p.out + o + c) = ld_bf2(proj + (size_t)tok * DIN + c);
      }
    }
    if (l > 0) {
      __syncthreads();
      const bf16_t* v1t = (const bf16_t*)(ws + W_V1T) + (size_t)(l - 1) * 32 * DRW;
      f32x4 acc0 = f32x4{0, 0, 0, 0}, acc1 = acc0;
      const int fo = swz(fr, fq * 16);
#pragma unroll
      for (int kk = 0; kk < 6; ++kk) {
        const int ks = wv * 6 + kk;
        const bf16x8 af = *(const bf16x8*)(lds + ks * 1024 + fo);
        const bf16x8 b0 = *(const bf16x8*)(v1t + (size_t)fr * DRW + ks * 32 + fq * 8);
        const bf16x8 b1 = *(const bf16x8*)(v1t + (size_t)(16 + fr) * DRW + ks * 32 + fq * 8);
        acc0 = MFMA(af, b0, acc0);
        acc1 = MFMA(af, b1, acc1);
      }
      float* red = (float*)(lds + 24576);
#pragma unroll
      for (int i = 0; i < 4; ++i) {
        red[(wv * 16 + fq * 4 + i) * 32 + fr] = acc0[i];
        red[(wv * 16 + fq * 4 + i) * 32 + 16 + fr] = acc1[i];
      }
      __syncthreads();
      {
        const int row = tid >> 4, c2 = (tid & 15) * 2;
        float s0 = 0.f, s1 = 0.f;
#pragma unroll
        for (int w = 0; w < 4; ++w) { s0 += red[(w * 16 + row) * 32 + c2]; s1 += red[(w * 16 + row) * 32 + c2 + 1]; }
        *(unsigned*)(vmid + (size_t)(tokb + row) * 32 + c2) = pk_bf2(s0, s1);
      }
      __syncthreads();
    }
  }
}

__device__ void phase_lora(const Params& p, int l, char* lds) {
  const int TX = tid_();
  char* ws = p.ws;
  const bf16_t* proj = (const bf16_t*)(ws + B_PROJ);
  const bf16_t* L = (const bf16_t*)(ws + B_LBUF);
  const bf16_t* vmid = (const bf16_t*)(ws + B_VMID);
  const bf16_t* XC = (const bf16_t*)(ws + B_ALRU);
  const int lane = TX & 63, wv = TX >> 6, fr = lane & 15, fq = lane >> 4;
  const int NRW = (MT / 128) * 12;
  for (int item = blockIdx.x; item < 2 * NRW; item += gridDim.x) {
    if (item < NRW) {
      const int h = item % 12, tb = (item / 12) * 128 + wv * 32;
      const bf16_t* w2t = (const bf16_t*)(ws + W_W2T) + ((size_t)l * DRW + h * 64) * 64;
      const bf16_t* a2t = (const bf16_t*)(ws + W_A2T) + ((size_t)l * DRW + h * 64) * 64;
      const bf16_t* g2t = (const bf16_t*)(ws + W_G2T) + ((size_t)l * DRW + h * 64) * 128;
      bf16_t* gbuf = (bf16_t*)(ws + B_GBUF);
      {
        f32x4 ag[2][4];
#pragma unroll
        for (int a = 0; a < 2; ++a)
#pragma unroll
          for (int b = 0; b < 4; ++b) ag[a][b] = f32x4{0, 0, 0, 0};
#pragma unroll
        for (int ks = 0; ks < 4; ++ks) {
          bf16x8 af[2], bf_[4];
#pragma unroll
          for (int mt = 0; mt < 2; ++mt) af[mt] = *(const bf16x8*)(L + (size_t)(tb + mt * 16 + fr) * 256 + 128 + ks * 32 + fq * 8);
#pragma unroll
          for (int nt = 0; nt < 4; ++nt) bf_[nt] = *(const bf16x8*)(g2t + (size_t)(nt * 16 + fr) * 128 + ks * 32 + fq * 8);
#pragma unroll
          for (int mt = 0; mt < 2; ++mt)
#pragma unroll
            for (int nt = 0; nt < 4; ++nt) ag[mt][nt] = MFMA(af[mt], bf_[nt], ag[mt][nt]);
        }
#pragma unroll
        for (int mt = 0; mt < 2; ++mt)
#pragma unroll
          for (int nt = 0; nt < 4; ++nt)
#pragma unroll
            for (int i = 0; i < 4; ++i)
              gbuf[(size_t)(tb + mt * 16 + fq * 4 + i) * DRW + h * 64 + nt * 16 + fr] = f2bf(ag[mt][nt][i]);
      }
      f32x4 aw[2][4], aa[2][4], av[2][4];
#pragma unroll
      for (int a = 0; a < 2; ++a)
#pragma unroll
        for (int b = 0; b < 4; ++b) { aw[a][b] = f32x4{0, 0, 0, 0}; aa[a][b] = aw[a][b]; av[a][b] = aw[a][b]; }
#pragma unroll
      for (int ks = 0; ks < 2; ++ks) {
        bf16x8 af[2], bf_[4];
#pragma unroll
        for (int mt = 0; mt < 2; ++mt) af[mt] = *(const bf16x8*)(L + (size_t)(tb + mt * 16 + fr) * 256 + ks * 32 + fq * 8);
#pragma unroll
        for (int nt = 0; nt < 4; ++nt) bf_[nt] = *(const bf16x8*)(w2t + (size_t)(nt * 16 + fr) * 64 + ks * 32 + fq * 8);
#pragma unroll
        for (int mt = 0; mt < 2; ++mt)
#pragma unroll
          for (int nt = 0; nt < 4; ++nt) aw[mt][nt] = MFMA(af[mt], bf_[nt], aw[mt][nt]);
#pragma unroll
        for (int mt = 0; mt < 2; ++mt) af[mt] = *(const bf16x8*)(L + (size_t)(tb + mt * 16 + fr) * 256 + 64 + ks * 32 + fq * 8);
#pragma unroll
        for (int nt = 0; nt < 4; ++nt) bf_[nt] = *(const bf16x8*)(a2t + (size_t)(nt * 16 + fr) * 64 + ks * 32 + fq * 8);
#pragma unroll
        for (int mt = 0; mt < 2; ++mt)
#pragma unroll
          for (int nt = 0; nt < 4; ++nt) aa[mt][nt] = MFMA(af[mt], bf_[nt], aa[mt][nt]);
      }
      if (l > 0) {
        const bf16_t* v2t = (const bf16_t*)(ws + W_V2T) + ((size_t)(l - 1) * DRW + h * 64) * 32;
        bf16x8 af[2], bf_[4];
#pragma unroll
        for (int mt = 0; mt < 2; ++mt) af[mt] = *(const bf16x8*)(vmid + (size_t)(tb + mt * 16 + fr) * 32 + fq * 8);
#pragma unroll
        for (int nt = 0; nt < 4; ++nt) bf_[nt] = *(const bf16x8*)(v2t + (size_t)(nt * 16 + fr) * 32 + fq * 8);
#pragma unroll
        for (int mt = 0; mt < 2; ++mt)
#pragma unroll
          for (int nt = 0; nt < 4; ++nt) av[mt][nt] = MFMA(af[mt], bf_[nt], av[mt][nt]);
      }
      const float* mu = p.in[I_MU] + (size_t)l * RWC;
      float mur[4], muk[4], muv[4], w0[4], a0[4], v0[4], kkp[4], kap[4], rkp[4];
#pragma unroll
      for (int nt = 0; nt < 4; ++nt) {
        int c = h * 64 + nt * 16 + fr;
        mur[nt] = mu[c]; muk[nt] = mu[768 + c]; muv[nt] = mu[1536 + c];
        w0[nt] = p.in[I_W0][(size_t)l * DRW + c];
        a0[nt] = p.in[I_A0][(size_t)l * DRW + c];
        v0[nt] = (l > 0) ? p.in[I_V0][(size_t)(l - 1) * DRW + c] : 0.f;
        kkp[nt] = p.in[I_KK][(size_t)l * DRW + c];
        kap[nt] = p.in[I_KA][(size_t)l * DRW + c];
        rkp[nt] = p.in[I_RK][(size_t)l * DRW + c];
      }
      bf16_t* vfirst = (bf16_t*)(ws + B_VFIRST);
      float* cbuf = (float*)(ws + B_CBUF);
      char* scan = ws + B_SCAN;
#pragma unroll
      for (int mt = 0; mt < 2; ++mt)
#pragma unroll
        for (int i = 0; i < 4; ++i) {
          const int tok = tb + mt * 16 + fq * 4 + i;
          int seq, t, T;
          tok_info(tok, seq, t, T);
          const bf16_t* pr = proj + (size_t)tok * DIN;
          float rr[4], kx[4], vv[4], aval[4], dec[4], kkr[4], kmod[4];
          float ss = 0.f, s1 = 0.f, s2 = 0.f, s3 = 0.f;
#pragma unroll
          for (int nt = 0; nt < 4; ++nt) {
            const int cc = nt * 16 + fr, c = h * 64 + cc;
            float pc, pp;
            pc = bf2f(pr[c]); pp = prw_prev(p, proj, l, tok, seq, t, c);
            rr[nt] = pc + (pp - pc) * mur[nt];
            pc = bf2f(pr[768 + c]); pp = prw_prev(p, proj, l, tok, seq, t, 768 + c);
            kx[nt] = pc + (pp - pc) * muk[nt];
            pc = bf2f(pr[1536 + c]); pp = prw_prev(p, proj, l, tok, seq, t, 1536 + c);
            float vx = pc + (pp - pc) * muv[nt];
            float wraw = -softplusf_(-(w0[nt] + aw[mt][nt][i])) - 0.5f;
            dec[nt] = __expf(-__expf(wraw));
            aval[nt] = sigmoidf_(a0[nt] + aa[mt][nt][i]);
            if (l > 0) {
              float vf = bf2f(vfirst[(size_t)tok * DRW + c]);
              vv[nt] = vx + (vf - vx) * sigmoidf_(v0[nt] + av[mt][nt][i]);
            } else {
              vfirst[(size_t)tok * DRW + c] = f2bf(vx);
              vv[nt] = vx;
            }
            kkr[nt] = kx[nt] * kkp[nt];
            kmod[nt] = kx[nt] * (1.f + (aval[nt] - 1.f) * kap[nt]);
            ss += kkr[nt] * kkr[nt];
            s1 += kkr[nt] * aval[nt] * rr[nt];
            s2 += kmod[nt] * rr[nt];
            s3 += rr[nt] * kmod[nt] * rkp[nt];
          }
          ss = red16_sum(ss); s1 = red16_sum(s1); s2 = red16_sum(s2); s3 = red16_sum(s3);
          const float inv = 1.f / fmaxf(sqrtf(ss), 1e-12f);
          char* so = scan + ((size_t)tok * 12 + h) * 896;
#pragma unroll
          for (int nt = 0; nt < 4; ++nt) {
            const int cc = nt * 16 + fr;
            float kkn = kkr[nt] * inv;
            ((float*)so)[cc] = dec[nt];
            ((bf16_t*)(so + 256))[cc] = f2bf(dec[nt] * rr[nt]);
            ((bf16_t*)(so + 384))[cc] = f2bf(-kkn);
            ((bf16_t*)(so + 512))[cc] = f2bf(kkn * aval[nt]);
            ((bf16_t*)(so + 640))[cc] = f2bf(kmod[nt]);
            ((bf16_t*)(so + 768))[cc] = f2bf(vv[nt]);
          }
          if (fr == 0) {
            float4 cv = make_float4(s1 * inv, s2, s3, 0.f);
            *(float4*)(cbuf + ((size_t)tok * 12 + h) * 4) = cv;
          }
        }
    } else {
      const int it = item - NRW;
      const int nb = it % 12, tb = (it / 12) * 128 + wv * 32;
      const bf16_t* rgt = (const bf16_t*)(ws + W_RGT) + ((size_t)l * 12 + nb) * 4096;
      const bf16_t* igt = (const bf16_t*)(ws + W_IGT) + ((size_t)l * 12 + nb) * 4096;
      f32x4 ar[2][4], ai[2][4];
#pragma unroll
      for (int a = 0; a < 2; ++a)
#pragma unroll
        for (int b = 0; b < 4; ++b) { ar[a][b] = f32x4{0, 0, 0, 0}; ai[a][b] = ar[a][b]; }
#pragma unroll
      for (int ks = 0; ks < 2; ++ks) {
        bf16x8 af[2], b1[4], b2[4];
#pragma unroll
        for (int mt = 0; mt < 2; ++mt) af[mt] = *(const bf16x8*)(XC + (size_t)(tb + mt * 16 + fr) * DLRU + nb * 64 + ks * 32 + fq * 8);
#pragma unroll
        for (int nt = 0; nt < 4; ++nt) {
          b1[nt] = *(const bf16x8*)(rgt + (size_t)(nt * 16 + fr) * 64 + ks * 32 + fq * 8);
          b2[nt] = *(const bf16x8*)(igt + (size_t)(nt * 16 + fr) * 64 + ks * 32 + fq * 8);
        }
#pragma unroll
        for (int mt = 0; mt < 2; ++mt)
#pragma unroll
          for (int nt = 0; nt < 4; ++nt) {
            ar[mt][nt] = MFMA(af[mt], b1[nt], ar[mt][nt]);
            ai[mt][nt] = MFMA(af[mt], b2[nt], ai[mt][nt]);
          }
      }
      float* abuf = (float*)(ws + B_ABUF);
      float* ubuf = (float*)(ws + B_UBUF);
#pragma unroll
      for (int nt = 0; nt < 4; ++nt) {
        const int c = nb * 64 + nt * 16 + fr;
        const float brg = p.in[I_BRG][(size_t)l * DLRU + c], big = p.in[I_BIG][(size_t)l * DLRU + c];
        const float sp = softplusf_(-p.in[I_LAMBDA][(size_t)l * DLRU + c]);
#pragma unroll
        for (int mt = 0; mt < 2; ++mt)
#pragma unroll
          for (int i = 0; i < 4; ++i) {
            const int tok = tb + mt * 16 + fq * 4 + i;
            float rg = sigmoidf_(ar[mt][nt][i] + brg), ig = sigmoidf_(ai[mt][nt][i] + big);
            float la = -8.f * rg * sp;
            float a = __expf(la);
            float xc = ubuf[(size_t)tok * DLRU + c];
            float u = sqrtf(fmaxf(-expm1f(2.f * la), 0.f)) * (ig * xc);
            abuf[(size_t)tok * DLRU + c] = a;
            ubuf[(size_t)tok * DLRU + c] = u;
          }
      }
    }
  }
}

constexpr int STEP_B = 1360;
__device__ void wkv_scan_item(const Params& p, int l, int seq, int h, int qt, char* lds) {
  const int TX = tid_();
  char* ws = p.ws;
  const int tid = TX, lane = tid & 63, wv = tid >> 6;
  const int kq = lane & 15, rl = lane >> 4;
  const int row = qt * 16 + wv * 4 + rl;
  const int T = (seq < 8) ? 2048 : 4;
  const int tok0 = seq_tok0(seq);
  const char* scan = ws + B_SCAN;
  const float* cbuf = (const float*)(ws + B_CBUF);
  float* ybuf = (float*)(ws + B_YBUF);
  float S0 = 0.f, S1 = 0.f, S2 = 0.f, S3 = 0.f;
  if (seq >= 8) {
    const float4 s = *(const float4*)(p.in[I_SWKV] + ((((size_t)l * 128 + (seq - 8)) * 12 + h) * 64 + row) * 64 + kq * 4);
    S0 = s.x; S1 = s.y; S2 = s.z; S3 = s.w;
  }
  const int nch = (T + 15) >> 4;
  uint4 st[4];
  float4 cst;
  auto stage_load = [&](int c) {
    const int ns = min(16, T - c * 16);
#pragma unroll
    for (int j = 0; j < 4; ++j) {
      const int u = tid + 256 * j;
      if (u < ns * 56) {
        const int s = u / 56, q = u % 56;
        st[j] = *(const uint4*)(scan + ((size_t)(tok0 + c * 16 + s) * 12 + h) * 896 + q * 16);
      }
    }
    if (tid >= 128 && tid < 128 + ns) cst = *(const float4*)(cbuf + ((size_t)(tok0 + c * 16 + (tid - 128)) * 12 + h) * 4);
  };
  auto stage_write = [&](int c, char* buf) {
    const int ns = min(16, T - c * 16);
#pragma unroll
    for (int j = 0; j < 4; ++j) {
      const int u = tid + 256 * j;
      if (u < ns * 56) {
        const int s = u / 56, q = u % 56;
        char* base = buf + s * STEP_B;
        if (q < 16) {
          *(uint4*)(base + q * 16) = st[j];
        } else {
          float4 lo, hi;
          lo.x = __uint_as_float(st[j].x << 16); lo.y = __uint_as_float(st[j].x & 0xffff0000u);
          lo.z = __uint_as_float(st[j].y << 16); lo.w = __uint_as_float(st[j].y & 0xffff0000u);
          hi.x = __uint_as_float(st[j].z << 16); hi.y = __uint_as_float(st[j].z & 0xffff0000u);
          hi.z = __uint_as_float(st[j].w << 16); hi.w = __uint_as_float(st[j].w & 0xffff0000u);
          int off = -1;
          if (q < 48) off = 256 + (q - 16) * 32;
          else { int r8 = q - 48 - 2 * qt; if (r8 == 0 || r8 == 1) off = 1280 + r8 * 32; }
          if (off >= 0) { *(float4*)(base + off) = lo; *(float4*)(base + off + 16) = hi; }
        }
      }
    }
    if (tid >= 128 && tid < 128 + ns) *(float2*)(buf + (tid - 128) * STEP_B + 1344) = make_float2(cst.x, cst.y);
  };
  __syncthreads();
  stage_load(0);
  stage_write(0, lds);
  __syncthreads();
  for (int c = 0; c < nch; ++c) {
    const int ns = min(16, T - c * 16);
    if (c + 1 < nch) stage_load(c + 1);
    const char* buf = lds + (c & 1) * (16 * STEP_B);
#pragma unroll 2
    for (int s = 0; s < ns; ++s) {
      const char* b = buf + s * STEP_B;
      const float4 w4 = *(const float4*)(b + kq * 16);
      const float4 r4 = *(const float4*)(b + 256 + kq * 16);
      const float4 n4 = *(const float4*)(b + 512 + kq * 16);
      const float4 b4 = *(const float4*)(b + 768 + kq * 16);
      const float4 k4 = *(const float4*)(b + 1024 + kq * 16);
      const float v = *(const float*)(b + 1280 + (wv * 4 + rl) * 4);
      const float2 cc = *(const float2*)(b + 1344);
      float sa = S0 * n4.x + S1 * n4.y + S2 * n4.z + S3 * n4.w;
      float z = S0 * r4.x + S1 * r4.y + S2 * r4.z + S3 * r4.w;
      sa = red16_sum(sa);
      z = red16_sum(z);
      const float y = z + sa * cc.x + v * cc.y;
      S0 = S0 * w4.x + (sa * b4.x + v * k4.x);
      S1 = S1 * w4.y + (sa * b4.y + v * k4.y);
      S2 = S2 * w4.z + (sa * b4.z + v * k4.z);
      S3 = S3 * w4.w + (sa * b4.w + v * k4.w);
      if (kq == 0) ybuf[(size_t)(tok0 + c * 16 + s) * DRW + h * 64 + row] = y;
    }
    if (c + 1 < nch) stage_write(c + 1, lds + ((c + 1) & 1) * (16 * STEP_B));
    __syncthreads();
  }
  const size_t o = (seq < 8) ? O_WKVP + ((((size_t)l * 8 + seq) * 12 + h) * 64 + row) * 64
                             : O_WKVS + ((((size_t)l * 128 + (seq - 8)) * 12 + h) * 64 + row) * 64;
  *(float4*)(p.out + o + kq * 4) = make_float4(S0, S1, S2, S3);
}

__device__ void lru_scan_item(const Params& p, int l, int seq, int cg3) {
  const int TX = tid_();
  char* ws = p.ws;
  const int ch = cg3 * 256 + TX;
  const int T = (seq < 8) ? 2048 : 4;
  const int tok0 = seq_tok0(seq);
  const float* abuf = (const float*)(ws + B_ABUF);
  float* ubuf = (float*)(ws + B_UBUF);
  float h = (seq >= 8) ? p.in[I_SH][((size_t)l * 128 + (seq - 8)) * DLRU + ch] : 0.f;
  for (int t0 = 0; t0 < T; t0 += 4) {
    float a[4], u[4];
#pragma unroll
    for (int j = 0; j < 4; ++j) {
      a[j] = abuf[(size_t)(tok0 + t0 + j) * DLRU + ch];
      u[j] = ubuf[(size_t)(tok0 + t0 + j) * DLRU + ch];
    }
#pragma unroll
    for (int j = 0; j < 4; ++j) {
      h = a[j] * h + u[j];
      ubuf[(size_t)(tok0 + t0 + j) * DLRU + ch] = h;
    }
  }
  const size_t o = (seq < 8) ? O_HP + ((size_t)l * 8 + seq) * DLRU : O_HS + ((size_t)l * 128 + (seq - 8)) * DLRU;
  p.out[o + ch] = h;
}

__device__ void attn_prompt_item(const Params& p, int l, int b, int h, int qt, char* lds) {
  const int TX = tid_();
  char* ws = p.ws;
  const int lane = TX & 63, wv = TX >> 6, fr = lane & 15, fq = lane >> 4;
  const bf16_t* proj = (const bf16_t*)(ws + B_PROJ);
  const bf16_t* kb = (const bf16_t*)(ws + B_KB) + ((size_t)(l * 8 + b) * 256) * 512 + h * 128;
  const bf16_t* vt = (const bf16_t*)(ws + B_VTB) + (((size_t)(l * 8 + b) * 4 + h) * 128) * 256;
  bf16_t* axa = (bf16_t*)(ws + B_AXA);
  const int tok0 = b * 2048 + qt * 64 + wv * 16;
  bf16x8 aq[4];
#pragma unroll
  for (int ks = 0; ks < 4; ++ks) aq[ks] = *(const bf16x8*)(proj + (size_t)(tok0 + fr) * DIN + C_Q + h * 128 + ks * 32 + fq * 8);
  f32x4 s[16];
#pragma unroll
  for (int nt = 0; nt < 16; ++nt) {
    s[nt] = f32x4{0, 0, 0, 0};
#pragma unroll
    for (int ks = 0; ks < 4; ++ks) {
      bf16x8 bk = *(const bf16x8*)(kb + (size_t)(nt * 16 + fr) * 512 + ks * 32 + fq * 8);
      s[nt] = MFMA(aq[ks], bk, s[nt]);
    }
  }
  const float scale = 0.08838834764831845f;
  float rs[4];
  char* pl = lds + wv * 8192;
  __syncthreads();
#pragma unroll
  for (int i = 0; i < 4; ++i) {
    float m = s[0][i];
#pragma unroll
    for (int nt = 1; nt < 16; ++nt) m = fmaxf(m, s[nt][i]);
    m = red16_max(m);
    float sum = 0.f;
#pragma unroll
    for (int nt = 0; nt < 16; ++nt) {
      float e = __expf((s[nt][i] - m) * scale);
      sum += e;
      const int key = nt * 16 + fr, rr = fq * 4 + i;
      *(bf16_t*)(pl + (key >> 5) * 1024 + swz(rr, (key & 31) * 2)) = f2bf(e);
    }
    rs[i] = red16_sum(sum);
  }
  __syncthreads();
  f32x4 o[8];
#pragma unroll
  for (int nt = 0; nt < 8; ++nt) o[nt] = f32x4{0, 0, 0, 0};
  const int fo = swz(fr, fq * 16);
#pragma unroll
  for (int ks = 0; ks < 8; ++ks) {
    bf16x8 ap = *(const bf16x8*)(pl + ks * 1024 + fo);
#pragma unroll
    for (int nt = 0; nt < 8; ++nt) {
      bf16x8 bv = *(const bf16x8*)(vt + (size_t)(nt * 16 + fr) * 256 + ks * 32 + fq * 8);
      o[nt] = MFMA(ap, bv, o[nt]);
    }
  }
#pragma unroll
  for (int nt = 0; nt < 8; ++nt)
#pragma unroll
    for (int i = 0; i < 4; ++i)
      axa[(size_t)(tok0 + fq * 4 + i) * DXA + h * 128 + nt * 16 + fr] = f2bf(o[nt][i] / rs[i]);
  __syncthreads();
}

__device__ void attn_sample_item(const Params& p, int l, int b, int h, char* lds) {
  const int TX = tid_();
  char* ws = p.ws;
  const int tid = TX, lane = tid & 63, wv = tid >> 6;
  const bf16_t* proj = (const bf16_t*)(ws + B_PROJ);
  bf16_t* axa = (bf16_t*)(ws + B_AXA);
  const int tok0 = MP + b * 4;
  float* q = (float*)lds;
  float* pr = q + 512;
  float* red = pr + 1024;
  float* part = red + 32;
  __syncthreads();
  for (int i = tid; i < 512; i += 256) q[i] = bf2f(proj[(size_t)(tok0 + (i >> 7)) * DIN + C_Q + h * 128 + (i & 127)]);
  __syncthreads();
  const float* kc = p.in[I_CK] + (((size_t)l * 128 + b) * 256 + tid) * 512 + h * 128;
  float s0 = 0.f, s1 = 0.f, s2 = 0.f, s3 = 0.f;
#pragma unroll 4
  for (int d = 0; d < 128; d += 4) {
    const float4 kv = *(const float4*)(kc + d);
    const float4 q0 = *(const float4*)(q + d), q1 = *(const float4*)(q + 128 + d), q2 = *(const float4*)(q + 256 + d),
                 q3 = *(const float4*)(q + 384 + d);
    s0 += kv.x * q0.x + kv.y * q0.y + kv.z * q0.z + kv.w * q0.w;
    s1 += kv.x * q1.x + kv.y * q1.y + kv.z * q1.z + kv.w * q1.w;
    s2 += kv.x * q2.x + kv.y * q2.y + kv.z * q2.z + kv.w * q2.w;
    s3 += kv.x * q3.x + kv.y * q3.y + kv.z * q3.z + kv.w * q3.w;
  }
  const float scale = 0.08838834764831845f;
  s0 *= scale; s1 *= scale; s2 *= scale; s3 *= scale;
  float m0 = s0, m1 = s1, m2 = s2, m3 = s3;
#pragma unroll
  for (int m = 1; m < 64; m <<= 1) {
    m0 = fmaxf(m0, __shfl_xor(m0, m, 64)); m1 = fmaxf(m1, __shfl_xor(m1, m, 64));
    m2 = fmaxf(m2, __shfl_xor(m2, m, 64)); m3 = fmaxf(m3, __shfl_xor(m3, m, 64));
  }
  if (lane == 0) { red[wv * 4 + 0] = m0; red[wv * 4 + 1] = m1; red[wv * 4 + 2] = m2; red[wv * 4 + 3] = m3; }
  __syncthreads();
  m0 = fmaxf(fmaxf(red[0], red[4]), fmaxf(red[8], red[12]));
  m1 = fmaxf(fmaxf(red[1], red[5]), fmaxf(red[9], red[13]));
  m2 = fmaxf(fmaxf(red[2], red[6]), fmaxf(red[10], red[14]));
  m3 = fmaxf(fmaxf(red[3], red[7]), fmaxf(red[11], red[15]));
  const float e0 = __expf(s0 - m0), e1 = __expf(s1 - m1), e2 = __expf(s2 - m2), e3 = __expf(s3 - m3);
  pr[tid] = e0; pr[256 + tid] = e1; pr[512 + tid] = e2; pr[768 + tid] = e3;
  float t0 = wave_sum(e0), t1 = wave_sum(e1), t2 = wave_sum(e2), t3 = wave_sum(e3);
  if (lane == 0) { red[16 + wv * 4 + 0] = t0; red[16 + wv * 4 + 1] = t1; red[16 + wv * 4 + 2] = t2; red[16 + wv * 4 + 3] = t3; }
  __syncthreads();
  const float z0 = red[16] + red[20] + red[24] + red[28], z1 = red[17] + red[21] + red[25] + red[29];
  const float z2 = red[18] + red[22] + red[26] + red[30], z3 = red[19] + red[23] + red[27] + red[31];
  const int d = tid & 127, half = tid >> 7;
  const float* vc = p.in[I_CV] + (((size_t)l * 128 + b) * 256 + half * 128) * 512 + h * 128 + d;
  float o0 = 0.f, o1 = 0.f, o2 = 0.f, o3 = 0.f;
#pragma unroll 8
  for (int k = 0; k < 128; ++k) {
    const float vv = vc[(size_t)k * 512];
    const int key = half * 128 + k;
    o0 += pr[key] * vv; o1 += pr[256 + key] * vv; o2 += pr[512 + key] * vv; o3 += pr[768 + key] * vv;
  }
  if (half == 1) { part[d] = o0; part[128 + d] = o1; part[256 + d] = o2; part[384 + d] = o3; }
  __syncthreads();
  if (half == 0) {
    o0 += part[d]; o1 += part[128 + d]; o2 += part[256 + d]; o3 += part[384 + d];
    axa[(size_t)(tok0 + 0) * DXA + h * 128 + d] = f2bf(o0 / z0);
    axa[(size_t)(tok0 + 1) * DXA + h * 128 + d] = f2bf(o1 / z1);
    axa[(size_t)(tok0 + 2) * DXA + h * 128 + d] = f2bf(o2 / z2);
    axa[(size_t)(tok0 + 3) * DXA + h * 128 + d] = f2bf(o3 / z3);
  }
  __syncthreads();
}

__device__ void phase_mix(const Params& p, int l, char* lds, int* s_item) {
  const int TX = tid_();
  int* cnt = (int*)(p.ws + B_CNT) + l;
  constexpr int N_WKVP = 96 * 4, N_LRUP = 24, N_ATTP = 1024, N_WKVS = 128 * 12 * 4, N_LRUS = 384, N_ATTS = 512;
  constexpr int E1 = N_WKVP, E2 = E1 + N_LRUP, E3 = E2 + N_ATTP, E4 = E3 + N_WKVS, E5 = E4 + N_LRUS, E6 = E5 + N_ATTS;
  for (;;) {
    __syncthreads();
    if (TX == 0) *s_item = atomicAdd(cnt, 1);
    __syncthreads();
    const int it = *s_item;
    if (it >= E6) break;
    if (it < E1) {
      const int qt = it & 3, bh = it >> 2;
      wkv_scan_item(p, l, bh / 12, bh % 12, qt, lds);
    } else if (it < E2) {
      const int j = it - E1;
      lru_scan_item(p, l, j / 3, j % 3);
    } else if (it < E3) {
      const int j = it - E2;
      attn_prompt_item(p, l, j >> 7, (j >> 5) & 3, j & 31, lds);
    } else if (it < E4) {
      const int j = it - E3;
      const int qt = j & 3, bh = j >> 2;
      wkv_scan_item(p, l, 8 + bh / 12, bh % 12, qt, lds);
    } else if (it < E5) {
      const int j = it - E4;
      lru_scan_item(p, l, 8 + j / 3, j % 3);
    } else {
      const int j = it - E5;
      attn_sample_item(p, l, j >> 2, j & 3, lds);
    }
  }
}

__device__ void phase_post(const Params& p, int l) {
  const int TX = tid_();
  char* ws = p.ws;
  const int tid = TX, lane = tid & 63, wv = tid >> 6;
  const float* ybuf = (const float*)(ws + B_YBUF);
  const float* cbuf = (const float*)(ws + B_CBUF);
  const bf16_t* gbuf = (const bf16_t*)(ws + B_GBUF);
  const char* scan = ws + B_SCAN;
  const float* hbuf = (const float*)(ws + B_UBUF);
  const bf16_t* proj = (const bf16_t*)(ws + B_PROJ);
  bf16_t* arw = (bf16_t*)(ws + B_ARW);
  bf16_t* alru = (bf16_t*)(ws + B_ALRU);
  const float* gng = p.in[I_GNG] + (size_t)l * DRW;
  const float* gnb = p.in[I_GNB] + (size_t)l * DRW;
  for (int tok = blockIdx.x; tok < MT; tok += gridDim.x) {
#pragma unroll
    for (int hh = 0; hh < 3; ++hh) {
      const int h = wv + hh * 4, c = h * 64 + lane;
      const float y = ybuf[(size_t)tok * DRW + c];
      const float mean = wave_sum(y) * (1.f / 64.f);
      const float d = y - mean;
      const float var = wave_sum(d * d) * (1.f / 64.f);
      const float yn = d * rsqrtf(var + 64e-5f) * gng[c] + gnb[c];
      const float c3 = cbuf[((size_t)tok * 12 + h) * 4 + 2];
      const float v = bf2f(((const bf16_t*)(scan + ((size_t)tok * 12 + h) * 896 + 768))[lane]);
      const float g = bf2f(gbuf[(size_t)tok * DRW + c]);
      arw[(size_t)tok * DRW + c] = f2bf((yn + c3 * v) * g);
    }
    for (int c = tid; c < DLRU; c += 256) {
      const float hv = hbuf[(size_t)tok * DLRU + c];
      const float x = bf2f(proj[(size_t)tok * DIN + C_LG + c]);
      const float ge = 0.5f * x * (1.f + tanhf(0.7978845608028654f * (x + 0.044715f * x * x * x)));
      alru[(size_t)tok * DLRU + c] = f2bf(hv * ge);
    }
  }
}

__device__ void phase_merge(const Params& p, int l, char* lds) {
  const int TX = tid_();
  char* ws = p.ws;
  const bf16_t* proj = (const bf16_t*)(ws + B_PROJ);
  bf16_t* mixin = (bf16_t*)(ws + B_MIXIN);
  const int lane = TX & 63, wv = TX >> 6, wr = wv >> 1, wc = wv & 1, fr = lane & 15, fq = lane >> 4;
  const int ntiles = (MT / 128) * 16;
  for (TileIter it = tile_iter(ntiles); it.L < it.Lend; it.L += it.step) {
    int tm, tn;
    tile_mn(it.L, MT / 128, 16, tm, tn);
    const int m0 = tm * 128, n0 = tn * 64;
    f32x4 sum[4][2], acc[4][2];
    zero_acc(sum);
#pragma unroll 1
    for (int br = 0; br < 3; ++br) {
      zero_acc(acc);
      const bf16_t* A; const bf16_t* Bt; int K;
      if (br == 0) { A = (const bf16_t*)(ws + B_ARW); Bt = (const bf16_t*)(ws + W_RWOUT) + (size_t)l * D * DRW; K = DRW; }
      else if (br == 1) { A = (const bf16_t*)(ws + B_ALRU); Bt = (const bf16_t*)(ws + W_LRUOUT) + (size_t)l * D * DLRU; K = DLRU; }
      else { A = (const bf16_t*)(ws + B_AXA); Bt = (const bf16_t*)(ws + W_XAOUT) + (size_t)l * D * DXA; K = DXA; }
      gemm_main<4, 2>(A, K, Bt, K, K, m0, n0, lds, acc);
#pragma unroll
      for (int mt = 0; mt < 4; ++mt)
#pragma unroll
        for (int nt = 0; nt < 2; ++nt)
#pragma unroll
          for (int i = 0; i < 4; ++i) {
            int row = m0 + wr * 64 + mt * 16 + fq * 4 + i, col = n0 + wc * 32 + nt * 16 + fr;
            float g = sigmoidf_(bf2f(proj[(size_t)row * DIN + C_G + br * D + col]));
            sum[mt][nt][i] += g * acc[mt][nt][i];
          }
    }
#pragma unroll
    for (int mt = 0; mt < 4; ++mt)
#pragma unroll
      for (int nt = 0; nt < 2; ++nt)
#pragma unroll
        for (int i = 0; i < 4; ++i) {
          int row = m0 + wr * 64 + mt * 16 + fq * 4 + i, col = n0 + wc * 32 + nt * 16 + fr;
          mixin[(size_t)row * D + col] = f2bf(sum[mt][nt][i]);
        }
  }
}

__device__ void phase_resid_gemm(const Params& p, const bf16_t* A, const bf16_t* Bt, int K, char* lds) {
  const int TX = tid_();
  char* ws = p.ws;
  const float* xf = (const float*)(ws + B_XF);
  float* t = p.out + O_Y;
  const int lane = TX & 63, wv = TX >> 6, wr = wv >> 1, wc = wv & 1, fr = lane & 15, fq = lane >> 4;
  const int ntiles = (MT / 128) * 8;
  for (TileIter it = tile_iter(ntiles); it.L < it.Lend; it.L += it.step) {
    int tm, tn;
    tile_mn(it.L, MT / 128, 8, tm, tn);
    const int m0 = tm * 128, n0 = tn * 128;
    f32x4 acc[4][4];
    zero_acc(acc);
    gemm_main<4, 4>(A, K, Bt, K, K, m0, n0, lds, acc);
#pragma unroll
    for (int mt = 0; mt < 4; ++mt)
#pragma unroll
      for (int nt = 0; nt < 4; ++nt)
#pragma unroll
        for (int i = 0; i < 4; ++i) {
          int row = m0 + wr * 64 + mt * 16 + fq * 4 + i, col = n0 + wc * 64 + nt * 16 + fr;
          t[(size_t)row * D + col] = ALPHA * xf[(size_t)row * D + col] + acc[mt][nt][i];
        }
  }
}

__device__ void phase_ln(const Params& p, const float* g, const float* bta, bool final_out) {
  const int TX = tid_();
  char* ws = p.ws;
  const int lane = TX & 63, wv = TX >> 6;
  float* t = p.out + O_Y;
  float* xf = (float*)(ws + B_XF);
  bf16_t* xb = (bf16_t*)(ws + B_XB);
  for (int r4 = blockIdx.x; r4 < MT / 4; r4 += gridDim.x) {
    const int row = r4 * 4 + wv;
    float4 v[4];
    float s = 0.f;
#pragma unroll
    for (int j = 0; j < 4; ++j) {
      v[j] = *(const float4*)(t + (size_t)row * D + j * 256 + lane * 4);
      s += v[j].x + v[j].y + v[j].z + v[j].w;
    }
    const float mean = wave_sum(s) * (1.f / 1024.f);
    float q = 0.f;
#pragma unroll
    for (int j = 0; j < 4; ++j) {
      v[j].x -= mean; v[j].y -= mean; v[j].z -= mean; v[j].w -= mean;
      q += v[j].x * v[j].x + v[j].y * v[j].y + v[j].z * v[j].z + v[j].w * v[j].w;
    }
    const float rstd = rsqrtf(wave_sum(q) * (1.f / 1024.f) + 1e-5f);
#pragma unroll
    for (int j = 0; j < 4; ++j) {
      const int c = j * 256 + lane * 4;
      const float4 gg = *(const float4*)(g + c), bb = *(const float4*)(bta + c);
      float4 o;
      o.x = v[j].x * rstd * gg.x + bb.x; o.y = v[j].y * rstd * gg.y + bb.y;
      o.z = v[j].z * rstd * gg.z + bb.z; o.w = v[j].w * rstd * gg.w + bb.w;
      if (final_out) {
        *(float4*)(t + (size_t)row * D + c) = o;
      } else {
        *(float4*)(xf + (size_t)row * D + c) = o;
        uint2 ob;
        ob.x = (unsigned)f2bf(o.x) | ((unsigned)f2bf(o.y) << 16);
        ob.y = (unsigned)f2bf(o.z) | ((unsigned)f2bf(o.w) << 16);
        *(uint2*)(xb + (size_t)row * D + c) = ob;
      }
    }
  }
}

__device__ void phase_ffn_in(const Params& p, int l, char* lds) {
  const int TX = tid_();
  char* ws = p.ws;
  const bf16_t* xb = (const bf16_t*)(ws + B_XB);
  const bf16_t* wt = (const bf16_t*)(ws + W_FFNIN) + (size_t)l * 2 * DFF * D;
  bf16_t* act = (bf16_t*)(ws + B_ACT);
  const int lane = TX & 63, wv = TX >> 6, wr = wv >> 1, wc = wv & 1, fr = lane & 15, fq = lane >> 4;
  const int nN = 2 * DFF / 128, ntiles = (MT / 128) * nN;
  for (TileIter it = tile_iter(ntiles); it.L < it.Lend; it.L += it.step) {
    int tm, tn;
    tile_mn(it.L, MT / 128, nN, tm, tn);
    const int m0 = tm * 128, n0 = tn * 128;
    f32x4 acc[4][4];
    zero_acc(acc);
    gemm_main<4, 4>(xb, D, wt, D, D, m0, n0, lds, acc);
    const int jb = (n0 + wc * 64) / 2;
#pragma unroll
    for (int mt = 0; mt < 4; ++mt)
#pragma unroll
      for (int nt = 0; nt < 2; ++nt)
#pragma unroll
        for (int i = 0; i < 4; ++i) {
          int row = m0 + wr * 64 + mt * 16 + fq * 4 + i;
          float u = acc[mt][nt][i], gt = acc[mt][nt + 2][i];
          act[(size_t)row * DFF + jb + nt * 16 + fr] = f2bf(gt * sigmoidf_(gt) * u);
        }
  }
}

__global__ void __launch_bounds__(256, 2) fwd_megakernel(Params p) {
  cg::grid_group grid = cg::this_grid();
  __shared__ __attribute__((aligned(1024))) char lds[LDS_BYTES];
  __shared__ int s_item;
  __shared__ uint4 xb_words;
  char* ws = p.ws;
  if (threadIdx.x == 0) xb_words = make_uint4(0u, 0u, 0u, 0u);
  __syncthreads();
  XcdBarrier xb = xcd_barrier_post((unsigned*)(ws + B_BAR), (volatile LAS unsigned*)&xb_words);
  constexpr int NPH = 1 + NL * 11;
#pragma unroll 1
  for (int ph = 0; ph < NPH; ++ph) {
    int phl = ph;
    asm volatile("" : "+s"(phl));
    if (phl == 0) {
      phase_convert(p, lds);
    } else {
      const int l = (phl - 1) / 11, k = (phl - 1) % 11;
      switch (k) {
        case 0: phase_proj(p, l, lds); break;
        case 1: phase_prep(p, l, lds); break;
        case 2: phase_lora(p, l, lds); break;
        case 3: phase_mix(p, l, lds, &s_item); break;
        case 4: phase_post(p, l); break;
        case 5: phase_merge(p, l, lds); break;
        case 6: phase_resid_gemm(p, (const bf16_t*)(ws + B_MIXIN), (const bf16_t*)(ws + W_O) + (size_t)l * D * D, D, lds); break;
        case 7: phase_ln(p, p.in[I_LN1G] + (size_t)l * D, p.in[I_LN1B] + (size_t)l * D, false); break;
        case 8: phase_ffn_in(p, l, lds); break;
        case 9: phase_resid_gemm(p, (const bf16_t*)(ws + B_ACT), (const bf16_t*)(ws + W_FFNOUT) + (size_t)l * D * DFF, DFF, lds); break;
        default: phase_ln(p, p.in[I_LN2G] + (size_t)l * D, p.in[I_LN2B] + (size_t)l * D, l == NL - 1); break;
      }
    }
    if (ph + 1 < NPH) { if (ph == 0) grid.sync(); else xcd_barrier(xb); }
  }
}

extern "C" void kernel_launch(void* const* d_in, const int* in_sizes, int n_in, void* d_out, int out_size, void* d_ws,
                              size_t ws_size, hipStream_t stream) {
  static int grid_blocks = 0;
  if (!grid_blocks) {
    int dev = 0, cus = 0, per_cu = 0;
    (void)hipGetDevice(&dev);
    (void)hipDeviceGetAttribute(&cus, hipDeviceAttributeMultiprocessorCount, dev);
    (void)hipOccupancyMaxActiveBlocksPerMultiprocessor(&per_cu, fwd_megakernel, 256, 0);
    if (per_cu > 2) per_cu = 2;
    if (per_cu < 1) per_cu = 1;
    grid_blocks = cus * per_cu;
  }
  if (ws_size < WS_NEED || n_in < 42) {
    fprintf(stderr, "workspace too small: %zu < %zu\n", ws_size, (size_t)WS_NEED);
    return;
  }
  (void)hipMemsetAsync((char*)d_ws + B_CNT, 0, 256 + BAR_BYTES, stream);
  Params p{};
  for (int i = 0; i < 42; ++i) p.in[i] = (const float*)d_in[i];
  p.out = (float*)d_out;
  p.ws = (char*)d_ws;
  void* args[] = {&p};
  hipError_t e = hipLaunchCooperativeKernel((void*)fwd_megakernel, dim3(grid_blocks), dim3(256), args, 0, stream);
  if (e != hipSuccess) fprintf(stderr, "cooperative launch failed: %s (grid %d)\n", hipGetErrorString(e), grid_blocks);
}
```

```cpp
#include <hip/hip_runtime.h>
#include <hip/hip_cooperative_groups.h>
#include <cstdio>
namespace cg = cooperative_groups;

typedef unsigned short bf16_t;
typedef __attribute__((ext_vector_type(8))) short bf16x8;
typedef __attribute__((ext_vector_type(4))) float f32x4;

constexpr int D = 1024, MP = 16384, MS = 512, MT = 16896, NL = 4;
constexpr int DIN = 7680, DRW = 768, DLRU = 768, DXA = 512, DFF = 2816, RWC = 2560;
constexpr int C_LX = 2560, C_LG = 3328, C_Q = 4096, C_G = 4608;
constexpr int NSEQ = 136;
constexpr float ALPHA = 1.681792830507429f;

constexpr size_t O_Y = 0;
constexpr size_t O_SHP = O_Y + (size_t)MT * D;
constexpr size_t O_WKVP = O_SHP + (size_t)NL * 8 * RWC;
constexpr size_t O_CONVP = O_WKVP + (size_t)NL * 8 * 12 * 64 * 64;
constexpr size_t O_HP = O_CONVP + (size_t)NL * 8 * 3 * DLRU;
constexpr size_t O_MKP = O_HP + (size_t)NL * 8 * DLRU;
constexpr size_t O_MVP = O_MKP + (size_t)NL * 8 * 256 * 512;
constexpr size_t O_SHS = O_MVP + (size_t)NL * 8 * 256 * 512;
constexpr size_t O_WKVS = O_SHS + (size_t)NL * 128 * RWC;
constexpr size_t O_CONVS = O_WKVS + (size_t)NL * 128 * 12 * 64 * 64;
constexpr size_t O_HS = O_CONVS + (size_t)NL * 128 * 3 * DLRU;
constexpr size_t O_END = O_HS + (size_t)NL * 128 * DLRU;

constexpr size_t al256(size_t x) { return (x + 255) & ~(size_t)255; }
constexpr size_t W_IN = 0;
constexpr size_t W_RWOUT = W_IN + al256((size_t)NL * DIN * D * 2);
constexpr size_t W_LRUOUT = W_RWOUT + al256((size_t)NL * D * DRW * 2);
constexpr size_t W_XAOUT = W_LRUOUT + al256((size_t)NL * D * DLRU * 2);
constexpr size_t W_O = W_XAOUT + al256((size_t)NL * D * DXA * 2);
constexpr size_t W_FFNIN = W_O + al256((size_t)NL * D * D * 2);
constexpr size_t W_FFNOUT = W_FFNIN + al256((size_t)NL * 2 * DFF * D * 2);
constexpr size_t W_MEMKV = W_FFNOUT + al256((size_t)NL * D * DFF * 2);
constexpr size_t W_W2T = W_MEMKV + al256((size_t)NL * D * D * 2);
constexpr size_t W_A2T = W_W2T + al256((size_t)NL * DRW * 64 * 2);
constexpr size_t W_G2T = W_A2T + al256((size_t)NL * DRW * 64 * 2);
constexpr size_t W_V2T = W_G2T + al256((size_t)NL * DRW * 128 * 2);
constexpr size_t W_RGT = W_V2T + al256((size_t)3 * DRW * 32 * 2);
constexpr size_t W_IGT = W_RGT + al256((size_t)NL * 12 * 64 * 64 * 2);
constexpr size_t B_XF = W_IGT + al256((size_t)NL * 12 * 64 * 64 * 2);
constexpr size_t B_XB = B_XF + al256((size_t)MT * D * 4);
constexpr size_t B_MEMB = B_XB + al256((size_t)MT * D * 2);
constexpr size_t B_KB = B_MEMB + al256((size_t)2048 * D * 2);
constexpr size_t B_VTB = B_KB + al256((size_t)NL * 8 * 256 * 512 * 2);
constexpr size_t B_VFIRST = B_VTB + al256((size_t)NL * 8 * 256 * 512 * 2);
constexpr size_t B_PROJ = B_VFIRST + al256((size_t)MT * DRW * 2);
constexpr size_t B_SCAN = B_PROJ + al256((size_t)MT * DIN * 2);
constexpr size_t SCAN_BYTES = (size_t)MT * 12 * 896;
constexpr size_t B_MIXIN = B_SCAN;
constexpr size_t B_ACT = B_SCAN + al256((size_t)MT * D * 2);
constexpr size_t B_CBUF = B_SCAN + al256(SCAN_BYTES);
constexpr size_t B_YBUF = B_CBUF + al256((size_t)MT * 12 * 16);
constexpr size_t B_GBUF = B_YBUF + al256((size_t)MT * DRW * 4);
constexpr size_t B_ABUF = B_GBUF + al256((size_t)MT * DRW * 2);
constexpr size_t B_UBUF = B_ABUF + al256((size_t)MT * DLRU * 4);
constexpr size_t B_LBUF = B_UBUF + al256((size_t)MT * DLRU * 4);
constexpr size_t B_VMID = B_LBUF + al256((size_t)MT * 256 * 2);
constexpr size_t B_ARW = B_VMID + al256((size_t)MT * 32 * 2);
constexpr size_t B_ALRU = B_ARW + al256((size_t)MT * DRW * 2);
constexpr size_t B_AXA = B_ALRU + al256((size_t)MT * DLRU * 2);
constexpr size_t B_CNT = B_AXA + al256((size_t)MT * DXA * 2);
constexpr size_t B_BAR = B_CNT + 256;
constexpr size_t BAR_BYTES = 16384;
constexpr size_t W_V1T = B_BAR + BAR_BYTES;
constexpr size_t WS_NEED = W_V1T + al256((size_t)3 * 32 * DRW * 2);
static_assert(al256((size_t)MT * D * 2) + (size_t)MT * DFF * 2 <= SCAN_BYTES, "alias overflow");

enum { I_XP = 0, I_XS, I_MEM, I_SSHIFT, I_SWKV, I_SCONV, I_SH, I_CK, I_CV, I_WIN, I_MU, I_W0, I_W2, I_A0, I_A2,
       I_G2, I_V0, I_V1, I_V2, I_KK, I_KA, I_RK, I_GNG, I_GNB, I_WRWOUT, I_CONVW, I_CONVB, I_WRG, I_BRG, I_WIG,
       I_BIG, I_LAMBDA, I_WLRUOUT, I_WMEMKV, I_WXAOUT, I_WO, I_LN1G, I_LN1B, I_WFFNIN, I_WFFNOUT, I_LN2G, I_LN2B };

struct Params {
  const float* in[42];
  float* out;
  char* ws;
};

constexpr int LDS_BYTES = 65536;

__device__ __forceinline__ bf16_t f2bf(float f) {
  unsigned u = __float_as_uint(f);
  u += 0x7fffu + ((u >> 16) & 1u);
  return (bf16_t)(u >> 16);
}
__device__ __forceinline__ float bf2f(bf16_t h) { return __uint_as_float(((unsigned)h) << 16); }
__device__ __forceinline__ float sigmoidf_(float x) { return 1.f / (1.f + __expf(-x)); }
__device__ __forceinline__ float softplusf_(float x) { return fmaxf(x, 0.f) + log1pf(__expf(-fabsf(x))); }
__device__ __forceinline__ int swz(int rr, int b) { int ob = rr * 64 + b; return ob ^ (((ob >> 9) & 1) << 5); }

__device__ __forceinline__ int tid_() {
  int t = threadIdx.x;
  asm volatile("" : "+v"(t));
  return t;
}
template <int CTRL>
__device__ __forceinline__ float dppf(float x) {
  return __int_as_float(__builtin_amdgcn_update_dpp(0, __float_as_int(x), CTRL, 0xf, 0xf, true));
}
__device__ __forceinline__ float red16_sum(float x) {
  x += dppf<0xB1>(x);
  x += dppf<0x4E>(x);
  x += dppf<0x141>(x);
  x += dppf<0x140>(x);
  return x;
}
__device__ __forceinline__ float red16_max(float x) {
  x = fmaxf(x, dppf<0xB1>(x));
  x = fmaxf(x, dppf<0x4E>(x));
  x = fmaxf(x, dppf<0x141>(x));
  x = fmaxf(x, dppf<0x140>(x));
  return x;
}
__device__ __forceinline__ float wave_sum(float x) {
#pragma unroll
  for (int m = 1; m < 64; m <<= 1) x += __shfl_xor(x, m, 64);
  return x;
}

__device__ __forceinline__ void tok_info(int tok, int& seq, int& t, int& T) {
  if (tok < MP) { seq = tok >> 11; t = tok & 2047; T = 2048; }
  else { int s = tok - MP; seq = 8 + (s >> 2); t = s & 3; T = 4; }
}
__device__ __forceinline__ int seq_tok0(int seq) { return seq < 8 ? seq * 2048 : MP + (seq - 8) * 4; }


#define XB_TMO      128
#define XB_XCNT(j)  (256  + 64 * (j))
#define XB_XSUB(j)  (1280 + 64 * (j))
#define XB_XGEN(j)  (2304 + 64 * (j))
#define XB_TOP      3328
#define XB_TOPGEN   3392
#define XCD_BAR_WORDS 3456
#define XB_SPIN_CAP (1u << 22)
#define LAS __attribute__((address_space(3)))
__device__ __forceinline__ unsigned xb_ld(unsigned* p) { return __hip_atomic_load(p, __ATOMIC_RELAXED, __HIP_MEMORY_SCOPE_AGENT); }
__device__ __forceinline__ unsigned xb_add(unsigned* p, unsigned v) { return __hip_atomic_fetch_add(p, v, __ATOMIC_RELAXED, __HIP_MEMORY_SCOPE_AGENT); }
__device__ __forceinline__ unsigned xb_xcc_id() { return (unsigned)__builtin_amdgcn_s_getreg((3 << 11) | 20) & 0xFu; }
#define XB_SPIN(cond, bar) do { unsigned _sp = 0; while (cond) { __builtin_amdgcn_s_sleep(1); \
    if ((++_sp & 255u) == 0u) { if (xb_ld(&(bar)[XB_TMO])) break; if (_sp > XB_SPIN_CAP) { atomicAdd(&(bar)[XB_TMO], 1u); break; } } } } while (0)
struct XcdBarrier { unsigned* bar; unsigned x; volatile LAS unsigned* st; };
__device__ __forceinline__ XcdBarrier xcd_barrier_post(unsigned* bar, volatile LAS unsigned* st) {
  XcdBarrier b; b.bar = bar; b.x = xb_xcc_id(); b.st = st;
  if (threadIdx.x == 0) (void)xb_add(&bar[XB_XCNT(b.x)], 1u);
  return b;
}
__device__ __forceinline__ void xcd_barrier_complete(unsigned* bar, unsigned x, unsigned& nloc, unsigned& nx) {
  const unsigned G = gridDim.x * gridDim.y * gridDim.z;
  unsigned sum, cnt, mine, sp = 0u;
  for (;;) {
    sum = 0u; cnt = 0u; mine = 0u;
#pragma unroll
    for (unsigned j = 0; j < 16; ++j) { const unsigned c = xb_ld(&bar[XB_XCNT(j)]); sum += c; cnt += (c > 0u) ? 1u : 0u; mine = (j == x) ? c : mine; }
    if (sum == G) break;
    __builtin_amdgcn_s_sleep(1);
    if ((++sp & 255u) == 0u) { if (xb_ld(&bar[XB_TMO])) break; if (sp > XB_SPIN_CAP) { atomicAdd(&bar[XB_TMO], 1u); break; } }
  }
  nloc = mine > 0u ? mine : 1u; nx = cnt > 0u ? cnt : 1u;
}
__device__ __forceinline__ void xcd_barrier(const XcdBarrier& b) {
  asm volatile("s_waitcnt vmcnt(0)" ::: "memory");
  __syncthreads();
  if (threadIdx.x == 0) {
    unsigned* bar = b.bar;
    __builtin_amdgcn_s_waitcnt(0);
    unsigned nloc = b.st[0], nx = b.st[1];
    if (nloc == 0u) { xcd_barrier_complete(bar, b.x, nloc, nx); b.st[0] = nloc; b.st[1] = nx; }
    const unsigned old = xb_add(&bar[XB_XSUB(b.x)], 1u);
    const unsigned gen = old / nloc;
    if (old + 1u == (gen + 1u) * nloc) {
      __builtin_amdgcn_fence(__ATOMIC_RELEASE, "agent");
      asm volatile("s_waitcnt vmcnt(0)" ::: "memory");
      const unsigned og = xb_add(&bar[XB_TOP], 1u);
      const unsigned tg = og / nx;
      if (og + 1u == (tg + 1u) * nx) xb_add(&bar[XB_TOPGEN], 1u);
      else XB_SPIN(xb_ld(&bar[XB_TOPGEN]) == tg, bar);
      __builtin_amdgcn_fence(__ATOMIC_ACQUIRE, "agent");
      xb_add(&bar[XB_XGEN(b.x)], 1u);
      asm volatile("s_waitcnt vmcnt(0)" ::: "memory");
    } else {
      XB_SPIN(xb_ld(&bar[XB_XGEN(b.x)]) == gen, bar);
      __builtin_amdgcn_fence(__ATOMIC_ACQUIRE, "agent");
      asm volatile("s_waitcnt vmcnt(0)" ::: "memory");
    }
  }
  __syncthreads();
}

#define MFMA(a, b, c) __builtin_amdgcn_mfma_f32_16x16x32_bf16((a), (b), (c), 0, 0, 0)

template <int OFF>
__device__ __forceinline__ bf16x8 lds_rd128(unsigned addr) {
  bf16x8 v;
  asm volatile("ds_read_b128 %0, %1 offset:%2" : "=v"(v) : "v"(addr), "n"(OFF));
  return v;
}
template <int MTW, int NTW>
struct GemmCtx {
  const bf16_t* ga;
  const bf16_t* gb;
  int lda, ldb;
};
#define GEMM_STAGE_BYTES(MTW, NTW) (2048 * ((MTW) + (NTW)))
#define GEMM_NLD(MTW, NTW) (((MTW) + (NTW)) / 2)

template <int NTW>
__device__ __forceinline__ int gemm_brow(int s  , int rr  ) {
  return (s / NTW) * (16 * NTW) + (rr >> 2) * (4 * NTW) + (s % NTW) * 4 + (rr & 3);
}
template <int MTW, int NTW>
__device__ __forceinline__ void gemm_issue(const bf16_t* ga, int lda, const bf16_t* gb0, const bf16_t* gb1, int kt, char* wstage) {
#pragma unroll
  for (int j = 0; j < MTW / 2; ++j)
    __builtin_amdgcn_global_load_lds((const unsigned*)(ga + (size_t)(64 * j) * lda + kt * 32), (unsigned*)(wstage + j * 4096), 16, 0, 0);
  __builtin_amdgcn_global_load_lds((const unsigned*)(gb0 + kt * 32), (unsigned*)(wstage + MTW * 2048), 16, 0, 0);
  if constexpr (NTW == 4)
    __builtin_amdgcn_global_load_lds((const unsigned*)(gb1 + kt * 32), (unsigned*)(wstage + MTW * 2048 + 4096), 16, 0, 0);
}

template <int MTW, int NTW>
__device__ __forceinline__ void gemm_prologue(const bf16_t* __restrict__ A, int lda, const bf16_t* __restrict__ Bt, int ldb,
                                              int m0, int n0, char* lds) {
  constexpr int SB = GEMM_STAGE_BYTES(MTW, NTW);
  const int TX = tid_();
  const int lane = TX & 63, wv = TX >> 6;
  const int obs = lane * 16;
  const int ob = obs ^ (((obs >> 9) & 1) << 5);
  const int srow = wv * 16 + (ob >> 6), scol = (ob & 63) >> 1;
  const bf16_t* ga = A + (size_t)(m0 + srow) * lda + scol;
  const bf16_t* gb0 = Bt + (size_t)(n0 + gemm_brow<NTW>(wv, ob >> 6)) * ldb + scol;
  const bf16_t* gb1 = Bt + (size_t)(n0 + gemm_brow<NTW>(wv + 4, ob >> 6)) * ldb + scol;
  char* wbase = lds + wv * 1024;
#pragma unroll
  for (int t = 0; t < 3; ++t) gemm_issue<MTW, NTW>(ga, lda, gb0, gb1, t, wbase + t * SB);
}

template <int MTW, int NTW>
__device__ __forceinline__ void gemm_loop(const bf16_t* __restrict__ A, int lda, const bf16_t* __restrict__ Bt, int ldb,
                                          int K, int m0, int n0, char* lds, f32x4 (&acc)[MTW][NTW]) {
  constexpr int SB = GEMM_STAGE_BYTES(MTW, NTW), NLD = GEMM_NLD(MTW, NTW);
  static_assert(NLD == 4 || NLD == 3, "vmcnt immediates below assume 3 or 4 loads per k-step");
  const int TX = tid_();
  const int lane = TX & 63, wv = TX >> 6;
  const int wr = wv >> 1, wc = wv & 1, fr = lane & 15, fq = lane >> 4;
  const int obs = lane * 16;
  const int ob = obs ^ (((obs >> 9) & 1) << 5);
  const int srow = wv * 16 + (ob >> 6), scol = (ob & 63) >> 1;
  const bf16_t* ga = A + (size_t)(m0 + srow) * lda + scol;
  const bf16_t* gb0 = Bt + (size_t)(n0 + gemm_brow<NTW>(wv, ob >> 6)) * ldb + scol;
  const bf16_t* gb1 = Bt + (size_t)(n0 + gemm_brow<NTW>(wv + 4, ob >> 6)) * ldb + scol;
  char* wbase = lds + wv * 1024;
  const int fo = swz(fr, fq * 16);
  const unsigned lbase = (unsigned)(unsigned long)((__attribute__((address_space(3))) char*)lds);
  const unsigned a_off = lbase + (wr * MTW) * 1024 + fo, b_off = lbase + MTW * 2048 + (wc * NTW) * 1024 + fo;
  const int nk = K >> 5;
  for (int kt = 0; kt < nk; ++kt) {
    if (kt + 2 < nk) { if (NLD == 4) asm volatile("s_waitcnt vmcnt(8)" ::: "memory"); else asm volatile("s_waitcnt vmcnt(6)" ::: "memory"); }
    else if (kt + 1 < nk) { if (NLD == 4) asm volatile("s_waitcnt vmcnt(4)" ::: "memory"); else asm volatile("s_waitcnt vmcnt(3)" ::: "memory"); }
    else asm volatile("s_waitcnt vmcnt(0)" ::: "memory");
    __builtin_amdgcn_s_barrier();
    asm volatile("" ::: "memory");
    static_assert(MTW == 4, "fragment read block below is written for 4 m-tiles per wave");
    const unsigned sa_ = a_off + (kt & 3) * SB, sb_ = b_off + (kt & 3) * SB;
    bf16x8 af[MTW], bfr[NTW];
    af[0] = lds_rd128<0>(sa_); af[1] = lds_rd128<1024>(sa_); af[2] = lds_rd128<2048>(sa_); af[3] = lds_rd128<3072>(sa_);
    bfr[0] = lds_rd128<0>(sb_); bfr[1] = lds_rd128<1024>(sb_);
    if constexpr (NTW == 4) { bfr[2] = lds_rd128<2048>(sb_); bfr[3] = lds_rd128<3072>(sb_); }
    if (kt + 3 < nk) gemm_issue<MTW, NTW>(ga, lda, gb0, gb1, kt + 3, wbase + ((kt + 3) & 3) * SB);
    if constexpr (NTW == 4)
      asm volatile("s_waitcnt lgkmcnt(0)" : "+v"(af[0]), "+v"(af[1]), "+v"(af[2]), "+v"(af[3]), "+v"(bfr[0]), "+v"(bfr[1]), "+v"(bfr[2]), "+v"(bfr[3]) :: "memory");
    else
      asm volatile("s_waitcnt lgkmcnt(0)" : "+v"(af[0]), "+v"(af[1]), "+v"(af[2]), "+v"(af[3]), "+v"(bfr[0]), "+v"(bfr[1]) :: "memory");
#pragma unroll
    for (int mt = 0; mt < MTW; ++mt)
#pragma unroll
      for (int nt = 0; nt < NTW; ++nt) acc[mt][nt] = MFMA(bfr[nt], af[mt], acc[mt][nt]);
  }
  asm volatile("s_waitcnt lgkmcnt(0)" ::: "memory");
  __builtin_amdgcn_s_barrier();
  asm volatile("" ::: "memory");
}

template <int MTW, int NTW>
__device__ __forceinline__ void gemm_main(const bf16_t* __restrict__ A, int lda, const bf16_t* __restrict__ Bt, int ldb,
                                          int K, int m0, int n0, char* lds, f32x4 (&acc)[MTW][NTW]) {
  gemm_prologue<MTW, NTW>(A, lda, Bt, ldb, m0, n0, lds);
  gemm_loop<MTW, NTW>(A, lda, Bt, ldb, K, m0, n0, lds, acc);
}

__device__ __forceinline__ uint4 pack8(const f32x4& a, const f32x4& b) {
  uint4 o;
  o.x = (unsigned)f2bf(a[0]) | ((unsigned)f2bf(a[1]) << 16);
  o.y = (unsigned)f2bf(a[2]) | ((unsigned)f2bf(a[3]) << 16);
  o.z = (unsigned)f2bf(b[0]) | ((unsigned)f2bf(b[1]) << 16);
  o.w = (unsigned)f2bf(b[2]) | ((unsigned)f2bf(b[3]) << 16);
  return o;
}

struct TileIter {
  int L, Lend, step;
};
__device__ __forceinline__ TileIter tile_iter(int ntiles) {
  const int G = (int)gridDim.x, b = (int)blockIdx.x;
  TileIter it;
  if ((G & 7) == 0) {
    const int tpx = (ntiles + 7) >> 3, x = b & 7;
    it.L = x * tpx + (b >> 3);
    it.Lend = min(ntiles, (x + 1) * tpx);
    it.step = G >> 3;
  } else {
    it.L = b; it.Lend = ntiles; it.step = G;
  }
  return it;
}
__device__ __forceinline__ void tile_mn(int L, int nM, int nN, int& m, int& n) {
  const int full = (nM >> 3) * 8 * nN;
  if (L < full) {
    const int band = L / (8 * nN), r = L % (8 * nN);
    n = r >> 3; m = band * 8 + (r & 7);
  } else {
    const int rem = nM & 7, r = L - full;
    n = r / rem; m = (nM >> 3) * 8 + r % rem;
  }
}

template <int MTW, int NTW>
__device__ __forceinline__ void zero_acc(f32x4 (&acc)[MTW][NTW]) {
#pragma unroll
  for (int a = 0; a < MTW; ++a)
#pragma unroll
    for (int b = 0; b < NTW; ++b) acc[a][b] = f32x4{0.f, 0.f, 0.f, 0.f};
}

__device__ void transpose_tile(const float* __restrict__ W, int ldw, bf16_t* __restrict__ Wt, int ldt, int k0, int n0,
                               int perm, char* lds) {
  const int TX = tid_();
  float* tile = (float*)lds;
  const int tid = TX;
  const int c = tid & 63, r0 = tid >> 6;
#pragma unroll
  for (int r = 0; r < 16; ++r) {
    int row = r * 4 + r0;
    tile[row * 65 + c] = W[(size_t)(k0 + row) * ldw + n0 + c];
  }
  __syncthreads();
#pragma unroll
  for (int r = 0; r < 16; ++r) {
    int n = n0 + r * 4 + r0;
    int np = n;
    if (perm) {
      if (n < DFF) np = (n >> 3) * 16 + (n & 7);
      else { int j = n - DFF; np = (j >> 3) * 16 + 8 + (j & 7); }
    }
    Wt[(size_t)np * ldt + k0 + c] = f2bf(tile[c * 65 + (r * 4 + r0)]);
  }
  __syncthreads();
}

__device__ __forceinline__ void convert_job(const float* __restrict__ src, bf16_t* __restrict__ dst, int K, int N, int nmat,
                                            int perm, int& start, char* lds) {
  const int tk = K / 64, tn = N / 64;
  const int ntiles = nmat * tk * tn;
  const int G = (int)gridDim.x;
  const int first = (((int)blockIdx.x - start) % G + G) % G;
  for (int i = first; i < ntiles; i += G) {
    const int mat = i / (tk * tn), r = i % (tk * tn);
    const int kt = r / tn, nt = r % tn;
    transpose_tile(src + (size_t)mat * K * N, N, dst + (size_t)mat * K * N, K, kt * 64, nt * 64, perm, lds);
  }
  start += ntiles;
}

__device__ void phase_convert(const Params& p, char* lds) {
  const int TX = tid_();
  char* ws = p.ws;
  int start = 0;
  convert_job(p.in[I_WIN], (bf16_t*)(ws + W_IN), 1024, 7680, NL, 0, start, lds);
  convert_job(p.in[I_WFFNIN], (bf16_t*)(ws + W_FFNIN), 1024, 5632, NL, 1, start, lds);
  convert_job(p.in[I_WFFNOUT], (bf16_t*)(ws + W_FFNOUT), 2816, 1024, NL, 0, start, lds);
  convert_job(p.in[I_WRWOUT], (bf16_t*)(ws + W_RWOUT), 768, 1024, NL, 0, start, lds);
  convert_job(p.in[I_WLRUOUT], (bf16_t*)(ws + W_LRUOUT), 768, 1024, NL, 0, start, lds);
  convert_job(p.in[I_WXAOUT], (bf16_t*)(ws + W_XAOUT), 512, 1024, NL, 0, start, lds);
  convert_job(p.in[I_WO], (bf16_t*)(ws + W_O), 1024, 1024, NL, 0, start, lds);
  convert_job(p.in[I_WMEMKV], (bf16_t*)(ws + W_MEMKV), 1024, 1024, NL, 0, start, lds);
  convert_job(p.in[I_W2], (bf16_t*)(ws + W_W2T), 64, 768, NL, 0, start, lds);
  convert_job(p.in[I_A2], (bf16_t*)(ws + W_A2T), 64, 768, NL, 0, start, lds);
  convert_job(p.in[I_G2], (bf16_t*)(ws + W_G2T), 128, 768, NL, 0, start, lds);
  convert_job(p.in[I_WRG], (bf16_t*)(ws + W_RGT), 64, 64, NL * 12, 0, start, lds);
  convert_job(p.in[I_WIG], (bf16_t*)(ws + W_IGT), 64, 64, NL * 12, 0, start, lds);
  const size_t gtid = (size_t)blockIdx.x * 256 + TX, gsz = (size_t)gridDim.x * 256;
  {
    float4* xf = (float4*)(ws + B_XF);
    uint2* xb = (uint2*)(ws + B_XB);
    const float4* xp = (const float4*)p.in[I_XP];
    const float4* xs = (const float4*)p.in[I_XS];
    const size_t np4 = (size_t)MP * D / 4, nt4 = (size_t)MT * D / 4;
    for (size_t i = gtid; i < nt4; i += gsz) {
      float4 v = (i < np4) ? xp[i] : xs[i - np4];
      xf[i] = v;
      uint2 o;
      o.x = (unsigned)f2bf(v.x) | ((unsigned)f2bf(v.y) << 16);
      o.y = (unsigned)f2bf(v.z) | ((unsigned)f2bf(v.w) << 16);
      xb[i] = o;
    }
  }
  {
    uint2* mb = (uint2*)(ws + B_MEMB);
    const float4* m = (const float4*)p.in[I_MEM];
    const size_t n4 = (size_t)2048 * D / 4;
    for (size_t i = gtid; i < n4; i += gsz) {
      float4 v = m[i];
      uint2 o;
      o.x = (unsigned)f2bf(v.x) | ((unsigned)f2bf(v.y) << 16);
      o.y = (unsigned)f2bf(v.z) | ((unsigned)f2bf(v.w) << 16);
      mb[i] = o;
    }
  }
  {
    bf16_t* v1t = (bf16_t*)(ws + W_V1T);
    const float* v1 = p.in[I_V1];
    for (size_t i = gtid; i < (size_t)3 * 768 * 32; i += gsz) {
      int j = (int)(i / (768 * 32)), r = (int)(i % (768 * 32));
      int n = r / 768, k = r % 768;
      v1t[i] = f2bf(v1[(size_t)j * 768 * 32 + (size_t)k * 32 + n]);
    }
  }
  {
    bf16_t* v2t = (bf16_t*)(ws + W_V2T);
    const float* v2 = p.in[I_V2];
    for (size_t i = gtid; i < (size_t)3 * 768 * 32; i += gsz) {
      int j = (int)(i / (768 * 32)), r = (int)(i % (768 * 32));
      int n = r / 32, k = r % 32;
      v2t[i] = f2bf(v2[(size_t)j * 32 * 768 + (size_t)k * 768 + n]);
    }
  }
}

__device__ void phase_proj(const Params& p, int l, char* lds) {
  const int TX = tid_();
  char* ws = p.ws;
  const bf16_t* xb = (const bf16_t*)(ws + B_XB);
  const bf16_t* wt = (const bf16_t*)(ws + W_IN) + (size_t)l * DIN * D;
  bf16_t* proj = (bf16_t*)(ws + B_PROJ);
  const int lane = TX & 63, wv = TX >> 6, wr = wv >> 1, wc = wv & 1, fr = lane & 15, fq = lane >> 4;
  const int nN = DIN / 128, ntiles = (MT / 128) * nN;
  const int nextra = (l == 0) ? NL * 16 * 8 : 0;
  for (TileIter it = tile_iter(ntiles + nextra); it.L < it.Lend; it.L += it.step) {
    const int tile = it.L;
    f32x4 acc[4][4];
    zero_acc(acc);
    if (tile >= nextra) {
      int tm, tn;
      tile_mn(tile - nextra, MT / 128, nN, tm, tn);
      const int m0 = tm * 128, n0 = tn * 128;
      gemm_main<4, 4>(xb, D, wt, D, D, m0, n0, lds, acc);
#pragma unroll
      for (int mt = 0; mt < 4; ++mt) {
        const int row = m0 + wr * 64 + mt * 16 + fr, col = n0 + wc * 64 + fq * 16;
        uint4* dst = (uint4*)(proj + (size_t)row * DIN + col);
        dst[0] = pack8(acc[mt][0], acc[mt][1]);
        dst[1] = pack8(acc[mt][2], acc[mt][3]);
      }
    } else {
      const int e = tile;
      const int ll = e / 128, r = e % 128;
      const int m0 = (r / 8) * 128, n0 = (r % 8) * 128;
      const bf16_t* memb = (const bf16_t*)(ws + B_MEMB);
      const bf16_t* wm = (const bf16_t*)(ws + W_MEMKV) + (size_t)ll * D * D;
      gemm_main<4, 4>(memb, D, wm, D, D, m0, n0, lds, acc);
      bf16_t* kb = (bf16_t*)(ws + B_KB);
      bf16_t* vtb = (bf16_t*)(ws + B_VTB);
#pragma unroll
      for (int mt = 0; mt < 4; ++mt)
#pragma unroll
        for (int nt = 0; nt < 4; ++nt)
#pragma unroll
          for (int i = 0; i < 4; ++i) {
            int row = m0 + wr * 64 + mt * 16 + fr, col = n0 + wc * 64 + fq * 16 + nt * 4 + i;
            int b = row >> 8, key = row & 255;
            float v = acc[mt][nt][i];
            if (col < 512) {
              p.out[O_MKP + ((size_t)(ll * 8 + b) * 256 + key) * 512 + col] = v;
              kb[((size_t)(ll * 8 + b) * 256 + key) * 512 + col] = f2bf(v);
            } else {
              int c2 = col - 512, h = c2 >> 7, d = c2 & 127;
              p.out[O_MVP + ((size_t)(ll * 8 + b) * 256 + key) * 512 + c2] = v;
              vtb[(((size_t)(ll * 8 + b) * 4 + h) * 128 + d) * 256 + key] = f2bf(v);
            }
          }
    }
  }
}

__device__ __forceinline__ float prw_prev(const Params& p, const bf16_t* proj, int l, int tok, int seq, int t, int c) {
  if (t > 0) return bf2f(proj[(size_t)(tok - 1) * DIN + c]);
  if (seq >= 8) return p.in[I_SSHIFT][((size_t)l * 128 + (seq - 8)) * RWC + c];
  return 0.f;
}
__device__ __forceinline__ float plx_back(const Params& p, const bf16_t* proj, int l, int tok, int seq, int t, int j, int ch) {
  if (t - j >= 0) return bf2f(proj[(size_t)(tok - j) * DIN + C_LX + ch]);
  if (seq >= 8) return p.in[I_SCONV][(((size_t)l * 128 + (seq - 8)) * 3 + (3 + t - j)) * DLRU + ch];
  return 0.f;
}

__device__ __forceinline__ float2 ld_bf2(const bf16_t* p) {
  const unsigned u = *(const unsigned*)p;
  return make_float2(__uint_as_float(u << 16), __uint_as_float(u & 0xffff0000u));
}
__device__ __forceinline__ unsigned pk_bf2(float a, float b) { return (unsigned)f2bf(a) | ((unsigned)f2bf(b) << 16); }
__device__ __forceinline__ float2 prw_prev2(const Params& p, const bf16_t* proj, int l, int tok, int seq, int t, int c) {
  if (t > 0) return ld_bf2(proj + (size_t)(tok - 1) * DIN + c);
  if (seq >= 8) return *(const float2*)(p.in[I_SSHIFT] + ((size_t)l * 128 + (seq - 8)) * RWC + c);
  return make_float2(0.f, 0.f);
}
__device__ __forceinline__ float2 plx_back2(const Params& p, const bf16_t* proj, int l, int tok, int seq, int t, int j, int ch) {
  if (t - j >= 0) return ld_bf2(proj + (size_t)(tok - j) * DIN + C_LX + ch);
  if (seq >= 8) return *(const float2*)(p.in[I_SCONV] + (((size_t)l * 128 + (seq - 8)) * 3 + (3 + t - j)) * DLRU + ch);
  return make_float2(0.f, 0.f);
}

__device__ void phase_prep(const Params& p, int l, char* lds) {
  const int TX = tid_();
  char* ws = p.ws;
  const bf16_t* proj = (const bf16_t*)(ws + B_PROJ);
  bf16_t* L = (bf16_t*)(ws + B_LBUF);
  bf16_t* XC = (bf16_t*)(ws + B_ALRU);
  float* ubuf = (float*)(ws + B_UBUF);
  bf16_t* vmid = (bf16_t*)(ws + B_VMID);
  const float* mu = p.in[I_MU] + (size_t)l * RWC;
  const float* cw = p.in[I_CONVW] + (size_t)l * 4 * DLRU;
  const float* cb = p.in[I_CONVB] + (size_t)l * DLRU;
  const int tid = TX, lane = tid & 63, wv = tid >> 6, fr = lane & 15, fq = lane >> 4;
  for (int item = blockIdx.x; item < MT / 16; item += gridDim.x) {
    const int tokb = item * 16;
#pragma unroll 4
    for (int u = tid; u < 16 * 128; u += 256) {
      const int tk = u >> 7, cp = (u & 127) * 2, tok = tokb + tk, c = 2304 + cp;
      int seq, t, T;
      tok_info(tok, seq, t, T);
      const float2 pc = ld_bf2(proj + (size_t)tok * DIN + c);
      const float2 pp = prw_prev2(p, proj, l, tok, seq, t, c);
      const float2 m2 = *(const float2*)(mu + c);
      const float x0 = pc.x + (pp.x - pc.x) * m2.x, x1 = pc.y + (pp.y - pc.y) * m2.y;
      float o0, o1;
      if (cp < 64) { o0 = tanhf(x0); o1 = tanhf(x1); }
      else if (cp < 128) { o0 = x0; o1 = x1; }
      else { o0 = sigmoidf_(x0); o1 = sigmoidf_(x1); }
      *(unsigned*)(L + (size_t)tok * 256 + cp) = pk_bf2(o0, o1);
    }
#pragma unroll 2
    for (int u = tid; u < 16 * 384; u += 256) {
      const int tk = u / 384, ch = (u % 384) * 2, tok = tokb + tk;
      int seq, t, T;
      tok_info(tok, seq, t, T);
      const float2 x0 = ld_bf2(proj + (size_t)tok * DIN + C_LX + ch);
      const float2 x1 = plx_back2(p, proj, l, tok, seq, t, 1, ch);
      const float2 x2 = plx_back2(p, proj, l, tok, seq, t, 2, ch);
      const float2 x3 = plx_back2(p, proj, l, tok, seq, t, 3, ch);
      const float2 b2 = *(const float2*)(cb + ch), w3 = *(const float2*)(cw + 3 * DLRU + ch), w2 = *(const float2*)(cw + 2 * DLRU + ch),
                   w1 = *(const float2*)(cw + DLRU + ch), w0 = *(const float2*)(cw + ch);
      const float xa = b2.x + w3.x * x0.x + w2.x * x1.x + w1.x * x2.x + w0.x * x3.x;
      const float xb_ = b2.y + w3.y * x0.y + w2.y * x1.y + w1.y * x2.y + w0.y * x3.y;
      *(float2*)(ubuf + (size_t)tok * DLRU + ch) = make_float2(xa, xb_);
      *(unsigned*)(XC + (size_t)tok * DLRU + ch) = pk_bf2(xa, xb_);
      if (t >= T - 3) {
        const size_t o = (seq < 8) ? O_CONVP + (((size_t)l * 8 + seq) * 3 + (t - (T - 3))) * DLRU
                                   : O_CONVS + (((size_t)l * 128 + (seq - 8)) * 3 + (t - (T - 3))) * DLRU;
        *(float2*)(p.out + o + ch) = x0;
      }
      if (l > 0) {
        const int c = 1536 + ch;
        const float2 pc = ld_bf2(proj + (size_t)tok * DIN + c);
        const float2 pp = prw_prev2(p, proj, l, tok, seq, t, c);
        const float2 m2 = *(const float2*)(mu + c);
        const float v0 = pc.x + (pp.x - pc.x) * m2.x, v1 = pc.y + (pp.y - pc.y) * m2.y;
        *(unsigned*)(lds + (ch >> 5) * 1024 + swz(tk, (ch & 31) * 2)) = pk_bf2(v0, v1);
      }
    }
    for (int tk = 0; tk < 16; ++tk) {
      const int tok = tokb + tk;
      int seq, t, T;
      tok_info(tok, seq, t, T);
      if (t == T - 1) {
        const size_t o = (seq < 8) ? O_SHP + ((size_t)l * 8 + seq) * RWC : O_SHS + ((size_t)l * 128 + (seq - 8)) * RWC;
        for (int c = tid * 2; c < RWC; c += 512) *(float2*)(p.out + o + c) = ld_bf2(proj + (size_t)tok * DIN + c);
      }
    }
    if (l > 0) {
      __syncthreads();
      const bf16_t* v1t = (const bf16_t*)(ws + W_V1T) + (size_t)(l - 1) * 32 * DRW;
      f32x4 acc0 = f32x4{0, 0, 0, 0}, acc1 = acc0;
      const int fo = swz(fr, fq * 16);
#pragma unroll
      for (int kk = 0; kk < 6; ++kk) {
        const int ks = wv * 6 + kk;
        const bf16x8 af = *(const bf16x8*)(lds + ks * 1024 + fo);
        const bf16x8 b0 = *(const bf16x8*)(v1t + (size_t)fr * DRW + ks * 32 + fq * 8);
        const bf16x8 b1 = *(const bf16x8*)(v1t + (size_t)(16 + fr) * DRW + ks * 32 + fq * 8);
        acc0 = MFMA(af, b0, acc0);
        acc1 = MFMA(af, b1, acc1);
      }
      float* red = (float*)(lds + 24576);
#pragma unroll
      for (int i = 0; i < 4; ++i) {
        red[(wv * 16 + fq * 4 + i) * 32 + fr] = acc0[i];
        red[(wv * 16 + fq * 4 + i) * 32 + 16 + fr] = acc1[i];
      }
      __syncthreads();
      {
        const int row = tid >> 4, c2 = (tid & 15) * 2;
        float s0 = 0.f, s1 = 0.f;
#pragma unroll
        for (int w = 0; w < 4; ++w) { s0 += red[(w * 16 + row) * 32 + c2]; s1 += red[(w * 16 + row) * 32 + c2 + 1]; }
        *(unsigned*)(vmid + (size_t)(tokb + row) * 32 + c2) = pk_bf2(s0, s1);
      }
      __syncthreads();
    }
  }
}

__device__ void phase_lora(const Params& p, int l, char* lds) {
  const int TX = tid_();
  char* ws = p.ws;
  const bf16_t* proj = (const bf16_t*)(ws + B_PROJ);
  const bf16_t* L = (const bf16_t*)(ws + B_LBUF);
  const bf16_t* vmid = (const bf16_t*)(ws + B_VMID);
  const bf16_t* XC = (const bf16_t*)(ws + B_ALRU);
  const int lane = TX & 63, wv = TX >> 6, fr = lane & 15, fq = lane >> 4;
  const int NRW = (MT / 128) * 12;
  for (int item = blockIdx.x; item < 2 * NRW; item += gridDim.x) {
    if (item < NRW) {
      const int h = item % 12, tb = (item / 12) * 128 + wv * 32;
      const bf16_t* w2t = (const bf16_t*)(ws + W_W2T) + ((size_t)l * DRW + h * 64) * 64;
      const bf16_t* a2t = (const bf16_t*)(ws + W_A2T) + ((size_t)l * DRW + h * 64) * 64;
      const bf16_t* g2t = (const bf16_t*)(ws + W_G2T) + ((size_t)l * DRW + h * 64) * 128;
      bf16_t* gbuf = (bf16_t*)(ws + B_GBUF);
      {
        f32x4 ag[2][4];
#pragma unroll
        for (int a = 0; a < 2; ++a)
#pragma unroll
          for (int b = 0; b < 4; ++b) ag[a][b] = f32x4{0, 0, 0, 0};
#pragma unroll
        for (int ks = 0; ks < 4; ++ks) {
          bf16x8 af[2], bf_[4];
#pragma unroll
          for (int mt = 0; mt < 2; ++mt) af[mt] = *(const bf16x8*)(L + (size_t)(tb + mt * 16 + fr) * 256 + 128 + ks * 32 + fq * 8);
#pragma unroll
          for (int nt = 0; nt < 4; ++nt) bf_[nt] = *(const bf16x8*)(g2t + (size_t)(nt * 16 + fr) * 128 + ks * 32 + fq * 8);
#pragma unroll
          for (int mt = 0; mt < 2; ++mt)
#pragma unroll
            for (int nt = 0; nt < 4; ++nt) ag[mt][nt] = MFMA(af[mt], bf_[nt], ag[mt][nt]);
        }
#pragma unroll
        for (int mt = 0; mt < 2; ++mt)
#pragma unroll
          for (int nt = 0; nt < 4; ++nt)
#pragma unroll
            for (int i = 0; i < 4; ++i)
              gbuf[(size_t)(tb + mt * 16 + fq * 4 + i) * DRW + h * 64 + nt * 16 + fr] = f2bf(ag[mt][nt][i]);
      }
      f32x4 aw[2][4], aa[2][4], av[2][4];
#pragma unroll
      for (int a = 0; a < 2; ++a)
#pragma unroll
        for (int b = 0; b < 4; ++b) { aw[a][b] = f32x4{0, 0, 0, 0}; aa[a][b] = aw[a][b]; av[a][b] = aw[a][b]; }
#pragma unroll
      for (int ks = 0; ks < 2; ++ks) {
        bf16x8 af[2], bf_[4];
#pragma unroll
        for (int mt = 0; mt < 2; ++mt) af[mt] = *(const bf16x8*)(L + (size_t)(tb + mt * 16 + fr) * 256 + ks * 32 + fq * 8);
#pragma unroll
        for (int nt = 0; nt < 4; ++nt) bf_[nt] = *(const bf16x8*)(w2t + (size_t)(nt * 16 + fr) * 64 + ks * 32 + fq * 8);
#pragma unroll
        for (int mt = 0; mt < 2; ++mt)
#pragma unroll
          for (int nt = 0; nt < 4; ++nt) aw[mt][nt] = MFMA(af[mt], bf_[nt], aw[mt][nt]);
#pragma unroll
        for (int mt = 0; mt < 2; ++mt) af[mt] = *(const bf16x8*)(L + (size_t)(tb + mt * 16 + fr) * 256 + 64 + ks * 32 + fq * 8);
#pragma unroll
        for (int nt = 0; nt < 4; ++nt) bf_[nt] = *(const bf16x8*)(a2t + (size_t)(nt * 16 + fr) * 64 + ks * 32 + fq * 8);
#pragma unroll
        for (int mt = 0; mt < 2; ++mt)
#pragma unroll
          for (int nt = 0; nt < 4; ++nt) aa[mt][nt] = MFMA(af[mt], bf_[nt], aa[mt][nt]);
      }
      if (l > 0) {
        const bf16_t* v2t = (const bf16_t*)(ws + W_V2T) + ((size_t)(l - 1) * DRW + h * 64) * 32;
        bf16x8 af[2], bf_[4];
#pragma unroll
        for (int mt = 0; mt < 2; ++mt) af[mt] = *(const bf16x8*)(vmid + (size_t)(tb + mt * 16 + fr) * 32 + fq * 8);
#pragma unroll
        for (int nt = 0; nt < 4; ++nt) bf_[nt] = *(const bf16x8*)(v2t + (size_t)(nt * 16 + fr) * 32 + fq * 8);
#pragma unroll
        for (int mt = 0; mt < 2; ++mt)
#pragma unroll
          for (int nt = 0; nt < 4; ++nt) av[mt][nt] = MFMA(af[mt], bf_[nt], av[mt][nt]);
      }
      const float* mu = p.in[I_MU] + (size_t)l * RWC;
      float mur[4], muk[4], muv[4], w0[4], a0[4], v0[4], kkp[4], kap[4], rkp[4];
#pragma unroll
      for (int nt = 0; nt < 4; ++nt) {
        int c = h * 64 + nt * 16 + fr;
        mur[nt] = mu[c]; muk[nt] = mu[768 + c]; muv[nt] = mu[1536 + c];
        w0[nt] = p.in[I_W0][(size_t)l * DRW + c];
        a0[nt] = p.in[I_A0][(size_t)l * DRW + c];
        v0[nt] = (l > 0) ? p.in[I_V0][(size_t)(l - 1) * DRW + c] : 0.f;
        kkp[nt] = p.in[I_KK][(size_t)l * DRW + c];
        kap[nt] = p.in[I_KA][(size_t)l * DRW + c];
        rkp[nt] = p.in[I_RK][(size_t)l * DRW + c];
      }
      bf16_t* vfirst = (bf16_t*)(ws + B_VFIRST);
      float* cbuf = (float*)(ws + B_CBUF);
      char* scan = ws + B_SCAN;
#pragma unroll
      for (int mt = 0; mt < 2; ++mt)
#pragma unroll
        for (int i = 0; i < 4; ++i) {
          const int tok = tb + mt * 16 + fq * 4 + i;
          int seq, t, T;
          tok_info(tok, seq, t, T);
          const bf16_t* pr = proj + (size_t)tok * DIN;
          float rr[4], kx[4], vv[4], aval[4], dec[4], kkr[4], kmod[4];
          float ss = 0.f, s1 = 0.f, s2 = 0.f, s3 = 0.f;
#pragma unroll
          for (int nt = 0; nt < 4; ++nt) {
            const int cc = nt * 16 + fr, c = h * 64 + cc;
            float pc, pp;
            pc = bf2f(pr[c]); pp = prw_prev(p, proj, l, tok, seq, t, c);
            rr[nt] = pc + (pp - pc) * mur[nt];
            pc = bf2f(pr[768 + c]); pp = prw_prev(p, proj, l, tok, seq, t, 768 + c);
            kx[nt] = pc + (pp - pc) * muk[nt];
            pc = bf2f(pr[1536 + c]); pp = prw_prev(p, proj, l, tok, seq, t, 1536 + c);
            float vx = pc + (pp - pc) * muv[nt];
            float wraw = -softplusf_(-(w0[nt] + aw[mt][nt][i])) - 0.5f;
            dec[nt] = __expf(-__expf(wraw));
            aval[nt] = sigmoidf_(a0[nt] + aa[mt][nt][i]);
            if (l > 0) {
              float vf = bf2f(vfirst[(size_t)tok * DRW + c]);
              vv[nt] = vx + (vf - vx) * sigmoidf_(v0[nt] + av[mt][nt][i]);
            } else {
              vfirst[(size_t)tok * DRW + c] = f2bf(vx);
              vv[nt] = vx;
            }
            kkr[nt] = kx[nt] * kkp[nt];
            kmod[nt] = kx[nt] * (1.f + (aval[nt] - 1.f) * kap[nt]);
            ss += kkr[nt] * kkr[nt];
            s1 += kkr[nt] * aval[nt] * rr[nt];
            s2 += kmod[nt] * rr[nt];
            s3 += rr[nt] * kmod[nt] * rkp[nt];
          }
          ss = red16_sum(ss); s1 = red16_sum(s1); s2 = red16_sum(s2); s3 = red16_sum(s3);
          const float inv = 1.f / fmaxf(sqrtf(ss), 1e-12f);
          char* so = scan + ((size_t)tok * 12 + h) * 896;
#pragma unroll
          for (int nt = 0; nt < 4; ++nt) {
            const int cc = nt * 16 + fr;
            float kkn = kkr[nt] * inv;
            ((float*)so)[cc] = dec[nt];
            ((bf16_t*)(so + 256))[cc] = f2bf(dec[nt] * rr[nt]);
            ((bf16_t*)(so + 384))[cc] = f2bf(-kkn);
            ((bf16_t*)(so + 512))[cc] = f2bf(kkn * aval[nt]);
            ((bf16_t*)(so + 640))[cc] = f2bf(kmod[nt]);
            ((bf16_t*)(so + 768))[cc] = f2bf(vv[nt]);
          }
          if (fr == 0) {
            float4 cv = make_float4(s1 * inv, s2, s3, 0.f);
            *(float4*)(cbuf + ((size_t)tok * 12 + h) * 4) = cv;
          }
        }
    } else {
      const int it = item - NRW;
      const int nb = it % 12, tb = (it / 12) * 128 + wv * 32;
      const bf16_t* rgt = (const bf16_t*)(ws + W_RGT) + ((size_t)l * 12 + nb) * 4096;
      const bf16_t* igt = (const bf16_t*)(ws + W_IGT) + ((size_t)l * 12 + nb) * 4096;
      f32x4 ar[2][4], ai[2][4];
#pragma unroll
      for (int a = 0; a < 2; ++a)
#pragma unroll
        for (int b = 0; b < 4; ++b) { ar[a][b] = f32x4{0, 0, 0, 0}; ai[a][b] = ar[a][b]; }
#pragma unroll
      for (int ks = 0; ks < 2; ++ks) {
        bf16x8 af[2], b1[4], b2[4];
#pragma unroll
        for (int mt = 0; mt < 2; ++mt) af[mt] = *(const bf16x8*)(XC + (size_t)(tb + mt * 16 + fr) * DLRU + nb * 64 + ks * 32 + fq * 8);
#pragma unroll
        for (int nt = 0; nt < 4; ++nt) {
          b1[nt] = *(const bf16x8*)(rgt + (size_t)(nt * 16 + fr) * 64 + ks * 32 + fq * 8);
          b2[nt] = *(const bf16x8*)(igt + (size_t)(nt * 16 + fr) * 64 + ks * 32 + fq * 8);
        }
#pragma unroll
        for (int mt = 0; mt < 2; ++mt)
#pragma unroll
          for (int nt = 0; nt < 4; ++nt) {
            ar[mt][nt] = MFMA(af[mt], b1[nt], ar[mt][nt]);
            ai[mt][nt] = MFMA(af[mt], b2[nt], ai[mt][nt]);
          }
      }
      float* abuf = (float*)(ws + B_ABUF);
      float* ubuf = (float*)(ws + B_UBUF);
#pragma unroll
      for (int nt = 0; nt < 4; ++nt) {
        const int c = nb * 64 + nt * 16 + fr;
        const float brg = p.in[I_BRG][(size_t)l * DLRU + c], big = p.in[I_BIG][(size_t)l * DLRU + c];
        const float sp = softplusf_(-p.in[I_LAMBDA][(size_t)l * DLRU + c]);
#pragma unroll
        for (int mt = 0; mt < 2; ++mt)
#pragma unroll
          for (int i = 0; i < 4; ++i) {
            const int tok = tb + mt * 16 + fq * 4 + i;
            float rg = sigmoidf_(ar[mt][nt][i] + brg), ig = sigmoidf_(ai[mt][nt][i] + big);
            float la = -8.f * rg * sp;
            float a = __expf(la);
            float xc = ubuf[(size_t)tok * DLRU + c];
            float u = sqrtf(fmaxf(-expm1f(2.f * la), 0.f)) * (ig * xc);
            abuf[(size_t)tok * DLRU + c] = a;
            ubuf[(size_t)tok * DLRU + c] = u;
          }
      }
    }
  }
}

constexpr int STEP_B = 1552;
struct WkvOps { float4 w4, r4, n4, b4, k4; float v; float2 cc; };
__device__ __forceinline__ void wkv_load(WkvOps& o, const char* b, int kq, int vrow) {
  o.w4 = *(const float4*)(b + kq * 16);
  o.r4 = *(const float4*)(b + 256 + kq * 16);
  o.n4 = *(const float4*)(b + 512 + kq * 16);
  o.b4 = *(const float4*)(b + 768 + kq * 16);
  o.k4 = *(const float4*)(b + 1024 + kq * 16);
  o.v = *(const float*)(b + 1280 + vrow * 4);
  o.cc = *(const float2*)(b + 1536);
}
__device__ __forceinline__ void wkv_step(const WkvOps& o, float& S0, float& S1, float& S2, float& S3, float& ykeep, bool keep) {
  float sa = S0 * o.n4.x + S1 * o.n4.y + S2 * o.n4.z + S3 * o.n4.w;
  float z = S0 * o.r4.x + S1 * o.r4.y + S2 * o.r4.z + S3 * o.r4.w;
  sa = red16_sum(sa);
  z = red16_sum(z);
  const float y = z + sa * o.cc.x + o.v * o.cc.y;
  ykeep = keep ? y : ykeep;
  S0 = S0 * o.w4.x + (sa * o.b4.x + o.v * o.k4.x);
  S1 = S1 * o.w4.y + (sa * o.b4.y + o.v * o.k4.y);
  S2 = S2 * o.w4.z + (sa * o.b4.z + o.v * o.k4.z);
  S3 = S3 * o.w4.w + (sa * o.b4.w + o.v * o.k4.w);
}

struct WkvStage { uint4 st[4]; float4 cst; };
__device__ __forceinline__ void wkv_stage_load(WkvStage& g, const char* scan, const float* cbuf, int tid, int tok0, int h, int c, int T) {
  const int ns = min(16, T - c * 16);
#pragma unroll
  for (int j = 0; j < 4; ++j) {
    const int u = tid + 256 * j;
    if (u < ns * 56) {
      const int s = u / 56, q = u % 56;
      g.st[j] = *(const uint4*)(scan + ((size_t)(tok0 + c * 16 + s) * 12 + h) * 896 + q * 16);
    }
  }
  if (tid >= 128 && tid < 128 + ns) g.cst = *(const float4*)(cbuf + ((size_t)(tok0 + c * 16 + (tid - 128)) * 12 + h) * 4);
}
__device__ __forceinline__ void wkv_stage_write(const WkvStage& g, char* buf, int tid, int c, int T) {
  const int ns = min(16, T - c * 16);
#pragma unroll
  for (int j = 0; j < 4; ++j) {
    const int u = tid + 256 * j;
    if (u < ns * 56) {
      const int s = u / 56, q = u % 56;
      char* base = buf + s * STEP_B;
      if (q < 16) {
        *(uint4*)(base + q * 16) = g.st[j];
      } else {
        float4 lo, hi;
        lo.x = __uint_as_float(g.st[j].x << 16); lo.y = __uint_as_float(g.st[j].x & 0xffff0000u);
        lo.z = __uint_as_float(g.st[j].y << 16); lo.w = __uint_as_float(g.st[j].y & 0xffff0000u);
        hi.x = __uint_as_float(g.st[j].z << 16); hi.y = __uint_as_float(g.st[j].z & 0xffff0000u);
        hi.z = __uint_as_float(g.st[j].w << 16); hi.w = __uint_as_float(g.st[j].w & 0xffff0000u);
        const int off = 256 + (q - 16) * 32;
        *(float4*)(base + off) = lo;
        *(float4*)(base + off + 16) = hi;
      }
    }
  }
  if (tid >= 128 && tid < 128 + ns) *(float2*)(buf + (tid - 128) * STEP_B + 1536) = make_float2(g.cst.x, g.cst.y);
}
__device__ __forceinline__ void wkv_chunk16(const char* buf, int kq, int vrow, float& S0, float& S1, float& S2, float& S3, float& ykeep) {
  WkvOps oa, ob;
  wkv_load(oa, buf, kq, vrow);
#pragma unroll
  for (int s = 0; s < 16; s += 2) {
    wkv_load(ob, buf + (s + 1) * STEP_B, kq, vrow);
    wkv_step(oa, S0, S1, S2, S3, ykeep, kq == s);
    if (s + 2 < 16) wkv_load(oa, buf + (s + 2) * STEP_B, kq, vrow);
    wkv_step(ob, S0, S1, S2, S3, ykeep, kq == s + 1);
  }
}

__device__ void wkv_scan_item(const Params& p, int l, int seq, int h, int qt, char* lds) {
  const int TX = tid_();
  char* ws = p.ws;
  const int tid = TX, lane = tid & 63, wv = tid >> 6;
  const int kq = lane & 15, rl = lane >> 4;
  const int T = (seq < 8) ? 2048 : 4;
  const int tok0 = seq_tok0(seq);
  const char* scan = ws + B_SCAN;
  const float* cbuf = (const float*)(ws + B_CBUF);
  float* ybuf = (float*)(ws + B_YBUF);
  WkvStage ga, gb;
  float4 sin[4];
  if (seq >= 8) {
#pragma unroll
    for (int q4 = 0; q4 < 4; ++q4)
      sin[q4] = *(const float4*)(p.in[I_SWKV] + ((((size_t)l * 128 + (seq - 8)) * 12 + h) * 64 + q4 * 16 + wv * 4 + rl) * 64 + kq * 4);
  }
  __syncthreads();
  wkv_stage_load(ga, scan, cbuf, tid, tok0, h, 0, T);
  if (seq < 8) wkv_stage_load(gb, scan, cbuf, tid, tok0, h, 1, T);
  wkv_stage_write(ga, lds, tid, 0, T);
  __syncthreads();
  if (seq < 8) {
    constexpr int NCH = 128;
    const int vrow = qt * 16 + wv * 4 + rl;
    float S0 = 0.f, S1 = 0.f, S2 = 0.f, S3 = 0.f;
    char* buf0 = lds;
    char* buf1 = lds + 16 * STEP_B;
#pragma unroll 1
    for (int c = 0; c < NCH; c += 2) {
      if (c + 2 < NCH) wkv_stage_load(ga, scan, cbuf, tid, tok0, h, c + 2, T);
      float ykeep = 0.f;
      wkv_chunk16(buf0, kq, vrow, S0, S1, S2, S3, ykeep);
      ybuf[(size_t)(tok0 + c * 16 + kq) * DRW + h * 64 + vrow] = ykeep;
      wkv_stage_write(gb, buf1, tid, c + 1, T);
      __syncthreads();
      if (c + 3 < NCH) wkv_stage_load(gb, scan, cbuf, tid, tok0, h, c + 3, T);
      ykeep = 0.f;
      wkv_chunk16(buf1, kq, vrow, S0, S1, S2, S3, ykeep);
      ybuf[(size_t)(tok0 + (c + 1) * 16 + kq) * DRW + h * 64 + vrow] = ykeep;
      if (c + 2 < NCH) wkv_stage_write(ga, buf0, tid, c + 2, T);
      __syncthreads();
    }
    *(float4*)(p.out + O_WKVP + ((((size_t)l * 8 + seq) * 12 + h) * 64 + vrow) * 64 + kq * 4) = make_float4(S0, S1, S2, S3);
  } else {
    const int b = seq - 8;
#pragma unroll
    for (int q4 = 0; q4 < 4; ++q4) {
      const int vrow = q4 * 16 + wv * 4 + rl;
      float S0 = sin[q4].x, S1 = sin[q4].y, S2 = sin[q4].z, S3 = sin[q4].w;
      float ykeep = 0.f;
      WkvOps oa, ob;
      wkv_load(oa, lds, kq, vrow);
#pragma unroll
      for (int s2 = 0; s2 < 4; s2 += 2) {
        wkv_load(ob, lds + (s2 + 1) * STEP_B, kq, vrow);
        wkv_step(oa, S0, S1, S2, S3, ykeep, kq == s2);
        if (s2 + 2 < 4) wkv_load(oa, lds + (s2 + 2) * STEP_B, kq, vrow);
        wkv_step(ob, S0, S1, S2, S3, ykeep, kq == s2 + 1);
      }
      if (kq < 4) ybuf[(size_t)(tok0 + kq) * DRW + h * 64 + vrow] = ykeep;
      *(float4*)(p.out + O_WKVS + ((((size_t)l * 128 + b) * 12 + h) * 64 + vrow) * 64 + kq * 4) = make_float4(S0, S1, S2, S3);
    }
    __syncthreads();
  }
}

__device__ void lru_scan_prompt_item(const Params& p, int l, int seq, int cg, char* lds) {
  const int TX = tid_();
  char* ws = p.ws;
  const int ts = TX >> 5, ch = cg * 32 + (TX & 31);
  const float* abuf = (const float*)(ws + B_ABUF);
  float* ubuf = (float*)(ws + B_UBUF);
  const size_t base = ((size_t)seq * 2048 + ts * 256) * DLRU + ch;
  float* sA = (float*)lds;
  float* sU = sA + 256;
  __syncthreads();
  float A = 1.f, U = 0.f;
  for (int t0 = 0; t0 < 256; t0 += 16) {
    float a[16], u[16];
#pragma unroll
    for (int j = 0; j < 16; ++j) {
      a[j] = abuf[base + (size_t)(t0 + j) * DLRU];
      u[j] = ubuf[base + (size_t)(t0 + j) * DLRU];
    }
#pragma unroll
    for (int j = 0; j < 16; ++j) { U = a[j] * U + u[j]; A *= a[j]; }
  }
  sA[TX] = A;
  sU[TX] = U;
  __syncthreads();
  float h = 0.f;
  for (int j = 0; j < ts; ++j) h = sA[j * 32 + (TX & 31)] * h + sU[j * 32 + (TX & 31)];
  {
    float a[16], u[16], an[16], un[16];
#pragma unroll
    for (int j = 0; j < 16; ++j) {
      a[j] = abuf[base + (size_t)j * DLRU];
      u[j] = ubuf[base + (size_t)j * DLRU];
    }
    for (int t0 = 0; t0 < 256; t0 += 16) {
      if (t0 + 16 < 256) {
#pragma unroll
        for (int j = 0; j < 16; ++j) {
          an[j] = abuf[base + (size_t)(t0 + 16 + j) * DLRU];
          un[j] = ubuf[base + (size_t)(t0 + 16 + j) * DLRU];
        }
      }
#pragma unroll
      for (int j = 0; j < 16; ++j) {
        h = a[j] * h + u[j];
        ubuf[base + (size_t)(t0 + j) * DLRU] = h;
      }
#pragma unroll
      for (int j = 0; j < 16; ++j) { a[j] = an[j]; u[j] = un[j]; }
    }
  }
  if (ts == 7) p.out[O_HP + ((size_t)l * 8 + seq) * DLRU + ch] = h;
  __syncthreads();
}

__device__ void lru_scan_item(const Params& p, int l, int seq, int cg3) {
  const int TX = tid_();
  char* ws = p.ws;
  const int ch = cg3 * 256 + TX;
  const int tok0 = seq_tok0(seq);
  const float* abuf = (const float*)(ws + B_ABUF);
  float* ubuf = (float*)(ws + B_UBUF);
  float h = p.in[I_SH][((size_t)l * 128 + (seq - 8)) * DLRU + ch];
  float a[4], u[4];
#pragma unroll
  for (int j = 0; j < 4; ++j) {
    a[j] = abuf[(size_t)(tok0 + j) * DLRU + ch];
    u[j] = ubuf[(size_t)(tok0 + j) * DLRU + ch];
  }
#pragma unroll
  for (int j = 0; j < 4; ++j) {
    h = a[j] * h + u[j];
    ubuf[(size_t)(tok0 + j) * DLRU + ch] = h;
  }
  p.out[O_HS + ((size_t)l * 128 + (seq - 8)) * DLRU + ch] = h;
}

__device__ void attn_prompt_item(const Params& p, int l, int b, int h, int qt, char* lds) {
  const int TX = tid_();
  char* ws = p.ws;
  const int lane = TX & 63, wv = TX >> 6, fr = lane & 15, fq = lane >> 4;
  const bf16_t* proj = (const bf16_t*)(ws + B_PROJ);
  const bf16_t* kb = (const bf16_t*)(ws + B_KB) + ((size_t)(l * 8 + b) * 256) * 512 + h * 128;
  const bf16_t* vt = (const bf16_t*)(ws + B_VTB) + (((size_t)(l * 8 + b) * 4 + h) * 128) * 256;
  bf16_t* axa = (bf16_t*)(ws + B_AXA);
  const int tok0 = b * 2048 + qt * 64 + wv * 16;
  bf16x8 aq[4];
#pragma unroll
  for (int ks = 0; ks < 4; ++ks) aq[ks] = *(const bf16x8*)(proj + (size_t)(tok0 + fr) * DIN + C_Q + h * 128 + ks * 32 + fq * 8);
  f32x4 s[16];
#pragma unroll
  for (int nt = 0; nt < 16; ++nt) {
    s[nt] = f32x4{0, 0, 0, 0};
#pragma unroll
    for (int ks = 0; ks < 4; ++ks) {
      bf16x8 bk = *(const bf16x8*)(kb + (size_t)(nt * 16 + fr) * 512 + ks * 32 + fq * 8);
      s[nt] = MFMA(aq[ks], bk, s[nt]);
    }
  }
  const float scale = 0.08838834764831845f;
  float rs[4];
  char* pl = lds + wv * 8192;
  __syncthreads();
#pragma unroll
  for (int i = 0; i < 4; ++i) {
    float m = s[0][i];
#pragma unroll
    for (int nt = 1; nt < 16; ++nt) m = fmaxf(m, s[nt][i]);
    m = red16_max(m);
    float sum = 0.f;
#pragma unroll
    for (int nt = 0; nt < 16; ++nt) {
      float e = __expf((s[nt][i] - m) * scale);
      sum += e;
      const int key = nt * 16 + fr, rr = fq * 4 + i;
      *(bf16_t*)(pl + (key >> 5) * 1024 + swz(rr, (key & 31) * 2)) = f2bf(e);
    }
    rs[i] = red16_sum(sum);
  }
  __syncthreads();
  f32x4 o[8];
#pragma unroll
  for (int nt = 0; nt < 8; ++nt) o[nt] = f32x4{0, 0, 0, 0};
  const int fo = swz(fr, fq * 16);
#pragma unroll
  for (int ks = 0; ks < 8; ++ks) {
    bf16x8 ap = *(const bf16x8*)(pl + ks * 1024 + fo);
#pragma unroll
    for (int nt = 0; nt < 8; ++nt) {
      bf16x8 bv = *(const bf16x8*)(vt + (size_t)(nt * 16 + fr) * 256 + ks * 32 + fq * 8);
      o[nt] = MFMA(ap, bv, o[nt]);
    }
  }
#pragma unroll
  for (int nt = 0; nt < 8; ++nt)
#pragma unroll
    for (int i = 0; i < 4; ++i)
      axa[(size_t)(tok0 + fq * 4 + i) * DXA + h * 128 + nt * 16 + fr] = f2bf(o[nt][i] / rs[i]);
  __syncthreads();
}

__device__ void attn_sample_item(const Params& p, int l, int b, int h, char* lds) {
  const int TX = tid_();
  char* ws = p.ws;
  const int tid = TX, lane = tid & 63, wv = tid >> 6;
  const bf16_t* proj = (const bf16_t*)(ws + B_PROJ);
  bf16_t* axa = (bf16_t*)(ws + B_AXA);
  const int tok0 = MP + b * 4;
  float* q = (float*)lds;
  float* pr = q + 512;
  float* red = pr + 1024;
  float* part = red + 32;
  __syncthreads();
  for (int i = tid; i < 512; i += 256) q[i] = bf2f(proj[(size_t)(tok0 + (i >> 7)) * DIN + C_Q + h * 128 + (i & 127)]);
  __syncthreads();
  const float* kc = p.in[I_CK] + (((size_t)l * 128 + b) * 256 + tid) * 512 + h * 128;
  float s0 = 0.f, s1 = 0.f, s2 = 0.f, s3 = 0.f;
#pragma unroll 4
  for (int d = 0; d < 128; d += 4) {
    const float4 kv = *(const float4*)(kc + d);
    const float4 q0 = *(const float4*)(q + d), q1 = *(const float4*)(q + 128 + d), q2 = *(const float4*)(q + 256 + d),
                 q3 = *(const float4*)(q + 384 + d);
    s0 += kv.x * q0.x + kv.y * q0.y + kv.z * q0.z + kv.w * q0.w;
    s1 += kv.x * q1.x + kv.y * q1.y + kv.z * q1.z + kv.w * q1.w;
    s2 += kv.x * q2.x + kv.y * q2.y + kv.z * q2.z + kv.w * q2.w;
    s3 += kv.x * q3.x + kv.y * q3.y + kv.z * q3.z + kv.w * q3.w;
  }
  const float scale = 0.08838834764831845f;
  s0 *= scale; s1 *= scale; s2 *= scale; s3 *= scale;
  float m0 = s0, m1 = s1, m2 = s2, m3 = s3;
#pragma unroll
  for (int m = 1; m < 64; m <<= 1) {
    m0 = fmaxf(m0, __shfl_xor(m0, m, 64)); m1 = fmaxf(m1, __shfl_xor(m1, m, 64));
    m2 = fmaxf(m2, __shfl_xor(m2, m, 64)); m3 = fmaxf(m3, __shfl_xor(m3, m, 64));
  }
  if (lane == 0) { red[wv * 4 + 0] = m0; red[wv * 4 + 1] = m1; red[wv * 4 + 2] = m2; red[wv * 4 + 3] = m3; }
  __syncthreads();
  m0 = fmaxf(fmaxf(red[0], red[4]), fmaxf(red[8], red[12]));
  m1 = fmaxf(fmaxf(red[1], red[5]), fmaxf(red[9], red[13]));
  m2 = fmaxf(fmaxf(red[2], red[6]), fmaxf(red[10], red[14]));
  m3 = fmaxf(fmaxf(red[3], red[7]), fmaxf(red[11], red[15]));
  const float e0 = __expf(s0 - m0), e1 = __expf(s1 - m1), e2 = __expf(s2 - m2), e3 = __expf(s3 - m3);
  pr[tid] = e0; pr[256 + tid] = e1; pr[512 + tid] = e2; pr[768 + tid] = e3;
  float t0 = wave_sum(e0), t1 = wave_sum(e1), t2 = wave_sum(e2), t3 = wave_sum(e3);
  if (lane == 0) { red[16 + wv * 4 + 0] = t0; red[16 + wv * 4 + 1] = t1; red[16 + wv * 4 + 2] = t2; red[16 + wv * 4 + 3] = t3; }
  __syncthreads();
  const float z0 = red[16] + red[20] + red[24] + red[28], z1 = red[17] + red[21] + red[25] + red[29];
  const float z2 = red[18] + red[22] + red[26] + red[30], z3 = red[19] + red[23] + red[27] + red[31];
  const int d = tid & 127, half = tid >> 7;
  const float* vc = p.in[I_CV] + (((size_t)l * 128 + b) * 256 + half * 128) * 512 + h * 128 + d;
  float o0 = 0.f, o1 = 0.f, o2 = 0.f, o3 = 0.f;
#pragma unroll 8
  for (int k = 0; k < 128; ++k) {
    const float vv = vc[(size_t)k * 512];
    const int key = half * 128 + k;
    o0 += pr[key] * vv; o1 += pr[256 + key] * vv; o2 += pr[512 + key] * vv; o3 += pr[768 + key] * vv;
  }
  if (half == 1) { part[d] = o0; part[128 + d] = o1; part[256 + d] = o2; part[384 + d] = o3; }
  __syncthreads();
  if (half == 0) {
    o0 += part[d]; o1 += part[128 + d]; o2 += part[256 + d]; o3 += part[384 + d];
    axa[(size_t)(tok0 + 0) * DXA + h * 128 + d] = f2bf(o0 / z0);
    axa[(size_t)(tok0 + 1) * DXA + h * 128 + d] = f2bf(o1 / z1);
    axa[(size_t)(tok0 + 2) * DXA + h * 128 + d] = f2bf(o2 / z2);
    axa[(size_t)(tok0 + 3) * DXA + h * 128 + d] = f2bf(o3 / z3);
  }
  __syncthreads();
}

__device__ void phase_mix(const Params& p, int l, char* lds, int* s_item) {
  const int TX = tid_();
  int* cnt = (int*)(p.ws + B_CNT) + l;
  constexpr int N_WKVP = 96 * 4, N_LRUP = 8 * 24, N_ATTP = 1024, N_WKVS = 128 * 12, N_LRUS = 384, N_ATTS = 512;
  constexpr int E1 = N_WKVP, E2 = E1 + N_LRUP, E3 = E2 + N_ATTP, E4 = E3 + N_WKVS, E5 = E4 + N_LRUS, E6 = E5 + N_ATTS;
  for (;;) {
    __syncthreads();
    if (TX == 0) *s_item = atomicAdd(cnt, 1);
    __syncthreads();
    const int it = *s_item;
    if (it >= E6) break;
    if (it < E1) {
      const int qt = it & 3, bh = it >> 2;
      wkv_scan_item(p, l, bh / 12, bh % 12, qt, lds);
    } else if (it < E2) {
      const int j = it - E1;
      lru_scan_prompt_item(p, l, j / 24, j % 24, lds);
    } else if (it < E3) {
      const int j = it - E2;
      attn_prompt_item(p, l, j >> 7, (j >> 5) & 3, j & 31, lds);
    } else if (it < E4) {
      const int j = it - E3;
      wkv_scan_item(p, l, 8 + j / 12, j % 12, -1, lds);
    } else if (it < E5) {
      const int j = it - E4;
      lru_scan_item(p, l, 8 + j / 3, j % 3);
    } else {
      const int j = it - E5;
      attn_sample_item(p, l, j >> 2, j & 3, lds);
    }
  }
}

__device__ void phase_post(const Params& p, int l) {
  const int TX = tid_();
  char* ws = p.ws;
  const int tid = TX, lane = tid & 63, wv = tid >> 6;
  const float* ybuf = (const float*)(ws + B_YBUF);
  const float* cbuf = (const float*)(ws + B_CBUF);
  const bf16_t* gbuf = (const bf16_t*)(ws + B_GBUF);
  const char* scan = ws + B_SCAN;
  const float* hbuf = (const float*)(ws + B_UBUF);
  const bf16_t* proj = (const bf16_t*)(ws + B_PROJ);
  bf16_t* arw = (bf16_t*)(ws + B_ARW);
  bf16_t* alru = (bf16_t*)(ws + B_ALRU);
  const float* gng = p.in[I_GNG] + (size_t)l * DRW;
  const float* gnb = p.in[I_GNB] + (size_t)l * DRW;
  for (int tok = blockIdx.x; tok < MT; tok += gridDim.x) {
#pragma unroll
    for (int hh = 0; hh < 3; ++hh) {
      const int h = wv + hh * 4, c = h * 64 + lane;
      const float y = ybuf[(size_t)tok * DRW + c];
      const float mean = wave_sum(y) * (1.f / 64.f);
      const float d = y - mean;
      const float var = wave_sum(d * d) * (1.f / 64.f);
      const float yn = d * rsqrtf(var + 64e-5f) * gng[c] + gnb[c];
      const float c3 = cbuf[((size_t)tok * 12 + h) * 4 + 2];
      const float v = bf2f(((const bf16_t*)(scan + ((size_t)tok * 12 + h) * 896 + 768))[lane]);
      const float g = bf2f(gbuf[(size_t)tok * DRW + c]);
      arw[(size_t)tok * DRW + c] = f2bf((yn + c3 * v) * g);
    }
    for (int c = tid; c < DLRU; c += 256) {
      const float hv = hbuf[(size_t)tok * DLRU + c];
      const float x = bf2f(proj[(size_t)tok * DIN + C_LG + c]);
      const float ge = 0.5f * x * (1.f + tanhf(0.7978845608028654f * (x + 0.044715f * x * x * x)));
      alru[(size_t)tok * DLRU + c] = f2bf(hv * ge);
    }
  }
}

__device__ void phase_merge(const Params& p, int l, char* lds) {
  const int TX = tid_();
  char* ws = p.ws;
  const bf16_t* proj = (const bf16_t*)(ws + B_PROJ);
  bf16_t* mixin = (bf16_t*)(ws + B_MIXIN);
  const int lane = TX & 63, wv = TX >> 6, wr = wv >> 1, wc = wv & 1, fr = lane & 15, fq = lane >> 4;
  const int ntiles = (MT / 128) * 16;
  for (TileIter it = tile_iter(ntiles); it.L < it.Lend; it.L += it.step) {
    int tm, tn;
    tile_mn(it.L, MT / 128, 16, tm, tn);
    const int m0 = tm * 128, n0 = tn * 64;
    f32x4 sum[4][2], acc[4][2];
    zero_acc(sum);
#pragma unroll 1
    for (int br = 0; br < 3; ++br) {
      zero_acc(acc);
      const bf16_t* A; const bf16_t* Bt; int K;
      if (br == 0) { A = (const bf16_t*)(ws + B_ARW); Bt = (const bf16_t*)(ws + W_RWOUT) + (size_t)l * D * DRW; K = DRW; }
      else if (br == 1) { A = (const bf16_t*)(ws + B_ALRU); Bt = (const bf16_t*)(ws + W_LRUOUT) + (size_t)l * D * DLRU; K = DLRU; }
      else { A = (const bf16_t*)(ws + B_AXA); Bt = (const bf16_t*)(ws + W_XAOUT) + (size_t)l * D * DXA; K = DXA; }
      gemm_main<4, 2>(A, K, Bt, K, K, m0, n0, lds, acc);
#pragma unroll
      for (int mt = 0; mt < 4; ++mt) {
        const int row = m0 + wr * 64 + mt * 16 + fr, col = n0 + wc * 32 + fq * 8;
        const uint4 gq = *(const uint4*)(proj + (size_t)row * DIN + C_G + br * D + col);
        const unsigned gw[4] = {gq.x, gq.y, gq.z, gq.w};
#pragma unroll
        for (int nt = 0; nt < 2; ++nt)
#pragma unroll
          for (int i = 0; i < 4; ++i) {
            const unsigned w = gw[nt * 2 + (i >> 1)];
            const float gv = __uint_as_float((i & 1) ? (w & 0xffff0000u) : (w << 16));
            sum[mt][nt][i] += sigmoidf_(gv) * acc[mt][nt][i];
          }
      }
    }
#pragma unroll
    for (int mt = 0; mt < 4; ++mt) {
      const int row = m0 + wr * 64 + mt * 16 + fr, col = n0 + wc * 32 + fq * 8;
      *(uint4*)(mixin + (size_t)row * D + col) = pack8(sum[mt][0], sum[mt][1]);
    }
  }
}

__device__ void phase_resid_gemm(const Params& p, const bf16_t* A, const bf16_t* Bt, int K, char* lds) {
  const int TX = tid_();
  char* ws = p.ws;
  const float* xf = (const float*)(ws + B_XF);
  float* t = p.out + O_Y;
  const int lane = TX & 63, wv = TX >> 6, wr = wv >> 1, wc = wv & 1, fr = lane & 15, fq = lane >> 4;
  const int ntiles = (MT / 128) * 8;
  for (TileIter it = tile_iter(ntiles); it.L < it.Lend; it.L += it.step) {
    int tm, tn;
    tile_mn(it.L, MT / 128, 8, tm, tn);
    const int m0 = tm * 128, n0 = tn * 128;
    f32x4 acc[4][4];
    zero_acc(acc);
    gemm_main<4, 4>(A, K, Bt, K, K, m0, n0, lds, acc);
#pragma unroll
    for (int mt = 0; mt < 4; ++mt) {
      const int row = m0 + wr * 64 + mt * 16 + fr, col = n0 + wc * 64 + fq * 16;
      const float4* xs = (const float4*)(xf + (size_t)row * D + col);
      float4* ts = (float4*)(t + (size_t)row * D + col);
#pragma unroll
      for (int nt = 0; nt < 4; ++nt) {
        const float4 xv = xs[nt];
        ts[nt] = make_float4(ALPHA * xv.x + acc[mt][nt][0], ALPHA * xv.y + acc[mt][nt][1], ALPHA * xv.z + acc[mt][nt][2], ALPHA * xv.w + acc[mt][nt][3]);
      }
    }
  }
}

__device__ void phase_ln(const Params& p, const float* g, const float* bta, bool final_out) {
  const int TX = tid_();
  char* ws = p.ws;
  const int lane = TX & 63, wv = TX >> 6;
  float* t = p.out + O_Y;
  float* xf = (float*)(ws + B_XF);
  bf16_t* xb = (bf16_t*)(ws + B_XB);
  for (int r4 = blockIdx.x; r4 < MT / 4; r4 += gridDim.x) {
    const int row = r4 * 4 + wv;
    float4 v[4];
    float s = 0.f;
#pragma unroll
    for (int j = 0; j < 4; ++j) {
      v[j] = *(const float4*)(t + (size_t)row * D + j * 256 + lane * 4);
      s += v[j].x + v[j].y + v[j].z + v[j].w;
    }
    const float mean = wave_sum(s) * (1.f / 1024.f);
    float q = 0.f;
#pragma unroll
    for (int j = 0; j < 4; ++j) {
      v[j].x -= mean; v[j].y -= mean; v[j].z -= mean; v[j].w -= mean;
      q += v[j].x * v[j].x + v[j].y * v[j].y + v[j].z * v[j].z + v[j].w * v[j].w;
    }
    const float rstd = rsqrtf(wave_sum(q) * (1.f / 1024.f) + 1e-5f);
#pragma unroll
    for (int j = 0; j < 4; ++j) {
      const int c = j * 256 + lane * 4;
      const float4 gg = *(const float4*)(g + c), bb = *(const float4*)(bta + c);
      float4 o;
      o.x = v[j].x * rstd * gg.x + bb.x; o.y = v[j].y * rstd * gg.y + bb.y;
      o.z = v[j].z * rstd * gg.z + bb.z; o.w = v[j].w * rstd * gg.w + bb.w;
      if (final_out) {
        *(float4*)(t + (size_t)row * D + c) = o;
      } else {
        *(float4*)(xf + (size_t)row * D + c) = o;
        uint2 ob;
        ob.x = (unsigned)f2bf(o.x) | ((unsigned)f2bf(o.y) << 16);
        ob.y = (unsigned)f2bf(o.z) | ((unsigned)f2bf(o.w) << 16);
        *(uint2*)(xb + (size_t)row * D + c) = ob;
      }
    }
  }
}

__device__ void phase_ffn_in(const Params& p, int l, char* lds) {
  const int TX = tid_();
  char* ws = p.ws;
  const bf16_t* xb = (const bf16_t*)(ws + B_XB);
  const bf16_t* wt = (const bf16_t*)(ws + W_FFNIN) + (size_t)l * 2 * DFF * D;
  bf16_t* act = (bf16_t*)(ws + B_ACT);
  const int lane = TX & 63, wv = TX >> 6, wr = wv >> 1, wc = wv & 1, fr = lane & 15, fq = lane >> 4;
  const int nN = 2 * DFF / 128, ntiles = (MT / 128) * nN;
  for (TileIter it = tile_iter(ntiles); it.L < it.Lend; it.L += it.step) {
    int tm, tn;
    tile_mn(it.L, MT / 128, nN, tm, tn);
    const int m0 = tm * 128, n0 = tn * 128;
    f32x4 acc[4][4];
    zero_acc(acc);
    gemm_main<4, 4>(xb, D, wt, D, D, m0, n0, lds, acc);
    const int jb = (n0 + wc * 64 + fq * 16) / 2;
#pragma unroll
    for (int mt = 0; mt < 4; ++mt) {
      const int row = m0 + wr * 64 + mt * 16 + fr;
      f32x4 o0, o1;
#pragma unroll
      for (int i = 0; i < 4; ++i) {
        const float g0 = acc[mt][2][i], g1 = acc[mt][3][i];
        o0[i] = g0 * sigmoidf_(g0) * acc[mt][0][i];
        o1[i] = g1 * sigmoidf_(g1) * acc[mt][1][i];
      }
      *(uint4*)(act + (size_t)row * DFF + jb) = pack8(o0, o1);
    }
  }
}

__global__ void __launch_bounds__(256, 2) fwd_megakernel(Params p) {
  cg::grid_group grid = cg::this_grid();
  __shared__ __attribute__((aligned(1024))) char lds[LDS_BYTES];
  __shared__ int s_item;
  __shared__ uint4 xb_words;
  char* ws = p.ws;
  if (threadIdx.x == 0) xb_words = make_uint4(0u, 0u, 0u, 0u);
  __syncthreads();
  XcdBarrier xb = xcd_barrier_post((unsigned*)(ws + B_BAR), (volatile LAS unsigned*)&xb_words);
  constexpr int NPH = 1 + NL * 11;
#pragma unroll 1
  for (int ph = 0; ph < NPH; ++ph) {
    int phl = ph;
    asm volatile("" : "+s"(phl));
    if (phl == 0) {
      phase_convert(p, lds);
    } else {
      const int l = (phl - 1) / 11, k = (phl - 1) % 11;
      switch (k) {
        case 0: phase_proj(p, l, lds); break;
        case 1: phase_prep(p, l, lds); break;
        case 2: phase_lora(p, l, lds); break;
        case 3: phase_mix(p, l, lds, &s_item); break;
        case 4: phase_post(p, l); break;
        case 5: phase_merge(p, l, lds); break;
        case 6: phase_resid_gemm(p, (const bf16_t*)(ws + B_MIXIN), (const bf16_t*)(ws + W_O) + (size_t)l * D * D, D, lds); break;
        case 7: phase_ln(p, p.in[I_LN1G] + (size_t)l * D, p.in[I_LN1B] + (size_t)l * D, false); break;
        case 8: phase_ffn_in(p, l, lds); break;
        case 9: phase_resid_gemm(p, (const bf16_t*)(ws + B_ACT), (const bf16_t*)(ws + W_FFNOUT) + (size_t)l * D * DFF, DFF, lds); break;
        default: phase_ln(p, p.in[I_LN2G] + (size_t)l * D, p.in[I_LN2B] + (size_t)l * D, l == NL - 1); break;
      }
    }
    if (ph + 1 < NPH) { if (ph == 0) grid.sync(); else xcd_barrier(xb); }
  }
}

extern "C" void kernel_launch(void* const* d_in, const int* in_sizes, int n_in, void* d_out, int out_size, void* d_ws,
                              size_t ws_size, hipStream_t stream) {
  static int grid_blocks = 0;
  if (!grid_blocks) {
    int dev = 0, cus = 0, per_cu = 0;
    (void)hipGetDevice(&dev);
    (void)hipDeviceGetAttribute(&cus, hipDeviceAttributeMultiprocessorCount, dev);
    (void)hipOccupancyMaxActiveBlocksPerMultiprocessor(&per_cu, fwd_megakernel, 256, 0);
    if (per_cu > 2) per_cu = 2;
    if (per_cu < 1) per_cu = 1;
    grid_blocks = cus * per_cu;
  }
  if (ws_size < WS_NEED || n_in < 42) {
    fprintf(stderr, "workspace too small: %zu < %zu\n", ws_size, (size_t)WS_NEED);
    return;
  }
  (void)hipMemsetAsync((char*)d_ws + B_CNT, 0, 256 + BAR_BYTES, stream);
  Params p{};
  for (int i = 0; i < 42; ++i) p.in[i] = (const float*)d_in[i];
  p.out = (float*)d_out;
  p.ws = (char*)d_ws;
  void* args[] = {&p};
  hipError_t e = hipLaunchCooperativeKernel((void*)fwd_megakernel, dim3(grid_blocks), dim3(256), args, 0, stream);
  if (e != hipSuccess) fprintf(stderr, "cooperative launch failed: %s (grid %d)\n", hipGetErrorString(e), grid_blocks);
}
```

```cpp
#include <hip/hip_runtime.h>
#include <hip/hip_cooperative_groups.h>
#include <cstdio>
namespace cg = cooperative_groups;

typedef unsigned short bf16_t;
typedef __attribute__((ext_vector_type(8))) short bf16x8;
typedef __attribute__((ext_vector_type(4))) float f32x4;

constexpr int D = 1024, MP = 16384, MS = 512, MT = 16896, NL = 4;
constexpr int DIN = 7680, DRW = 768, DLRU = 768, DXA = 512, DFF = 2816, RWC = 2560;
constexpr int C_LX = 2560, C_LG = 3328, C_Q = 4096, C_G = 4608;
constexpr int NSEQ = 136;
constexpr float ALPHA = 1.681792830507429f;

constexpr size_t O_Y = 0;
constexpr size_t O_SHP = O_Y + (size_t)MT * D;
constexpr size_t O_WKVP = O_SHP + (size_t)NL * 8 * RWC;
constexpr size_t O_CONVP = O_WKVP + (size_t)NL * 8 * 12 * 64 * 64;
constexpr size_t O_HP = O_CONVP + (size_t)NL * 8 * 3 * DLRU;
constexpr size_t O_MKP = O_HP + (size_t)NL * 8 * DLRU;
constexpr size_t O_MVP = O_MKP + (size_t)NL * 8 * 256 * 512;
constexpr size_t O_SHS = O_MVP + (size_t)NL * 8 * 256 * 512;
constexpr size_t O_WKVS = O_SHS + (size_t)NL * 128 * RWC;
constexpr size_t O_CONVS = O_WKVS + (size_t)NL * 128 * 12 * 64 * 64;
constexpr size_t O_HS = O_CONVS + (size_t)NL * 128 * 3 * DLRU;
constexpr size_t O_END = O_HS + (size_t)NL * 128 * DLRU;

constexpr size_t al256(size_t x) { return (x + 255) & ~(size_t)255; }
constexpr size_t W_IN = 0;
constexpr size_t W_RWOUT = W_IN + al256((size_t)NL * DIN * D * 2);
constexpr size_t W_LRUOUT = W_RWOUT + al256((size_t)NL * D * DRW * 2);
constexpr size_t W_XAOUT = W_LRUOUT + al256((size_t)NL * D * DLRU * 2);
constexpr size_t W_O = W_XAOUT + al256((size_t)NL * D * DXA * 2);
constexpr size_t W_FFNIN = W_O + al256((size_t)NL * D * D * 2);
constexpr size_t W_FFNOUT = W_FFNIN + al256((size_t)NL * 2 * DFF * D * 2);
constexpr size_t W_MEMKV = W_FFNOUT + al256((size_t)NL * D * DFF * 2);
constexpr size_t W_W2T = W_MEMKV + al256((size_t)NL * D * D * 2);
constexpr size_t W_A2T = W_W2T + al256((size_t)NL * DRW * 64 * 2);
constexpr size_t W_G2T = W_A2T + al256((size_t)NL * DRW * 64 * 2);
constexpr size_t W_V2T = W_G2T + al256((size_t)NL * DRW * 128 * 2);
constexpr size_t W_RGT = W_V2T + al256((size_t)3 * DRW * 32 * 2);
constexpr size_t W_IGT = W_RGT + al256((size_t)NL * 12 * 64 * 64 * 2);
constexpr size_t B_XF = W_IGT + al256((size_t)NL * 12 * 64 * 64 * 2);
constexpr size_t B_XB = B_XF + al256((size_t)MT * D * 4);
constexpr size_t B_MEMB = B_XB + al256((size_t)MT * D * 2);
constexpr size_t B_KB = B_MEMB + al256((size_t)2048 * D * 2);
constexpr size_t B_VTB = B_KB + al256((size_t)NL * 8 * 256 * 512 * 2);
constexpr size_t B_VFIRST = B_VTB + al256((size_t)NL * 8 * 256 * 512 * 2);
constexpr size_t B_PROJ = B_VFIRST + al256((size_t)MT * DRW * 2);
constexpr size_t B_SCAN = B_PROJ + al256((size_t)MT * DIN * 2);
constexpr size_t SCAN_BYTES = (size_t)MT * 12 * 896;
constexpr size_t B_MIXIN = B_SCAN;
constexpr size_t B_ACT = B_SCAN + al256((size_t)MT * D * 2);
constexpr size_t B_CBUF = B_SCAN + al256(SCAN_BYTES);
constexpr size_t B_YBUF = B_CBUF + al256((size_t)MT * 12 * 16);
constexpr size_t B_GBUF = B_YBUF + al256((size_t)MT * DRW * 4);
constexpr size_t B_ABUF = B_GBUF + al256((size_t)MT * DRW * 2);
constexpr size_t B_UBUF = B_ABUF + al256((size_t)MT * DLRU * 4);
constexpr size_t B_LBUF = B_UBUF + al256((size_t)MT * DLRU * 4);
constexpr size_t B_VMID = B_LBUF + al256((size_t)MT * 256 * 2);
constexpr size_t B_ARW = B_VMID + al256((size_t)MT * 32 * 2);
constexpr size_t B_ALRU = B_ARW + al256((size_t)MT * DRW * 2);
constexpr size_t B_AXA = B_ALRU + al256((size_t)MT * DLRU * 2);
constexpr size_t B_CNT = B_AXA + al256((size_t)MT * DXA * 2);
constexpr size_t B_BAR = B_CNT + 256;
constexpr size_t BAR_BYTES = 16384;
constexpr size_t W_V1T = B_BAR + BAR_BYTES;
constexpr size_t WS_NEED = W_V1T + al256((size_t)3 * 32 * DRW * 2);
static_assert(al256((size_t)MT * D * 2) + (size_t)MT * DFF * 2 <= SCAN_BYTES, "alias overflow");

enum { I_XP = 0, I_XS, I_MEM, I_SSHIFT, I_SWKV, I_SCONV, I_SH, I_CK, I_CV, I_WIN, I_MU, I_W0, I_W2, I_A0, I_A2,
       I_G2, I_V0, I_V1, I_V2, I_KK, I_KA, I_RK, I_GNG, I_GNB, I_WRWOUT, I_CONVW, I_CONVB, I_WRG, I_BRG, I_WIG,
       I_BIG, I_LAMBDA, I_WLRUOUT, I_WMEMKV, I_WXAOUT, I_WO, I_LN1G, I_LN1B, I_WFFNIN, I_WFFNOUT, I_LN2G, I_LN2B };

struct Params {
  const float* in[42];
  float* out;
  char* ws;
};

constexpr int LDS_BYTES = 65536;

__device__ __forceinline__ bf16_t f2bf(float f) {
  unsigned u = __float_as_uint(f);
  u += 0x7fffu + ((u >> 16) & 1u);
  return (bf16_t)(u >> 16);
}
__device__ __forceinline__ float bf2f(bf16_t h) { return __uint_as_float(((unsigned)h) << 16); }
__device__ __forceinline__ float sigmoidf_(float x) { return 1.f / (1.f + __expf(-x)); }
__device__ __forceinline__ float softplusf_(float x) { return fmaxf(x, 0.f) + log1pf(__expf(-fabsf(x))); }
__device__ __forceinline__ int swz(int rr, int b) { int ob = rr * 64 + b; return ob ^ (((ob >> 9) & 1) << 5); }

__device__ __forceinline__ int tid_() {
  int t = threadIdx.x;
  asm volatile("" : "+v"(t));
  return t;
}
template <int CTRL>
__device__ __forceinline__ float dppf(float x) {
  return __int_as_float(__builtin_amdgcn_update_dpp(0, __float_as_int(x), CTRL, 0xf, 0xf, true));
}
__device__ __forceinline__ float red16_sum(float x) {
  x += dppf<0xB1>(x);
  x += dppf<0x4E>(x);
  x += dppf<0x141>(x);
  x += dppf<0x140>(x);
  return x;
}
__device__ __forceinline__ float red16_max(float x) {
  x = fmaxf(x, dppf<0xB1>(x));
  x = fmaxf(x, dppf<0x4E>(x));
  x = fmaxf(x, dppf<0x141>(x));
  x = fmaxf(x, dppf<0x140>(x));
  return x;
}
__device__ __forceinline__ float wave_sum(float x) {
#pragma unroll
  for (int m = 1; m < 64; m <<= 1) x += __shfl_xor(x, m, 64);
  return x;
}

__device__ __forceinline__ void tok_info(int tok, int& seq, int& t, int& T) {
  if (tok < MP) { seq = tok >> 11; t = tok & 2047; T = 2048; }
  else { int s = tok - MP; seq = 8 + (s >> 2); t = s & 3; T = 4; }
}
__device__ __forceinline__ int seq_tok0(int seq) { return seq < 8 ? seq * 2048 : MP + (seq - 8) * 4; }


#define XB_TMO      128
#define XB_XCNT(j)  (256  + 64 * (j))
#define XB_XSUB(j)  (1280 + 64 * (j))
#define XB_XGEN(j)  (2304 + 64 * (j))
#define XB_TOP      3328
#define XB_TOPGEN   3392
#define XCD_BAR_WORDS 3456
#define XB_SPIN_CAP (1u << 22)
#define LAS __attribute__((address_space(3)))
__device__ __forceinline__ unsigned xb_ld(unsigned* p) { return __hip_atomic_load(p, __ATOMIC_RELAXED, __HIP_MEMORY_SCOPE_AGENT); }
__device__ __forceinline__ unsigned xb_add(unsigned* p, unsigned v) { return __hip_atomic_fetch_add(p, v, __ATOMIC_RELAXED, __HIP_MEMORY_SCOPE_AGENT); }
__device__ __forceinline__ unsigned xb_xcc_id() { return (unsigned)__builtin_amdgcn_s_getreg((3 << 11) | 20) & 0xFu; }
#define XB_SPIN(cond, bar) do { unsigned _sp = 0; while (cond) { __builtin_amdgcn_s_sleep(1); \
    if ((++_sp & 255u) == 0u) { if (xb_ld(&(bar)[XB_TMO])) break; if (_sp > XB_SPIN_CAP) { atomicAdd(&(bar)[XB_TMO], 1u); break; } } } } while (0)
struct XcdBarrier { unsigned* bar; unsigned x; volatile LAS unsigned* st; };
__device__ __forceinline__ XcdBarrier xcd_barrier_post(unsigned* bar, volatile LAS unsigned* st) {
  XcdBarrier b; b.bar = bar; b.x = xb_xcc_id(); b.st = st;
  if (threadIdx.x == 0) (void)xb_add(&bar[XB_XCNT(b.x)], 1u);
  return b;
}
__device__ __forceinline__ void xcd_barrier_complete(unsigned* bar, unsigned x, unsigned& nloc, unsigned& nx) {
  const unsigned G = gridDim.x * gridDim.y * gridDim.z;
  unsigned sum, cnt, mine, sp = 0u;
  for (;;) {
    sum = 0u; cnt = 0u; mine = 0u;
#pragma unroll
    for (unsigned j = 0; j < 16; ++j) { const unsigned c = xb_ld(&bar[XB_XCNT(j)]); sum += c; cnt += (c > 0u) ? 1u : 0u; mine = (j == x) ? c : mine; }
    if (sum == G) break;
    __builtin_amdgcn_s_sleep(1);
    if ((++sp & 255u) == 0u) { if (xb_ld(&bar[XB_TMO])) break; if (sp > XB_SPIN_CAP) { atomicAdd(&bar[XB_TMO], 1u); break; } }
  }
  nloc = mine > 0u ? mine : 1u; nx = cnt > 0u ? cnt : 1u;
}
__device__ __forceinline__ void xcd_barrier(const XcdBarrier& b) {
  asm volatile("s_waitcnt vmcnt(0)" ::: "memory");
  __syncthreads();
  if (threadIdx.x == 0) {
    unsigned* bar = b.bar;
    __builtin_amdgcn_s_waitcnt(0);
    unsigned nloc = b.st[0], nx = b.st[1];
    if (nloc == 0u) { xcd_barrier_complete(bar, b.x, nloc, nx); b.st[0] = nloc; b.st[1] = nx; }
    const unsigned old = xb_add(&bar[XB_XSUB(b.x)], 1u);
    const unsigned gen = old / nloc;
    if (old + 1u == (gen + 1u) * nloc) {
      __builtin_amdgcn_fence(__ATOMIC_RELEASE, "agent");
      asm volatile("s_waitcnt vmcnt(0)" ::: "memory");
      const unsigned og = xb_add(&bar[XB_TOP], 1u);
      const unsigned tg = og / nx;
      if (og + 1u == (tg + 1u) * nx) xb_add(&bar[XB_TOPGEN], 1u);
      else XB_SPIN(xb_ld(&bar[XB_TOPGEN]) == tg, bar);
      __builtin_amdgcn_fence(__ATOMIC_ACQUIRE, "agent");
      xb_add(&bar[XB_XGEN(b.x)], 1u);
      asm volatile("s_waitcnt vmcnt(0)" ::: "memory");
    } else {
      XB_SPIN(xb_ld(&bar[XB_XGEN(b.x)]) == gen, bar);
      __builtin_amdgcn_fence(__ATOMIC_ACQUIRE, "agent");
      asm volatile("s_waitcnt vmcnt(0)" ::: "memory");
    }
  }
  __syncthreads();
}

#define MFMA(a, b, c) __builtin_amdgcn_mfma_f32_16x16x32_bf16((a), (b), (c), 0, 0, 0)

template <int OFF>
__device__ __forceinline__ bf16x8 lds_rd128(unsigned addr) {
  bf16x8 v;
  asm volatile("ds_read_b128 %0, %1 offset:%2" : "=v"(v) : "v"(addr), "n"(OFF));
  return v;
}
template <int MTW, int NTW>
struct GemmCtx {
  const bf16_t* ga;
  const bf16_t* gb;
  int lda, ldb;
};
#define GEMM_STAGE_BYTES(MTW, NTW) (2048 * ((MTW) + (NTW)))
#define GEMM_NLD(MTW, NTW) (((MTW) + (NTW)) / 2)

template <int NTW>
__device__ __forceinline__ int gemm_brow(int s  , int rr  ) {
  return (s / NTW) * (16 * NTW) + (rr >> 2) * (4 * NTW) + (s % NTW) * 4 + (rr & 3);
}
template <int MTW, int NTW>
__device__ __forceinline__ void gemm_issue(const bf16_t* ga, int lda, const bf16_t* gb0, const bf16_t* gb1, int kt, char* wstage) {
#pragma unroll
  for (int j = 0; j < MTW / 2; ++j)
    __builtin_amdgcn_global_load_lds((const unsigned*)(ga + (size_t)(64 * j) * lda + kt * 32), (unsigned*)(wstage + j * 4096), 16, 0, 0);
  __builtin_amdgcn_global_load_lds((const unsigned*)(gb0 + kt * 32), (unsigned*)(wstage + MTW * 2048), 16, 0, 0);
  if constexpr (NTW == 4)
    __builtin_amdgcn_global_load_lds((const unsigned*)(gb1 + kt * 32), (unsigned*)(wstage + MTW * 2048 + 4096), 16, 0, 0);
}

template <int MTW, int NTW>
__device__ __forceinline__ void gemm_prologue(const bf16_t* __restrict__ A, int lda, const bf16_t* __restrict__ Bt, int ldb,
                                              int m0, int n0, char* lds) {
  constexpr int SB = GEMM_STAGE_BYTES(MTW, NTW);
  const int TX = tid_();
  const int lane = TX & 63, wv = TX >> 6;
  const int obs = lane * 16;
  const int ob = obs ^ (((obs >> 9) & 1) << 5);
  const int srow = wv * 16 + (ob >> 6), scol = (ob & 63) >> 1;
  const bf16_t* ga = A + (size_t)(m0 + srow) * lda + scol;
  const bf16_t* gb0 = Bt + (size_t)(n0 + gemm_brow<NTW>(wv, ob >> 6)) * ldb + scol;
  const bf16_t* gb1 = Bt + (size_t)(n0 + gemm_brow<NTW>(wv + 4, ob >> 6)) * ldb + scol;
  char* wbase = lds + wv * 1024;
#pragma unroll
  for (int t = 0; t < 3; ++t) gemm_issue<MTW, NTW>(ga, lda, gb0, gb1, t, wbase + t * SB);
}

template <int MTW, int NTW>
__device__ __forceinline__ void gemm_loop(const bf16_t* __restrict__ A, int lda, const bf16_t* __restrict__ Bt, int ldb,
                                          int K, int m0, int n0, char* lds, f32x4 (&acc)[MTW][NTW]) {
  constexpr int SB = GEMM_STAGE_BYTES(MTW, NTW), NLD = GEMM_NLD(MTW, NTW);
  static_assert(NLD == 4 || NLD == 3, "vmcnt immediates below assume 3 or 4 loads per k-step");
  const int TX = tid_();
  const int lane = TX & 63, wv = TX >> 6;
  const int wr = wv >> 1, wc = wv & 1, fr = lane & 15, fq = lane >> 4;
  const int obs = lane * 16;
  const int ob = obs ^ (((obs >> 9) & 1) << 5);
  const int srow = wv * 16 + (ob >> 6), scol = (ob & 63) >> 1;
  const bf16_t* ga = A + (size_t)(m0 + srow) * lda + scol;
  const bf16_t* gb0 = Bt + (size_t)(n0 + gemm_brow<NTW>(wv, ob >> 6)) * ldb + scol;
  const bf16_t* gb1 = Bt + (size_t)(n0 + gemm_brow<NTW>(wv + 4, ob >> 6)) * ldb + scol;
  char* wbase = lds + wv * 1024;
  const int fo = swz(fr, fq * 16);
  const unsigned lbase = (unsigned)(unsigned long)((__attribute__((address_space(3))) char*)lds);
  const unsigned a_off = lbase + (wr * MTW) * 1024 + fo, b_off = lbase + MTW * 2048 + (wc * NTW) * 1024 + fo;
  const int nk = K >> 5;
  for (int kt = 0; kt < nk; ++kt) {
    if (kt + 2 < nk) { if (NLD == 4) asm volatile("s_waitcnt vmcnt(8)" ::: "memory"); else asm volatile("s_waitcnt vmcnt(6)" ::: "memory"); }
    else if (kt + 1 < nk) { if (NLD == 4) asm volatile("s_waitcnt vmcnt(4)" ::: "memory"); else asm volatile("s_waitcnt vmcnt(3)" ::: "memory"); }
    else asm volatile("s_waitcnt vmcnt(0)" ::: "memory");
    __builtin_amdgcn_s_barrier();
    asm volatile("" ::: "memory");
    static_assert(MTW == 4, "fragment read block below is written for 4 m-tiles per wave");
    const unsigned sa_ = a_off + (kt & 3) * SB, sb_ = b_off + (kt & 3) * SB;
    bf16x8 af[MTW], bfr[NTW];
    af[0] = lds_rd128<0>(sa_); af[1] = lds_rd128<1024>(sa_); af[2] = lds_rd128<2048>(sa_); af[3] = lds_rd128<3072>(sa_);
    bfr[0] = lds_rd128<0>(sb_); bfr[1] = lds_rd128<1024>(sb_);
    if constexpr (NTW == 4) { bfr[2] = lds_rd128<2048>(sb_); bfr[3] = lds_rd128<3072>(sb_); }
    if (kt + 3 < nk) gemm_issue<MTW, NTW>(ga, lda, gb0, gb1, kt + 3, wbase + ((kt + 3) & 3) * SB);
    if constexpr (NTW == 4)
      asm volatile("s_waitcnt lgkmcnt(0)" : "+v"(af[0]), "+v"(af[1]), "+v"(af[2]), "+v"(af[3]), "+v"(bfr[0]), "+v"(bfr[1]), "+v"(bfr[2]), "+v"(bfr[3]) :: "memory");
    else
      asm volatile("s_waitcnt lgkmcnt(0)" : "+v"(af[0]), "+v"(af[1]), "+v"(af[2]), "+v"(af[3]), "+v"(bfr[0]), "+v"(bfr[1]) :: "memory");
#pragma unroll
    for (int mt = 0; mt < MTW; ++mt)
#pragma unroll
      for (int nt = 0; nt < NTW; ++nt) acc[mt][nt] = MFMA(bfr[nt], af[mt], acc[mt][nt]);
  }
  asm volatile("s_waitcnt lgkmcnt(0)" ::: "memory");
  __builtin_amdgcn_s_barrier();
  asm volatile("" ::: "memory");
}

template <int MTW, int NTW>
__device__ __forceinline__ void gemm_main(const bf16_t* __restrict__ A, int lda, const bf16_t* __restrict__ Bt, int ldb,
                                          int K, int m0, int n0, char* lds, f32x4 (&acc)[MTW][NTW]) {
  gemm_prologue<MTW, NTW>(A, lda, Bt, ldb, m0, n0, lds);
  gemm_loop<MTW, NTW>(A, lda, Bt, ldb, K, m0, n0, lds, acc);
}

__device__ __forceinline__ uint4 pack8(const f32x4& a, const f32x4& b) {
  uint4 o;
  o.x = (unsigned)f2bf(a[0]) | ((unsigned)f2bf(a[1]) << 16);
  o.y = (unsigned)f2bf(a[2]) | ((unsigned)f2bf(a[3]) << 16);
  o.z = (unsigned)f2bf(b[0]) | ((unsigned)f2bf(b[1]) << 16);
  o.w = (unsigned)f2bf(b[2]) | ((unsigned)f2bf(b[3]) << 16);
  return o;
}

struct TileIter {
  int L, Lend, step;
};
__device__ __forceinline__ TileIter tile_iter(int ntiles) {
  const int G = (int)gridDim.x, b = (int)blockIdx.x;
  TileIter it;
  if ((G & 7) == 0) {
    const int tpx = (ntiles + 7) >> 3, x = b & 7;
    it.L = x * tpx + (b >> 3);
    it.Lend = min(ntiles, (x + 1) * tpx);
    it.step = G >> 3;
  } else {
    it.L = b; it.Lend = ntiles; it.step = G;
  }
  return it;
}
__device__ __forceinline__ void tile_mn(int L, int nM, int nN, int& m, int& n) {
  const int full = (nM >> 3) * 8 * nN;
  if (L < full) {
    const int band = L / (8 * nN), r = L % (8 * nN);
    n = r >> 3; m = band * 8 + (r & 7);
  } else {
    const int rem = nM & 7, r = L - full;
    n = r / rem; m = (nM >> 3) * 8 + r % rem;
  }
}

template <int MTW, int NTW>
__device__ __forceinline__ void zero_acc(f32x4 (&acc)[MTW][NTW]) {
#pragma unroll
  for (int a = 0; a < MTW; ++a)
#pragma unroll
    for (int b = 0; b < NTW; ++b) acc[a][b] = f32x4{0.f, 0.f, 0.f, 0.f};
}

__device__ void transpose_tile(const float* __restrict__ W, int ldw, bf16_t* __restrict__ Wt, int ldt, int k0, int n0,
                               int perm, char* lds) {
  const int TX = tid_();
  float* tile = (float*)lds;
  const int tid = TX;
  const int c = tid & 63, r0 = tid >> 6;
#pragma unroll
  for (int r = 0; r < 16; ++r) {
    int row = r * 4 + r0;
    tile[row * 65 + c] = W[(size_t)(k0 + row) * ldw + n0 + c];
  }
  __syncthreads();
#pragma unroll
  for (int r = 0; r < 16; ++r) {
    int n = n0 + r * 4 + r0;
    int np = n;
    if (perm) {
      if (n < DFF) np = (n >> 3) * 16 + (n & 7);
      else { int j = n - DFF; np = (j >> 3) * 16 + 8 + (j & 7); }
    }
    Wt[(size_t)np * ldt + k0 + c] = f2bf(tile[c * 65 + (r * 4 + r0)]);
  }
  __syncthreads();
}

__device__ __forceinline__ void convert_job(const float* __restrict__ src, bf16_t* __restrict__ dst, int K, int N, int nmat,
                                            int perm, int& start, char* lds) {
  const int tk = K / 64, tn = N / 64;
  const int ntiles = nmat * tk * tn;
  const int G = (int)gridDim.x;
  const int first = (((int)blockIdx.x - start) % G + G) % G;
  for (int i = first; i < ntiles; i += G) {
    const int mat = i / (tk * tn), r = i % (tk * tn);
    const int kt = r / tn, nt = r % tn;
    transpose_tile(src + (size_t)mat * K * N, N, dst + (size_t)mat * K * N, K, kt * 64, nt * 64, perm, lds);
  }
  start += ntiles;
}

__device__ void phase_convert(const Params& p, char* lds) {
  const int TX = tid_();
  char* ws = p.ws;
  int start = 0;
  convert_job(p.in[I_WIN], (bf16_t*)(ws + W_IN), 1024, 7680, NL, 0, start, lds);
  convert_job(p.in[I_WFFNIN], (bf16_t*)(ws + W_FFNIN), 1024, 5632, NL, 1, start, lds);
  convert_job(p.in[I_WFFNOUT], (bf16_t*)(ws + W_FFNOUT), 2816, 1024, NL, 0, start, lds);
  convert_job(p.in[I_WRWOUT], (bf16_t*)(ws + W_RWOUT), 768, 1024, NL, 0, start, lds);
  convert_job(p.in[I_WLRUOUT], (bf16_t*)(ws + W_LRUOUT), 768, 1024, NL, 0, start, lds);
  convert_job(p.in[I_WXAOUT], (bf16_t*)(ws + W_XAOUT), 512, 1024, NL, 0, start, lds);
  convert_job(p.in[I_WO], (bf16_t*)(ws + W_O), 1024, 1024, NL, 0, start, lds);
  convert_job(p.in[I_WMEMKV], (bf16_t*)(ws + W_MEMKV), 1024, 1024, NL, 0, start, lds);
  convert_job(p.in[I_W2], (bf16_t*)(ws + W_W2T), 64, 768, NL, 0, start, lds);
  convert_job(p.in[I_A2], (bf16_t*)(ws + W_A2T), 64, 768, NL, 0, start, lds);
  convert_job(p.in[I_G2], (bf16_t*)(ws + W_G2T), 128, 768, NL, 0, start, lds);
  convert_job(p.in[I_WRG], (bf16_t*)(ws + W_RGT), 64, 64, NL * 12, 0, start, lds);
  convert_job(p.in[I_WIG], (bf16_t*)(ws + W_IGT), 64, 64, NL * 12, 0, start, lds);
  const size_t gtid = (size_t)blockIdx.x * 256 + TX, gsz = (size_t)gridDim.x * 256;
  {
    float4* xf = (float4*)(ws + B_XF);
    uint2* xb = (uint2*)(ws + B_XB);
    const float4* xp = (const float4*)p.in[I_XP];
    const float4* xs = (const float4*)p.in[I_XS];
    const size_t np4 = (size_t)MP * D / 4, nt4 = (size_t)MT * D / 4;
    for (size_t i = gtid; i < nt4; i += gsz) {
      float4 v = (i < np4) ? xp[i] : xs[i - np4];
      xf[i] = v;
      uint2 o;
      o.x = (unsigned)f2bf(v.x) | ((unsigned)f2bf(v.y) << 16);
      o.y = (unsigned)f2bf(v.z) | ((unsigned)f2bf(v.w) << 16);
      xb[i] = o;
    }
  }
  {
    uint2* mb = (uint2*)(ws + B_MEMB);
    const float4* m = (const float4*)p.in[I_MEM];
    const size_t n4 = (size_t)2048 * D / 4;
    for (size_t i = gtid; i < n4; i += gsz) {
      float4 v = m[i];
      uint2 o;
      o.x = (unsigned)f2bf(v.x) | ((unsigned)f2bf(v.y) << 16);
      o.y = (unsigned)f2bf(v.z) | ((unsigned)f2bf(v.w) << 16);
      mb[i] = o;
    }
  }
  {
    bf16_t* v1t = (bf16_t*)(ws + W_V1T);
    const float* v1 = p.in[I_V1];
    for (size_t i = gtid; i < (size_t)3 * 768 * 32; i += gsz) {
      int j = (int)(i / (768 * 32)), r = (int)(i % (768 * 32));
      int n = r / 768, k = r % 768;
      v1t[i] = f2bf(v1[(size_t)j * 768 * 32 + (size_t)k * 32 + n]);
    }
  }
  {
    bf16_t* v2t = (bf16_t*)(ws + W_V2T);
    const float* v2 = p.in[I_V2];
    for (size_t i = gtid; i < (size_t)3 * 768 * 32; i += gsz) {
      int j = (int)(i / (768 * 32)), r = (int)(i % (768 * 32));
      int n = r / 32, k = r % 32;
      v2t[i] = f2bf(v2[(size_t)j * 32 * 768 + (size_t)k * 768 + n]);
    }
  }
}

struct ProjTile { const bf16_t* A; const bf16_t* Bt; int m0, n0, ll; bool main; };
__device__ __forceinline__ ProjTile proj_tile(const Params& p, int l, int tile, int nextra) {
  char* ws = p.ws;
  ProjTile t;
  if (tile >= nextra) {
    int tm, tn;
    tile_mn(tile - nextra, MT / 128, DIN / 128, tm, tn);
    t.A = (const bf16_t*)(ws + B_XB); t.Bt = (const bf16_t*)(ws + W_IN) + (size_t)l * DIN * D;
    t.m0 = tm * 128; t.n0 = tn * 128; t.ll = l; t.main = true;
  } else {
    const int ll = tile / 128, r = tile % 128;
    t.A = (const bf16_t*)(ws + B_MEMB); t.Bt = (const bf16_t*)(ws + W_MEMKV) + (size_t)ll * D * D;
    t.m0 = (r / 8) * 128; t.n0 = (r % 8) * 128; t.ll = ll; t.main = false;
  }
  return t;
}

__device__ void phase_proj(const Params& p, int l, char* lds) {
  const int TX = tid_();
  char* ws = p.ws;
  bf16_t* proj = (bf16_t*)(ws + B_PROJ);
  const int lane = TX & 63, wv = TX >> 6, wr = wv >> 1, wc = wv & 1, fr = lane & 15, fq = lane >> 4;
  const int ntiles = (MT / 128) * (DIN / 128);
  const int nextra = (l == 0) ? NL * 16 * 8 : 0;
  TileIter it = tile_iter(ntiles + nextra);
  bool have = it.L < it.Lend;
  ProjTile cur;
  if (have) { cur = proj_tile(p, l, it.L, nextra); gemm_prologue<4, 4>(cur.A, D, cur.Bt, D, cur.m0, cur.n0, lds); }
  while (have) {
    f32x4 acc[4][4];
    zero_acc(acc);
    gemm_loop<4, 4>(cur.A, D, cur.Bt, D, D, cur.m0, cur.n0, lds, acc);
    const int Ln = it.L + it.step;
    const bool hn = Ln < it.Lend;
    ProjTile nxt = cur;
    if (hn) { nxt = proj_tile(p, l, Ln, nextra); gemm_prologue<4, 4>(nxt.A, D, nxt.Bt, D, nxt.m0, nxt.n0, lds); }
    const int m0 = cur.m0, n0 = cur.n0;
    if (cur.main) {
#pragma unroll
      for (int mt = 0; mt < 4; ++mt) {
        const int row = m0 + wr * 64 + mt * 16 + fr, col = n0 + wc * 64 + fq * 16;
        uint4* dst = (uint4*)(proj + (size_t)row * DIN + col);
        dst[0] = pack8(acc[mt][0], acc[mt][1]);
        dst[1] = pack8(acc[mt][2], acc[mt][3]);
      }
    } else {
      const int ll = cur.ll;
      bf16_t* kb = (bf16_t*)(ws + B_KB);
      bf16_t* vtb = (bf16_t*)(ws + B_VTB);
#pragma unroll
      for (int mt = 0; mt < 4; ++mt)
#pragma unroll
        for (int nt = 0; nt < 4; ++nt)
#pragma unroll
          for (int i = 0; i < 4; ++i) {
            int row = m0 + wr * 64 + mt * 16 + fr, col = n0 + wc * 64 + fq * 16 + nt * 4 + i;
            int b = row >> 8, key = row & 255;
            float v = acc[mt][nt][i];
            if (col < 512) {
              p.out[O_MKP + ((size_t)(ll * 8 + b) * 256 + key) * 512 + col] = v;
              kb[((size_t)(ll * 8 + b) * 256 + key) * 512 + col] = f2bf(v);
            } else {
              int c2 = col - 512, h = c2 >> 7, d = c2 & 127;
              p.out[O_MVP + ((size_t)(ll * 8 + b) * 256 + key) * 512 + c2] = v;
              vtb[(((size_t)(ll * 8 + b) * 4 + h) * 128 + d) * 256 + key] = f2bf(v);
            }
          }
    }
    it.L = Ln; have = hn; cur = nxt;
  }
}

__device__ __forceinline__ float prw_prev(const Params& p, const bf16_t* proj, int l, int tok, int seq, int t, int c) {
  if (t > 0) return bf2f(proj[(size_t)(tok - 1) * DIN + c]);
  if (seq >= 8) return p.in[I_SSHIFT][((size_t)l * 128 + (seq - 8)) * RWC + c];
  return 0.f;
}
__device__ __forceinline__ float plx_back(const Params& p, const bf16_t* proj, int l, int tok, int seq, int t, int j, int ch) {
  if (t - j >= 0) return bf2f(proj[(size_t)(tok - j) * DIN + C_LX + ch]);
  if (seq >= 8) return p.in[I_SCONV][(((size_t)l * 128 + (seq - 8)) * 3 + (3 + t - j)) * DLRU + ch];
  return 0.f;
}

__device__ __forceinline__ float2 ld_bf2(const bf16_t* p) {
  const unsigned u = *(const unsigned*)p;
  return make_float2(__uint_as_float(u << 16), __uint_as_float(u & 0xffff0000u));
}
__device__ __forceinline__ unsigned pk_bf2(float a, float b) { return (unsigned)f2bf(a) | ((unsigned)f2bf(b) << 16); }
__device__ __forceinline__ float2 prw_prev2(const Params& p, const bf16_t* proj, int l, int tok, int seq, int t, int c) {
  if (t > 0) return ld_bf2(proj + (size_t)(tok - 1) * DIN + c);
  if (seq >= 8) return *(const float2*)(p.in[I_SSHIFT] + ((size_t)l * 128 + (seq - 8)) * RWC + c);
  return make_float2(0.f, 0.f);
}
__device__ __forceinline__ float2 plx_back2(const Params& p, const bf16_t* proj, int l, int tok, int seq, int t, int j, int ch) {
  if (t - j >= 0) return ld_bf2(proj + (size_t)(tok - j) * DIN + C_LX + ch);
  if (seq >= 8) return *(const float2*)(p.in[I_SCONV] + (((size_t)l * 128 + (seq - 8)) * 3 + (3 + t - j)) * DLRU + ch);
  return make_float2(0.f, 0.f);
}

__device__ void phase_prep(const Params& p, int l, char* lds) {
  const int TX = tid_();
  char* ws = p.ws;
  const bf16_t* proj = (const bf16_t*)(ws + B_PROJ);
  bf16_t* L = (bf16_t*)(ws + B_LBUF);
  bf16_t* XC = (bf16_t*)(ws + B_ALRU);
  float* ubuf = (float*)(ws + B_UBUF);
  bf16_t* vmid = (bf16_t*)(ws + B_VMID);
  const float* mu = p.in[I_MU] + (size_t)l * RWC;
  const float* cw = p.in[I_CONVW] + (size_t)l * 4 * DLRU;
  const float* cb = p.in[I_CONVB] + (size_t)l * DLRU;
  const int tid = TX, lane = tid & 63, wv = tid >> 6, fr = lane & 15, fq = lane >> 4;
  for (int item = blockIdx.x; item < MT / 16; item += gridDim.x) {
    const int tokb = item * 16;
#pragma unroll 4
    for (int u = tid; u < 16 * 128; u += 256) {
      const int tk = u >> 7, cp = (u & 127) * 2, tok = tokb + tk, c = 2304 + cp;
      int seq, t, T;
      tok_info(tok, seq, t, T);
      const float2 pc = ld_bf2(proj + (size_t)tok * DIN + c);
      const float2 pp = prw_prev2(p, proj, l, tok, seq, t, c);
      const float2 m2 = *(const float2*)(mu + c);
      const float x0 = pc.x + (pp.x - pc.x) * m2.x, x1 = pc.y + (pp.y - pc.y) * m2.y;
      float o0, o1;
      if (cp < 64) { o0 = tanhf(x0); o1 = tanhf(x1); }
      else if (cp < 128) { o0 = x0; o1 = x1; }
      else { o0 = sigmoidf_(x0); o1 = sigmoidf_(x1); }
      *(unsigned*)(L + (size_t)tok * 256 + cp) = pk_bf2(o0, o1);
    }
#pragma unroll 2
    for (int u = tid; u < 16 * 384; u += 256) {
      const int tk = u / 384, ch = (u % 384) * 2, tok = tokb + tk;
      int seq, t, T;
      tok_info(tok, seq, t, T);
      const float2 x0 = ld_bf2(proj + (size_t)tok * DIN + C_LX + ch);
      const float2 x1 = plx_back2(p, proj, l, tok, seq, t, 1, ch);
      const float2 x2 = plx_back2(p, proj, l, tok, seq, t, 2, ch);
      const float2 x3 = plx_back2(p, proj, l, tok, seq, t, 3, ch);
      const float2 b2 = *(const float2*)(cb + ch), w3 = *(const float2*)(cw + 3 * DLRU + ch), w2 = *(const float2*)(cw + 2 * DLRU + ch),
                   w1 = *(const float2*)(cw + DLRU + ch), w0 = *(const float2*)(cw + ch);
      const float xa = b2.x + w3.x * x0.x + w2.x * x1.x + w1.x * x2.x + w0.x * x3.x;
      const float xb_ = b2.y + w3.y * x0.y + w2.y * x1.y + w1.y * x2.y + w0.y * x3.y;
      *(float2*)(ubuf + (size_t)tok * DLRU + ch) = make_float2(xa, xb_);
      *(unsigned*)(XC + (size_t)tok * DLRU + ch) = pk_bf2(xa, xb_);
      if (t >= T - 3) {
        const size_t o = (seq < 8) ? O_CONVP + (((size_t)l * 8 + seq) * 3 + (t - (T - 3))) * DLRU
                                   : O_CONVS + (((size_t)l * 128 + (seq - 8)) * 3 + (t - (T - 3))) * DLRU;
        *(float2*)(p.out + o + ch) = x0;
      }
      if (l > 0) {
        const int c = 1536 + ch;
        const float2 pc = ld_bf2(proj + (size_t)tok * DIN + c);
        const float2 pp = prw_prev2(p, proj, l, tok, seq, t, c);
        const float2 m2 = *(const float2*)(mu + c);
        const float v0 = pc.x + (pp.x - pc.x) * m2.x, v1 = pc.y + (pp.y - pc.y) * m2.y;
        *(unsigned*)(lds + (ch >> 5) * 1024 + swz(tk, (ch & 31) * 2)) = pk_bf2(v0, v1);
      }
    }
    for (int tk = 0; tk < 16; ++tk) {
      const int tok = tokb + tk;
      int seq, t, T;
      tok_info(tok, seq, t, T);
      if (t == T - 1) {
        const size_t o = (seq < 8) ? O_SHP + ((size_t)l * 8 + seq) * RWC : O_SHS + ((size_t)l * 128 + (seq - 8)) * RWC;
        for (int c = tid * 2; c < RWC; c += 512) *(float2*)(p.out + o + c) = ld_bf2(proj + (size_t)tok * DIN + c);
      }
    }
    if (l > 0) {
      __syncthreads();
      const bf16_t* v1t = (const bf16_t*)(ws + W_V1T) + (size_t)(l - 1) * 32 * DRW;
      f32x4 acc0 = f32x4{0, 0, 0, 0}, acc1 = acc0;
      const int fo = swz(fr, fq * 16);
#pragma unroll
      for (int kk = 0; kk < 6; ++kk) {
        const int ks = wv * 6 + kk;
        const bf16x8 af = *(const bf16x8*)(lds + ks * 1024 + fo);
        const bf16x8 b0 = *(const bf16x8*)(v1t + (size_t)fr * DRW + ks * 32 + fq * 8);
        const bf16x8 b1 = *(const bf16x8*)(v1t + (size_t)(16 + fr) * DRW + ks * 32 + fq * 8);
        acc0 = MFMA(af, b0, acc0);
        acc1 = MFMA(af, b1, acc1);
      }
      float* red = (float*)(lds + 24576);
#pragma unroll
      for (int i = 0; i < 4; ++i) {
        red[(wv * 16 + fq * 4 + i) * 32 + fr] = acc0[i];
        red[(wv * 16 + fq * 4 + i) * 32 + 16 + fr] = acc1[i];
      }
      __syncthreads();
      {
        const int row = tid >> 4, c2 = (tid & 15) * 2;
        float s0 = 0.f, s1 = 0.f;
#pragma unroll
        for (int w = 0; w < 4; ++w) { s0 += red[(w * 16 + row) * 32 + c2]; s1 += red[(w * 16 + row) * 32 + c2 + 1]; }
        *(unsigned*)(vmid + (size_t)(tokb + row) * 32 + c2) = pk_bf2(s0, s1);
      }
      __syncthreads();
    }
  }
}

__device__ __forceinline__ void unpack4(const uint2 q, float (&o)[4]) {
  o[0] = __uint_as_float(q.x << 16); o[1] = __uint_as_float(q.x & 0xffff0000u);
  o[2] = __uint_as_float(q.y << 16); o[3] = __uint_as_float(q.y & 0xffff0000u);
}
__device__ __forceinline__ void prw_prev4(const Params& p, const bf16_t* proj, int l, int tok, int seq, int t, int c, float (&o)[4]) {
  if (t > 0) { unpack4(*(const uint2*)(proj + (size_t)(tok - 1) * DIN + c), o); return; }
  if (seq >= 8) {
    const float4 s = *(const float4*)(p.in[I_SSHIFT] + ((size_t)l * 128 + (seq - 8)) * RWC + c);
    o[0] = s.x; o[1] = s.y; o[2] = s.z; o[3] = s.w;
    return;
  }
  o[0] = 0.f; o[1] = 0.f; o[2] = 0.f; o[3] = 0.f;
}

__device__ void phase_lora(const Params& p, int l, char* lds) {
  const int TX = tid_();
  char* ws = p.ws;
  const bf16_t* proj = (const bf16_t*)(ws + B_PROJ);
  const bf16_t* L = (const bf16_t*)(ws + B_LBUF);
  const bf16_t* vmid = (const bf16_t*)(ws + B_VMID);
  const bf16_t* XC = (const bf16_t*)(ws + B_ALRU);
  const int NRW = (MT / 128) * 12;
  for (int item = blockIdx.x; item < NRW; item += gridDim.x) {
    int txl = TX;
    asm volatile("" : "+v"(txl));
    const int lane = txl & 63, wv = txl >> 6, fr = lane & 15, fq = lane >> 4;
    {
      const int h = item % 12, tb = (item / 12) * 128 + wv * 32;
      const bf16_t* w2t = (const bf16_t*)(ws + W_W2T) + ((size_t)l * DRW + h * 64) * 64;
      const bf16_t* a2t = (const bf16_t*)(ws + W_A2T) + ((size_t)l * DRW + h * 64) * 64;
      const bf16_t* g2t = (const bf16_t*)(ws + W_G2T) + ((size_t)l * DRW + h * 64) * 128;
      bf16_t* gbuf = (bf16_t*)(ws + B_GBUF);
      {
        f32x4 ag[2][4];
#pragma unroll
        for (int a = 0; a < 2; ++a)
#pragma unroll
          for (int b = 0; b < 4; ++b) ag[a][b] = f32x4{0, 0, 0, 0};
#pragma unroll
        for (int ks = 0; ks < 4; ++ks) {
          bf16x8 af[2], bf_[4];
#pragma unroll
          for (int mt = 0; mt < 2; ++mt) af[mt] = *(const bf16x8*)(L + (size_t)(tb + mt * 16 + fr) * 256 + 128 + ks * 32 + fq * 8);
#pragma unroll
          for (int nt = 0; nt < 4; ++nt) bf_[nt] = *(const bf16x8*)(g2t + (size_t)(nt * 16 + fr) * 128 + ks * 32 + fq * 8);
#pragma unroll
          for (int mt = 0; mt < 2; ++mt)
#pragma unroll
            for (int nt = 0; nt < 4; ++nt) ag[mt][nt] = MFMA(af[mt], bf_[nt], ag[mt][nt]);
        }
#pragma unroll
        for (int mt = 0; mt < 2; ++mt)
#pragma unroll
          for (int nt = 0; nt < 4; ++nt)
#pragma unroll
            for (int i = 0; i < 4; ++i)
              gbuf[(size_t)(tb + mt * 16 + fq * 4 + i) * DRW + h * 64 + nt * 16 + fr] = f2bf(ag[mt][nt][i]);
      }
      f32x4 aw[2][4], aa[2][4], av[2][4];
#pragma unroll
      for (int a = 0; a < 2; ++a)
#pragma unroll
        for (int b = 0; b < 4; ++b) { aw[a][b] = f32x4{0, 0, 0, 0}; aa[a][b] = aw[a][b]; av[a][b] = aw[a][b]; }
#pragma unroll
      for (int ks = 0; ks < 2; ++ks) {
        bf16x8 af[2], bf_[4];
#pragma unroll
        for (int mt = 0; mt < 2; ++mt) af[mt] = *(const bf16x8*)(L + (size_t)(tb + mt * 16 + fr) * 256 + ks * 32 + fq * 8);
#pragma unroll
        for (int nt = 0; nt < 4; ++nt) bf_[nt] = *(const bf16x8*)(w2t + (size_t)(nt * 16 + fr) * 64 + ks * 32 + fq * 8);
#pragma unroll
        for (int mt = 0; mt < 2; ++mt)
#pragma unroll
          for (int nt = 0; nt < 4; ++nt) aw[mt][nt] = MFMA(af[mt], bf_[nt], aw[mt][nt]);
#pragma unroll
        for (int mt = 0; mt < 2; ++mt) af[mt] = *(const bf16x8*)(L + (size_t)(tb + mt * 16 + fr) * 256 + 64 + ks * 32 + fq * 8);
#pragma unroll
        for (int nt = 0; nt < 4; ++nt) bf_[nt] = *(const bf16x8*)(a2t + (size_t)(nt * 16 + fr) * 64 + ks * 32 + fq * 8);
#pragma unroll
        for (int mt = 0; mt < 2; ++mt)
#pragma unroll
          for (int nt = 0; nt < 4; ++nt) aa[mt][nt] = MFMA(af[mt], bf_[nt], aa[mt][nt]);
      }
      if (l > 0) {
        const bf16_t* v2t = (const bf16_t*)(ws + W_V2T) + ((size_t)(l - 1) * DRW + h * 64) * 32;
        bf16x8 af[2], bf_[4];
#pragma unroll
        for (int mt = 0; mt < 2; ++mt) af[mt] = *(const bf16x8*)(vmid + (size_t)(tb + mt * 16 + fr) * 32 + fq * 8);
#pragma unroll
        for (int nt = 0; nt < 4; ++nt) bf_[nt] = *(const bf16x8*)(v2t + (size_t)(nt * 16 + fr) * 32 + fq * 8);
#pragma unroll
        for (int mt = 0; mt < 2; ++mt)
#pragma unroll
          for (int nt = 0; nt < 4; ++nt) av[mt][nt] = MFMA(af[mt], bf_[nt], av[mt][nt]);
      }
      const float* mu = p.in[I_MU] + (size_t)l * RWC;
      float mur[4], muk[4], muv[4], w0[4], a0[4], v0[4], kkp[4], kap[4], rkp[4];
#pragma unroll
      for (int nt = 0; nt < 4; ++nt) {
        int c = h * 64 + nt * 16 + fr;
        mur[nt] = mu[c]; muk[nt] = mu[768 + c]; muv[nt] = mu[1536 + c];
        w0[nt] = p.in[I_W0][(size_t)l * DRW + c];
        a0[nt] = p.in[I_A0][(size_t)l * DRW + c];
        v0[nt] = (l > 0) ? p.in[I_V0][(size_t)(l - 1) * DRW + c] : 0.f;
        kkp[nt] = p.in[I_KK][(size_t)l * DRW + c];
        kap[nt] = p.in[I_KA][(size_t)l * DRW + c];
        rkp[nt] = p.in[I_RK][(size_t)l * DRW + c];
      }
      bf16_t* vfirst = (bf16_t*)(ws + B_VFIRST);
      float* cbuf = (float*)(ws + B_CBUF);
      char* scan = ws + B_SCAN;
#pragma unroll
      for (int mt = 0; mt < 2; ++mt)
#pragma unroll
        for (int i = 0; i < 4; ++i) {
          const int tok = tb + mt * 16 + fq * 4 + i;
          int seq, t, T;
          tok_info(tok, seq, t, T);
          const bf16_t* pr = proj + (size_t)tok * DIN;
          float rr[4], kx[4], vv[4], aval[4], dec[4], kkr[4], kmod[4];
          float ss = 0.f, s1 = 0.f, s2 = 0.f, s3 = 0.f;
#pragma unroll
          for (int nt = 0; nt < 4; ++nt) {
            const int cc = nt * 16 + fr, c = h * 64 + cc;
            float pc, pp;
            pc = bf2f(pr[c]); pp = prw_prev(p, proj, l, tok, seq, t, c);
            rr[nt] = pc + (pp - pc) * mur[nt];
            pc = bf2f(pr[768 + c]); pp = prw_prev(p, proj, l, tok, seq, t, 768 + c);
            kx[nt] = pc + (pp - pc) * muk[nt];
            pc = bf2f(pr[1536 + c]); pp = prw_prev(p, proj, l, tok, seq, t, 1536 + c);
            float vx = pc + (pp - pc) * muv[nt];
            float wraw = -softplusf_(-(w0[nt] + aw[mt][nt][i])) - 0.5f;
            dec[nt] = __expf(-__expf(wraw));
            aval[nt] = sigmoidf_(a0[nt] + aa[mt][nt][i]);
            if (l > 0) {
              float vf = bf2f(vfirst[(size_t)tok * DRW + c]);
              vv[nt] = vx + (vf - vx) * sigmoidf_(v0[nt] + av[mt][nt][i]);
            } else {
              vfirst[(size_t)tok * DRW + c] = f2bf(vx);
              vv[nt] = vx;
            }
            kkr[nt] = kx[nt] * kkp[nt];
            kmod[nt] = kx[nt] * (1.f + (aval[nt] - 1.f) * kap[nt]);
            ss += kkr[nt] * kkr[nt];
            s1 += kkr[nt] * aval[nt] * rr[nt];
            s2 += kmod[nt] * rr[nt];
            s3 += rr[nt] * kmod[nt] * rkp[nt];
          }
          ss = red16_sum(ss); s1 = red16_sum(s1); s2 = red16_sum(s2); s3 = red16_sum(s3);
          const float inv = 1.f / fmaxf(sqrtf(ss), 1e-12f);
          char* so = scan + ((size_t)tok * 12 + h) * 896;
#pragma unroll
          for (int nt = 0; nt < 4; ++nt) {
            const int cc = nt * 16 + fr;
            float kkn = kkr[nt] * inv;
            ((float*)so)[cc] = dec[nt];
            ((bf16_t*)(so + 256))[cc] = f2bf(dec[nt] * rr[nt]);
            ((bf16_t*)(so + 384))[cc] = f2bf(-kkn);
            ((bf16_t*)(so + 512))[cc] = f2bf(kkn * aval[nt]);
            ((bf16_t*)(so + 640))[cc] = f2bf(kmod[nt]);
            ((bf16_t*)(so + 768))[cc] = f2bf(vv[nt]);
          }
          if (fr == 0) {
            float4 cv = make_float4(s1 * inv, s2, s3, 0.f);
            *(float4*)(cbuf + ((size_t)tok * 12 + h) * 4) = cv;
          }
        }
    }
  }
  for (int item = NRW + (int)blockIdx.x; item < 2 * NRW; item += gridDim.x) {
    int txl = TX;
    asm volatile("" : "+v"(txl));
    const int lane = txl & 63, wv = txl >> 6, fr = lane & 15, fq = lane >> 4;
    {
      const int it = item - NRW;
      const int nb = it % 12, tb = (it / 12) * 128 + wv * 32;
      const bf16_t* rgt = (const bf16_t*)(ws + W_RGT) + ((size_t)l * 12 + nb) * 4096;
      const bf16_t* igt = (const bf16_t*)(ws + W_IGT) + ((size_t)l * 12 + nb) * 4096;
      const int wrow0 = (fr >> 2) * 16 + (fr & 3);
      f32x4 ar[2][4], ai[2][4];
#pragma unroll
      for (int a = 0; a < 2; ++a)
#pragma unroll
        for (int b = 0; b < 4; ++b) { ar[a][b] = f32x4{0, 0, 0, 0}; ai[a][b] = ar[a][b]; }
#pragma unroll
      for (int ks = 0; ks < 2; ++ks) {
        bf16x8 af[2], b1[4], b2[4];
#pragma unroll
        for (int mt = 0; mt < 2; ++mt) af[mt] = *(const bf16x8*)(XC + (size_t)(tb + mt * 16 + fr) * DLRU + nb * 64 + ks * 32 + fq * 8);
#pragma unroll
        for (int nt = 0; nt < 4; ++nt) {
          b1[nt] = *(const bf16x8*)(rgt + (size_t)(wrow0 + nt * 4) * 64 + ks * 32 + fq * 8);
          b2[nt] = *(const bf16x8*)(igt + (size_t)(wrow0 + nt * 4) * 64 + ks * 32 + fq * 8);
        }
#pragma unroll
        for (int mt = 0; mt < 2; ++mt)
#pragma unroll
          for (int nt = 0; nt < 4; ++nt) {
            ar[mt][nt] = MFMA(b1[nt], af[mt], ar[mt][nt]);
            ai[mt][nt] = MFMA(b2[nt], af[mt], ai[mt][nt]);
          }
      }
      float* abuf = (float*)(ws + B_ABUF);
      float* ubuf = (float*)(ws + B_UBUF);
#pragma unroll
      for (int nt = 0; nt < 4; ++nt) {
        const int c = nb * 64 + fq * 16 + nt * 4;
        const float4 brq = *(const float4*)(p.in[I_BRG] + (size_t)l * DLRU + c), biq = *(const float4*)(p.in[I_BIG] + (size_t)l * DLRU + c);
        const float4 lmq = *(const float4*)(p.in[I_LAMBDA] + (size_t)l * DLRU + c);
        const float br_[4] = {brq.x, brq.y, brq.z, brq.w}, bi_[4] = {biq.x, biq.y, biq.z, biq.w};
        const float sp_[4] = {softplusf_(-lmq.x), softplusf_(-lmq.y), softplusf_(-lmq.z), softplusf_(-lmq.w)};
#pragma unroll
        for (int mt = 0; mt < 2; ++mt) {
          const int tok = tb + mt * 16 + fr;
          const float4 xq = *(const float4*)(ubuf + (size_t)tok * DLRU + c);
          const float xc_[4] = {xq.x, xq.y, xq.z, xq.w};
          float ao[4], uo[4];
#pragma unroll
          for (int i = 0; i < 4; ++i) {
            const float rg = sigmoidf_(ar[mt][nt][i] + br_[i]), ig = sigmoidf_(ai[mt][nt][i] + bi_[i]);
            const float la = -8.f * rg * sp_[i];
            ao[i] = __expf(la);
            uo[i] = sqrtf(fmaxf(-expm1f(2.f * la), 0.f)) * (ig * xc_[i]);
          }
          *(float4*)(abuf + (size_t)tok * DLRU + c) = make_float4(ao[0], ao[1], ao[2], ao[3]);
          *(float4*)(ubuf + (size_t)tok * DLRU + c) = make_float4(uo[0], uo[1], uo[2], uo[3]);
        }
      }
    }
  }
}

constexpr int STEP_B = 1552;
struct WkvOps { float4 w4, r4, n4, b4, k4; float v; float2 cc; };
__device__ __forceinline__ void wkv_load(WkvOps& o, const char* b, int kq, int vrow) {
  o.w4 = *(const float4*)(b + kq * 16);
  o.r4 = *(const float4*)(b + 256 + kq * 16);
  o.n4 = *(const float4*)(b + 512 + kq * 16);
  o.b4 = *(const float4*)(b + 768 + kq * 16);
  o.k4 = *(const float4*)(b + 1024 + kq * 16);
  o.v = *(const float*)(b + 1280 + vrow * 4);
  o.cc = *(const float2*)(b + 1536);
}
__device__ __forceinline__ void wkv_step(const WkvOps& o, float& S0, float& S1, float& S2, float& S3, float& ykeep, bool keep) {
  float sa = S0 * o.n4.x + S1 * o.n4.y + S2 * o.n4.z + S3 * o.n4.w;
  float z = S0 * o.r4.x + S1 * o.r4.y + S2 * o.r4.z + S3 * o.r4.w;
  sa = red16_sum(sa);
  z = red16_sum(z);
  const float y = z + sa * o.cc.x + o.v * o.cc.y;
  ykeep = keep ? y : ykeep;
  S0 = S0 * o.w4.x + (sa * o.b4.x + o.v * o.k4.x);
  S1 = S1 * o.w4.y + (sa * o.b4.y + o.v * o.k4.y);
  S2 = S2 * o.w4.z + (sa * o.b4.z + o.v * o.k4.z);
  S3 = S3 * o.w4.w + (sa * o.b4.w + o.v * o.k4.w);
}

struct WkvStage { uint4 st[4]; float4 cst; };
__device__ __forceinline__ void wkv_stage_load(WkvStage& g, const char* scan, const float* cbuf, int tid, int tok0, int h, int c, int T) {
  const int ns = min(16, T - c * 16);
#pragma unroll
  for (int j = 0; j < 4; ++j) {
    const int u = tid + 256 * j;
    if (u < ns * 56) {
      const int s = u / 56, q = u % 56;
      g.st[j] = *(const uint4*)(scan + ((size_t)(tok0 + c * 16 + s) * 12 + h) * 896 + q * 16);
    }
  }
  if (tid >= 128 && tid < 128 + ns) g.cst = *(const float4*)(cbuf + ((size_t)(tok0 + c * 16 + (tid - 128)) * 12 + h) * 4);
}
__device__ __forceinline__ void wkv_stage_write(const WkvStage& g, char* buf, int tid, int c, int T) {
  const int ns = min(16, T - c * 16);
#pragma unroll
  for (int j = 0; j < 4; ++j) {
    const int u = tid + 256 * j;
    if (u < ns * 56) {
      const int s = u / 56, q = u % 56;
      char* base = buf + s * STEP_B;
      if (q < 16) {
        *(uint4*)(base + q * 16) = g.st[j];
      } else {
        float4 lo, hi;
        lo.x = __uint_as_float(g.st[j].x << 16); lo.y = __uint_as_float(g.st[j].x & 0xffff0000u);
        lo.z = __uint_as_float(g.st[j].y << 16); lo.w = __uint_as_float(g.st[j].y & 0xffff0000u);
        hi.x = __uint_as_float(g.st[j].z << 16); hi.y = __uint_as_float(g.st[j].z & 0xffff0000u);
        hi.z = __uint_as_float(g.st[j].w << 16); hi.w = __uint_as_float(g.st[j].w & 0xffff0000u);
        const int off = 256 + (q - 16) * 32;
        *(float4*)(base + off) = lo;
        *(float4*)(base + off + 16) = hi;
      }
    }
  }
  if (tid >= 128 && tid < 128 + ns) *(float2*)(buf + (tid - 128) * STEP_B + 1536) = make_float2(g.cst.x, g.cst.y);
}
__device__ __forceinline__ void wkv_chunk16(const char* buf, int kq, int vrow, float& S0, float& S1, float& S2, float& S3, float& ykeep) {
  WkvOps oa, ob;
  wkv_load(oa, buf, kq, vrow);
#pragma unroll
  for (int s = 0; s < 16; s += 2) {
    wkv_load(ob, buf + (s + 1) * STEP_B, kq, vrow);
    wkv_step(oa, S0, S1, S2, S3, ykeep, kq == s);
    if (s + 2 < 16) wkv_load(oa, buf + (s + 2) * STEP_B, kq, vrow);
    wkv_step(ob, S0, S1, S2, S3, ykeep, kq == s + 1);
  }
}

__device__ void wkv_scan_item(const Params& p, int l, int seq, int h, int qt, char* lds) {
  const int TX = tid_();
  char* ws = p.ws;
  const int tid = TX, lane = tid & 63, wv = tid >> 6;
  const int kq = lane & 15, rl = lane >> 4;
  const int T = (seq < 8) ? 2048 : 4;
  const int tok0 = seq_tok0(seq);
  const char* scan = ws + B_SCAN;
  const float* cbuf = (const float*)(ws + B_CBUF);
  float* ybuf = (float*)(ws + B_YBUF);
  WkvStage ga, gb;
  float4 sin[4];
  if (seq >= 8) {
#pragma unroll
    for (int q4 = 0; q4 < 4; ++q4)
      sin[q4] = *(const float4*)(p.in[I_SWKV] + ((((size_t)l * 128 + (seq - 8)) * 12 + h) * 64 + q4 * 16 + wv * 4 + rl) * 64 + kq * 4);
  }
  __syncthreads();
  wkv_stage_load(ga, scan, cbuf, tid, tok0, h, 0, T);
  if (seq < 8) wkv_stage_load(gb, scan, cbuf, tid, tok0, h, 1, T);
  wkv_stage_write(ga, lds, tid, 0, T);
  __syncthreads();
  if (seq < 8) {
    constexpr int NCH = 128;
    const int vrow = qt * 16 + wv * 4 + rl;
    float S0 = 0.f, S1 = 0.f, S2 = 0.f, S3 = 0.f;
    char* buf0 = lds;
    char* buf1 = lds + 16 * STEP_B;
#pragma unroll 1
    for (int c = 0; c < NCH; c += 2) {
      if (c + 2 < NCH) wkv_stage_load(ga, scan, cbuf, tid, tok0, h, c + 2, T);
      float ykeep = 0.f;
      wkv_chunk16(buf0, kq, vrow, S0, S1, S2, S3, ykeep);
      ybuf[(size_t)(tok0 + c * 16 + kq) * DRW + h * 64 + vrow] = ykeep;
      wkv_stage_write(gb, buf1, tid, c + 1, T);
      __syncthreads();
      if (c + 3 < NCH) wkv_stage_load(gb, scan, cbuf, tid, tok0, h, c + 3, T);
      ykeep = 0.f;
      wkv_chunk16(buf1, kq, vrow, S0, S1, S2, S3, ykeep);
      ybuf[(size_t)(tok0 + (c + 1) * 16 + kq) * DRW + h * 64 + vrow] = ykeep;
      if (c + 2 < NCH) wkv_stage_write(ga, buf0, tid, c + 2, T);
      __syncthreads();
    }
    *(float4*)(p.out + O_WKVP + ((((size_t)l * 8 + seq) * 12 + h) * 64 + vrow) * 64 + kq * 4) = make_float4(S0, S1, S2, S3);
  } else {
    const int b = seq - 8;
#pragma unroll
    for (int q4 = 0; q4 < 4; ++q4) {
      const int vrow = q4 * 16 + wv * 4 + rl;
      float S0 = sin[q4].x, S1 = sin[q4].y, S2 = sin[q4].z, S3 = sin[q4].w;
      float ykeep = 0.f;
      WkvOps oa, ob;
      wkv_load(oa, lds, kq, vrow);
#pragma unroll
      for (int s2 = 0; s2 < 4; s2 += 2) {
        wkv_load(ob, lds + (s2 + 1) * STEP_B, kq, vrow);
        wkv_step(oa, S0, S1, S2, S3, ykeep, kq == s2);
        if (s2 + 2 < 4) wkv_load(oa, lds + (s2 + 2) * STEP_B, kq, vrow);
        wkv_step(ob, S0, S1, S2, S3, ykeep, kq == s2 + 1);
      }
      if (kq < 4) ybuf[(size_t)(tok0 + kq) * DRW + h * 64 + vrow] = ykeep;
      *(float4*)(p.out + O_WKVS + ((((size_t)l * 128 + b) * 12 + h) * 64 + vrow) * 64 + kq * 4) = make_float4(S0, S1, S2, S3);
    }
    __syncthreads();
  }
}

__device__ void lru_scan_prompt_item(const Params& p, int l, int seq, int cg, char* lds) {
  const int TX = tid_();
  char* ws = p.ws;
  const int ts = TX >> 5, ch = cg * 32 + (TX & 31);
  const float* abuf = (const float*)(ws + B_ABUF);
  float* ubuf = (float*)(ws + B_UBUF);
  const size_t base = ((size_t)seq * 2048 + ts * 256) * DLRU + ch;
  float* sA = (float*)lds;
  float* sU = sA + 256;
  __syncthreads();
  float A = 1.f, U = 0.f;
  for (int t0 = 0; t0 < 256; t0 += 16) {
    float a[16], u[16];
#pragma unroll
    for (int j = 0; j < 16; ++j) {
      a[j] = abuf[base + (size_t)(t0 + j) * DLRU];
      u[j] = ubuf[base + (size_t)(t0 + j) * DLRU];
    }
#pragma unroll
    for (int j = 0; j < 16; ++j) { U = a[j] * U + u[j]; A *= a[j]; }
  }
  sA[TX] = A;
  sU[TX] = U;
  __syncthreads();
  float h = 0.f;
  for (int j = 0; j < ts; ++j) h = sA[j * 32 + (TX & 31)] * h + sU[j * 32 + (TX & 31)];
  {
    float a[16], u[16], an[16], un[16];
#pragma unroll
    for (int j = 0; j < 16; ++j) {
      a[j] = abuf[base + (size_t)j * DLRU];
      u[j] = ubuf[base + (size_t)j * DLRU];
    }
    for (int t0 = 0; t0 < 256; t0 += 16) {
      if (t0 + 16 < 256) {
#pragma unroll
        for (int j = 0; j < 16; ++j) {
          an[j] = abuf[base + (size_t)(t0 + 16 + j) * DLRU];
          un[j] = ubuf[base + (size_t)(t0 + 16 + j) * DLRU];
        }
      }
#pragma unroll
      for (int j = 0; j < 16; ++j) {
        h = a[j] * h + u[j];
        ubuf[base + (size_t)(t0 + j) * DLRU] = h;
      }
#pragma unroll
      for (int j = 0; j < 16; ++j) { a[j] = an[j]; u[j] = un[j]; }
    }
  }
  if (ts == 7) p.out[O_HP + ((size_t)l * 8 + seq) * DLRU + ch] = h;
  __syncthreads();
}

__device__ void lru_scan_item(const Params& p, int l, int seq, int cg3) {
  const int TX = tid_();
  char* ws = p.ws;
  const int ch = cg3 * 256 + TX;
  const int tok0 = seq_tok0(seq);
  const float* abuf = (const float*)(ws + B_ABUF);
  float* ubuf = (float*)(ws + B_UBUF);
  float h = p.in[I_SH][((size_t)l * 128 + (seq - 8)) * DLRU + ch];
  float a[4], u[4];
#pragma unroll
  for (int j = 0; j < 4; ++j) {
    a[j] = abuf[(size_t)(tok0 + j) * DLRU + ch];
    u[j] = ubuf[(size_t)(tok0 + j) * DLRU + ch];
  }
#pragma unroll
  for (int j = 0; j < 4; ++j) {
    h = a[j] * h + u[j];
    ubuf[(size_t)(tok0 + j) * DLRU + ch] = h;
  }
  p.out[O_HS + ((size_t)l * 128 + (seq - 8)) * DLRU + ch] = h;
}

__device__ void attn_prompt_item(const Params& p, int l, int b, int h, int qt, char* lds) {
  const int TX = tid_();
  char* ws = p.ws;
  const int lane = TX & 63, wv = TX >> 6, fr = lane & 15, fq = lane >> 4;
  const bf16_t* proj = (const bf16_t*)(ws + B_PROJ);
  const bf16_t* kb = (const bf16_t*)(ws + B_KB) + ((size_t)(l * 8 + b) * 256) * 512 + h * 128;
  const bf16_t* vt = (const bf16_t*)(ws + B_VTB) + (((size_t)(l * 8 + b) * 4 + h) * 128) * 256;
  bf16_t* axa = (bf16_t*)(ws + B_AXA);
  const int tok0 = b * 2048 + qt * 64 + wv * 16;
  bf16x8 aq[4];
#pragma unroll
  for (int ks = 0; ks < 4; ++ks) aq[ks] = *(const bf16x8*)(proj + (size_t)(tok0 + fr) * DIN + C_Q + h * 128 + ks * 32 + fq * 8);
  f32x4 s[16];
#pragma unroll
  for (int nt = 0; nt < 16; ++nt) {
    s[nt] = f32x4{0, 0, 0, 0};
#pragma unroll
    for (int ks = 0; ks < 4; ++ks) {
      bf16x8 bk = *(const bf16x8*)(kb + (size_t)(nt * 16 + fr) * 512 + ks * 32 + fq * 8);
      s[nt] = MFMA(aq[ks], bk, s[nt]);
    }
  }
  const float scale = 0.08838834764831845f;
  float rs[4];
  char* pl = lds + wv * 8192;
  __syncthreads();
#pragma unroll
  for (int i = 0; i < 4; ++i) {
    float m = s[0][i];
#pragma unroll
    for (int nt = 1; nt < 16; ++nt) m = fmaxf(m, s[nt][i]);
    m = red16_max(m);
    float sum = 0.f;
#pragma unroll
    for (int nt = 0; nt < 16; ++nt) {
      float e = __expf((s[nt][i] - m) * scale);
      sum += e;
      const int key = nt * 16 + fr, rr = fq * 4 + i;
      *(bf16_t*)(pl + (key >> 5) * 1024 + swz(rr, (key & 31) * 2)) = f2bf(e);
    }
    rs[i] = red16_sum(sum);
  }
  __syncthreads();
  f32x4 o[8];
#pragma unroll
  for (int nt = 0; nt < 8; ++nt) o[nt] = f32x4{0, 0, 0, 0};
  const int fo = swz(fr, fq * 16);
#pragma unroll
  for (int ks = 0; ks < 8; ++ks) {
    bf16x8 ap = *(const bf16x8*)(pl + ks * 1024 + fo);
#pragma unroll
    for (int nt = 0; nt < 8; ++nt) {
      bf16x8 bv = *(const bf16x8*)(vt + (size_t)(nt * 16 + fr) * 256 + ks * 32 + fq * 8);
      o[nt] = MFMA(ap, bv, o[nt]);
    }
  }
#pragma unroll
  for (int nt = 0; nt < 8; ++nt)
#pragma unroll
    for (int i = 0; i < 4; ++i)
      axa[(size_t)(tok0 + fq * 4 + i) * DXA + h * 128 + nt * 16 + fr] = f2bf(o[nt][i] / rs[i]);
  __syncthreads();
}

__device__ void attn_sample_item(const Params& p, int l, int b, int h, char* lds) {
  const int TX = tid_();
  char* ws = p.ws;
  const int tid = TX, lane = tid & 63, wv = tid >> 6;
  const bf16_t* proj = (const bf16_t*)(ws + B_PROJ);
  bf16_t* axa = (bf16_t*)(ws + B_AXA);
  const int tok0 = MP + b * 4;
  float* q = (float*)lds;
  float* pr = q + 512;
  float* red = pr + 1024;
  float* part = red + 32;
  __syncthreads();
  for (int i = tid; i < 512; i += 256) q[i] = bf2f(proj[(size_t)(tok0 + (i >> 7)) * DIN + C_Q + h * 128 + (i & 127)]);
  __syncthreads();
  const float* kc = p.in[I_CK] + (((size_t)l * 128 + b) * 256 + tid) * 512 + h * 128;
  float s0 = 0.f, s1 = 0.f, s2 = 0.f, s3 = 0.f;
#pragma unroll 4
  for (int d = 0; d < 128; d += 4) {
    const float4 kv = *(const float4*)(kc + d);
    const float4 q0 = *(const float4*)(q + d), q1 = *(const float4*)(q + 128 + d), q2 = *(const float4*)(q + 256 + d),
                 q3 = *(const float4*)(q + 384 + d);
    s0 += kv.x * q0.x + kv.y * q0.y + kv.z * q0.z + kv.w * q0.w;
    s1 += kv.x * q1.x + kv.y * q1.y + kv.z * q1.z + kv.w * q1.w;
    s2 += kv.x * q2.x + kv.y * q2.y + kv.z * q2.z + kv.w * q2.w;
    s3 += kv.x * q3.x + kv.y * q3.y + kv.z * q3.z + kv.w * q3.w;
  }
  const float scale = 0.08838834764831845f;
  s0 *= scale; s1 *= scale; s2 *= scale; s3 *= scale;
  float m0 = s0, m1 = s1, m2 = s2, m3 = s3;
#pragma unroll
  for (int m = 1; m < 64; m <<= 1) {
    m0 = fmaxf(m0, __shfl_xor(m0, m, 64)); m1 = fmaxf(m1, __shfl_xor(m1, m, 64));
    m2 = fmaxf(m2, __shfl_xor(m2, m, 64)); m3 = fmaxf(m3, __shfl_xor(m3, m, 64));
  }
  if (lane == 0) { red[wv * 4 + 0] = m0; red[wv * 4 + 1] = m1; red[wv * 4 + 2] = m2; red[wv * 4 + 3] = m3; }
  __syncthreads();
  m0 = fmaxf(fmaxf(red[0], red[4]), fmaxf(red[8], red[12]));
  m1 = fmaxf(fmaxf(red[1], red[5]), fmaxf(red[9], red[13]));
  m2 = fmaxf(fmaxf(red[2], red[6]), fmaxf(red[10], red[14]));
  m3 = fmaxf(fmaxf(red[3], red[7]), fmaxf(red[11], red[15]));
  const float e0 = __expf(s0 - m0), e1 = __expf(s1 - m1), e2 = __expf(s2 - m2), e3 = __expf(s3 - m3);
  pr[tid] = e0; pr[256 + tid] = e1; pr[512 + tid] = e2; pr[768 + tid] = e3;
  float t0 = wave_sum(e0), t1 = wave_sum(e1), t2 = wave_sum(e2), t3 = wave_sum(e3);
  if (lane == 0) { red[16 + wv * 4 + 0] = t0; red[16 + wv * 4 + 1] = t1; red[16 + wv * 4 + 2] = t2; red[16 + wv * 4 + 3] = t3; }
  __syncthreads();
  const float z0 = red[16] + red[20] + red[24] + red[28], z1 = red[17] + red[21] + red[25] + red[29];
  const float z2 = red[18] + red[22] + red[26] + red[30], z3 = red[19] + red[23] + red[27] + red[31];
  const int d = tid & 127, half = tid >> 7;
  const float* vc = p.in[I_CV] + (((size_t)l * 128 + b) * 256 + half * 128) * 512 + h * 128 + d;
  float o0 = 0.f, o1 = 0.f, o2 = 0.f, o3 = 0.f;
#pragma unroll 8
  for (int k = 0; k < 128; ++k) {
    const float vv = vc[(size_t)k * 512];
    const int key = half * 128 + k;
    o0 += pr[key] * vv; o1 += pr[256 + key] * vv; o2 += pr[512 + key] * vv; o3 += pr[768 + key] * vv;
  }
  if (half == 1) { part[d] = o0; part[128 + d] = o1; part[256 + d] = o2; part[384 + d] = o3; }
  __syncthreads();
  if (half == 0) {
    o0 += part[d]; o1 += part[128 + d]; o2 += part[256 + d]; o3 += part[384 + d];
    axa[(size_t)(tok0 + 0) * DXA + h * 128 + d] = f2bf(o0 / z0);
    axa[(size_t)(tok0 + 1) * DXA + h * 128 + d] = f2bf(o1 / z1);
    axa[(size_t)(tok0 + 2) * DXA + h * 128 + d] = f2bf(o2 / z2);
    axa[(size_t)(tok0 + 3) * DXA + h * 128 + d] = f2bf(o3 / z3);
  }
  __syncthreads();
}

__device__ void phase_mix(const Params& p, int l, char* lds, int* s_item) {
  const int TX = tid_();
  int* cnt = (int*)(p.ws + B_CNT) + l;
  constexpr int N_WKVP = 96 * 4, N_LRUP = 8 * 24, N_ATTP = 1024, N_WKVS = 128 * 12, N_LRUS = 384, N_ATTS = 512;
  constexpr int E1 = N_WKVP, E2 = E1 + N_LRUP, E3 = E2 + N_ATTP, E4 = E3 + N_WKVS, E5 = E4 + N_LRUS, E6 = E5 + N_ATTS;
  for (;;) {
    __syncthreads();
    if (TX == 0) *s_item = atomicAdd(cnt, 1);
    __syncthreads();
    const int it = *s_item;
    if (it >= E6) break;
    if (it < E1) {
      const int qt = it & 3, bh = it >> 2;
      wkv_scan_item(p, l, bh / 12, bh % 12, qt, lds);
    } else if (it < E2) {
      const int j = it - E1;
      lru_scan_prompt_item(p, l, j / 24, j % 24, lds);
    } else if (it < E3) {
      const int j = it - E2;
      attn_prompt_item(p, l, j >> 7, (j >> 5) & 3, j & 31, lds);
    } else if (it < E4) {
      const int j = it - E3;
      wkv_scan_item(p, l, 8 + j / 12, j % 12, -1, lds);
    } else if (it < E5) {
      const int j = it - E4;
      lru_scan_item(p, l, 8 + j / 3, j % 3);
    } else {
      const int j = it - E5;
      attn_sample_item(p, l, j >> 2, j & 3, lds);
    }
  }
}

__device__ void phase_post(const Params& p, int l) {
  const int TX = tid_();
  char* ws = p.ws;
  const int lane = TX & 63, wv = TX >> 6;
  const float* ybuf = (const float*)(ws + B_YBUF);
  const float* cbuf = (const float*)(ws + B_CBUF);
  const bf16_t* gbuf = (const bf16_t*)(ws + B_GBUF);
  const char* scan = ws + B_SCAN;
  const float* hbuf = (const float*)(ws + B_UBUF);
  const bf16_t* proj = (const bf16_t*)(ws + B_PROJ);
  bf16_t* arw = (bf16_t*)(ws + B_ARW);
  bf16_t* alru = (bf16_t*)(ws + B_ALRU);
  const float* gng = p.in[I_GNG] + (size_t)l * DRW;
  const float* gnb = p.in[I_GNB] + (size_t)l * DRW;
  for (int t4 = blockIdx.x; t4 < MT / 4; t4 += gridDim.x) {
    const int tok = t4 * 4 + wv;
#pragma unroll
    for (int ps = 0; ps < 3; ++ps) {
      const int c = ps * 256 + lane * 4, h = c >> 6;
      const float4 y = *(const float4*)(ybuf + (size_t)tok * DRW + c);
      const float mean = red16_sum(y.x + y.y + y.z + y.w) * (1.f / 64.f);
      const float d0 = y.x - mean, d1 = y.y - mean, d2 = y.z - mean, d3 = y.w - mean;
      const float var = red16_sum(d0 * d0 + d1 * d1 + d2 * d2 + d3 * d3) * (1.f / 64.f);
      const float rs = rsqrtf(var + 64e-5f);
      const float4 gg = *(const float4*)(gng + c), gb = *(const float4*)(gnb + c);
      const float c3 = cbuf[((size_t)tok * 12 + h) * 4 + 2];
      const uint2 vq = *(const uint2*)(scan + ((size_t)tok * 12 + h) * 896 + 768 + (c & 63) * 2);
      const uint2 gq = *(const uint2*)(gbuf + (size_t)tok * DRW + c);
      const float v0 = __uint_as_float(vq.x << 16), v1 = __uint_as_float(vq.x & 0xffff0000u);
      const float v2 = __uint_as_float(vq.y << 16), v3 = __uint_as_float(vq.y & 0xffff0000u);
      const float g0 = __uint_as_float(gq.x << 16), g1 = __uint_as_float(gq.x & 0xffff0000u);
      const float g2 = __uint_as_float(gq.y << 16), g3 = __uint_as_float(gq.y & 0xffff0000u);
      uint2 o;
      o.x = pk_bf2((d0 * rs * gg.x + gb.x + c3 * v0) * g0, (d1 * rs * gg.y + gb.y + c3 * v1) * g1);
      o.y = pk_bf2((d2 * rs * gg.z + gb.z + c3 * v2) * g2, (d3 * rs * gg.w + gb.w + c3 * v3) * g3);
      *(uint2*)(arw + (size_t)tok * DRW + c) = o;
      const float4 hv = *(const float4*)(hbuf + (size_t)tok * DLRU + c);
      const uint2 xq = *(const uint2*)(proj + (size_t)tok * DIN + C_LG + c);
      float x[4] = {__uint_as_float(xq.x << 16), __uint_as_float(xq.x & 0xffff0000u), __uint_as_float(xq.y << 16), __uint_as_float(xq.y & 0xffff0000u)};
      float ge[4];
#pragma unroll
      for (int i = 0; i < 4; ++i) {
        const float u = 0.7978845608028654f * (x[i] + 0.044715f * x[i] * x[i] * x[i]);
        const float th = 1.f - 2.f / (1.f + __expf(2.f * u));
        ge[i] = 0.5f * x[i] * (1.f + th);
      }
      uint2 o2;
      o2.x = pk_bf2(hv.x * ge[0], hv.y * ge[1]);
      o2.y = pk_bf2(hv.z * ge[2], hv.w * ge[3]);
      *(uint2*)(alru + (size_t)tok * DLRU + c) = o2;
    }
  }
}

__device__ void phase_merge(const Params& p, int l, char* lds) {
  const int TX = tid_();
  char* ws = p.ws;
  const bf16_t* proj = (const bf16_t*)(ws + B_PROJ);
  bf16_t* mixin = (bf16_t*)(ws + B_MIXIN);
  const int lane = TX & 63, wv = TX >> 6, wr = wv >> 1, wc = wv & 1, fr = lane & 15, fq = lane >> 4;
  const int ntiles = (MT / 128) * 16;
  for (TileIter it = tile_iter(ntiles); it.L < it.Lend; it.L += it.step) {
    int tm, tn;
    tile_mn(it.L, MT / 128, 16, tm, tn);
    const int m0 = tm * 128, n0 = tn * 64;
    f32x4 sum[4][2], acc[4][2];
    zero_acc(sum);
#pragma unroll 1
    for (int br = 0; br < 3; ++br) {
      zero_acc(acc);
      const bf16_t* A; const bf16_t* Bt; int K;
      if (br == 0) { A = (const bf16_t*)(ws + B_ARW); Bt = (const bf16_t*)(ws + W_RWOUT) + (size_t)l * D * DRW; K = DRW; }
      else if (br == 1) { A = (const bf16_t*)(ws + B_ALRU); Bt = (const bf16_t*)(ws + W_LRUOUT) + (size_t)l * D * DLRU; K = DLRU; }
      else { A = (const bf16_t*)(ws + B_AXA); Bt = (const bf16_t*)(ws + W_XAOUT) + (size_t)l * D * DXA; K = DXA; }
      gemm_main<4, 2>(A, K, Bt, K, K, m0, n0, lds, acc);
#pragma unroll
      for (int mt = 0; mt < 4; ++mt) {
        const int row = m0 + wr * 64 + mt * 16 + fr, col = n0 + wc * 32 + fq * 8;
        const uint4 gq = *(const uint4*)(proj + (size_t)row * DIN + C_G + br * D + col);
        const unsigned gw[4] = {gq.x, gq.y, gq.z, gq.w};
#pragma unroll
        for (int nt = 0; nt < 2; ++nt)
#pragma unroll
          for (int i = 0; i < 4; ++i) {
            const unsigned w = gw[nt * 2 + (i >> 1)];
            const float gv = __uint_as_float((i & 1) ? (w & 0xffff0000u) : (w << 16));
            sum[mt][nt][i] += sigmoidf_(gv) * acc[mt][nt][i];
          }
      }
    }
#pragma unroll
    for (int mt = 0; mt < 4; ++mt) {
      const int row = m0 + wr * 64 + mt * 16 + fr, col = n0 + wc * 32 + fq * 8;
      *(uint4*)(mixin + (size_t)row * D + col) = pack8(sum[mt][0], sum[mt][1]);
    }
  }
}

__device__ void phase_resid_gemm(const Params& p, const bf16_t* A, const bf16_t* Bt, int K, char* lds) {
  const int TX = tid_();
  char* ws = p.ws;
  const float* xf = (const float*)(ws + B_XF);
  float* t = p.out + O_Y;
  const int lane = TX & 63, wv = TX >> 6, wr = wv >> 1, wc = wv & 1, fr = lane & 15, fq = lane >> 4;
  const int ntiles = (MT / 128) * 8;
  TileIter it = tile_iter(ntiles);
  bool have = it.L < it.Lend;
  int m0 = 0, n0 = 0;
  if (have) { int tm, tn; tile_mn(it.L, MT / 128, 8, tm, tn); m0 = tm * 128; n0 = tn * 128; gemm_prologue<4, 4>(A, K, Bt, K, m0, n0, lds); }
  while (have) {
    f32x4 acc[4][4];
    zero_acc(acc);
    gemm_loop<4, 4>(A, K, Bt, K, K, m0, n0, lds, acc);
    float4 xv[4][4];
#pragma unroll
    for (int mt = 0; mt < 4; ++mt) {
      const float4* xs = (const float4*)(xf + (size_t)(m0 + wr * 64 + mt * 16 + fr) * D + n0 + wc * 64 + fq * 16);
#pragma unroll
      for (int nt = 0; nt < 4; ++nt) xv[mt][nt] = xs[nt];
    }
    const int Ln = it.L + it.step;
    const bool hn = Ln < it.Lend;
    int m1 = m0, n1 = n0;
    if (hn) { int tm, tn; tile_mn(Ln, MT / 128, 8, tm, tn); m1 = tm * 128; n1 = tn * 128; gemm_prologue<4, 4>(A, K, Bt, K, m1, n1, lds); }
#pragma unroll
    for (int mt = 0; mt < 4; ++mt) {
      float4* ts = (float4*)(t + (size_t)(m0 + wr * 64 + mt * 16 + fr) * D + n0 + wc * 64 + fq * 16);
#pragma unroll
      for (int nt = 0; nt < 4; ++nt)
        ts[nt] = make_float4(ALPHA * xv[mt][nt].x + acc[mt][nt][0], ALPHA * xv[mt][nt].y + acc[mt][nt][1],
                             ALPHA * xv[mt][nt].z + acc[mt][nt][2], ALPHA * xv[mt][nt].w + acc[mt][nt][3]);
    }
    it.L = Ln; have = hn; m0 = m1; n0 = n1;
  }
}

__device__ void phase_ln(const Params& p, const float* g, const float* bta, bool final_out) {
  const int TX = tid_();
  char* ws = p.ws;
  const int lane = TX & 63, wv = TX >> 6;
  float* t = p.out + O_Y;
  float* xf = (float*)(ws + B_XF);
  bf16_t* xb = (bf16_t*)(ws + B_XB);
  for (int r4 = blockIdx.x; r4 < MT / 4; r4 += gridDim.x) {
    const int row = r4 * 4 + wv;
    float4 v[4];
    float s = 0.f;
#pragma unroll
    for (int j = 0; j < 4; ++j) {
      v[j] = *(const float4*)(t + (size_t)row * D + j * 256 + lane * 4);
      s += v[j].x + v[j].y + v[j].z + v[j].w;
    }
    const float mean = wave_sum(s) * (1.f / 1024.f);
    float q = 0.f;
#pragma unroll
    for (int j = 0; j < 4; ++j) {
      v[j].x -= mean; v[j].y -= mean; v[j].z -= mean; v[j].w -= mean;
      q += v[j].x * v[j].x + v[j].y * v[j].y + v[j].z * v[j].z + v[j].w * v[j].w;
    }
    const float rstd = rsqrtf(wave_sum(q) * (1.f / 1024.f) + 1e-5f);
#pragma unroll
    for (int j = 0; j < 4; ++j) {
      const int c = j * 256 + lane * 4;
      const float4 gg = *(const float4*)(g + c), bb = *(const float4*)(bta + c);
      float4 o;
      o.x = v[j].x * rstd * gg.x + bb.x; o.y = v[j].y * rstd * gg.y + bb.y;
      o.z = v[j].z * rstd * gg.z + bb.z; o.w = v[j].w * rstd * gg.w + bb.w;
      if (final_out) {
        *(float4*)(t + (size_t)row * D + c) = o;
      } else {
        *(float4*)(xf + (size_t)row * D + c) = o;
        uint2 ob;
        ob.x = (unsigned)f2bf(o.x) | ((unsigned)f2bf(o.y) << 16);
        ob.y = (unsigned)f2bf(o.z) | ((unsigned)f2bf(o.w) << 16);
        *(uint2*)(xb + (size_t)row * D + c) = ob;
      }
    }
  }
}

__device__ void phase_ffn_in(const Params& p, int l, char* lds) {
  const int TX = tid_();
  char* ws = p.ws;
  const bf16_t* xb = (const bf16_t*)(ws + B_XB);
  const bf16_t* wt = (const bf16_t*)(ws + W_FFNIN) + (size_t)l * 2 * DFF * D;
  bf16_t* act = (bf16_t*)(ws + B_ACT);
  const int lane = TX & 63, wv = TX >> 6, wr = wv >> 1, wc = wv & 1, fr = lane & 15, fq = lane >> 4;
  const int nN = 2 * DFF / 128, ntiles = (MT / 128) * nN;
  TileIter it = tile_iter(ntiles);
  bool have = it.L < it.Lend;
  int m0 = 0, n0 = 0;
  if (have) { int tm, tn; tile_mn(it.L, MT / 128, nN, tm, tn); m0 = tm * 128; n0 = tn * 128; gemm_prologue<4, 4>(xb, D, wt, D, m0, n0, lds); }
  while (have) {
    f32x4 acc[4][4];
    zero_acc(acc);
    gemm_loop<4, 4>(xb, D, wt, D, D, m0, n0, lds, acc);
    const int Ln = it.L + it.step;
    const bool hn = Ln < it.Lend;
    int m1 = m0, n1 = n0;
    if (hn) { int tm, tn; tile_mn(Ln, MT / 128, nN, tm, tn); m1 = tm * 128; n1 = tn * 128; gemm_prologue<4, 4>(xb, D, wt, D, m1, n1, lds); }
    const int jb = (n0 + wc * 64 + fq * 16) / 2;
#pragma unroll
    for (int mt = 0; mt < 4; ++mt) {
      const int row = m0 + wr * 64 + mt * 16 + fr;
      f32x4 o0, o1;
#pragma unroll
      for (int i = 0; i < 4; ++i) {
        const float g0 = acc[mt][2][i], g1 = acc[mt][3][i];
        o0[i] = g0 * sigmoidf_(g0) * acc[mt][0][i];
        o1[i] = g1 * sigmoidf_(g1) * acc[mt][1][i];
      }
      *(uint4*)(act + (size_t)row * DFF + jb) = pack8(o0, o1);
    }
    it.L = Ln; have = hn; m0 = m1; n0 = n1;
  }
}

__global__ void __launch_bounds__(256, 2) fwd_megakernel(Params p) {
  cg::grid_group grid = cg::this_grid();
  __shared__ __attribute__((aligned(1024))) char lds[LDS_BYTES];
  __shared__ int s_item;
  __shared__ uint4 xb_words;
  char* ws = p.ws;
  if (threadIdx.x == 0) xb_words = make_uint4(0u, 0u, 0u, 0u);
  __syncthreads();
  XcdBarrier xb = xcd_barrier_post((unsigned*)(ws + B_BAR), (volatile LAS unsigned*)&xb_words);
  constexpr int NPH = 1 + NL * 11;
#pragma unroll 1
  for (int ph = 0; ph < NPH; ++ph) {
    int phl = ph;
    asm volatile("" : "+s"(phl));
    if (phl == 0) {
      phase_convert(p, lds);
    } else {
      const int l = (phl - 1) / 11, k = (phl - 1) % 11;
      switch (k) {
        case 0: phase_proj(p, l, lds); break;
        case 1: phase_prep(p, l, lds); break;
        case 2: phase_lora(p, l, lds); break;
        case 3: phase_mix(p, l, lds, &s_item); break;
        case 4: phase_post(p, l); break;
        case 5: phase_merge(p, l, lds); break;
        case 6: phase_resid_gemm(p, (const bf16_t*)(ws + B_MIXIN), (const bf16_t*)(ws + W_O) + (size_t)l * D * D, D, lds); break;
        case 7: phase_ln(p, p.in[I_LN1G] + (size_t)l * D, p.in[I_LN1B] + (size_t)l * D, false); break;
        case 8: phase_ffn_in(p, l, lds); break;
        case 9: phase_resid_gemm(p, (const bf16_t*)(ws + B_ACT), (const bf16_t*)(ws + W_FFNOUT) + (size_t)l * D * DFF, DFF, lds); break;
        default: phase_ln(p, p.in[I_LN2G] + (size_t)l * D, p.in[I_LN2B] + (size_t)l * D, l == NL - 1); break;
      }
    }
    if (ph + 1 < NPH) { if (ph == 0) grid.sync(); else xcd_barrier(xb); }
  }
}

extern "C" void kernel_launch(void* const* d_in, const int* in_sizes, int n_in, void* d_out, int out_size, void* d_ws,
                              size_t ws_size, hipStream_t stream) {
  static int grid_blocks = 0;
  if (!grid_blocks) {
    int dev = 0, cus = 0, per_cu = 0;
    (void)hipGetDevice(&dev);
    (void)hipDeviceGetAttribute(&cus, hipDeviceAttributeMultiprocessorCount, dev);
    (void)hipOccupancyMaxActiveBlocksPerMultiprocessor(&per_cu, fwd_megakernel, 256, 0);
    if (per_cu > 2) per_cu = 2;
    if (per_cu < 1) per_cu = 1;
    grid_blocks = cus * per_cu;
  }
  if (ws_size < WS_NEED || n_in < 42) {
    fprintf(stderr, "workspace too small: %zu < %zu\n", ws_size, (size_t)WS_NEED);
    return;
  }
  (void)hipMemsetAsync((char*)d_ws + B_CNT, 0, 256 + BAR_BYTES, stream);
  Params p{};
  for (int i = 0; i < 42; ++i) p.in[i] = (const float*)d_in[i];
  p.out = (float*)d_out;
  p.ws = (char*)d_ws;
  void* args[] = {&p};
  hipError_t e = hipLaunchCooperativeKernel((void*)fwd_megakernel, dim3(grid_blocks), dim3(256), args, 0, stream);
  if (e != hipSuccess) fprintf(stderr, "cooperative launch failed: %s (grid %d)\n", hipGetErrorString(e), grid_blocks);
}
```

```cpp
#include <hip/hip_runtime.h>
#include <hip/hip_cooperative_groups.h>
#include <cstdio>
#include <type_traits>
namespace cg = cooperative_groups;

typedef unsigned short bf16_t;
typedef __attribute__((ext_vector_type(8))) short bf16x8;
typedef __attribute__((ext_vector_type(4))) float f32x4;

constexpr int D = 1024, MP = 16384, MS = 512, MT = 16896, NL = 4;
constexpr int DIN = 7680, DRW = 768, DLRU = 768, DXA = 512, DFF = 2816, RWC = 2560;
constexpr int C_LX = 2560, C_LG = 3328, C_Q = 4096, C_G = 4608;
constexpr int NSEQ = 136;
constexpr float ALPHA = 1.681792830507429f;

constexpr size_t O_Y = 0;
constexpr size_t O_SHP = O_Y + (size_t)MT * D;
constexpr size_t O_WKVP = O_SHP + (size_t)NL * 8 * RWC;
constexpr size_t O_CONVP = O_WKVP + (size_t)NL * 8 * 12 * 64 * 64;
constexpr size_t O_HP = O_CONVP + (size_t)NL * 8 * 3 * DLRU;
constexpr size_t O_MKP = O_HP + (size_t)NL * 8 * DLRU;
constexpr size_t O_MVP = O_MKP + (size_t)NL * 8 * 256 * 512;
constexpr size_t O_SHS = O_MVP + (size_t)NL * 8 * 256 * 512;
constexpr size_t O_WKVS = O_SHS + (size_t)NL * 128 * RWC;
constexpr size_t O_CONVS = O_WKVS + (size_t)NL * 128 * 12 * 64 * 64;
constexpr size_t O_HS = O_CONVS + (size_t)NL * 128 * 3 * DLRU;
constexpr size_t O_END = O_HS + (size_t)NL * 128 * DLRU;

constexpr size_t al256(size_t x) { return (x + 255) & ~(size_t)255; }
constexpr size_t W_IN = 0;
constexpr size_t W_RWOUT = W_IN + al256((size_t)NL * DIN * D * 2);
constexpr size_t W_LRUOUT = W_RWOUT + al256((size_t)NL * D * DRW * 2);
constexpr size_t W_XAOUT = W_LRUOUT + al256((size_t)NL * D * DLRU * 2);
constexpr size_t W_O = W_XAOUT + al256((size_t)NL * D * DXA * 2);
constexpr size_t W_FFNIN = W_O + al256((size_t)NL * D * D * 2);
constexpr size_t W_FFNOUT = W_FFNIN + al256((size_t)NL * 2 * DFF * D * 2);
constexpr size_t W_MEMKV = W_FFNOUT + al256((size_t)NL * D * DFF * 2);
constexpr size_t W_W2T = W_MEMKV + al256((size_t)NL * D * D * 2);
constexpr size_t W_A2T = W_W2T + al256((size_t)NL * DRW * 64 * 2);
constexpr size_t W_G2T = W_A2T + al256((size_t)NL * DRW * 64 * 2);
constexpr size_t W_V2T = W_G2T + al256((size_t)NL * DRW * 128 * 2);
constexpr size_t W_RGT = W_V2T + al256((size_t)3 * DRW * 32 * 2);
constexpr size_t W_IGT = W_RGT + al256((size_t)NL * 12 * 64 * 64 * 2);
constexpr size_t B_XF = W_IGT + al256((size_t)NL * 12 * 64 * 64 * 2);
constexpr size_t B_XB = B_XF + al256((size_t)MT * D * 4);
constexpr size_t B_MEMB = B_XB + al256((size_t)MT * D * 2);
constexpr size_t B_KB = B_MEMB + al256((size_t)2048 * D * 2);
constexpr size_t B_VTB = B_KB + al256((size_t)NL * 8 * 256 * 512 * 2);
constexpr size_t B_VFIRST = B_VTB + al256((size_t)NL * 8 * 256 * 512 * 2);
constexpr size_t B_PROJ = B_VFIRST + al256((size_t)MT * DRW * 2);
constexpr size_t B_SCAN = B_PROJ + al256((size_t)MT * DIN * 2);
constexpr size_t SCAN_BYTES = (size_t)MT * 12 * 896;
constexpr size_t B_MIXIN = B_SCAN;
constexpr size_t B_ACT = B_SCAN + al256((size_t)MT * D * 2);
constexpr size_t B_CBUF = B_SCAN + al256(SCAN_BYTES);
constexpr size_t B_YBUF = B_CBUF + al256((size_t)MT * 12 * 16);
constexpr size_t B_GBUF = B_YBUF + al256((size_t)MT * DRW * 4);
constexpr size_t B_ABUF = B_GBUF + al256((size_t)MT * DRW * 2);
constexpr size_t B_UBUF = B_ABUF + al256((size_t)MT * DLRU * 4);
constexpr size_t B_LBUF = B_UBUF + al256((size_t)MT * DLRU * 4);
constexpr size_t B_VMID = B_LBUF + al256((size_t)MT * 256 * 2);
constexpr size_t B_ARW = B_VMID + al256((size_t)MT * 32 * 2);
constexpr size_t B_ALRU = B_ARW + al256((size_t)MT * DRW * 2);
constexpr size_t B_AXA = B_ALRU + al256((size_t)MT * DLRU * 2);
constexpr size_t B_CNT = B_AXA + al256((size_t)MT * DXA * 2);
constexpr size_t B_BAR = B_CNT + 256;
constexpr size_t BAR_BYTES = 16384;
constexpr size_t W_V1T = B_BAR + BAR_BYTES;
constexpr size_t WS_NEED = W_V1T + al256((size_t)3 * 32 * DRW * 2);
static_assert(al256((size_t)MT * D * 2) + (size_t)MT * DFF * 2 <= SCAN_BYTES, "alias overflow");

enum { I_XP = 0, I_XS, I_MEM, I_SSHIFT, I_SWKV, I_SCONV, I_SH, I_CK, I_CV, I_WIN, I_MU, I_W0, I_W2, I_A0, I_A2,
       I_G2, I_V0, I_V1, I_V2, I_KK, I_KA, I_RK, I_GNG, I_GNB, I_WRWOUT, I_CONVW, I_CONVB, I_WRG, I_BRG, I_WIG,
       I_BIG, I_LAMBDA, I_WLRUOUT, I_WMEMKV, I_WXAOUT, I_WO, I_LN1G, I_LN1B, I_WFFNIN, I_WFFNOUT, I_LN2G, I_LN2B };

struct Params {
  const float* in[42];
  float* out;
  char* ws;
};

constexpr int LDS_BYTES = 65536;

__device__ __forceinline__ bf16_t f2bf(float f) {
  unsigned u = __float_as_uint(f);
  u += 0x7fffu + ((u >> 16) & 1u);
  return (bf16_t)(u >> 16);
}
__device__ __forceinline__ float bf2f(bf16_t h) { return __uint_as_float(((unsigned)h) << 16); }
__device__ __forceinline__ float sigmoidf_(float x) { return 1.f / (1.f + __expf(-x)); }
__device__ __forceinline__ float softplusf_(float x) { return fmaxf(x, 0.f) + log1pf(__expf(-fabsf(x))); }
__device__ __forceinline__ int swz(int rr, int b) { int ob = rr * 64 + b; return ob ^ (((ob >> 9) & 1) << 5); }

__device__ __forceinline__ int tid_() {
  int t = threadIdx.x;
  asm volatile("" : "+v"(t));
  return t;
}
template <int CTRL>
__device__ __forceinline__ float dppf(float x) {
  return __int_as_float(__builtin_amdgcn_update_dpp(0, __float_as_int(x), CTRL, 0xf, 0xf, true));
}
__device__ __forceinline__ float red16_sum(float x) {
  x += dppf<0xB1>(x);
  x += dppf<0x4E>(x);
  x += dppf<0x141>(x);
  x += dppf<0x140>(x);
  return x;
}
__device__ __forceinline__ float red16_max(float x) {
  x = fmaxf(x, dppf<0xB1>(x));
  x = fmaxf(x, dppf<0x4E>(x));
  x = fmaxf(x, dppf<0x141>(x));
  x = fmaxf(x, dppf<0x140>(x));
  return x;
}
__device__ __forceinline__ float wave_sum(float x) {
#pragma unroll
  for (int m = 1; m < 64; m <<= 1) x += __shfl_xor(x, m, 64);
  return x;
}

__device__ __forceinline__ void tok_info(int tok, int& seq, int& t, int& T) {
  if (tok < MP) { seq = tok >> 11; t = tok & 2047; T = 2048; }
  else { int s = tok - MP; seq = 8 + (s >> 2); t = s & 3; T = 4; }
}
__device__ __forceinline__ int seq_tok0(int seq) { return seq < 8 ? seq * 2048 : MP + (seq - 8) * 4; }


#define XB_TMO      128
#define XB_XCNT(j)  (256  + 64 * (j))
#define XB_XSUB(j)  (1280 + 64 * (j))
#define XB_XGEN(j)  (2304 + 64 * (j))
#define XB_TOP      3328
#define XB_TOPGEN   3392
#define XCD_BAR_WORDS 3456
#define XB_SPIN_CAP (1u << 22)
#define LAS __attribute__((address_space(3)))
__device__ __forceinline__ unsigned xb_ld(unsigned* p) { return __hip_atomic_load(p, __ATOMIC_RELAXED, __HIP_MEMORY_SCOPE_AGENT); }
__device__ __forceinline__ unsigned xb_add(unsigned* p, unsigned v) { return __hip_atomic_fetch_add(p, v, __ATOMIC_RELAXED, __HIP_MEMORY_SCOPE_AGENT); }
__device__ __forceinline__ unsigned xb_xcc_id() { return (unsigned)__builtin_amdgcn_s_getreg((3 << 11) | 20) & 0xFu; }
#define XB_SPIN(cond, bar) do { unsigned _sp = 0; while (cond) { __builtin_amdgcn_s_sleep(1); \
    if ((++_sp & 255u) == 0u) { if (xb_ld(&(bar)[XB_TMO])) break; if (_sp > XB_SPIN_CAP) { atomicAdd(&(bar)[XB_TMO], 1u); break; } } } } while (0)
struct XcdBarrier { unsigned* bar; unsigned x; volatile LAS unsigned* st; };
__device__ __forceinline__ XcdBarrier xcd_barrier_post(unsigned* bar, volatile LAS unsigned* st) {
  XcdBarrier b; b.bar = bar; b.x = xb_xcc_id(); b.st = st;
  if (threadIdx.x == 0) (void)xb_add(&bar[XB_XCNT(b.x)], 1u);
  return b;
}
__device__ __forceinline__ void xcd_barrier_complete(unsigned* bar, unsigned x, unsigned& nloc, unsigned& nx) {
  const unsigned G = gridDim.x * gridDim.y * gridDim.z;
  unsigned sum, cnt, mine, sp = 0u;
  for (;;) {
    sum = 0u; cnt = 0u; mine = 0u;
#pragma unroll
    for (unsigned j = 0; j < 16; ++j) { const unsigned c = xb_ld(&bar[XB_XCNT(j)]); sum += c; cnt += (c > 0u) ? 1u : 0u; mine = (j == x) ? c : mine; }
    if (sum == G) break;
    __builtin_amdgcn_s_sleep(1);
    if ((++sp & 255u) == 0u) { if (xb_ld(&bar[XB_TMO])) break; if (sp > XB_SPIN_CAP) { atomicAdd(&bar[XB_TMO], 1u); break; } }
  }
  nloc = mine > 0u ? mine : 1u; nx = cnt > 0u ? cnt : 1u;
}
__device__ __forceinline__ void xcd_barrier(const XcdBarrier& b) {
  asm volatile("s_waitcnt vmcnt(0)" ::: "memory");
  __syncthreads();
  if (threadIdx.x == 0) {
    unsigned* bar = b.bar;
    __builtin_amdgcn_s_waitcnt(0);
    unsigned nloc = b.st[0], nx = b.st[1];
    if (nloc == 0u) { xcd_barrier_complete(bar, b.x, nloc, nx); b.st[0] = nloc; b.st[1] = nx; }
    const unsigned old = xb_add(&bar[XB_XSUB(b.x)], 1u);
    const unsigned gen = old / nloc;
    if (old + 1u == (gen + 1u) * nloc) {
      __builtin_amdgcn_fence(__ATOMIC_RELEASE, "agent");
      asm volatile("s_waitcnt vmcnt(0)" ::: "memory");
      const unsigned og = xb_add(&bar[XB_TOP], 1u);
      const unsigned tg = og / nx;
      if (og + 1u == (tg + 1u) * nx) xb_add(&bar[XB_TOPGEN], 1u);
      else XB_SPIN(xb_ld(&bar[XB_TOPGEN]) == tg, bar);
      __builtin_amdgcn_fence(__ATOMIC_ACQUIRE, "agent");
      xb_add(&bar[XB_XGEN(b.x)], 1u);
      asm volatile("s_waitcnt vmcnt(0)" ::: "memory");
    } else {
      XB_SPIN(xb_ld(&bar[XB_XGEN(b.x)]) == gen, bar);
      __builtin_amdgcn_fence(__ATOMIC_ACQUIRE, "agent");
      asm volatile("s_waitcnt vmcnt(0)" ::: "memory");
    }
  }
  __syncthreads();
}

#define MFMA(a, b, c) __builtin_amdgcn_mfma_f32_16x16x32_bf16((a), (b), (c), 0, 0, 0)

template <int OFF>
__device__ __forceinline__ bf16x8 lds_rd128(unsigned addr) {
  bf16x8 v;
  asm volatile("ds_read_b128 %0, %1 offset:%2" : "=v"(v) : "v"(addr), "n"(OFF));
  return v;
}
template <int MTW, int NTW>
struct GemmCtx {
  const bf16_t* ga;
  const bf16_t* gb;
  int lda, ldb;
};
#define GEMM_STAGE_BYTES(MTW, NTW) (2048 * ((MTW) + (NTW)))
#define GEMM_NLD(MTW, NTW) (((MTW) + (NTW)) / 2)

template <int NTW>
__device__ __forceinline__ int gemm_brow(int s  , int rr  ) {
  return (s / NTW) * (16 * NTW) + (rr >> 2) * (4 * NTW) + (s % NTW) * 4 + (rr & 3);
}
template <int MTW, int NTW>
__device__ __forceinline__ void gemm_issue(const bf16_t* ga, int lda, const bf16_t* gb0, const bf16_t* gb1, int kt, char* wstage) {
#pragma unroll
  for (int j = 0; j < MTW / 2; ++j)
    __builtin_amdgcn_global_load_lds((const unsigned*)(ga + (size_t)(64 * j) * lda + kt * 32), (unsigned*)(wstage + j * 4096), 16, 0, 0);
  __builtin_amdgcn_global_load_lds((const unsigned*)(gb0 + kt * 32), (unsigned*)(wstage + MTW * 2048), 16, 0, 0);
  if constexpr (NTW == 4)
    __builtin_amdgcn_global_load_lds((const unsigned*)(gb1 + kt * 32), (unsigned*)(wstage + MTW * 2048 + 4096), 16, 0, 0);
}

template <int MTW, int NTW>
__device__ __forceinline__ void gemm_prologue(const bf16_t* __restrict__ A, int lda, const bf16_t* __restrict__ Bt, int ldb,
                                              int m0, int n0, char* lds) {
  constexpr int SB = GEMM_STAGE_BYTES(MTW, NTW);
  const int TX = tid_();
  const int lane = TX & 63, wv = TX >> 6;
  const int obs = lane * 16;
  const int ob = obs ^ (((obs >> 9) & 1) << 5);
  const int srow = wv * 16 + (ob >> 6), scol = (ob & 63) >> 1;
  const bf16_t* ga = A + (size_t)(m0 + srow) * lda + scol;
  const bf16_t* gb0 = Bt + (size_t)(n0 + gemm_brow<NTW>(wv, ob >> 6)) * ldb + scol;
  const bf16_t* gb1 = Bt + (size_t)(n0 + gemm_brow<NTW>(wv + 4, ob >> 6)) * ldb + scol;
  char* wbase = lds + wv * 1024;
#pragma unroll
  for (int t = 0; t < 3; ++t) gemm_issue<MTW, NTW>(ga, lda, gb0, gb1, t, wbase + t * SB);
}

template <int MTW, int NTW>
__device__ __forceinline__ void gemm_loop(const bf16_t* __restrict__ A, int lda, const bf16_t* __restrict__ Bt, int ldb,
                                          int K, int m0, int n0, char* lds, f32x4 (&acc)[MTW][NTW]) {
  constexpr int SB = GEMM_STAGE_BYTES(MTW, NTW), NLD = GEMM_NLD(MTW, NTW);
  static_assert(NLD == 4 || NLD == 3, "vmcnt immediates below assume 3 or 4 loads per k-step");
  const int TX = tid_();
  const int lane = TX & 63, wv = TX >> 6;
  const int wr = wv >> 1, wc = wv & 1, fr = lane & 15, fq = lane >> 4;
  const int obs = lane * 16;
  const int ob = obs ^ (((obs >> 9) & 1) << 5);
  const int srow = wv * 16 + (ob >> 6), scol = (ob & 63) >> 1;
  const bf16_t* ga = A + (size_t)(m0 + srow) * lda + scol;
  const bf16_t* gb0 = Bt + (size_t)(n0 + gemm_brow<NTW>(wv, ob >> 6)) * ldb + scol;
  const bf16_t* gb1 = Bt + (size_t)(n0 + gemm_brow<NTW>(wv + 4, ob >> 6)) * ldb + scol;
  char* wbase = lds + wv * 1024;
  const int fo = swz(fr, fq * 16);
  const unsigned lbase = (unsigned)(unsigned long)((__attribute__((address_space(3))) char*)lds);
  const unsigned a_off = lbase + (wr * MTW) * 1024 + fo, b_off = lbase + MTW * 2048 + (wc * NTW) * 1024 + fo;
  const int nk = K >> 5;
  for (int kt = 0; kt < nk; ++kt) {
    if (kt + 2 < nk) { if (NLD == 4) asm volatile("s_waitcnt vmcnt(8)" ::: "memory"); else asm volatile("s_waitcnt vmcnt(6)" ::: "memory"); }
    else if (kt + 1 < nk) { if (NLD == 4) asm volatile("s_waitcnt vmcnt(4)" ::: "memory"); else asm volatile("s_waitcnt vmcnt(3)" ::: "memory"); }
    else asm volatile("s_waitcnt vmcnt(0)" ::: "memory");
    __builtin_amdgcn_s_barrier();
    asm volatile("" ::: "memory");
    static_assert(MTW == 4, "fragment read block below is written for 4 m-tiles per wave");
    const unsigned sa_ = a_off + (kt & 3) * SB, sb_ = b_off + (kt & 3) * SB;
    bf16x8 af[MTW], bfr[NTW];
    af[0] = lds_rd128<0>(sa_); af[1] = lds_rd128<1024>(sa_); af[2] = lds_rd128<2048>(sa_); af[3] = lds_rd128<3072>(sa_);
    bfr[0] = lds_rd128<0>(sb_); bfr[1] = lds_rd128<1024>(sb_);
    if constexpr (NTW == 4) { bfr[2] = lds_rd128<2048>(sb_); bfr[3] = lds_rd128<3072>(sb_); }
    if (kt + 3 < nk) gemm_issue<MTW, NTW>(ga, lda, gb0, gb1, kt + 3, wbase + ((kt + 3) & 3) * SB);
    if constexpr (NTW == 4)
      asm volatile("s_waitcnt lgkmcnt(0)" : "+v"(af[0]), "+v"(af[1]), "+v"(af[2]), "+v"(af[3]), "+v"(bfr[0]), "+v"(bfr[1]), "+v"(bfr[2]), "+v"(bfr[3]) :: "memory");
    else
      asm volatile("s_waitcnt lgkmcnt(0)" : "+v"(af[0]), "+v"(af[1]), "+v"(af[2]), "+v"(af[3]), "+v"(bfr[0]), "+v"(bfr[1]) :: "memory");
#pragma unroll
    for (int mt = 0; mt < MTW; ++mt)
#pragma unroll
      for (int nt = 0; nt < NTW; ++nt) acc[mt][nt] = MFMA(bfr[nt], af[mt], acc[mt][nt]);
  }
  asm volatile("s_waitcnt lgkmcnt(0)" ::: "memory");
  __builtin_amdgcn_s_barrier();
  asm volatile("" ::: "memory");
}

template <int MTW, int NTW>
__device__ __forceinline__ void gemm_main(const bf16_t* __restrict__ A, int lda, const bf16_t* __restrict__ Bt, int ldb,
                                          int K, int m0, int n0, char* lds, f32x4 (&acc)[MTW][NTW]) {
  gemm_prologue<MTW, NTW>(A, lda, Bt, ldb, m0, n0, lds);
  gemm_loop<MTW, NTW>(A, lda, Bt, ldb, K, m0, n0, lds, acc);
}

__device__ __forceinline__ uint4 pack8(const f32x4& a, const f32x4& b) {
  uint4 o;
  o.x = (unsigned)f2bf(a[0]) | ((unsigned)f2bf(a[1]) << 16);
  o.y = (unsigned)f2bf(a[2]) | ((unsigned)f2bf(a[3]) << 16);
  o.z = (unsigned)f2bf(b[0]) | ((unsigned)f2bf(b[1]) << 16);
  o.w = (unsigned)f2bf(b[2]) | ((unsigned)f2bf(b[3]) << 16);
  return o;
}

struct TileIter {
  int L, Lend, step;
};
__device__ __forceinline__ TileIter tile_iter(int ntiles) {
  const int G = (int)gridDim.x, b = (int)blockIdx.x;
  TileIter it;
  if ((G & 7) == 0) {
    const int tpx = (ntiles + 7) >> 3, x = b & 7;
    it.L = x * tpx + (b >> 3);
    it.Lend = min(ntiles, (x + 1) * tpx);
    it.step = G >> 3;
  } else {
    it.L = b; it.Lend = ntiles; it.step = G;
  }
  return it;
}
__device__ __forceinline__ void tile_mn(int L, int nM, int nN, int& m, int& n) {
  const int full = (nM >> 3) * 8 * nN;
  if (L < full) {
    const int band = L / (8 * nN), r = L % (8 * nN);
    n = r >> 3; m = band * 8 + (r & 7);
  } else {
    const int rem = nM & 7, r = L - full;
    n = r / rem; m = (nM >> 3) * 8 + r % rem;
  }
}

template <int MTW, int NTW>
__device__ __forceinline__ void zero_acc(f32x4 (&acc)[MTW][NTW]) {
#pragma unroll
  for (int a = 0; a < MTW; ++a)
#pragma unroll
    for (int b = 0; b < NTW; ++b) acc[a][b] = f32x4{0.f, 0.f, 0.f, 0.f};
}

__device__ void transpose_tile(const float* __restrict__ W, int ldw, bf16_t* __restrict__ Wt, int ldt, int k0, int n0,
                               int perm, char* lds) {
  const int TX = tid_();
  float* tile = (float*)lds;
  const int tid = TX;
  const int c = tid & 63, r0 = tid >> 6;
#pragma unroll
  for (int r = 0; r < 16; ++r) {
    int row = r * 4 + r0;
    tile[row * 65 + c] = W[(size_t)(k0 + row) * ldw + n0 + c];
  }
  __syncthreads();
#pragma unroll
  for (int r = 0; r < 16; ++r) {
    int n = n0 + r * 4 + r0;
    int np = n;
    if (perm) {
      if (n < DFF) np = (n >> 3) * 16 + (n & 7);
      else { int j = n - DFF; np = (j >> 3) * 16 + 8 + (j & 7); }
    }
    Wt[(size_t)np * ldt + k0 + c] = f2bf(tile[c * 65 + (r * 4 + r0)]);
  }
  __syncthreads();
}

__device__ __forceinline__ void convert_job(const float* __restrict__ src, bf16_t* __restrict__ dst, int K, int N, int nmat,
                                            int perm, int& start, char* lds) {
  const int tk = K / 64, tn = N / 64;
  const int ntiles = nmat * tk * tn;
  const int G = (int)gridDim.x;
  const int first = (((int)blockIdx.x - start) % G + G) % G;
  for (int i = first; i < ntiles; i += G) {
    const int mat = i / (tk * tn), r = i % (tk * tn);
    const int kt = r / tn, nt = r % tn;
    transpose_tile(src + (size_t)mat * K * N, N, dst + (size_t)mat * K * N, K, kt * 64, nt * 64, perm, lds);
  }
  start += ntiles;
}

__device__ void phase_convert(const Params& p, char* lds) {
  const int TX = tid_();
  char* ws = p.ws;
  int start = 0;
  convert_job(p.in[I_WIN], (bf16_t*)(ws + W_IN), 1024, 7680, NL, 0, start, lds);
  convert_job(p.in[I_WFFNIN], (bf16_t*)(ws + W_FFNIN), 1024, 5632, NL, 1, start, lds);
  convert_job(p.in[I_WFFNOUT], (bf16_t*)(ws + W_FFNOUT), 2816, 1024, NL, 0, start, lds);
  convert_job(p.in[I_WRWOUT], (bf16_t*)(ws + W_RWOUT), 768, 1024, NL, 0, start, lds);
  convert_job(p.in[I_WLRUOUT], (bf16_t*)(ws + W_LRUOUT), 768, 1024, NL, 0, start, lds);
  convert_job(p.in[I_WXAOUT], (bf16_t*)(ws + W_XAOUT), 512, 1024, NL, 0, start, lds);
  convert_job(p.in[I_WO], (bf16_t*)(ws + W_O), 1024, 1024, NL, 0, start, lds);
  convert_job(p.in[I_WMEMKV], (bf16_t*)(ws + W_MEMKV), 1024, 1024, NL, 0, start, lds);
  convert_job(p.in[I_W2], (bf16_t*)(ws + W_W2T), 64, 768, NL, 0, start, lds);
  convert_job(p.in[I_A2], (bf16_t*)(ws + W_A2T), 64, 768, NL, 0, start, lds);
  convert_job(p.in[I_G2], (bf16_t*)(ws + W_G2T), 128, 768, NL, 0, start, lds);
  convert_job(p.in[I_WRG], (bf16_t*)(ws + W_RGT), 64, 64, NL * 12, 0, start, lds);
  convert_job(p.in[I_WIG], (bf16_t*)(ws + W_IGT), 64, 64, NL * 12, 0, start, lds);
  const size_t gtid = (size_t)blockIdx.x * 256 + TX, gsz = (size_t)gridDim.x * 256;
  {
    float4* xf = (float4*)(ws + B_XF);
    uint2* xb = (uint2*)(ws + B_XB);
    const float4* xp = (const float4*)p.in[I_XP];
    const float4* xs = (const float4*)p.in[I_XS];
    const size_t np4 = (size_t)MP * D / 4, nt4 = (size_t)MT * D / 4;
    for (size_t i = gtid; i < nt4; i += gsz) {
      float4 v = (i < np4) ? xp[i] : xs[i - np4];
      xf[i] = v;
      uint2 o;
      o.x = (unsigned)f2bf(v.x) | ((unsigned)f2bf(v.y) << 16);
      o.y = (unsigned)f2bf(v.z) | ((unsigned)f2bf(v.w) << 16);
      xb[i] = o;
    }
  }
  {
    uint2* mb = (uint2*)(ws + B_MEMB);
    const float4* m = (const float4*)p.in[I_MEM];
    const size_t n4 = (size_t)2048 * D / 4;
    for (size_t i = gtid; i < n4; i += gsz) {
      float4 v = m[i];
      uint2 o;
      o.x = (unsigned)f2bf(v.x) | ((unsigned)f2bf(v.y) << 16);
      o.y = (unsigned)f2bf(v.z) | ((unsigned)f2bf(v.w) << 16);
      mb[i] = o;
    }
  }
  {
    bf16_t* v1t = (bf16_t*)(ws + W_V1T);
    const float* v1 = p.in[I_V1];
    for (size_t i = gtid; i < (size_t)3 * 768 * 32; i += gsz) {
      int j = (int)(i / (768 * 32)), r = (int)(i % (768 * 32));
      int n = r / 768, k = r % 768;
      v1t[i] = f2bf(v1[(size_t)j * 768 * 32 + (size_t)k * 32 + n]);
    }
  }
  {
    bf16_t* v2t = (bf16_t*)(ws + W_V2T);
    const float* v2 = p.in[I_V2];
    for (size_t i = gtid; i < (size_t)3 * 768 * 32; i += gsz) {
      int j = (int)(i / (768 * 32)), r = (int)(i % (768 * 32));
      int n = r / 32, k = r % 32;
      v2t[i] = f2bf(v2[(size_t)j * 32 * 768 + (size_t)k * 768 + n]);
    }
  }
}

struct ProjTile { const bf16_t* A; const bf16_t* Bt; int m0, n0, ll; bool main; };
__device__ __forceinline__ ProjTile proj_tile(const Params& p, int l, int tile, int nextra) {
  char* ws = p.ws;
  ProjTile t;
  if (tile >= nextra) {
    int tm, tn;
    tile_mn(tile - nextra, MT / 128, DIN / 128, tm, tn);
    t.A = (const bf16_t*)(ws + B_XB); t.Bt = (const bf16_t*)(ws + W_IN) + (size_t)l * DIN * D;
    t.m0 = tm * 128; t.n0 = tn * 128; t.ll = l; t.main = true;
  } else {
    const int ll = tile / 128, r = tile % 128;
    t.A = (const bf16_t*)(ws + B_MEMB); t.Bt = (const bf16_t*)(ws + W_MEMKV) + (size_t)ll * D * D;
    t.m0 = (r / 8) * 128; t.n0 = (r % 8) * 128; t.ll = ll; t.main = false;
  }
  return t;
}

__device__ void phase_proj(const Params& p, int l, char* lds) {
  const int TX = tid_();
  char* ws = p.ws;
  bf16_t* proj = (bf16_t*)(ws + B_PROJ);
  const int lane = TX & 63, wv = TX >> 6, wr = wv >> 1, wc = wv & 1, fr = lane & 15, fq = lane >> 4;
  const int ntiles = (MT / 128) * (DIN / 128);
  const int nextra = (l == 0) ? NL * 16 * 8 : 0;
  TileIter it = tile_iter(ntiles + nextra);
  bool have = it.L < it.Lend;
  ProjTile cur;
  if (have) { cur = proj_tile(p, l, it.L, nextra); gemm_prologue<4, 4>(cur.A, D, cur.Bt, D, cur.m0, cur.n0, lds); }
  while (have) {
    f32x4 acc[4][4];
    zero_acc(acc);
    gemm_loop<4, 4>(cur.A, D, cur.Bt, D, D, cur.m0, cur.n0, lds, acc);
    const int Ln = it.L + it.step;
    const bool hn = Ln < it.Lend;
    ProjTile nxt = cur;
    if (hn) { nxt = proj_tile(p, l, Ln, nextra); gemm_prologue<4, 4>(nxt.A, D, nxt.Bt, D, nxt.m0, nxt.n0, lds); }
    const int m0 = cur.m0, n0 = cur.n0;
    if (cur.main) {
#pragma unroll
      for (int mt = 0; mt < 4; ++mt) {
        const int row = m0 + wr * 64 + mt * 16 + fr, col = n0 + wc * 64 + fq * 16;
        uint4* dst = (uint4*)(proj + (size_t)row * DIN + col);
        dst[0] = pack8(acc[mt][0], acc[mt][1]);
        dst[1] = pack8(acc[mt][2], acc[mt][3]);
      }
    } else {
      const int ll = cur.ll;
      bf16_t* kb = (bf16_t*)(ws + B_KB);
      bf16_t* vtb = (bf16_t*)(ws + B_VTB);
#pragma unroll
      for (int mt = 0; mt < 4; ++mt)
#pragma unroll
        for (int nt = 0; nt < 4; ++nt)
#pragma unroll
          for (int i = 0; i < 4; ++i) {
            int row = m0 + wr * 64 + mt * 16 + fr, col = n0 + wc * 64 + fq * 16 + nt * 4 + i;
            int b = row >> 8, key = row & 255;
            float v = acc[mt][nt][i];
            if (col < 512) {
              p.out[O_MKP + ((size_t)(ll * 8 + b) * 256 + key) * 512 + col] = v;
              kb[((size_t)(ll * 8 + b) * 256 + key) * 512 + col] = f2bf(v);
            } else {
              int c2 = col - 512, h = c2 >> 7, d = c2 & 127;
              p.out[O_MVP + ((size_t)(ll * 8 + b) * 256 + key) * 512 + c2] = v;
              vtb[(((size_t)(ll * 8 + b) * 4 + h) * 128 + d) * 256 + key] = f2bf(v);
            }
          }
    }
    it.L = Ln; have = hn; cur = nxt;
  }
}

__device__ __forceinline__ float prw_prev(const Params& p, const bf16_t* proj, int l, int tok, int seq, int t, int c) {
  if (t > 0) return bf2f(proj[(size_t)(tok - 1) * DIN + c]);
  if (seq >= 8) return p.in[I_SSHIFT][((size_t)l * 128 + (seq - 8)) * RWC + c];
  return 0.f;
}
__device__ __forceinline__ float plx_back(const Params& p, const bf16_t* proj, int l, int tok, int seq, int t, int j, int ch) {
  if (t - j >= 0) return bf2f(proj[(size_t)(tok - j) * DIN + C_LX + ch]);
  if (seq >= 8) return p.in[I_SCONV][(((size_t)l * 128 + (seq - 8)) * 3 + (3 + t - j)) * DLRU + ch];
  return 0.f;
}

__device__ __forceinline__ float2 ld_bf2(const bf16_t* p) {
  const unsigned u = *(const unsigned*)p;
  return make_float2(__uint_as_float(u << 16), __uint_as_float(u & 0xffff0000u));
}
__device__ __forceinline__ unsigned pk_bf2(float a, float b) { return (unsigned)f2bf(a) | ((unsigned)f2bf(b) << 16); }
__device__ __forceinline__ float2 prw_prev2(const Params& p, const bf16_t* proj, int l, int tok, int seq, int t, int c) {
  if (t > 0) return ld_bf2(proj + (size_t)(tok - 1) * DIN + c);
  if (seq >= 8) return *(const float2*)(p.in[I_SSHIFT] + ((size_t)l * 128 + (seq - 8)) * RWC + c);
  return make_float2(0.f, 0.f);
}
__device__ __forceinline__ float2 plx_back2(const Params& p, const bf16_t* proj, int l, int tok, int seq, int t, int j, int ch) {
  if (t - j >= 0) return ld_bf2(proj + (size_t)(tok - j) * DIN + C_LX + ch);
  if (seq >= 8) return *(const float2*)(p.in[I_SCONV] + (((size_t)l * 128 + (seq - 8)) * 3 + (3 + t - j)) * DLRU + ch);
  return make_float2(0.f, 0.f);
}

__device__ void phase_prep(const Params& p, int l, char* lds) {
  const int TX = tid_();
  char* ws = p.ws;
  const bf16_t* proj = (const bf16_t*)(ws + B_PROJ);
  bf16_t* L = (bf16_t*)(ws + B_LBUF);
  bf16_t* XC = (bf16_t*)(ws + B_ALRU);
  float* ubuf = (float*)(ws + B_UBUF);
  bf16_t* vmid = (bf16_t*)(ws + B_VMID);
  const float* mu = p.in[I_MU] + (size_t)l * RWC;
  const float* cw = p.in[I_CONVW] + (size_t)l * 4 * DLRU;
  const float* cb = p.in[I_CONVB] + (size_t)l * DLRU;
  const int tid = TX, lane = tid & 63, wv = tid >> 6, fr = lane & 15, fq = lane >> 4;
  for (int item = blockIdx.x; item < MT / 16; item += gridDim.x) {
    const int tokb = item * 16;
    auto body = [&](auto interior_tag) {
    constexpr bool INTR = decltype(interior_tag)::value;
#pragma unroll 8
    for (int u = tid; u < 16 * 128; u += 256) {
      const int tk = u >> 7, cp = (u & 127) * 2, tok = tokb + tk, c = 2304 + cp;
      int seq = 0, t = 16, T = 2048;
      if constexpr (!INTR) tok_info(tok, seq, t, T);
      const float2 pc = ld_bf2(proj + (size_t)tok * DIN + c);
      float2 pp;
      if constexpr (INTR) pp = ld_bf2(proj + (size_t)(tok - 1) * DIN + c); else pp = prw_prev2(p, proj, l, tok, seq, t, c);
      const float2 m2 = *(const float2*)(mu + c);
      const float x0 = pc.x + (pp.x - pc.x) * m2.x, x1 = pc.y + (pp.y - pc.y) * m2.y;
      float o0, o1;
      if (cp < 64) { o0 = tanhf(x0); o1 = tanhf(x1); }
      else if (cp < 128) { o0 = x0; o1 = x1; }
      else { o0 = sigmoidf_(x0); o1 = sigmoidf_(x1); }
      *(unsigned*)(L + (size_t)tok * 256 + cp) = pk_bf2(o0, o1);
    }
#pragma unroll 4
    for (int u = tid; u < 16 * 384; u += 256) {
      const int tk = u / 384, ch = (u % 384) * 2, tok = tokb + tk;
      int seq = 0, t = 16, T = 2048;
      if constexpr (INTR) { seq = tok >> 11; t = tok & 2047; } else tok_info(tok, seq, t, T);
      const float2 x0 = ld_bf2(proj + (size_t)tok * DIN + C_LX + ch);
      float2 x1, x2, x3;
      if constexpr (INTR) {
        x1 = ld_bf2(proj + (size_t)(tok - 1) * DIN + C_LX + ch);
        x2 = ld_bf2(proj + (size_t)(tok - 2) * DIN + C_LX + ch);
        x3 = ld_bf2(proj + (size_t)(tok - 3) * DIN + C_LX + ch);
      } else {
        x1 = plx_back2(p, proj, l, tok, seq, t, 1, ch);
        x2 = plx_back2(p, proj, l, tok, seq, t, 2, ch);
        x3 = plx_back2(p, proj, l, tok, seq, t, 3, ch);
      }
      const float2 b2 = *(const float2*)(cb + ch), w3 = *(const float2*)(cw + 3 * DLRU + ch), w2 = *(const float2*)(cw + 2 * DLRU + ch),
                   w1 = *(const float2*)(cw + DLRU + ch), w0 = *(const float2*)(cw + ch);
      const float xa = b2.x + w3.x * x0.x + w2.x * x1.x + w1.x * x2.x + w0.x * x3.x;
      const float xb_ = b2.y + w3.y * x0.y + w2.y * x1.y + w1.y * x2.y + w0.y * x3.y;
      *(float2*)(ubuf + (size_t)tok * DLRU + ch) = make_float2(xa, xb_);
      *(unsigned*)(XC + (size_t)tok * DLRU + ch) = pk_bf2(xa, xb_);
      if (t >= T - 3) {
        const size_t o = (seq < 8) ? O_CONVP + (((size_t)l * 8 + seq) * 3 + (t - (T - 3))) * DLRU
                                   : O_CONVS + (((size_t)l * 128 + (seq - 8)) * 3 + (t - (T - 3))) * DLRU;
        *(float2*)(p.out + o + ch) = x0;
      }
      if (l > 0) {
        const int c = 1536 + ch;
        const float2 pc = ld_bf2(proj + (size_t)tok * DIN + c);
        float2 pp;
        if constexpr (INTR) pp = ld_bf2(proj + (size_t)(tok - 1) * DIN + c); else pp = prw_prev2(p, proj, l, tok, seq, t, c);
        const float2 m2 = *(const float2*)(mu + c);
        const float v0 = pc.x + (pp.x - pc.x) * m2.x, v1 = pc.y + (pp.y - pc.y) * m2.y;
        *(unsigned*)(lds + (ch >> 5) * 1024 + swz(tk, (ch & 31) * 2)) = pk_bf2(v0, v1);
      }
    }
    };
    if (tokb < MP && (tokb & 2047) != 0) body(std::true_type{}); else body(std::false_type{});
    for (int tk = 0; tk < 16; ++tk) {
      const int tok = tokb + tk;
      int seq, t, T;
      tok_info(tok, seq, t, T);
      if (t == T - 1) {
        const size_t o = (seq < 8) ? O_SHP + ((size_t)l * 8 + seq) * RWC : O_SHS + ((size_t)l * 128 + (seq - 8)) * RWC;
        for (int c = tid * 2; c < RWC; c += 512) *(float2*)(p.out + o + c) = ld_bf2(proj + (size_t)tok * DIN + c);
      }
    }
    if (l > 0) {
      __syncthreads();
      const bf16_t* v1t = (const bf16_t*)(ws + W_V1T) + (size_t)(l - 1) * 32 * DRW;
      f32x4 acc0 = f32x4{0, 0, 0, 0}, acc1 = acc0;
      const int fo = swz(fr, fq * 16);
#pragma unroll
      for (int kk = 0; kk < 6; ++kk) {
        const int ks = wv * 6 + kk;
        const bf16x8 af = *(const bf16x8*)(lds + ks * 1024 + fo);
        const bf16x8 b0 = *(const bf16x8*)(v1t + (size_t)fr * DRW + ks * 32 + fq * 8);
        const bf16x8 b1 = *(const bf16x8*)(v1t + (size_t)(16 + fr) * DRW + ks * 32 + fq * 8);
        acc0 = MFMA(af, b0, acc0);
        acc1 = MFMA(af, b1, acc1);
      }
      float* red = (float*)(lds + 24576);
#pragma unroll
      for (int i = 0; i < 4; ++i) {
        red[(wv * 16 + fq * 4 + i) * 32 + fr] = acc0[i];
        red[(wv * 16 + fq * 4 + i) * 32 + 16 + fr] = acc1[i];
      }
      __syncthreads();
      {
        const int row = tid >> 4, c2 = (tid & 15) * 2;
        float s0 = 0.f, s1 = 0.f;
#pragma unroll
        for (int w = 0; w < 4; ++w) { s0 += red[(w * 16 + row) * 32 + c2]; s1 += red[(w * 16 + row) * 32 + c2 + 1]; }
        *(unsigned*)(vmid + (size_t)(tokb + row) * 32 + c2) = pk_bf2(s0, s1);
      }
      __syncthreads();
    }
  }
}

__device__ __forceinline__ void unpack4(const uint2 q, float (&o)[4]) {
  o[0] = __uint_as_float(q.x << 16); o[1] = __uint_as_float(q.x & 0xffff0000u);
  o[2] = __uint_as_float(q.y << 16); o[3] = __uint_as_float(q.y & 0xffff0000u);
}
__device__ __forceinline__ void prw_prev4(const Params& p, const bf16_t* proj, int l, int tok, int seq, int t, int c, float (&o)[4]) {
  if (t > 0) { unpack4(*(const uint2*)(proj + (size_t)(tok - 1) * DIN + c), o); return; }
  if (seq >= 8) {
    const float4 s = *(const float4*)(p.in[I_SSHIFT] + ((size_t)l * 128 + (seq - 8)) * RWC + c);
    o[0] = s.x; o[1] = s.y; o[2] = s.z; o[3] = s.w;
    return;
  }
  o[0] = 0.f; o[1] = 0.f; o[2] = 0.f; o[3] = 0.f;
}

__device__ void phase_lora(const Params& p, int l, char* lds) {
  const int TX = tid_();
  char* ws = p.ws;
  const bf16_t* proj = (const bf16_t*)(ws + B_PROJ);
  const bf16_t* L = (const bf16_t*)(ws + B_LBUF);
  const bf16_t* vmid = (const bf16_t*)(ws + B_VMID);
  const bf16_t* XC = (const bf16_t*)(ws + B_ALRU);
  const int NRW = (MT / 128) * 12;
  for (int item = blockIdx.x; item < NRW; item += gridDim.x) {
    int txl = TX;
    asm volatile("" : "+v"(txl));
    const int lane = txl & 63, wv = txl >> 6, fr = lane & 15, fq = lane >> 4;
    {
      const int h = item % 12, tb = (item / 12) * 128 + wv * 32;
      const bf16_t* w2t = (const bf16_t*)(ws + W_W2T) + ((size_t)l * DRW + h * 64) * 64;
      const bf16_t* a2t = (const bf16_t*)(ws + W_A2T) + ((size_t)l * DRW + h * 64) * 64;
      const bf16_t* g2t = (const bf16_t*)(ws + W_G2T) + ((size_t)l * DRW + h * 64) * 128;
      bf16_t* gbuf = (bf16_t*)(ws + B_GBUF);
      {
        f32x4 ag[2][4];
#pragma unroll
        for (int a = 0; a < 2; ++a)
#pragma unroll
          for (int b = 0; b < 4; ++b) ag[a][b] = f32x4{0, 0, 0, 0};
#pragma unroll
        for (int ks = 0; ks < 4; ++ks) {
          bf16x8 af[2], bf_[4];
#pragma unroll
          for (int mt = 0; mt < 2; ++mt) af[mt] = *(const bf16x8*)(L + (size_t)(tb + mt * 16 + fr) * 256 + 128 + ks * 32 + fq * 8);
#pragma unroll
          for (int nt = 0; nt < 4; ++nt) bf_[nt] = *(const bf16x8*)(g2t + (size_t)(nt * 16 + fr) * 128 + ks * 32 + fq * 8);
#pragma unroll
          for (int mt = 0; mt < 2; ++mt)
#pragma unroll
            for (int nt = 0; nt < 4; ++nt) ag[mt][nt] = MFMA(af[mt], bf_[nt], ag[mt][nt]);
        }
#pragma unroll
        for (int mt = 0; mt < 2; ++mt)
#pragma unroll
          for (int nt = 0; nt < 4; ++nt)
#pragma unroll
            for (int i = 0; i < 4; ++i)
              gbuf[(size_t)(tb + mt * 16 + fq * 4 + i) * DRW + h * 64 + nt * 16 + fr] = f2bf(ag[mt][nt][i]);
      }
      f32x4 aw[2][4], aa[2][4], av[2][4];
#pragma unroll
      for (int a = 0; a < 2; ++a)
#pragma unroll
        for (int b = 0; b < 4; ++b) { aw[a][b] = f32x4{0, 0, 0, 0}; aa[a][b] = aw[a][b]; av[a][b] = aw[a][b]; }
#pragma unroll
      for (int ks = 0; ks < 2; ++ks) {
        bf16x8 af[2], bf_[4];
#pragma unroll
        for (int mt = 0; mt < 2; ++mt) af[mt] = *(const bf16x8*)(L + (size_t)(tb + mt * 16 + fr) * 256 + ks * 32 + fq * 8);
#pragma unroll
        for (int nt = 0; nt < 4; ++nt) bf_[nt] = *(const bf16x8*)(w2t + (size_t)(nt * 16 + fr) * 64 + ks * 32 + fq * 8);
#pragma unroll
        for (int mt = 0; mt < 2; ++mt)
#pragma unroll
          for (int nt = 0; nt < 4; ++nt) aw[mt][nt] = MFMA(af[mt], bf_[nt], aw[mt][nt]);
#pragma unroll
        for (int mt = 0; mt < 2; ++mt) af[mt] = *(const bf16x8*)(L + (size_t)(tb + mt * 16 + fr) * 256 + 64 + ks * 32 + fq * 8);
#pragma unroll
        for (int nt = 0; nt < 4; ++nt) bf_[nt] = *(const bf16x8*)(a2t + (size_t)(nt * 16 + fr) * 64 + ks * 32 + fq * 8);
#pragma unroll
        for (int mt = 0; mt < 2; ++mt)
#pragma unroll
          for (int nt = 0; nt < 4; ++nt) aa[mt][nt] = MFMA(af[mt], bf_[nt], aa[mt][nt]);
      }
      if (l > 0) {
        const bf16_t* v2t = (const bf16_t*)(ws + W_V2T) + ((size_t)(l - 1) * DRW + h * 64) * 32;
        bf16x8 af[2], bf_[4];
#pragma unroll
        for (int mt = 0; mt < 2; ++mt) af[mt] = *(const bf16x8*)(vmid + (size_t)(tb + mt * 16 + fr) * 32 + fq * 8);
#pragma unroll
        for (int nt = 0; nt < 4; ++nt) bf_[nt] = *(const bf16x8*)(v2t + (size_t)(nt * 16 + fr) * 32 + fq * 8);
#pragma unroll
        for (int mt = 0; mt < 2; ++mt)
#pragma unroll
          for (int nt = 0; nt < 4; ++nt) av[mt][nt] = MFMA(af[mt], bf_[nt], av[mt][nt]);
      }
      const float* mu = p.in[I_MU] + (size_t)l * RWC;
      float mur[4], muk[4], muv[4], w0[4], a0[4], v0[4], kkp[4], kap[4], rkp[4];
#pragma unroll
      for (int nt = 0; nt < 4; ++nt) {
        int c = h * 64 + nt * 16 + fr;
        mur[nt] = mu[c]; muk[nt] = mu[768 + c]; muv[nt] = mu[1536 + c];
        w0[nt] = p.in[I_W0][(size_t)l * DRW + c];
        a0[nt] = p.in[I_A0][(size_t)l * DRW + c];
        v0[nt] = (l > 0) ? p.in[I_V0][(size_t)(l - 1) * DRW + c] : 0.f;
        kkp[nt] = p.in[I_KK][(size_t)l * DRW + c];
        kap[nt] = p.in[I_KA][(size_t)l * DRW + c];
        rkp[nt] = p.in[I_RK][(size_t)l * DRW + c];
      }
      bf16_t* vfirst = (bf16_t*)(ws + B_VFIRST);
      float* cbuf = (float*)(ws + B_CBUF);
      char* scan = ws + B_SCAN;
      auto epi = [&](auto interior_tag) {
      constexpr bool INTR = decltype(interior_tag)::value;
#pragma unroll
      for (int mt = 0; mt < 2; ++mt)
#pragma unroll
        for (int i = 0; i < 4; ++i) {
          const int tok = tb + mt * 16 + fq * 4 + i;
          int seq = 0, t = 1, T = 2048;
          if constexpr (!INTR) tok_info(tok, seq, t, T);
          const bf16_t* pr = proj + (size_t)tok * DIN;
          float rr[4], kx[4], vv[4], aval[4], dec[4], kkr[4], kmod[4];
          float ss = 0.f, s1 = 0.f, s2 = 0.f, s3 = 0.f;
#pragma unroll
          for (int nt = 0; nt < 4; ++nt) {
            const int cc = nt * 16 + fr, c = h * 64 + cc;
            float pc, pp;
            pc = bf2f(pr[c]);
            if constexpr (INTR) pp = bf2f(pr[c - DIN]); else pp = prw_prev(p, proj, l, tok, seq, t, c);
            rr[nt] = pc + (pp - pc) * mur[nt];
            pc = bf2f(pr[768 + c]);
            if constexpr (INTR) pp = bf2f(pr[768 + c - DIN]); else pp = prw_prev(p, proj, l, tok, seq, t, 768 + c);
            kx[nt] = pc + (pp - pc) * muk[nt];
            pc = bf2f(pr[1536 + c]);
            if constexpr (INTR) pp = bf2f(pr[1536 + c - DIN]); else pp = prw_prev(p, proj, l, tok, seq, t, 1536 + c);
            float vx = pc + (pp - pc) * muv[nt];
            float wraw = -softplusf_(-(w0[nt] + aw[mt][nt][i])) - 0.5f;
            dec[nt] = __expf(-__expf(wraw));
            aval[nt] = sigmoidf_(a0[nt] + aa[mt][nt][i]);
            if (l > 0) {
              float vf = bf2f(vfirst[(size_t)tok * DRW + c]);
              vv[nt] = vx + (vf - vx) * sigmoidf_(v0[nt] + av[mt][nt][i]);
            } else {
              vfirst[(size_t)tok * DRW + c] = f2bf(vx);
              vv[nt] = vx;
            }
            kkr[nt] = kx[nt] * kkp[nt];
            kmod[nt] = kx[nt] * (1.f + (aval[nt] - 1.f) * kap[nt]);
            ss += kkr[nt] * kkr[nt];
            s1 += kkr[nt] * aval[nt] * rr[nt];
            s2 += kmod[nt] * rr[nt];
            s3 += rr[nt] * kmod[nt] * rkp[nt];
          }
          ss = red16_sum(ss); s1 = red16_sum(s1); s2 = red16_sum(s2); s3 = red16_sum(s3);
          const float inv = 1.f / fmaxf(sqrtf(ss), 1e-12f);
          char* so = scan + ((size_t)tok * 12 + h) * 896;
#pragma unroll
          for (int nt = 0; nt < 4; ++nt) {
            const int cc = nt * 16 + fr;
            float kkn = kkr[nt] * inv;
            ((float*)so)[cc] = dec[nt];
            ((bf16_t*)(so + 256))[cc] = f2bf(dec[nt] * rr[nt]);
            ((bf16_t*)(so + 384))[cc] = f2bf(-kkn);
            ((bf16_t*)(so + 512))[cc] = f2bf(kkn * aval[nt]);
            ((bf16_t*)(so + 640))[cc] = f2bf(kmod[nt]);
            ((bf16_t*)(so + 768))[cc] = f2bf(vv[nt]);
          }
          if (fr == 0) {
            float4 cv = make_float4(s1 * inv, s2, s3, 0.f);
            *(float4*)(cbuf + ((size_t)tok * 12 + h) * 4) = cv;
          }
        }
      };
      const int tbu = __builtin_amdgcn_readfirstlane(tb);
      if (tbu < MP && (tbu & 2047) != 0) epi(std::true_type{}); else epi(std::false_type{});
    }
  }
  for (int item = NRW + (int)blockIdx.x; item < 2 * NRW; item += gridDim.x) {
    int txl = TX;
    asm volatile("" : "+v"(txl));
    const int lane = txl & 63, wv = txl >> 6, fr = lane & 15, fq = lane >> 4;
    {
      const int it = item - NRW;
      const int nb = it % 12, tb = (it / 12) * 128 + wv * 32;
      const bf16_t* rgt = (const bf16_t*)(ws + W_RGT) + ((size_t)l * 12 + nb) * 4096;
      const bf16_t* igt = (const bf16_t*)(ws + W_IGT) + ((size_t)l * 12 + nb) * 4096;
      const int wrow0 = (fr >> 2) * 16 + (fr & 3);
      f32x4 ar[2][4], ai[2][4];
#pragma unroll
      for (int a = 0; a < 2; ++a)
#pragma unroll
        for (int b = 0; b < 4; ++b) { ar[a][b] = f32x4{0, 0, 0, 0}; ai[a][b] = ar[a][b]; }
#pragma unroll
      for (int ks = 0; ks < 2; ++ks) {
        bf16x8 af[2], b1[4], b2[4];
#pragma unroll
        for (int mt = 0; mt < 2; ++mt) af[mt] = *(const bf16x8*)(XC + (size_t)(tb + mt * 16 + fr) * DLRU + nb * 64 + ks * 32 + fq * 8);
#pragma unroll
        for (int nt = 0; nt < 4; ++nt) {
          b1[nt] = *(const bf16x8*)(rgt + (size_t)(wrow0 + nt * 4) * 64 + ks * 32 + fq * 8);
          b2[nt] = *(const bf16x8*)(igt + (size_t)(wrow0 + nt * 4) * 64 + ks * 32 + fq * 8);
        }
#pragma unroll
        for (int mt = 0; mt < 2; ++mt)
#pragma unroll
          for (int nt = 0; nt < 4; ++nt) {
            ar[mt][nt] = MFMA(b1[nt], af[mt], ar[mt][nt]);
            ai[mt][nt] = MFMA(b2[nt], af[mt], ai[mt][nt]);
          }
      }
      float* abuf = (float*)(ws + B_ABUF);
      float* ubuf = (float*)(ws + B_UBUF);
#pragma unroll
      for (int nt = 0; nt < 4; ++nt) {
        const int c = nb * 64 + fq * 16 + nt * 4;
        const float4 brq = *(const float4*)(p.in[I_BRG] + (size_t)l * DLRU + c), biq = *(const float4*)(p.in[I_BIG] + (size_t)l * DLRU + c);
        const float4 lmq = *(const float4*)(p.in[I_LAMBDA] + (size_t)l * DLRU + c);
        const float br_[4] = {brq.x, brq.y, brq.z, brq.w}, bi_[4] = {biq.x, biq.y, biq.z, biq.w};
        const float sp_[4] = {softplusf_(-lmq.x), softplusf_(-lmq.y), softplusf_(-lmq.z), softplusf_(-lmq.w)};
#pragma unroll
        for (int mt = 0; mt < 2; ++mt) {
          const int tok = tb + mt * 16 + fr;
          const float4 xq = *(const float4*)(ubuf + (size_t)tok * DLRU + c);
          const float xc_[4] = {xq.x, xq.y, xq.z, xq.w};
          float ao[4], uo[4];
#pragma unroll
          for (int i = 0; i < 4; ++i) {
            const float rg = sigmoidf_(ar[mt][nt][i] + br_[i]), ig = sigmoidf_(ai[mt][nt][i] + bi_[i]);
            const float la = -8.f * rg * sp_[i];
            ao[i] = __expf(la);
            uo[i] = sqrtf(fmaxf(-expm1f(2.f * la), 0.f)) * (ig * xc_[i]);
          }
          *(float4*)(abuf + (size_t)tok * DLRU + c) = make_float4(ao[0], ao[1], ao[2], ao[3]);
          *(float4*)(ubuf + (size_t)tok * DLRU + c) = make_float4(uo[0], uo[1], uo[2], uo[3]);
        }
      }
    }
  }
}

constexpr int STEP_B = 1552;
struct WkvOps { float4 w4, r4, n4, b4, k4; float v; float2 cc; };
__device__ __forceinline__ void wkv_load(WkvOps& o, const char* b, int kq, int vrow) {
  o.w4 = *(const float4*)(b + kq * 16);
  o.r4 = *(const float4*)(b + 256 + kq * 16);
  o.n4 = *(const float4*)(b + 512 + kq * 16);
  o.b4 = *(const float4*)(b + 768 + kq * 16);
  o.k4 = *(const float4*)(b + 1024 + kq * 16);
  o.v = *(const float*)(b + 1280 + vrow * 4);
  o.cc = *(const float2*)(b + 1536);
}
__device__ __forceinline__ void wkv_step(const WkvOps& o, float& S0, float& S1, float& S2, float& S3, float& ykeep, bool keep) {
  float sa = S0 * o.n4.x + S1 * o.n4.y + S2 * o.n4.z + S3 * o.n4.w;
  float z = S0 * o.r4.x + S1 * o.r4.y + S2 * o.r4.z + S3 * o.r4.w;
  sa = red16_sum(sa);
  z = red16_sum(z);
  const float y = z + sa * o.cc.x + o.v * o.cc.y;
  ykeep = keep ? y : ykeep;
  S0 = S0 * o.w4.x + (sa * o.b4.x + o.v * o.k4.x);
  S1 = S1 * o.w4.y + (sa * o.b4.y + o.v * o.k4.y);
  S2 = S2 * o.w4.z + (sa * o.b4.z + o.v * o.k4.z);
  S3 = S3 * o.w4.w + (sa * o.b4.w + o.v * o.k4.w);
}

struct WkvStage { uint4 st[4]; float4 cst; };
__device__ __forceinline__ void wkv_stage_load(WkvStage& g, const char* scan, const float* cbuf, int tid, int tok0, int h, int c, int T) {
  const int ns = min(16, T - c * 16);
#pragma unroll
  for (int j = 0; j < 4; ++j) {
    const int u = tid + 256 * j;
    if (u < ns * 56) {
      const int s = u / 56, q = u % 56;
      g.st[j] = *(const uint4*)(scan + ((size_t)(tok0 + c * 16 + s) * 12 + h) * 896 + q * 16);
    }
  }
  if (tid >= 128 && tid < 128 + ns) g.cst = *(const float4*)(cbuf + ((size_t)(tok0 + c * 16 + (tid - 128)) * 12 + h) * 4);
}
__device__ __forceinline__ void wkv_stage_write(const WkvStage& g, char* buf, int tid, int c, int T) {
  const int ns = min(16, T - c * 16);
#pragma unroll
  for (int j = 0; j < 4; ++j) {
    const int u = tid + 256 * j;
    if (u < ns * 56) {
      const int s = u / 56, q = u % 56;
      char* base = buf + s * STEP_B;
      if (q < 16) {
        *(uint4*)(base + q * 16) = g.st[j];
      } else {
        float4 lo, hi;
        lo.x = __uint_as_float(g.st[j].x << 16); lo.y = __uint_as_float(g.st[j].x & 0xffff0000u);
        lo.z = __uint_as_float(g.st[j].y << 16); lo.w = __uint_as_float(g.st[j].y & 0xffff0000u);
        hi.x = __uint_as_float(g.st[j].z << 16); hi.y = __uint_as_float(g.st[j].z & 0xffff0000u);
        hi.z = __uint_as_float(g.st[j].w << 16); hi.w = __uint_as_float(g.st[j].w & 0xffff0000u);
        const int off = 256 + (q - 16) * 32;
        *(float4*)(base + off) = lo;
        *(float4*)(base + off + 16) = hi;
      }
    }
  }
  if (tid >= 128 && tid < 128 + ns) *(float2*)(buf + (tid - 128) * STEP_B + 1536) = make_float2(g.cst.x, g.cst.y);
}
__device__ __forceinline__ void wkv_chunk16(const char* buf, int kq, int vrow, float& S0, float& S1, float& S2, float& S3, float& ykeep) {
  WkvOps oa, ob;
  wkv_load(oa, buf, kq, vrow);
#pragma unroll
  for (int s = 0; s < 16; s += 2) {
    wkv_load(ob, buf + (s + 1) * STEP_B, kq, vrow);
    wkv_step(oa, S0, S1, S2, S3, ykeep, kq == s);
    if (s + 2 < 16) wkv_load(oa, buf + (s + 2) * STEP_B, kq, vrow);
    wkv_step(ob, S0, S1, S2, S3, ykeep, kq == s + 1);
  }
}

__device__ void wkv_scan_item(const Params& p, int l, int seq, int h, int qt, char* lds) {
  const int TX = tid_();
  char* ws = p.ws;
  const int tid = TX, lane = tid & 63, wv = tid >> 6;
  const int kq = lane & 15, rl = lane >> 4;
  const int T = (seq < 8) ? 2048 : 4;
  const int tok0 = seq_tok0(seq);
  const char* scan = ws + B_SCAN;
  const float* cbuf = (const float*)(ws + B_CBUF);
  float* ybuf = (float*)(ws + B_YBUF);
  WkvStage ga, gb;
  float4 sin[4];
  if (seq >= 8) {
#pragma unroll
    for (int q4 = 0; q4 < 4; ++q4)
      sin[q4] = *(const float4*)(p.in[I_SWKV] + ((((size_t)l * 128 + (seq - 8)) * 12 + h) * 64 + q4 * 16 + wv * 4 + rl) * 64 + kq * 4);
  }
  __syncthreads();
  wkv_stage_load(ga, scan, cbuf, tid, tok0, h, 0, T);
  if (seq < 8) wkv_stage_load(gb, scan, cbuf, tid, tok0, h, 1, T);
  wkv_stage_write(ga, lds, tid, 0, T);
  __syncthreads();
  if (seq < 8) {
    constexpr int NCH = 128;
    const int vrow = qt * 16 + wv * 4 + rl;
    float S0 = 0.f, S1 = 0.f, S2 = 0.f, S3 = 0.f;
    char* buf0 = lds;
    char* buf1 = lds + 16 * STEP_B;
#pragma unroll 1
    for (int c = 0; c < NCH; c += 2) {
      if (c + 2 < NCH) wkv_stage_load(ga, scan, cbuf, tid, tok0, h, c + 2, T);
      float ykeep = 0.f;
      wkv_chunk16(buf0, kq, vrow, S0, S1, S2, S3, ykeep);
      ybuf[(size_t)(tok0 + c * 16 + kq) * DRW + h * 64 + vrow] = ykeep;
      wkv_stage_write(gb, buf1, tid, c + 1, T);
      __syncthreads();
      if (c + 3 < NCH) wkv_stage_load(gb, scan, cbuf, tid, tok0, h, c + 3, T);
      ykeep = 0.f;
      wkv_chunk16(buf1, kq, vrow, S0, S1, S2, S3, ykeep);
      ybuf[(size_t)(tok0 + (c + 1) * 16 + kq) * DRW + h * 64 + vrow] = ykeep;
      if (c + 2 < NCH) wkv_stage_write(ga, buf0, tid, c + 2, T);
      __syncthreads();
    }
    *(float4*)(p.out + O_WKVP + ((((size_t)l * 8 + seq) * 12 + h) * 64 + vrow) * 64 + kq * 4) = make_float4(S0, S1, S2, S3);
  } else {
    const int b = seq - 8;
#pragma unroll
    for (int q4 = 0; q4 < 4; ++q4) {
      const int vrow = q4 * 16 + wv * 4 + rl;
      float S0 = sin[q4].x, S1 = sin[q4].y, S2 = sin[q4].z, S3 = sin[q4].w;
      float ykeep = 0.f;
      WkvOps oa, ob;
      wkv_load(oa, lds, kq, vrow);
#pragma unroll
      for (int s2 = 0; s2 < 4; s2 += 2) {
        wkv_load(ob, lds + (s2 + 1) * STEP_B, kq, vrow);
        wkv_step(oa, S0, S1, S2, S3, ykeep, kq == s2);
        if (s2 + 2 < 4) wkv_load(oa, lds + (s2 + 2) * STEP_B, kq, vrow);
        wkv_step(ob, S0, S1, S2, S3, ykeep, kq == s2 + 1);
      }
      if (kq < 4) ybuf[(size_t)(tok0 + kq) * DRW + h * 64 + vrow] = ykeep;
      *(float4*)(p.out + O_WKVS + ((((size_t)l * 128 + b) * 12 + h) * 64 + vrow) * 64 + kq * 4) = make_float4(S0, S1, S2, S3);
    }
    __syncthreads();
  }
}

__device__ void lru_scan_prompt_item(const Params& p, int l, int seq, int cg, char* lds) {
  const int TX = tid_();
  char* ws = p.ws;
  const int ts = TX >> 5, ch = cg * 32 + (TX & 31);
  const float* abuf = (const float*)(ws + B_ABUF);
  float* ubuf = (float*)(ws + B_UBUF);
  const size_t base = ((size_t)seq * 2048 + ts * 256) * DLRU + ch;
  float* sA = (float*)lds;
  float* sU = sA + 256;
  __syncthreads();
  float A = 1.f, U = 0.f;
  for (int t0 = 0; t0 < 256; t0 += 16) {
    float a[16], u[16];
#pragma unroll
    for (int j = 0; j < 16; ++j) {
      a[j] = abuf[base + (size_t)(t0 + j) * DLRU];
      u[j] = ubuf[base + (size_t)(t0 + j) * DLRU];
    }
#pragma unroll
    for (int j = 0; j < 16; ++j) { U = a[j] * U + u[j]; A *= a[j]; }
  }
  sA[TX] = A;
  sU[TX] = U;
  __syncthreads();
  float h = 0.f;
  for (int j = 0; j < ts; ++j) h = sA[j * 32 + (TX & 31)] * h + sU[j * 32 + (TX & 31)];
  {
    float a[16], u[16], an[16], un[16];
#pragma unroll
    for (int j = 0; j < 16; ++j) {
      a[j] = abuf[base + (size_t)j * DLRU];
      u[j] = ubuf[base + (size_t)j * DLRU];
    }
    for (int t0 = 0; t0 < 256; t0 += 16) {
      if (t0 + 16 < 256) {
#pragma unroll
        for (int j = 0; j < 16; ++j) {
          an[j] = abuf[base + (size_t)(t0 + 16 + j) * DLRU];
          un[j] = ubuf[base + (size_t)(t0 + 16 + j) * DLRU];
        }
      }
#pragma unroll
      for (int j = 0; j < 16; ++j) {
        h = a[j] * h + u[j];
        ubuf[base + (size_t)(t0 + j) * DLRU] = h;
      }
#pragma unroll
      for (int j = 0; j < 16; ++j) { a[j] = an[j]; u[j] = un[j]; }
    }
  }
  if (ts == 7) p.out[O_HP + ((size_t)l * 8 + seq) * DLRU + ch] = h;
  __syncthreads();
}

__device__ void lru_scan_item(const Params& p, int l, int seq, int cg3) {
  const int TX = tid_();
  char* ws = p.ws;
  const int ch = cg3 * 256 + TX;
  const int tok0 = seq_tok0(seq);
  const float* abuf = (const float*)(ws + B_ABUF);
  float* ubuf = (float*)(ws + B_UBUF);
  float h = p.in[I_SH][((size_t)l * 128 + (seq - 8)) * DLRU + ch];
  float a[4], u[4];
#pragma unroll
  for (int j = 0; j < 4; ++j) {
    a[j] = abuf[(size_t)(tok0 + j) * DLRU + ch];
    u[j] = ubuf[(size_t)(tok0 + j) * DLRU + ch];
  }
#pragma unroll
  for (int j = 0; j < 4; ++j) {
    h = a[j] * h + u[j];
    ubuf[(size_t)(tok0 + j) * DLRU + ch] = h;
  }
  p.out[O_HS + ((size_t)l * 128 + (seq - 8)) * DLRU + ch] = h;
}

__device__ void attn_prompt_item(const Params& p, int l, int b, int h, int qt, char* lds) {
  const int TX = tid_();
  char* ws = p.ws;
  const int lane = TX & 63, wv = TX >> 6, fr = lane & 15, fq = lane >> 4;
  const bf16_t* proj = (const bf16_t*)(ws + B_PROJ);
  const bf16_t* kb = (const bf16_t*)(ws + B_KB) + ((size_t)(l * 8 + b) * 256) * 512 + h * 128;
  const bf16_t* vt = (const bf16_t*)(ws + B_VTB) + (((size_t)(l * 8 + b) * 4 + h) * 128) * 256;
  bf16_t* axa = (bf16_t*)(ws + B_AXA);
  const int tok0 = b * 2048 + qt * 64 + wv * 16;
  bf16x8 aq[4];
#pragma unroll
  for (int ks = 0; ks < 4; ++ks) aq[ks] = *(const bf16x8*)(proj + (size_t)(tok0 + fr) * DIN + C_Q + h * 128 + ks * 32 + fq * 8);
  f32x4 s[16];
#pragma unroll
  for (int nt = 0; nt < 16; ++nt) {
    s[nt] = f32x4{0, 0, 0, 0};
#pragma unroll
    for (int ks = 0; ks < 4; ++ks) {
      bf16x8 bk = *(const bf16x8*)(kb + (size_t)(nt * 16 + fr) * 512 + ks * 32 + fq * 8);
      s[nt] = MFMA(aq[ks], bk, s[nt]);
    }
  }
  const float scale = 0.08838834764831845f;
  float rs[4];
  char* pl = lds + wv * 8192;
  __syncthreads();
#pragma unroll
  for (int i = 0; i < 4; ++i) {
    float m = s[0][i];
#pragma unroll
    for (int nt = 1; nt < 16; ++nt) m = fmaxf(m, s[nt][i]);
    m = red16_max(m);
    float sum = 0.f;
#pragma unroll
    for (int nt = 0; nt < 16; ++nt) {
      float e = __expf((s[nt][i] - m) * scale);
      sum += e;
      const int key = nt * 16 + fr, rr = fq * 4 + i;
      *(bf16_t*)(pl + (key >> 5) * 1024 + swz(rr, (key & 31) * 2)) = f2bf(e);
    }
    rs[i] = red16_sum(sum);
  }
  __syncthreads();
  f32x4 o[8];
#pragma unroll
  for (int nt = 0; nt < 8; ++nt) o[nt] = f32x4{0, 0, 0, 0};
  const int fo = swz(fr, fq * 16);
#pragma unroll
  for (int ks = 0; ks < 8; ++ks) {
    bf16x8 ap = *(const bf16x8*)(pl + ks * 1024 + fo);
#pragma unroll
    for (int nt = 0; nt < 8; ++nt) {
      bf16x8 bv = *(const bf16x8*)(vt + (size_t)(nt * 16 + fr) * 256 + ks * 32 + fq * 8);
      o[nt] = MFMA(ap, bv, o[nt]);
    }
  }
#pragma unroll
  for (int nt = 0; nt < 8; ++nt)
#pragma unroll
    for (int i = 0; i < 4; ++i)
      axa[(size_t)(tok0 + fq * 4 + i) * DXA + h * 128 + nt * 16 + fr] = f2bf(o[nt][i] / rs[i]);
  __syncthreads();
}

__device__ void attn_sample_item(const Params& p, int l, int b, int h, char* lds) {
  const int TX = tid_();
  char* ws = p.ws;
  const int tid = TX, lane = tid & 63, wv = tid >> 6;
  const bf16_t* proj = (const bf16_t*)(ws + B_PROJ);
  bf16_t* axa = (bf16_t*)(ws + B_AXA);
  const int tok0 = MP + b * 4;
  float* q = (float*)lds;
  float* pr = q + 512;
  float* red = pr + 1024;
  float* part = red + 32;
  __syncthreads();
  for (int i = tid; i < 512; i += 256) q[i] = bf2f(proj[(size_t)(tok0 + (i >> 7)) * DIN + C_Q + h * 128 + (i & 127)]);
  __syncthreads();
  const float* kc = p.in[I_CK] + (((size_t)l * 128 + b) * 256 + tid) * 512 + h * 128;
  float s0 = 0.f, s1 = 0.f, s2 = 0.f, s3 = 0.f;
#pragma unroll 4
  for (int d = 0; d < 128; d += 4) {
    const float4 kv = *(const float4*)(kc + d);
    const float4 q0 = *(const float4*)(q + d), q1 = *(const float4*)(q + 128 + d), q2 = *(const float4*)(q + 256 + d),
                 q3 = *(const float4*)(q + 384 + d);
    s0 += kv.x * q0.x + kv.y * q0.y + kv.z * q0.z + kv.w * q0.w;
    s1 += kv.x * q1.x + kv.y * q1.y + kv.z * q1.z + kv.w * q1.w;
    s2 += kv.x * q2.x + kv.y * q2.y + kv.z * q2.z + kv.w * q2.w;
    s3 += kv.x * q3.x + kv.y * q3.y + kv.z * q3.z + kv.w * q3.w;
  }
  const float scale = 0.08838834764831845f;
  s0 *= scale; s1 *= scale; s2 *= scale; s3 *= scale;
  float m0 = s0, m1 = s1, m2 = s2, m3 = s3;
#pragma unroll
  for (int m = 1; m < 64; m <<= 1) {
    m0 = fmaxf(m0, __shfl_xor(m0, m, 64)); m1 = fmaxf(m1, __shfl_xor(m1, m, 64));
    m2 = fmaxf(m2, __shfl_xor(m2, m, 64)); m3 = fmaxf(m3, __shfl_xor(m3, m, 64));
  }
  if (lane == 0) { red[wv * 4 + 0] = m0; red[wv * 4 + 1] = m1; red[wv * 4 + 2] = m2; red[wv * 4 + 3] = m3; }
  __syncthreads();
  m0 = fmaxf(fmaxf(red[0], red[4]), fmaxf(red[8], red[12]));
  m1 = fmaxf(fmaxf(red[1], red[5]), fmaxf(red[9], red[13]));
  m2 = fmaxf(fmaxf(red[2], red[6]), fmaxf(red[10], red[14]));
  m3 = fmaxf(fmaxf(red[3], red[7]), fmaxf(red[11], red[15]));
  const float e0 = __expf(s0 - m0), e1 = __expf(s1 - m1), e2 = __expf(s2 - m2), e3 = __expf(s3 - m3);
  pr[tid] = e0; pr[256 + tid] = e1; pr[512 + tid] = e2; pr[768 + tid] = e3;
  float t0 = wave_sum(e0), t1 = wave_sum(e1), t2 = wave_sum(e2), t3 = wave_sum(e3);
  if (lane == 0) { red[16 + wv * 4 + 0] = t0; red[16 + wv * 4 + 1] = t1; red[16 + wv * 4 + 2] = t2; red[16 + wv * 4 + 3] = t3; }
  __syncthreads();
  const float z0 = red[16] + red[20] + red[24] + red[28], z1 = red[17] + red[21] + red[25] + red[29];
  const float z2 = red[18] + red[22] + red[26] + red[30], z3 = red[19] + red[23] + red[27] + red[31];
  const int d = tid & 127, half = tid >> 7;
  const float* vc = p.in[I_CV] + (((size_t)l * 128 + b) * 256 + half * 128) * 512 + h * 128 + d;
  float o0 = 0.f, o1 = 0.f, o2 = 0.f, o3 = 0.f;
#pragma unroll 8
  for (int k = 0; k < 128; ++k) {
    const float vv = vc[(size_t)k * 512];
    const int key = half * 128 + k;
    o0 += pr[key] * vv; o1 += pr[256 + key] * vv; o2 += pr[512 + key] * vv; o3 += pr[768 + key] * vv;
  }
  if (half == 1) { part[d] = o0; part[128 + d] = o1; part[256 + d] = o2; part[384 + d] = o3; }
  __syncthreads();
  if (half == 0) {
    o0 += part[d]; o1 += part[128 + d]; o2 += part[256 + d]; o3 += part[384 + d];
    axa[(size_t)(tok0 + 0) * DXA + h * 128 + d] = f2bf(o0 / z0);
    axa[(size_t)(tok0 + 1) * DXA + h * 128 + d] = f2bf(o1 / z1);
    axa[(size_t)(tok0 + 2) * DXA + h * 128 + d] = f2bf(o2 / z2);
    axa[(size_t)(tok0 + 3) * DXA + h * 128 + d] = f2bf(o3 / z3);
  }
  __syncthreads();
}

__device__ void phase_mix(const Params& p, int l, char* lds, int* s_item) {
  const int TX = tid_();
  int* cnt = (int*)(p.ws + B_CNT) + l;
  constexpr int N_WKVP = 96 * 4, N_LRUP = 8 * 24, N_ATTP = 1024, N_WKVS = 128 * 12, N_LRUS = 384, N_ATTS = 512;
  constexpr int E1 = N_WKVP, E2 = E1 + N_LRUP, E3 = E2 + N_ATTP, E4 = E3 + N_WKVS, E5 = E4 + N_LRUS, E6 = E5 + N_ATTS;
  for (;;) {
    __syncthreads();
    if (TX == 0) *s_item = atomicAdd(cnt, 1);
    __syncthreads();
    const int it = *s_item;
    if (it >= E6) break;
    if (it < E1) {
      const int qt = it & 3, bh = it >> 2;
      wkv_scan_item(p, l, bh / 12, bh % 12, qt, lds);
    } else if (it < E2) {
      const int j = it - E1;
      lru_scan_prompt_item(p, l, j / 24, j % 24, lds);
    } else if (it < E3) {
      const int j = it - E2;
      attn_prompt_item(p, l, j >> 7, (j >> 5) & 3, j & 31, lds);
    } else if (it < E4) {
      const int j = it - E3;
      wkv_scan_item(p, l, 8 + j / 12, j % 12, -1, lds);
    } else if (it < E5) {
      const int j = it - E4;
      lru_scan_item(p, l, 8 + j / 3, j % 3);
    } else {
      const int j = it - E5;
      attn_sample_item(p, l, j >> 2, j & 3, lds);
    }
  }
}

__device__ void phase_post(const Params& p, int l) {
  const int TX = tid_();
  char* ws = p.ws;
  const int lane = TX & 63, wv = TX >> 6;
  const float* ybuf = (const float*)(ws + B_YBUF);
  const float* cbuf = (const float*)(ws + B_CBUF);
  const bf16_t* gbuf = (const bf16_t*)(ws + B_GBUF);
  const char* scan = ws + B_SCAN;
  const float* hbuf = (const float*)(ws + B_UBUF);
  const bf16_t* proj = (const bf16_t*)(ws + B_PROJ);
  bf16_t* arw = (bf16_t*)(ws + B_ARW);
  bf16_t* alru = (bf16_t*)(ws + B_ALRU);
  const float* gng = p.in[I_GNG] + (size_t)l * DRW;
  const float* gnb = p.in[I_GNB] + (size_t)l * DRW;
  for (int t4 = blockIdx.x; t4 < MT / 4; t4 += gridDim.x) {
    const int tok = t4 * 4 + wv;
#pragma unroll
    for (int ps = 0; ps < 3; ++ps) {
      const int c = ps * 256 + lane * 4, h = c >> 6;
      const float4 y = *(const float4*)(ybuf + (size_t)tok * DRW + c);
      const float mean = red16_sum(y.x + y.y + y.z + y.w) * (1.f / 64.f);
      const float d0 = y.x - mean, d1 = y.y - mean, d2 = y.z - mean, d3 = y.w - mean;
      const float var = red16_sum(d0 * d0 + d1 * d1 + d2 * d2 + d3 * d3) * (1.f / 64.f);
      const float rs = rsqrtf(var + 64e-5f);
      const float4 gg = *(const float4*)(gng + c), gb = *(const float4*)(gnb + c);
      const float c3 = cbuf[((size_t)tok * 12 + h) * 4 + 2];
      const uint2 vq = *(const uint2*)(scan + ((size_t)tok * 12 + h) * 896 + 768 + (c & 63) * 2);
      const uint2 gq = *(const uint2*)(gbuf + (size_t)tok * DRW + c);
      const float v0 = __uint_as_float(vq.x << 16), v1 = __uint_as_float(vq.x & 0xffff0000u);
      const float v2 = __uint_as_float(vq.y << 16), v3 = __uint_as_float(vq.y & 0xffff0000u);
      const float g0 = __uint_as_float(gq.x << 16), g1 = __uint_as_float(gq.x & 0xffff0000u);
      const float g2 = __uint_as_float(gq.y << 16), g3 = __uint_as_float(gq.y & 0xffff0000u);
      uint2 o;
      o.x = pk_bf2((d0 * rs * gg.x + gb.x + c3 * v0) * g0, (d1 * rs * gg.y + gb.y + c3 * v1) * g1);
      o.y = pk_bf2((d2 * rs * gg.z + gb.z + c3 * v2) * g2, (d3 * rs * gg.w + gb.w + c3 * v3) * g3);
      *(uint2*)(arw + (size_t)tok * DRW + c) = o;
      const float4 hv = *(const float4*)(hbuf + (size_t)tok * DLRU + c);
      const uint2 xq = *(const uint2*)(proj + (size_t)tok * DIN + C_LG + c);
      float x[4] = {__uint_as_float(xq.x << 16), __uint_as_float(xq.x & 0xffff0000u), __uint_as_float(xq.y << 16), __uint_as_float(xq.y & 0xffff0000u)};
      float ge[4];
#pragma unroll
      for (int i = 0; i < 4; ++i) {
        const float u = 0.7978845608028654f * (x[i] + 0.044715f * x[i] * x[i] * x[i]);
        const float th = 1.f - 2.f / (1.f + __expf(2.f * u));
        ge[i] = 0.5f * x[i] * (1.f + th);
      }
      uint2 o2;
      o2.x = pk_bf2(hv.x * ge[0], hv.y * ge[1]);
      o2.y = pk_bf2(hv.z * ge[2], hv.w * ge[3]);
      *(uint2*)(alru + (size_t)tok * DLRU + c) = o2;
    }
  }
}

__device__ void phase_merge(const Params& p, int l, char* lds) {
  const int TX = tid_();
  char* ws = p.ws;
  const bf16_t* proj = (const bf16_t*)(ws + B_PROJ);
  bf16_t* mixin = (bf16_t*)(ws + B_MIXIN);
  const int lane = TX & 63, wv = TX >> 6, wr = wv >> 1, wc = wv & 1, fr = lane & 15, fq = lane >> 4;
  const int ntiles = (MT / 128) * 16;
  for (TileIter it = tile_iter(ntiles); it.L < it.Lend; it.L += it.step) {
    int tm, tn;
    tile_mn(it.L, MT / 128, 16, tm, tn);
    const int m0 = tm * 128, n0 = tn * 64;
    f32x4 sum[4][2], acc[4][2];
    zero_acc(sum);
#pragma unroll 1
    for (int br = 0; br < 3; ++br) {
      zero_acc(acc);
      const bf16_t* A; const bf16_t* Bt; int K;
      if (br == 0) { A = (const bf16_t*)(ws + B_ARW); Bt = (const bf16_t*)(ws + W_RWOUT) + (size_t)l * D * DRW; K = DRW; }
      else if (br == 1) { A = (const bf16_t*)(ws + B_ALRU); Bt = (const bf16_t*)(ws + W_LRUOUT) + (size_t)l * D * DLRU; K = DLRU; }
      else { A = (const bf16_t*)(ws + B_AXA); Bt = (const bf16_t*)(ws + W_XAOUT) + (size_t)l * D * DXA; K = DXA; }
      gemm_main<4, 2>(A, K, Bt, K, K, m0, n0, lds, acc);
#pragma unroll
      for (int mt = 0; mt < 4; ++mt) {
        const int row = m0 + wr * 64 + mt * 16 + fr, col = n0 + wc * 32 + fq * 8;
        const uint4 gq = *(const uint4*)(proj + (size_t)row * DIN + C_G + br * D + col);
        const unsigned gw[4] = {gq.x, gq.y, gq.z, gq.w};
#pragma unroll
        for (int nt = 0; nt < 2; ++nt)
#pragma unroll
          for (int i = 0; i < 4; ++i) {
            const unsigned w = gw[nt * 2 + (i >> 1)];
            const float gv = __uint_as_float((i & 1) ? (w & 0xffff0000u) : (w << 16));
            sum[mt][nt][i] += sigmoidf_(gv) * acc[mt][nt][i];
          }
      }
    }
#pragma unroll
    for (int mt = 0; mt < 4; ++mt) {
      const int row = m0 + wr * 64 + mt * 16 + fr, col = n0 + wc * 32 + fq * 8;
      *(uint4*)(mixin + (size_t)row * D + col) = pack8(sum[mt][0], sum[mt][1]);
    }
  }
}

__device__ void phase_resid_gemm(const Params& p, const bf16_t* A, const bf16_t* Bt, int K, char* lds) {
  const int TX = tid_();
  char* ws = p.ws;
  const float* xf = (const float*)(ws + B_XF);
  float* t = p.out + O_Y;
  const int lane = TX & 63, wv = TX >> 6, wr = wv >> 1, wc = wv & 1, fr = lane & 15, fq = lane >> 4;
  const int ntiles = (MT / 128) * 8;
  TileIter it = tile_iter(ntiles);
  bool have = it.L < it.Lend;
  int m0 = 0, n0 = 0;
  if (have) { int tm, tn; tile_mn(it.L, MT / 128, 8, tm, tn); m0 = tm * 128; n0 = tn * 128; gemm_prologue<4, 4>(A, K, Bt, K, m0, n0, lds); }
  while (have) {
    f32x4 acc[4][4];
    zero_acc(acc);
    gemm_loop<4, 4>(A, K, Bt, K, K, m0, n0, lds, acc);
    float4 xv[4][4];
#pragma unroll
    for (int mt = 0; mt < 4; ++mt) {
      const float4* xs = (const float4*)(xf + (size_t)(m0 + wr * 64 + mt * 16 + fr) * D + n0 + wc * 64 + fq * 16);
#pragma unroll
      for (int nt = 0; nt < 4; ++nt) xv[mt][nt] = xs[nt];
    }
    const int Ln = it.L + it.step;
    const bool hn = Ln < it.Lend;
    int m1 = m0, n1 = n0;
    if (hn) { int tm, tn; tile_mn(Ln, MT / 128, 8, tm, tn); m1 = tm * 128; n1 = tn * 128; gemm_prologue<4, 4>(A, K, Bt, K, m1, n1, lds); }
#pragma unroll
    for (int mt = 0; mt < 4; ++mt) {
      float4* ts = (float4*)(t + (size_t)(m0 + wr * 64 + mt * 16 + fr) * D + n0 + wc * 64 + fq * 16);
#pragma unroll
      for (int nt = 0; nt < 4; ++nt)
        ts[nt] = make_float4(ALPHA * xv[mt][nt].x + acc[mt][nt][0], ALPHA * xv[mt][nt].y + acc[mt][nt][1],
                             ALPHA * xv[mt][nt].z + acc[mt][nt][2], ALPHA * xv[mt][nt].w + acc[mt][nt][3]);
    }
    it.L = Ln; have = hn; m0 = m1; n0 = n1;
  }
}

__device__ void phase_ln(const Params& p, const float* g, const float* bta, bool final_out) {
  const int TX = tid_();
  char* ws = p.ws;
  const int lane = TX & 63, wv = TX >> 6;
  float* t = p.out + O_Y;
  float* xf = (float*)(ws + B_XF);
  bf16_t* xb = (bf16_t*)(ws + B_XB);
  for (int r4 = blockIdx.x; r4 < MT / 4; r4 += gridDim.x) {
    const int row = r4 * 4 + wv;
    float4 v[4];
    float s = 0.f;
#pragma unroll
    for (int j = 0; j < 4; ++j) {
      v[j] = *(const float4*)(t + (size_t)row * D + j * 256 + lane * 4);
      s += v[j].x + v[j].y + v[j].z + v[j].w;
    }
    const float mean = wave_sum(s) * (1.f / 1024.f);
    float q = 0.f;
#pragma unroll
    for (int j = 0; j < 4; ++j) {
      v[j].x -= mean; v[j].y -= mean; v[j].z -= mean; v[j].w -= mean;
      q += v[j].x * v[j].x + v[j].y * v[j].y + v[j].z * v[j].z + v[j].w * v[j].w;
    }
    const float rstd = rsqrtf(wave_sum(q) * (1.f / 1024.f) + 1e-5f);
#pragma unroll
    for (int j = 0; j < 4; ++j) {
      const int c = j * 256 + lane * 4;
      const float4 gg = *(const float4*)(g + c), bb = *(const float4*)(bta + c);
      float4 o;
      o.x = v[j].x * rstd * gg.x + bb.x; o.y = v[j].y * rstd * gg.y + bb.y;
      o.z = v[j].z * rstd * gg.z + bb.z; o.w = v[j].w * rstd * gg.w + bb.w;
      if (final_out) {
        *(float4*)(t + (size_t)row * D + c) = o;
      } else {
        *(float4*)(xf + (size_t)row * D + c) = o;
        uint2 ob;
        ob.x = (unsigned)f2bf(o.x) | ((unsigned)f2bf(o.y) << 16);
        ob.y = (unsigned)f2bf(o.z) | ((unsigned)f2bf(o.w) << 16);
        *(uint2*)(xb + (size_t)row * D + c) = ob;
      }
    }
  }
}

__device__ void phase_ffn_in(const Params& p, int l, char* lds) {
  const int TX = tid_();
  char* ws = p.ws;
  const bf16_t* xb = (const bf16_t*)(ws + B_XB);
  const bf16_t* wt = (const bf16_t*)(ws + W_FFNIN) + (size_t)l * 2 * DFF * D;
  bf16_t* act = (bf16_t*)(ws + B_ACT);
  const int lane = TX & 63, wv = TX >> 6, wr = wv >> 1, wc = wv & 1, fr = lane & 15, fq = lane >> 4;
  const int nN = 2 * DFF / 128, ntiles = (MT / 128) * nN;
  TileIter it = tile_iter(ntiles);
  bool have = it.L < it.Lend;
  int m0 = 0, n0 = 0;
  if (have) { int tm, tn; tile_mn(it.L, MT / 128, nN, tm, tn); m0 = tm * 128; n0 = tn * 128; gemm_prologue<4, 4>(xb, D, wt, D, m0, n0, lds); }
  while (have) {
    f32x4 acc[4][4];
    zero_acc(acc);
    gemm_loop<4, 4>(xb, D, wt, D, D, m0, n0, lds, acc);
    const int Ln = it.L + it.step;
    const bool hn = Ln < it.Lend;
    int m1 = m0, n1 = n0;
    if (hn) { int tm, tn; tile_mn(Ln, MT / 128, nN, tm, tn); m1 = tm * 128; n1 = tn * 128; gemm_prologue<4, 4>(xb, D, wt, D, m1, n1, lds); }
    const int jb = (n0 + wc * 64 + fq * 16) / 2;
#pragma unroll
    for (int mt = 0; mt < 4; ++mt) {
      const int row = m0 + wr * 64 + mt * 16 + fr;
      f32x4 o0, o1;
#pragma unroll
      for (int i = 0; i < 4; ++i) {
        const float g0 = acc[mt][2][i], g1 = acc[mt][3][i];
        o0[i] = g0 * sigmoidf_(g0) * acc[mt][0][i];
        o1[i] = g1 * sigmoidf_(g1) * acc[mt][1][i];
      }
      *(uint4*)(act + (size_t)row * DFF + jb) = pack8(o0, o1);
    }
    it.L = Ln; have = hn; m0 = m1; n0 = n1;
  }
}

__global__ void __launch_bounds__(256, 2) fwd_megakernel(Params p) {
  cg::grid_group grid = cg::this_grid();
  __shared__ __attribute__((aligned(1024))) char lds[LDS_BYTES];
  __shared__ int s_item;
  __shared__ uint4 xb_words;
  char* ws = p.ws;
  if (threadIdx.x == 0) xb_words = make_uint4(0u, 0u, 0u, 0u);
  __syncthreads();
  XcdBarrier xb = xcd_barrier_post((unsigned*)(ws + B_BAR), (volatile LAS unsigned*)&xb_words);
  constexpr int NPH = 1 + NL * 11;
#pragma unroll 1
  for (int ph = 0; ph < NPH; ++ph) {
    int phl = ph;
    asm volatile("" : "+s"(phl));
    if (phl == 0) {
      phase_convert(p, lds);
    } else {
      const int l = (phl - 1) / 11, k = (phl - 1) % 11;
      switch (k) {
        case 0: phase_proj(p, l, lds); break;
        case 1: phase_prep(p, l, lds); break;
        case 2: phase_lora(p, l, lds); break;
        case 3: phase_mix(p, l, lds, &s_item); break;
        case 4: phase_post(p, l); break;
        case 5: phase_merge(p, l, lds); break;
        case 6: phase_resid_gemm(p, (const bf16_t*)(ws + B_MIXIN), (const bf16_t*)(ws + W_O) + (size_t)l * D * D, D, lds); break;
        case 7: phase_ln(p, p.in[I_LN1G] + (size_t)l * D, p.in[I_LN1B] + (size_t)l * D, false); break;
        case 8: phase_ffn_in(p, l, lds); break;
        case 9: phase_resid_gemm(p, (const bf16_t*)(ws + B_ACT), (const bf16_t*)(ws + W_FFNOUT) + (size_t)l * D * DFF, DFF, lds); break;
        default: phase_ln(p, p.in[I_LN2G] + (size_t)l * D, p.in[I_LN2B] + (size_t)l * D, l == NL - 1); break;
      }
    }
    if (ph + 1 < NPH) { if (ph == 0) grid.sync(); else xcd_barrier(xb); }
  }
}

extern "C" void kernel_launch(void* const* d_in, const int* in_sizes, int n_in, void* d_out, int out_size, void* d_ws,
                              size_t ws_size, hipStream_t stream) {
  static int grid_blocks = 0;
  if (!grid_blocks) {
    int dev = 0, cus = 0, per_cu = 0;
    (void)hipGetDevice(&dev);
    (void)hipDeviceGetAttribute(&cus, hipDeviceAttributeMultiprocessorCount, dev);
    (void)hipOccupancyMaxActiveBlocksPerMultiprocessor(&per_cu, fwd_megakernel, 256, 0);
    if (per_cu > 2) per_cu = 2;
    if (per_cu < 1) per_cu = 1;
    grid_blocks = cus * per_cu;
  }
  if (ws_size < WS_NEED || n_in < 42) {
    fprintf(stderr, "workspace too small: %zu < %zu\n", ws_size, (size_t)WS_NEED);
    return;
  }
  (void)hipMemsetAsync((char*)d_ws + B_CNT, 0, 256 + BAR_BYTES, stream);
  Params p{};
  for (int i = 0; i < 42; ++i) p.in[i] = (const float*)d_in[i];
  p.out = (float*)d_out;
  p.ws = (char*)d_ws;
  void* args[] = {&p};
  hipError_t e = hipLaunchCooperativeKernel((void*)fwd_megakernel, dim3(grid_blocks), dim3(256), args, 0, stream);
  if (e != hipSuccess) fprintf(stderr, "cooperative launch failed: %s (grid %d)\n", hipGetErrorString(e), grid_blocks);
}
```

```cpp
#include <hip/hip_runtime.h>
#include <hip/hip_cooperative_groups.h>
#include <cstdio>
#include <type_traits>
namespace cg = cooperative_groups;

typedef unsigned short bf16_t;
typedef __attribute__((ext_vector_type(8))) short bf16x8;
typedef __attribute__((ext_vector_type(4))) float f32x4;

constexpr int D = 1024, MP = 16384, MS = 512, MT = 16896, NL = 4;
constexpr int DIN = 7680, DRW = 768, DLRU = 768, DXA = 512, DFF = 2816, RWC = 2560;
constexpr int C_LX = 2560, C_LG = 3328, C_Q = 4096, C_G = 4608;
constexpr int NSEQ = 136;
constexpr float ALPHA = 1.681792830507429f;

constexpr size_t O_Y = 0;
constexpr size_t O_SHP = O_Y + (size_t)MT * D;
constexpr size_t O_WKVP = O_SHP + (size_t)NL * 8 * RWC;
constexpr size_t O_CONVP = O_WKVP + (size_t)NL * 8 * 12 * 64 * 64;
constexpr size_t O_HP = O_CONVP + (size_t)NL * 8 * 3 * DLRU;
constexpr size_t O_MKP = O_HP + (size_t)NL * 8 * DLRU;
constexpr size_t O_MVP = O_MKP + (size_t)NL * 8 * 256 * 512;
constexpr size_t O_SHS = O_MVP + (size_t)NL * 8 * 256 * 512;
constexpr size_t O_WKVS = O_SHS + (size_t)NL * 128 * RWC;
constexpr size_t O_CONVS = O_WKVS + (size_t)NL * 128 * 12 * 64 * 64;
constexpr size_t O_HS = O_CONVS + (size_t)NL * 128 * 3 * DLRU;
constexpr size_t O_END = O_HS + (size_t)NL * 128 * DLRU;

constexpr size_t al256(size_t x) { return (x + 255) & ~(size_t)255; }
constexpr size_t W_IN = 0;
constexpr size_t W_RWOUT = W_IN + al256((size_t)NL * DIN * D * 2);
constexpr size_t W_LRUOUT = W_RWOUT + al256((size_t)NL * D * DRW * 2);
constexpr size_t W_XAOUT = W_LRUOUT + al256((size_t)NL * D * DLRU * 2);
constexpr size_t W_O = W_XAOUT + al256((size_t)NL * D * DXA * 2);
constexpr size_t W_FFNIN = W_O + al256((size_t)NL * D * D * 2);
constexpr size_t W_FFNOUT = W_FFNIN + al256((size_t)NL * 2 * DFF * D * 2);
constexpr size_t W_MEMKV = W_FFNOUT + al256((size_t)NL * D * DFF * 2);
constexpr size_t W_W2T = W_MEMKV + al256((size_t)NL * D * D * 2);
constexpr size_t W_A2T = W_W2T + al256((size_t)NL * DRW * 64 * 2);
constexpr size_t W_G2T = W_A2T + al256((size_t)NL * DRW * 64 * 2);
constexpr size_t W_V2T = W_G2T + al256((size_t)NL * DRW * 128 * 2);
constexpr size_t W_RGT = W_V2T + al256((size_t)3 * DRW * 32 * 2);
constexpr size_t W_IGT = W_RGT + al256((size_t)NL * 12 * 64 * 64 * 2);
constexpr size_t B_XF = W_IGT + al256((size_t)NL * 12 * 64 * 64 * 2);
constexpr size_t B_XB = B_XF + al256((size_t)MT * D * 4);
constexpr size_t B_MEMB = B_XB + al256((size_t)MT * D * 2);
constexpr size_t B_KB = B_MEMB + al256((size_t)2048 * D * 2);
constexpr size_t B_VTB = B_KB + al256((size_t)NL * 8 * 256 * 512 * 2);
constexpr size_t B_VFIRST = B_VTB + al256((size_t)NL * 8 * 256 * 512 * 2);
constexpr size_t B_PROJ = B_VFIRST + al256((size_t)MT * DRW * 2);
constexpr size_t B_SCAN = B_PROJ + al256((size_t)MT * DIN * 2);
constexpr size_t SCAN_BYTES = (size_t)MT * 12 * 896;
constexpr size_t B_MIXIN = B_SCAN;
constexpr size_t B_ACT = B_SCAN + al256((size_t)MT * D * 2);
constexpr size_t B_CBUF = B_SCAN + al256(SCAN_BYTES);
constexpr size_t B_YBUF = B_CBUF + al256((size_t)MT * 12 * 16);
constexpr size_t B_GBUF = B_YBUF + al256((size_t)MT * DRW * 4);
constexpr size_t B_ABUF = B_GBUF + al256((size_t)MT * DRW * 2);
constexpr size_t B_UBUF = B_ABUF + al256((size_t)MT * DLRU * 4);
constexpr size_t B_LBUF = B_UBUF + al256((size_t)MT * DLRU * 4);
constexpr size_t B_VMID = B_LBUF + al256((size_t)MT * 256 * 2);
constexpr size_t B_ARW = B_VMID + al256((size_t)MT * 32 * 2);
constexpr size_t B_ALRU = B_ARW + al256((size_t)MT * DRW * 2);
constexpr size_t B_AXA = B_ALRU + al256((size_t)MT * DLRU * 2);
constexpr size_t B_CNT = B_AXA + al256((size_t)MT * DXA * 2);
constexpr size_t B_BAR = B_CNT + 256;
constexpr size_t BAR_BYTES = 16384;
constexpr size_t W_V1T = B_BAR + BAR_BYTES;
constexpr size_t WS_NEED = W_V1T + al256((size_t)3 * 32 * DRW * 2);
static_assert(al256((size_t)MT * D * 2) + (size_t)MT * DFF * 2 <= SCAN_BYTES, "alias overflow");

enum { I_XP = 0, I_XS, I_MEM, I_SSHIFT, I_SWKV, I_SCONV, I_SH, I_CK, I_CV, I_WIN, I_MU, I_W0, I_W2, I_A0, I_A2,
       I_G2, I_V0, I_V1, I_V2, I_KK, I_KA, I_RK, I_GNG, I_GNB, I_WRWOUT, I_CONVW, I_CONVB, I_WRG, I_BRG, I_WIG,
       I_BIG, I_LAMBDA, I_WLRUOUT, I_WMEMKV, I_WXAOUT, I_WO, I_LN1G, I_LN1B, I_WFFNIN, I_WFFNOUT, I_LN2G, I_LN2B };

struct Params {
  const float* in[42];
  float* out;
  char* ws;
};

constexpr int LDS_BYTES = 65536;

__device__ __forceinline__ bf16_t f2bf(float f) {
  unsigned u = __float_as_uint(f);
  u += 0x7fffu + ((u >> 16) & 1u);
  return (bf16_t)(u >> 16);
}
__device__ __forceinline__ float bf2f(bf16_t h) { return __uint_as_float(((unsigned)h) << 16); }
__device__ __forceinline__ float sigmoidf_(float x) { return 1.f / (1.f + __expf(-x)); }
__device__ __forceinline__ float softplusf_(float x) { return fmaxf(x, 0.f) + log1pf(__expf(-fabsf(x))); }
__device__ __forceinline__ int swz(int rr, int b) { int ob = rr * 64 + b; return ob ^ (((ob >> 9) & 1) << 5); }

__device__ __forceinline__ int tid_() {
  int t = threadIdx.x;
  asm volatile("" : "+v"(t));
  return t;
}
template <int CTRL>
__device__ __forceinline__ float dppf(float x) {
  return __int_as_float(__builtin_amdgcn_update_dpp(0, __float_as_int(x), CTRL, 0xf, 0xf, true));
}
__device__ __forceinline__ float red16_sum(float x) {
  x += dppf<0xB1>(x);
  x += dppf<0x4E>(x);
  x += dppf<0x141>(x);
  x += dppf<0x140>(x);
  return x;
}
__device__ __forceinline__ float red16_max(float x) {
  x = fmaxf(x, dppf<0xB1>(x));
  x = fmaxf(x, dppf<0x4E>(x));
  x = fmaxf(x, dppf<0x141>(x));
  x = fmaxf(x, dppf<0x140>(x));
  return x;
}
__device__ __forceinline__ float wave_sum(float x) {
#pragma unroll
  for (int m = 1; m < 64; m <<= 1) x += __shfl_xor(x, m, 64);
  return x;
}

__device__ __forceinline__ void tok_info(int tok, int& seq, int& t, int& T) {
  if (tok < MP) { seq = tok >> 11; t = tok & 2047; T = 2048; }
  else { int s = tok - MP; seq = 8 + (s >> 2); t = s & 3; T = 4; }
}
__device__ __forceinline__ int seq_tok0(int seq) { return seq < 8 ? seq * 2048 : MP + (seq - 8) * 4; }


#define XB_TMO      128
#define XB_XCNT(j)  (256  + 64 * (j))
#define XB_XSUB(j)  (1280 + 64 * (j))
#define XB_XGEN(j)  (2304 + 64 * (j))
#define XB_TOP      3328
#define XB_TOPGEN   3392
#define XCD_BAR_WORDS 3456
#define XB_SPIN_CAP (1u << 22)
#define LAS __attribute__((address_space(3)))
__device__ __forceinline__ unsigned xb_ld(unsigned* p) { return __hip_atomic_load(p, __ATOMIC_RELAXED, __HIP_MEMORY_SCOPE_AGENT); }
__device__ __forceinline__ unsigned xb_add(unsigned* p, unsigned v) { return __hip_atomic_fetch_add(p, v, __ATOMIC_RELAXED, __HIP_MEMORY_SCOPE_AGENT); }
__device__ __forceinline__ unsigned xb_xcc_id() { return (unsigned)__builtin_amdgcn_s_getreg((3 << 11) | 20) & 0xFu; }
#define XB_SPIN(cond, bar) do { unsigned _sp = 0; while (cond) { __builtin_amdgcn_s_sleep(1); \
    if ((++_sp & 255u) == 0u) { if (xb_ld(&(bar)[XB_TMO])) break; if (_sp > XB_SPIN_CAP) { atomicAdd(&(bar)[XB_TMO], 1u); break; } } } } while (0)
struct XcdBarrier { unsigned* bar; unsigned x; volatile LAS unsigned* st; };
__device__ __forceinline__ XcdBarrier xcd_barrier_post(unsigned* bar, volatile LAS unsigned* st) {
  XcdBarrier b; b.bar = bar; b.x = xb_xcc_id(); b.st = st;
  if (threadIdx.x == 0) (void)xb_add(&bar[XB_XCNT(b.x)], 1u);
  return b;
}
__device__ __forceinline__ void xcd_barrier_complete(unsigned* bar, unsigned x, unsigned& nloc, unsigned& nx) {
  const unsigned G = gridDim.x * gridDim.y * gridDim.z;
  unsigned sum, cnt, mine, sp = 0u;
  for (;;) {
    sum = 0u; cnt = 0u; mine = 0u;
#pragma unroll
    for (unsigned j = 0; j < 16; ++j) { const unsigned c = xb_ld(&bar[XB_XCNT(j)]); sum += c; cnt += (c > 0u) ? 1u : 0u; mine = (j == x) ? c : mine; }
    if (sum == G) break;
    __builtin_amdgcn_s_sleep(1);
    if ((++sp & 255u) == 0u) { if (xb_ld(&bar[XB_TMO])) break; if (sp > XB_SPIN_CAP) { atomicAdd(&bar[XB_TMO], 1u); break; } }
  }
  nloc = mine > 0u ? mine : 1u; nx = cnt > 0u ? cnt : 1u;
}
__device__ __forceinline__ void xcd_barrier(const XcdBarrier& b) {
  asm volatile("s_waitcnt vmcnt(0)" ::: "memory");
  __syncthreads();
  if (threadIdx.x == 0) {
    unsigned* bar = b.bar;
    __builtin_amdgcn_s_waitcnt(0);
    unsigned nloc = b.st[0], nx = b.st[1];
    if (nloc == 0u) { xcd_barrier_complete(bar, b.x, nloc, nx); b.st[0] = nloc; b.st[1] = nx; }
    const unsigned old = xb_add(&bar[XB_XSUB(b.x)], 1u);
    const unsigned gen = old / nloc;
    if (old + 1u == (gen + 1u) * nloc) {
      __builtin_amdgcn_fence(__ATOMIC_RELEASE, "agent");
      asm volatile("s_waitcnt vmcnt(0)" ::: "memory");
      const unsigned og = xb_add(&bar[XB_TOP], 1u);
      const unsigned tg = og / nx;
      if (og + 1u == (tg + 1u) * nx) xb_add(&bar[XB_TOPGEN], 1u);
      else XB_SPIN(xb_ld(&bar[XB_TOPGEN]) == tg, bar);
      __builtin_amdgcn_fence(__ATOMIC_ACQUIRE, "agent");
      xb_add(&bar[XB_XGEN(b.x)], 1u);
      asm volatile("s_waitcnt vmcnt(0)" ::: "memory");
    } else {
      XB_SPIN(xb_ld(&bar[XB_XGEN(b.x)]) == gen, bar);
      __builtin_amdgcn_fence(__ATOMIC_ACQUIRE, "agent");
      asm volatile("s_waitcnt vmcnt(0)" ::: "memory");
    }
  }
  __syncthreads();
}

#define MFMA(a, b, c) __builtin_amdgcn_mfma_f32_16x16x32_bf16((a), (b), (c), 0, 0, 0)

template <int OFF>
__device__ __forceinline__ bf16x8 lds_rd128(unsigned addr) {
  bf16x8 v;
  asm volatile("ds_read_b128 %0, %1 offset:%2" : "=v"(v) : "v"(addr), "n"(OFF));
  return v;
}
template <int MTW, int NTW>
struct GemmCtx {
  const bf16_t* ga;
  const bf16_t* gb;
  int lda, ldb;
};
#define GEMM_STAGE_BYTES(MTW, NTW) (2048 * ((MTW) + (NTW)))
#define GEMM_NLD(MTW, NTW) (((MTW) + (NTW)) / 2)

template <int NTW>
__device__ __forceinline__ int gemm_brow(int s  , int rr  ) {
  return (s / NTW) * (16 * NTW) + (rr >> 2) * (4 * NTW) + (s % NTW) * 4 + (rr & 3);
}
template <int MTW, int NTW>
__device__ __forceinline__ void gemm_issue(const bf16_t* ga, int lda, const bf16_t* gb0, const bf16_t* gb1, int kt, char* wstage) {
#pragma unroll
  for (int j = 0; j < MTW / 2; ++j)
    __builtin_amdgcn_global_load_lds((const unsigned*)(ga + (size_t)(64 * j) * lda + kt * 32), (unsigned*)(wstage + j * 4096), 16, 0, 0);
  __builtin_amdgcn_global_load_lds((const unsigned*)(gb0 + kt * 32), (unsigned*)(wstage + MTW * 2048), 16, 0, 0);
  if constexpr (NTW == 4)
    __builtin_amdgcn_global_load_lds((const unsigned*)(gb1 + kt * 32), (unsigned*)(wstage + MTW * 2048 + 4096), 16, 0, 0);
}

template <int MTW, int NTW>
__device__ __forceinline__ void gemm_prologue(const bf16_t* __restrict__ A, int lda, const bf16_t* __restrict__ Bt, int ldb,
                                              int m0, int n0, char* lds) {
  constexpr int SB = GEMM_STAGE_BYTES(MTW, NTW);
  const int TX = tid_();
  const int lane = TX & 63, wv = TX >> 6;
  const int obs = lane * 16;
  const int ob = obs ^ (((obs >> 9) & 1) << 5);
  const int srow = wv * 16 + (ob >> 6), scol = (ob & 63) >> 1;
  const bf16_t* ga = A + (size_t)(m0 + srow) * lda + scol;
  const bf16_t* gb0 = Bt + (size_t)(n0 + gemm_brow<NTW>(wv, ob >> 6)) * ldb + scol;
  const bf16_t* gb1 = Bt + (size_t)(n0 + gemm_brow<NTW>(wv + 4, ob >> 6)) * ldb + scol;
  char* wbase = lds + wv * 1024;
#pragma unroll
  for (int t = 0; t < 3; ++t) gemm_issue<MTW, NTW>(ga, lda, gb0, gb1, t, wbase + t * SB);
}

template <int MTW, int NTW>
__device__ __forceinline__ void gemm_loop(const bf16_t* __restrict__ A, int lda, const bf16_t* __restrict__ Bt, int ldb,
                                          int K, int m0, int n0, char* lds, f32x4 (&acc)[MTW][NTW]) {
  constexpr int SB = GEMM_STAGE_BYTES(MTW, NTW), NLD = GEMM_NLD(MTW, NTW);
  static_assert(NLD == 4 || NLD == 3, "vmcnt immediates below assume 3 or 4 loads per k-step");
  const int TX = tid_();
  const int lane = TX & 63, wv = TX >> 6;
  const int wr = wv >> 1, wc = wv & 1, fr = lane & 15, fq = lane >> 4;
  const int obs = lane * 16;
  const int ob = obs ^ (((obs >> 9) & 1) << 5);
  const int srow = wv * 16 + (ob >> 6), scol = (ob & 63) >> 1;
  const bf16_t* ga = A + (size_t)(m0 + srow) * lda + scol;
  const bf16_t* gb0 = Bt + (size_t)(n0 + gemm_brow<NTW>(wv, ob >> 6)) * ldb + scol;
  const bf16_t* gb1 = Bt + (size_t)(n0 + gemm_brow<NTW>(wv + 4, ob >> 6)) * ldb + scol;
  char* wbase = lds + wv * 1024;
  const int fo = swz(fr, fq * 16);
  const unsigned lbase = (unsigned)(unsigned long)((__attribute__((address_space(3))) char*)lds);
  const unsigned a_off = lbase + (wr * MTW) * 1024 + fo, b_off = lbase + MTW * 2048 + (wc * NTW) * 1024 + fo;
  const int nk = K >> 5;
  for (int kt = 0; kt < nk; ++kt) {
    if (kt + 2 < nk) { if (NLD == 4) asm volatile("s_waitcnt vmcnt(8)" ::: "memory"); else asm volatile("s_waitcnt vmcnt(6)" ::: "memory"); }
    else if (kt + 1 < nk) { if (NLD == 4) asm volatile("s_waitcnt vmcnt(4)" ::: "memory"); else asm volatile("s_waitcnt vmcnt(3)" ::: "memory"); }
    else asm volatile("s_waitcnt vmcnt(0)" ::: "memory");
    __builtin_amdgcn_s_barrier();
    asm volatile("" ::: "memory");
    static_assert(MTW == 4, "fragment read block below is written for 4 m-tiles per wave");
    const unsigned sa_ = a_off + (kt & 3) * SB, sb_ = b_off + (kt & 3) * SB;
    bf16x8 af[MTW], bfr[NTW];
    af[0] = lds_rd128<0>(sa_); af[1] = lds_rd128<1024>(sa_); af[2] = lds_rd128<2048>(sa_); af[3] = lds_rd128<3072>(sa_);
    bfr[0] = lds_rd128<0>(sb_); bfr[1] = lds_rd128<1024>(sb_);
    if constexpr (NTW == 4) { bfr[2] = lds_rd128<2048>(sb_); bfr[3] = lds_rd128<3072>(sb_); }
    if (kt + 3 < nk) gemm_issue<MTW, NTW>(ga, lda, gb0, gb1, kt + 3, wbase + ((kt + 3) & 3) * SB);
    if constexpr (NTW == 4)
      asm volatile("s_waitcnt lgkmcnt(0)" : "+v"(af[0]), "+v"(af[1]), "+v"(af[2]), "+v"(af[3]), "+v"(bfr[0]), "+v"(bfr[1]), "+v"(bfr[2]), "+v"(bfr[3]) :: "memory");
    else
      asm volatile("s_waitcnt lgkmcnt(0)" : "+v"(af[0]), "+v"(af[1]), "+v"(af[2]), "+v"(af[3]), "+v"(bfr[0]), "+v"(bfr[1]) :: "memory");
#pragma unroll
    for (int mt = 0; mt < MTW; ++mt)
#pragma unroll
      for (int nt = 0; nt < NTW; ++nt) acc[mt][nt] = MFMA(bfr[nt], af[mt], acc[mt][nt]);
  }
  asm volatile("s_waitcnt lgkmcnt(0)" ::: "memory");
  __builtin_amdgcn_s_barrier();
  asm volatile("" ::: "memory");
}

template <int MTW, int NTW>
__device__ __forceinline__ void gemm_main(const bf16_t* __restrict__ A, int lda, const bf16_t* __restrict__ Bt, int ldb,
                                          int K, int m0, int n0, char* lds, f32x4 (&acc)[MTW][NTW]) {
  gemm_prologue<MTW, NTW>(A, lda, Bt, ldb, m0, n0, lds);
  gemm_loop<MTW, NTW>(A, lda, Bt, ldb, K, m0, n0, lds, acc);
}

__device__ __forceinline__ uint4 pack8(const f32x4& a, const f32x4& b) {
  uint4 o;
  o.x = (unsigned)f2bf(a[0]) | ((unsigned)f2bf(a[1]) << 16);
  o.y = (unsigned)f2bf(a[2]) | ((unsigned)f2bf(a[3]) << 16);
  o.z = (unsigned)f2bf(b[0]) | ((unsigned)f2bf(b[1]) << 16);
  o.w = (unsigned)f2bf(b[2]) | ((unsigned)f2bf(b[3]) << 16);
  return o;
}

struct TileIter {
  int L, Lend, step;
};
__device__ __forceinline__ TileIter tile_iter(int ntiles) {
  const int G = (int)gridDim.x, b = (int)blockIdx.x;
  TileIter it;
  if ((G & 7) == 0) {
    const int tpx = (ntiles + 7) >> 3, x = b & 7;
    it.L = x * tpx + (b >> 3);
    it.Lend = min(ntiles, (x + 1) * tpx);
    it.step = G >> 3;
  } else {
    it.L = b; it.Lend = ntiles; it.step = G;
  }
  return it;
}
__device__ __forceinline__ void tile_mn(int L, int nM, int nN, int& m, int& n) {
  const int full = (nM >> 3) * 8 * nN;
  if (L < full) {
    const int band = L / (8 * nN), r = L % (8 * nN);
    n = r >> 3; m = band * 8 + (r & 7);
  } else {
    const int rem = nM & 7, r = L - full;
    n = r / rem; m = (nM >> 3) * 8 + r % rem;
  }
}

template <int MTW, int NTW>
__device__ __forceinline__ void zero_acc(f32x4 (&acc)[MTW][NTW]) {
#pragma unroll
  for (int a = 0; a < MTW; ++a)
#pragma unroll
    for (int b = 0; b < NTW; ++b) acc[a][b] = f32x4{0.f, 0.f, 0.f, 0.f};
}

__device__ void transpose_tile(const float* __restrict__ W, int ldw, bf16_t* __restrict__ Wt, int ldt, int k0, int n0,
                               int perm, char* lds) {
  const int TX = tid_();
  float* tile = (float*)lds;
  const int tid = TX;
  const int c = tid & 63, r0 = tid >> 6;
#pragma unroll
  for (int r = 0; r < 16; ++r) {
    int row = r * 4 + r0;
    tile[row * 65 + c] = W[(size_t)(k0 + row) * ldw + n0 + c];
  }
  __syncthreads();
#pragma unroll
  for (int r = 0; r < 16; ++r) {
    int n = n0 + r * 4 + r0;
    int np = n;
    if (perm) {
      if (n < DFF) np = (n >> 3) * 16 + (n & 7);
      else { int j = n - DFF; np = (j >> 3) * 16 + 8 + (j & 7); }
    }
    Wt[(size_t)np * ldt + k0 + c] = f2bf(tile[c * 65 + (r * 4 + r0)]);
  }
  __syncthreads();
}

__device__ __forceinline__ void convert_job(const float* __restrict__ src, bf16_t* __restrict__ dst, int K, int N, int nmat,
                                            int perm, int& start, char* lds) {
  const int tk = K / 64, tn = N / 64;
  const int ntiles = nmat * tk * tn;
  const int G = (int)gridDim.x;
  const int first = (((int)blockIdx.x - start) % G + G) % G;
  for (int i = first; i < ntiles; i += G) {
    const int mat = i / (tk * tn), r = i % (tk * tn);
    const int kt = r / tn, nt = r % tn;
    transpose_tile(src + (size_t)mat * K * N, N, dst + (size_t)mat * K * N, K, kt * 64, nt * 64, perm, lds);
  }
  start += ntiles;
}

__device__ void phase_convert(const Params& p, char* lds) {
  const int TX = tid_();
  char* ws = p.ws;
  int start = 0;
  convert_job(p.in[I_WIN], (bf16_t*)(ws + W_IN), 1024, 7680, NL, 0, start, lds);
  convert_job(p.in[I_WFFNIN], (bf16_t*)(ws + W_FFNIN), 1024, 5632, NL, 1, start, lds);
  convert_job(p.in[I_WFFNOUT], (bf16_t*)(ws + W_FFNOUT), 2816, 1024, NL, 0, start, lds);
  convert_job(p.in[I_WRWOUT], (bf16_t*)(ws + W_RWOUT), 768, 1024, NL, 0, start, lds);
  convert_job(p.in[I_WLRUOUT], (bf16_t*)(ws + W_LRUOUT), 768, 1024, NL, 0, start, lds);
  convert_job(p.in[I_WXAOUT], (bf16_t*)(ws + W_XAOUT), 512, 1024, NL, 0, start, lds);
  convert_job(p.in[I_WO], (bf16_t*)(ws + W_O), 1024, 1024, NL, 0, start, lds);
  convert_job(p.in[I_WMEMKV], (bf16_t*)(ws + W_MEMKV), 1024, 1024, NL, 0, start, lds);
  convert_job(p.in[I_W2], (bf16_t*)(ws + W_W2T), 64, 768, NL, 0, start, lds);
  convert_job(p.in[I_A2], (bf16_t*)(ws + W_A2T), 64, 768, NL, 0, start, lds);
  convert_job(p.in[I_G2], (bf16_t*)(ws + W_G2T), 128, 768, NL, 0, start, lds);
  convert_job(p.in[I_WRG], (bf16_t*)(ws + W_RGT), 64, 64, NL * 12, 0, start, lds);
  convert_job(p.in[I_WIG], (bf16_t*)(ws + W_IGT), 64, 64, NL * 12, 0, start, lds);
  const size_t gtid = (size_t)blockIdx.x * 256 + TX, gsz = (size_t)gridDim.x * 256;
  {
    uint2* xb = (uint2*)(ws + B_XB);
    const float4* xp = (const float4*)p.in[I_XP];
    const float4* xs = (const float4*)p.in[I_XS];
    const size_t np4 = (size_t)MP * D / 4, nt4 = (size_t)MT * D / 4;
    for (size_t i = gtid; i < nt4; i += gsz) {
      float4 v = (i < np4) ? xp[i] : xs[i - np4];
      uint2 o;
      o.x = (unsigned)f2bf(v.x) | ((unsigned)f2bf(v.y) << 16);
      o.y = (unsigned)f2bf(v.z) | ((unsigned)f2bf(v.w) << 16);
      xb[i] = o;
    }
  }
  {
    uint2* mb = (uint2*)(ws + B_MEMB);
    const float4* m = (const float4*)p.in[I_MEM];
    const size_t n4 = (size_t)2048 * D / 4;
    for (size_t i = gtid; i < n4; i += gsz) {
      float4 v = m[i];
      uint2 o;
      o.x = (unsigned)f2bf(v.x) | ((unsigned)f2bf(v.y) << 16);
      o.y = (unsigned)f2bf(v.z) | ((unsigned)f2bf(v.w) << 16);
      mb[i] = o;
    }
  }
  {
    bf16_t* v1t = (bf16_t*)(ws + W_V1T);
    const float* v1 = p.in[I_V1];
    for (size_t i = gtid; i < (size_t)3 * 768 * 32; i += gsz) {
      int j = (int)(i / (768 * 32)), r = (int)(i % (768 * 32));
      int n = r / 768, k = r % 768;
      v1t[i] = f2bf(v1[(size_t)j * 768 * 32 + (size_t)k * 32 + n]);
    }
  }
  {
    bf16_t* v2t = (bf16_t*)(ws + W_V2T);
    const float* v2 = p.in[I_V2];
    for (size_t i = gtid; i < (size_t)3 * 768 * 32; i += gsz) {
      int j = (int)(i / (768 * 32)), r = (int)(i % (768 * 32));
      int n = r / 32, k = r % 32;
      v2t[i] = f2bf(v2[(size_t)j * 32 * 768 + (size_t)k * 768 + n]);
    }
  }
}

struct ProjTile { const bf16_t* A; const bf16_t* Bt; int m0, n0, ll; bool main; };
__device__ __forceinline__ ProjTile proj_tile(const Params& p, int l, int tile, int nextra) {
  char* ws = p.ws;
  ProjTile t;
  if (tile >= nextra) {
    int tm, tn;
    tile_mn(tile - nextra, MT / 128, DIN / 128, tm, tn);
    t.A = (const bf16_t*)(ws + B_XB); t.Bt = (const bf16_t*)(ws + W_IN) + (size_t)l * DIN * D;
    t.m0 = tm * 128; t.n0 = tn * 128; t.ll = l; t.main = true;
  } else {
    const int ll = tile / 128, r = tile % 128;
    t.A = (const bf16_t*)(ws + B_MEMB); t.Bt = (const bf16_t*)(ws + W_MEMKV) + (size_t)ll * D * D;
    t.m0 = (r / 8) * 128; t.n0 = (r % 8) * 128; t.ll = ll; t.main = false;
  }
  return t;
}

__device__ void phase_proj(const Params& p, int l, char* lds) {
  const int TX = tid_();
  char* ws = p.ws;
  bf16_t* proj = (bf16_t*)(ws + B_PROJ);
  const int lane = TX & 63, wv = TX >> 6, wr = wv >> 1, wc = wv & 1, fr = lane & 15, fq = lane >> 4;
  const int ntiles = (MT / 128) * (DIN / 128);
  const int nextra = (l == 0) ? NL * 16 * 8 : 0;
  TileIter it = tile_iter(ntiles + nextra);
  bool have = it.L < it.Lend;
  ProjTile cur;
  if (have) { cur = proj_tile(p, l, it.L, nextra); gemm_prologue<4, 4>(cur.A, D, cur.Bt, D, cur.m0, cur.n0, lds); }
  while (have) {
    f32x4 acc[4][4];
    zero_acc(acc);
    gemm_loop<4, 4>(cur.A, D, cur.Bt, D, D, cur.m0, cur.n0, lds, acc);
    const int Ln = it.L + it.step;
    const bool hn = Ln < it.Lend;
    ProjTile nxt = cur;
    if (hn) { nxt = proj_tile(p, l, Ln, nextra); gemm_prologue<4, 4>(nxt.A, D, nxt.Bt, D, nxt.m0, nxt.n0, lds); }
    const int m0 = cur.m0, n0 = cur.n0;
    if (cur.main) {
#pragma unroll
      for (int mt = 0; mt < 4; ++mt) {
        const int row = m0 + wr * 64 + mt * 16 + fr, col = n0 + wc * 64 + fq * 16;
        uint4* dst = (uint4*)(proj + (size_t)row * DIN + col);
        dst[0] = pack8(acc[mt][0], acc[mt][1]);
        dst[1] = pack8(acc[mt][2], acc[mt][3]);
      }
    } else {
      const int ll = cur.ll;
      bf16_t* kb = (bf16_t*)(ws + B_KB);
      bf16_t* vtb = (bf16_t*)(ws + B_VTB);
#pragma unroll
      for (int mt = 0; mt < 4; ++mt)
#pragma unroll
        for (int nt = 0; nt < 4; ++nt)
#pragma unroll
          for (int i = 0; i < 4; ++i) {
            int row = m0 + wr * 64 + mt * 16 + fr, col = n0 + wc * 64 + fq * 16 + nt * 4 + i;
            int b = row >> 8, key = row & 255;
            float v = acc[mt][nt][i];
            if (col < 512) {
              p.out[O_MKP + ((size_t)(ll * 8 + b) * 256 + key) * 512 + col] = v;
              kb[((size_t)(ll * 8 + b) * 256 + key) * 512 + col] = f2bf(v);
            } else {
              int c2 = col - 512, h = c2 >> 7, d = c2 & 127;
              p.out[O_MVP + ((size_t)(ll * 8 + b) * 256 + key) * 512 + c2] = v;
              vtb[(((size_t)(ll * 8 + b) * 4 + h) * 128 + d) * 256 + key] = f2bf(v);
            }
          }
    }
    it.L = Ln; have = hn; cur = nxt;
  }
}

__device__ __forceinline__ float prw_prev(const Params& p, const bf16_t* proj, int l, int tok, int seq, int t, int c) {
  if (t > 0) return bf2f(proj[(size_t)(tok - 1) * DIN + c]);
  if (seq >= 8) return p.in[I_SSHIFT][((size_t)l * 128 + (seq - 8)) * RWC + c];
  return 0.f;
}
__device__ __forceinline__ float plx_back(const Params& p, const bf16_t* proj, int l, int tok, int seq, int t, int j, int ch) {
  if (t - j >= 0) return bf2f(proj[(size_t)(tok - j) * DIN + C_LX + ch]);
  if (seq >= 8) return p.in[I_SCONV][(((size_t)l * 128 + (seq - 8)) * 3 + (3 + t - j)) * DLRU + ch];
  return 0.f;
}

__device__ __forceinline__ float2 ld_bf2(const bf16_t* p) {
  const unsigned u = *(const unsigned*)p;
  return make_float2(__uint_as_float(u << 16), __uint_as_float(u & 0xffff0000u));
}
__device__ __forceinline__ unsigned pk_bf2(float a, float b) { return (unsigned)f2bf(a) | ((unsigned)f2bf(b) << 16); }
__device__ __forceinline__ float2 prw_prev2(const Params& p, const bf16_t* proj, int l, int tok, int seq, int t, int c) {
  if (t > 0) return ld_bf2(proj + (size_t)(tok - 1) * DIN + c);
  if (seq >= 8) return *(const float2*)(p.in[I_SSHIFT] + ((size_t)l * 128 + (seq - 8)) * RWC + c);
  return make_float2(0.f, 0.f);
}
__device__ __forceinline__ float2 plx_back2(const Params& p, const bf16_t* proj, int l, int tok, int seq, int t, int j, int ch) {
  if (t - j >= 0) return ld_bf2(proj + (size_t)(tok - j) * DIN + C_LX + ch);
  if (seq >= 8) return *(const float2*)(p.in[I_SCONV] + (((size_t)l * 128 + (seq - 8)) * 3 + (3 + t - j)) * DLRU + ch);
  return make_float2(0.f, 0.f);
}

__device__ void phase_prep(const Params& p, int l, char* lds) {
  const int TX = tid_();
  char* ws = p.ws;
  const bf16_t* proj = (const bf16_t*)(ws + B_PROJ);
  bf16_t* L = (bf16_t*)(ws + B_LBUF);
  bf16_t* XC = (bf16_t*)(ws + B_ALRU);
  float* ubuf = (float*)(ws + B_UBUF);
  bf16_t* vmid = (bf16_t*)(ws + B_VMID);
  const float* mu = p.in[I_MU] + (size_t)l * RWC;
  const float* cw = p.in[I_CONVW] + (size_t)l * 4 * DLRU;
  const float* cb = p.in[I_CONVB] + (size_t)l * DLRU;
  const int tid = TX, lane = tid & 63, wv = tid >> 6, fr = lane & 15, fq = lane >> 4;
  for (int item = blockIdx.x; item < MT / 16; item += gridDim.x) {
    const int tokb = item * 16;
    auto body = [&](auto interior_tag) {
    constexpr bool INTR = decltype(interior_tag)::value;
#pragma unroll 8
    for (int u = tid; u < 16 * 128; u += 256) {
      const int tk = u >> 7, cp = (u & 127) * 2, tok = tokb + tk, c = 2304 + cp;
      int seq = 0, t = 16, T = 2048;
      if constexpr (!INTR) tok_info(tok, seq, t, T);
      const float2 pc = ld_bf2(proj + (size_t)tok * DIN + c);
      float2 pp;
      if constexpr (INTR) pp = ld_bf2(proj + (size_t)(tok - 1) * DIN + c); else pp = prw_prev2(p, proj, l, tok, seq, t, c);
      const float2 m2 = *(const float2*)(mu + c);
      const float x0 = pc.x + (pp.x - pc.x) * m2.x, x1 = pc.y + (pp.y - pc.y) * m2.y;
      float o0, o1;
      if (cp < 64) { o0 = tanhf(x0); o1 = tanhf(x1); }
      else if (cp < 128) { o0 = x0; o1 = x1; }
      else { o0 = sigmoidf_(x0); o1 = sigmoidf_(x1); }
      *(unsigned*)(L + (size_t)tok * 256 + cp) = pk_bf2(o0, o1);
    }
#pragma unroll 4
    for (int u = tid; u < 16 * 384; u += 256) {
      const int tk = u / 384, ch = (u % 384) * 2, tok = tokb + tk;
      int seq = 0, t = 16, T = 2048;
      if constexpr (INTR) { seq = tok >> 11; t = tok & 2047; } else tok_info(tok, seq, t, T);
      const float2 x0 = ld_bf2(proj + (size_t)tok * DIN + C_LX + ch);
      float2 x1, x2, x3;
      if constexpr (INTR) {
        x1 = ld_bf2(proj + (size_t)(tok - 1) * DIN + C_LX + ch);
        x2 = ld_bf2(proj + (size_t)(tok - 2) * DIN + C_LX + ch);
        x3 = ld_bf2(proj + (size_t)(tok - 3) * DIN + C_LX + ch);
      } else {
        x1 = plx_back2(p, proj, l, tok, seq, t, 1, ch);
        x2 = plx_back2(p, proj, l, tok, seq, t, 2, ch);
        x3 = plx_back2(p, proj, l, tok, seq, t, 3, ch);
      }
      const float2 b2 = *(const float2*)(cb + ch), w3 = *(const float2*)(cw + 3 * DLRU + ch), w2 = *(const float2*)(cw + 2 * DLRU + ch),
                   w1 = *(const float2*)(cw + DLRU + ch), w0 = *(const float2*)(cw + ch);
      const float xa = b2.x + w3.x * x0.x + w2.x * x1.x + w1.x * x2.x + w0.x * x3.x;
      const float xb_ = b2.y + w3.y * x0.y + w2.y * x1.y + w1.y * x2.y + w0.y * x3.y;
      *(float2*)(ubuf + (size_t)tok * DLRU + ch) = make_float2(xa, xb_);
      *(unsigned*)(XC + (size_t)tok * DLRU + ch) = pk_bf2(xa, xb_);
      if (t >= T - 3) {
        const size_t o = (seq < 8) ? O_CONVP + (((size_t)l * 8 + seq) * 3 + (t - (T - 3))) * DLRU
                                   : O_CONVS + (((size_t)l * 128 + (seq - 8)) * 3 + (t - (T - 3))) * DLRU;
        *(float2*)(p.out + o + ch) = x0;
      }
      if (l > 0) {
        const int c = 1536 + ch;
        const float2 pc = ld_bf2(proj + (size_t)tok * DIN + c);
        float2 pp;
        if constexpr (INTR) pp = ld_bf2(proj + (size_t)(tok - 1) * DIN + c); else pp = prw_prev2(p, proj, l, tok, seq, t, c);
        const float2 m2 = *(const float2*)(mu + c);
        const float v0 = pc.x + (pp.x - pc.x) * m2.x, v1 = pc.y + (pp.y - pc.y) * m2.y;
        *(unsigned*)(lds + (ch >> 5) * 1024 + swz(tk, (ch & 31) * 2)) = pk_bf2(v0, v1);
      }
    }
    };
    if (tokb < MP && (tokb & 2047) != 0) body(std::true_type{}); else body(std::false_type{});
    for (int tk = 0; tk < 16; ++tk) {
      const int tok = tokb + tk;
      int seq, t, T;
      tok_info(tok, seq, t, T);
      if (t == T - 1) {
        const size_t o = (seq < 8) ? O_SHP + ((size_t)l * 8 + seq) * RWC : O_SHS + ((size_t)l * 128 + (seq - 8)) * RWC;
        for (int c = tid * 2; c < RWC; c += 512) *(float2*)(p.out + o + c) = ld_bf2(proj + (size_t)tok * DIN + c);
      }
    }
    if (l > 0) {
      __syncthreads();
      const bf16_t* v1t = (const bf16_t*)(ws + W_V1T) + (size_t)(l - 1) * 32 * DRW;
      f32x4 acc0 = f32x4{0, 0, 0, 0}, acc1 = acc0;
      const int fo = swz(fr, fq * 16);
#pragma unroll
      for (int kk = 0; kk < 6; ++kk) {
        const int ks = wv * 6 + kk;
        const bf16x8 af = *(const bf16x8*)(lds + ks * 1024 + fo);
        const bf16x8 b0 = *(const bf16x8*)(v1t + (size_t)fr * DRW + ks * 32 + fq * 8);
        const bf16x8 b1 = *(const bf16x8*)(v1t + (size_t)(16 + fr) * DRW + ks * 32 + fq * 8);
        acc0 = MFMA(af, b0, acc0);
        acc1 = MFMA(af, b1, acc1);
      }
      float* red = (float*)(lds + 24576);
#pragma unroll
      for (int i = 0; i < 4; ++i) {
        red[(wv * 16 + fq * 4 + i) * 32 + fr] = acc0[i];
        red[(wv * 16 + fq * 4 + i) * 32 + 16 + fr] = acc1[i];
      }
      __syncthreads();
      {
        const int row = tid >> 4, c2 = (tid & 15) * 2;
        float s0 = 0.f, s1 = 0.f;
#pragma unroll
        for (int w = 0; w < 4; ++w) { s0 += red[(w * 16 + row) * 32 + c2]; s1 += red[(w * 16 + row) * 32 + c2 + 1]; }
        *(unsigned*)(vmid + (size_t)(tokb + row) * 32 + c2) = pk_bf2(s0, s1);
      }
      __syncthreads();
    }
  }
}

__device__ __forceinline__ void unpack4(const uint2 q, float (&o)[4]) {
  o[0] = __uint_as_float(q.x << 16); o[1] = __uint_as_float(q.x & 0xffff0000u);
  o[2] = __uint_as_float(q.y << 16); o[3] = __uint_as_float(q.y & 0xffff0000u);
}
__device__ __forceinline__ void prw_prev4(const Params& p, const bf16_t* proj, int l, int tok, int seq, int t, int c, float (&o)[4]) {
  if (t > 0) { unpack4(*(const uint2*)(proj + (size_t)(tok - 1) * DIN + c), o); return; }
  if (seq >= 8) {
    const float4 s = *(const float4*)(p.in[I_SSHIFT] + ((size_t)l * 128 + (seq - 8)) * RWC + c);
    o[0] = s.x; o[1] = s.y; o[2] = s.z; o[3] = s.w;
    return;
  }
  o[0] = 0.f; o[1] = 0.f; o[2] = 0.f; o[3] = 0.f;
}

__device__ void phase_lora(const Params& p, int l, char* lds) {
  const int TX = tid_();
  char* ws = p.ws;
  const bf16_t* proj = (const bf16_t*)(ws + B_PROJ);
  const bf16_t* L = (const bf16_t*)(ws + B_LBUF);
  const bf16_t* vmid = (const bf16_t*)(ws + B_VMID);
  const bf16_t* XC = (const bf16_t*)(ws + B_ALRU);
  const int NRW = (MT / 128) * 12;
  for (int item = blockIdx.x; item < NRW; item += gridDim.x) {
    int txl = TX;
    asm volatile("" : "+v"(txl));
    const int lane = txl & 63, wv = txl >> 6, fr = lane & 15, fq = lane >> 4;
    {
      const int h = item % 12, tb = (item / 12) * 128 + wv * 32;
      const bf16_t* w2t = (const bf16_t*)(ws + W_W2T) + ((size_t)l * DRW + h * 64) * 64;
      const bf16_t* a2t = (const bf16_t*)(ws + W_A2T) + ((size_t)l * DRW + h * 64) * 64;
      const bf16_t* g2t = (const bf16_t*)(ws + W_G2T) + ((size_t)l * DRW + h * 64) * 128;
      bf16_t* gbuf = (bf16_t*)(ws + B_GBUF);
      {
        f32x4 ag[2][4];
#pragma unroll
        for (int a = 0; a < 2; ++a)
#pragma unroll
          for (int b = 0; b < 4; ++b) ag[a][b] = f32x4{0, 0, 0, 0};
#pragma unroll
        for (int ks = 0; ks < 4; ++ks) {
          bf16x8 af[2], bf_[4];
#pragma unroll
          for (int mt = 0; mt < 2; ++mt) af[mt] = *(const bf16x8*)(L + (size_t)(tb + mt * 16 + fr) * 256 + 128 + ks * 32 + fq * 8);
#pragma unroll
          for (int nt = 0; nt < 4; ++nt) bf_[nt] = *(const bf16x8*)(g2t + (size_t)(nt * 16 + fr) * 128 + ks * 32 + fq * 8);
#pragma unroll
          for (int mt = 0; mt < 2; ++mt)
#pragma unroll
            for (int nt = 0; nt < 4; ++nt) ag[mt][nt] = MFMA(af[mt], bf_[nt], ag[mt][nt]);
        }
#pragma unroll
        for (int mt = 0; mt < 2; ++mt)
#pragma unroll
          for (int nt = 0; nt < 4; ++nt)
#pragma unroll
            for (int i = 0; i < 4; ++i)
              gbuf[(size_t)(tb + mt * 16 + fq * 4 + i) * DRW + h * 64 + nt * 16 + fr] = f2bf(ag[mt][nt][i]);
      }
      f32x4 aw[2][4], aa[2][4], av[2][4];
#pragma unroll
      for (int a = 0; a < 2; ++a)
#pragma unroll
        for (int b = 0; b < 4; ++b) { aw[a][b] = f32x4{0, 0, 0, 0}; aa[a][b] = aw[a][b]; av[a][b] = aw[a][b]; }
#pragma unroll
      for (int ks = 0; ks < 2; ++ks) {
        bf16x8 af[2], bf_[4];
#pragma unroll
        for (int mt = 0; mt < 2; ++mt) af[mt] = *(const bf16x8*)(L + (size_t)(tb + mt * 16 + fr) * 256 + ks * 32 + fq * 8);
#pragma unroll
        for (int nt = 0; nt < 4; ++nt) bf_[nt] = *(const bf16x8*)(w2t + (size_t)(nt * 16 + fr) * 64 + ks * 32 + fq * 8);
#pragma unroll
        for (int mt = 0; mt < 2; ++mt)
#pragma unroll
          for (int nt = 0; nt < 4; ++nt) aw[mt][nt] = MFMA(af[mt], bf_[nt], aw[mt][nt]);
#pragma unroll
        for (int mt = 0; mt < 2; ++mt) af[mt] = *(const bf16x8*)(L + (size_t)(tb + mt * 16 + fr) * 256 + 64 + ks * 32 + fq * 8);
#pragma unroll
        for (int nt = 0; nt < 4; ++nt) bf_[nt] = *(const bf16x8*)(a2t + (size_t)(nt * 16 + fr) * 64 + ks * 32 + fq * 8);
#pragma unroll
        for (int mt = 0; mt < 2; ++mt)
#pragma unroll
          for (int nt = 0; nt < 4; ++nt) aa[mt][nt] = MFMA(af[mt], bf_[nt], aa[mt][nt]);
      }
      if (l > 0) {
        const bf16_t* v2t = (const bf16_t*)(ws + W_V2T) + ((size_t)(l - 1) * DRW + h * 64) * 32;
        bf16x8 af[2], bf_[4];
#pragma unroll
        for (int mt = 0; mt < 2; ++mt) af[mt] = *(const bf16x8*)(vmid + (size_t)(tb + mt * 16 + fr) * 32 + fq * 8);
#pragma unroll
        for (int nt = 0; nt < 4; ++nt) bf_[nt] = *(const bf16x8*)(v2t + (size_t)(nt * 16 + fr) * 32 + fq * 8);
#pragma unroll
        for (int mt = 0; mt < 2; ++mt)
#pragma unroll
          for (int nt = 0; nt < 4; ++nt) av[mt][nt] = MFMA(af[mt], bf_[nt], av[mt][nt]);
      }
      const float* mu = p.in[I_MU] + (size_t)l * RWC;
      float mur[4], muk[4], muv[4], w0[4], a0[4], v0[4], kkp[4], kap[4], rkp[4];
#pragma unroll
      for (int nt = 0; nt < 4; ++nt) {
        int c = h * 64 + nt * 16 + fr;
        mur[nt] = mu[c]; muk[nt] = mu[768 + c]; muv[nt] = mu[1536 + c];
        w0[nt] = p.in[I_W0][(size_t)l * DRW + c];
        a0[nt] = p.in[I_A0][(size_t)l * DRW + c];
        v0[nt] = (l > 0) ? p.in[I_V0][(size_t)(l - 1) * DRW + c] : 0.f;
        kkp[nt] = p.in[I_KK][(size_t)l * DRW + c];
        kap[nt] = p.in[I_KA][(size_t)l * DRW + c];
        rkp[nt] = p.in[I_RK][(size_t)l * DRW + c];
      }
      bf16_t* vfirst = (bf16_t*)(ws + B_VFIRST);
      float* cbuf = (float*)(ws + B_CBUF);
      char* scan = ws + B_SCAN;
      auto epi = [&](auto interior_tag) {
      constexpr bool INTR = decltype(interior_tag)::value;
#pragma unroll
      for (int mt = 0; mt < 2; ++mt)
#pragma unroll
        for (int i = 0; i < 4; ++i) {
          const int tok = tb + mt * 16 + fq * 4 + i;
          int seq = 0, t = 1, T = 2048;
          if constexpr (!INTR) tok_info(tok, seq, t, T);
          const bf16_t* pr = proj + (size_t)tok * DIN;
          float rr[4], kx[4], vv[4], aval[4], dec[4], kkr[4], kmod[4];
          float ss = 0.f, s1 = 0.f, s2 = 0.f, s3 = 0.f;
#pragma unroll
          for (int nt = 0; nt < 4; ++nt) {
            const int cc = nt * 16 + fr, c = h * 64 + cc;
            float pc, pp;
            pc = bf2f(pr[c]);
            if constexpr (INTR) pp = bf2f(pr[c - DIN]); else pp = prw_prev(p, proj, l, tok, seq, t, c);
            rr[nt] = pc + (pp - pc) * mur[nt];
            pc = bf2f(pr[768 + c]);
            if constexpr (INTR) pp = bf2f(pr[768 + c - DIN]); else pp = prw_prev(p, proj, l, tok, seq, t, 768 + c);
            kx[nt] = pc + (pp - pc) * muk[nt];
            pc = bf2f(pr[1536 + c]);
            if constexpr (INTR) pp = bf2f(pr[1536 + c - DIN]); else pp = prw_prev(p, proj, l, tok, seq, t, 1536 + c);
            float vx = pc + (pp - pc) * muv[nt];
            float wraw = -softplusf_(-(w0[nt] + aw[mt][nt][i])) - 0.5f;
            dec[nt] = __expf(-__expf(wraw));
            aval[nt] = sigmoidf_(a0[nt] + aa[mt][nt][i]);
            if (l > 0) {
              float vf = bf2f(vfirst[(size_t)tok * DRW + c]);
              vv[nt] = vx + (vf - vx) * sigmoidf_(v0[nt] + av[mt][nt][i]);
            } else {
              vfirst[(size_t)tok * DRW + c] = f2bf(vx);
              vv[nt] = vx;
            }
            kkr[nt] = kx[nt] * kkp[nt];
            kmod[nt] = kx[nt] * (1.f + (aval[nt] - 1.f) * kap[nt]);
            ss += kkr[nt] * kkr[nt];
            s1 += kkr[nt] * aval[nt] * rr[nt];
            s2 += kmod[nt] * rr[nt];
            s3 += rr[nt] * kmod[nt] * rkp[nt];
          }
          ss = red16_sum(ss); s1 = red16_sum(s1); s2 = red16_sum(s2); s3 = red16_sum(s3);
          const float inv = 1.f / fmaxf(sqrtf(ss), 1e-12f);
          char* so = scan + ((size_t)tok * 12 + h) * 896;
#pragma unroll
          for (int nt = 0; nt < 4; ++nt) {
            const int cc = nt * 16 + fr;
            float kkn = kkr[nt] * inv;
            ((float*)so)[cc] = dec[nt];
            ((bf16_t*)(so + 256))[cc] = f2bf(dec[nt] * rr[nt]);
            ((bf16_t*)(so + 384))[cc] = f2bf(-kkn);
            ((bf16_t*)(so + 512))[cc] = f2bf(kkn * aval[nt]);
            ((bf16_t*)(so + 640))[cc] = f2bf(kmod[nt]);
            ((bf16_t*)(so + 768))[cc] = f2bf(vv[nt]);
          }
          if (fr == 0) {
            float4 cv = make_float4(s1 * inv, s2, s3, 0.f);
            *(float4*)(cbuf + ((size_t)tok * 12 + h) * 4) = cv;
          }
        }
      };
      const int tbu = __builtin_amdgcn_readfirstlane(tb);
      if (tbu < MP && (tbu & 2047) != 0) epi(std::true_type{}); else epi(std::false_type{});
    }
  }
  for (int item = NRW + (int)blockIdx.x; item < 2 * NRW; item += gridDim.x) {
    int txl = TX;
    asm volatile("" : "+v"(txl));
    const int lane = txl & 63, wv = txl >> 6, fr = lane & 15, fq = lane >> 4;
    {
      const int it = item - NRW;
      const int nb = it % 12, tb = (it / 12) * 128 + wv * 32;
      const bf16_t* rgt = (const bf16_t*)(ws + W_RGT) + ((size_t)l * 12 + nb) * 4096;
      const bf16_t* igt = (const bf16_t*)(ws + W_IGT) + ((size_t)l * 12 + nb) * 4096;
      const int wrow0 = (fr >> 2) * 16 + (fr & 3);
      f32x4 ar[2][4], ai[2][4];
#pragma unroll
      for (int a = 0; a < 2; ++a)
#pragma unroll
        for (int b = 0; b < 4; ++b) { ar[a][b] = f32x4{0, 0, 0, 0}; ai[a][b] = ar[a][b]; }
#pragma unroll
      for (int ks = 0; ks < 2; ++ks) {
        bf16x8 af[2], b1[4], b2[4];
#pragma unroll
        for (int mt = 0; mt < 2; ++mt) af[mt] = *(const bf16x8*)(XC + (size_t)(tb + mt * 16 + fr) * DLRU + nb * 64 + ks * 32 + fq * 8);
#pragma unroll
        for (int nt = 0; nt < 4; ++nt) {
          b1[nt] = *(const bf16x8*)(rgt + (size_t)(wrow0 + nt * 4) * 64 + ks * 32 + fq * 8);
          b2[nt] = *(const bf16x8*)(igt + (size_t)(wrow0 + nt * 4) * 64 + ks * 32 + fq * 8);
        }
#pragma unroll
        for (int mt = 0; mt < 2; ++mt)
#pragma unroll
          for (int nt = 0; nt < 4; ++nt) {
            ar[mt][nt] = MFMA(b1[nt], af[mt], ar[mt][nt]);
            ai[mt][nt] = MFMA(b2[nt], af[mt], ai[mt][nt]);
          }
      }
      float* abuf = (float*)(ws + B_ABUF);
      float* ubuf = (float*)(ws + B_UBUF);
#pragma unroll
      for (int nt = 0; nt < 4; ++nt) {
        const int c = nb * 64 + fq * 16 + nt * 4;
        const float4 brq = *(const float4*)(p.in[I_BRG] + (size_t)l * DLRU + c), biq = *(const float4*)(p.in[I_BIG] + (size_t)l * DLRU + c);
        const float4 lmq = *(const float4*)(p.in[I_LAMBDA] + (size_t)l * DLRU + c);
        const float br_[4] = {brq.x, brq.y, brq.z, brq.w}, bi_[4] = {biq.x, biq.y, biq.z, biq.w};
        const float sp_[4] = {softplusf_(-lmq.x), softplusf_(-lmq.y), softplusf_(-lmq.z), softplusf_(-lmq.w)};
#pragma unroll
        for (int mt = 0; mt < 2; ++mt) {
          const int tok = tb + mt * 16 + fr;
          const float4 xq = *(const float4*)(ubuf + (size_t)tok * DLRU + c);
          const float xc_[4] = {xq.x, xq.y, xq.z, xq.w};
          float ao[4], uo[4];
#pragma unroll
          for (int i = 0; i < 4; ++i) {
            const float rg = sigmoidf_(ar[mt][nt][i] + br_[i]), ig = sigmoidf_(ai[mt][nt][i] + bi_[i]);
            const float la = -8.f * rg * sp_[i];
            ao[i] = __expf(la);
            uo[i] = sqrtf(fmaxf(-expm1f(2.f * la), 0.f)) * (ig * xc_[i]);
          }
          *(float4*)(abuf + (size_t)tok * DLRU + c) = make_float4(ao[0], ao[1], ao[2], ao[3]);
          *(float4*)(ubuf + (size_t)tok * DLRU + c) = make_float4(uo[0], uo[1], uo[2], uo[3]);
        }
      }
    }
  }
}

constexpr int STEP_B = 1552;
struct WkvOps { float4 w4, r4, n4, b4, k4; float v; float2 cc; };
__device__ __forceinline__ void wkv_load(WkvOps& o, const char* b, int kq, int vrow) {
  o.w4 = *(const float4*)(b + kq * 16);
  o.r4 = *(const float4*)(b + 256 + kq * 16);
  o.n4 = *(const float4*)(b + 512 + kq * 16);
  o.b4 = *(const float4*)(b + 768 + kq * 16);
  o.k4 = *(const float4*)(b + 1024 + kq * 16);
  o.v = *(const float*)(b + 1280 + vrow * 4);
  o.cc = *(const float2*)(b + 1536);
}
__device__ __forceinline__ void wkv_step(const WkvOps& o, float& S0, float& S1, float& S2, float& S3, float& ykeep, bool keep) {
  float sa = S0 * o.n4.x + S1 * o.n4.y + S2 * o.n4.z + S3 * o.n4.w;
  float z = S0 * o.r4.x + S1 * o.r4.y + S2 * o.r4.z + S3 * o.r4.w;
  sa = red16_sum(sa);
  z = red16_sum(z);
  const float y = z + sa * o.cc.x + o.v * o.cc.y;
  ykeep = keep ? y : ykeep;
  S0 = S0 * o.w4.x + (sa * o.b4.x + o.v * o.k4.x);
  S1 = S1 * o.w4.y + (sa * o.b4.y + o.v * o.k4.y);
  S2 = S2 * o.w4.z + (sa * o.b4.z + o.v * o.k4.z);
  S3 = S3 * o.w4.w + (sa * o.b4.w + o.v * o.k4.w);
}

struct WkvStage { uint4 st[4]; float4 cst; };
__device__ __forceinline__ void wkv_stage_load(WkvStage& g, const char* scan, const float* cbuf, int tid, int tok0, int h, int c, int T) {
  const int ns = min(16, T - c * 16);
#pragma unroll
  for (int j = 0; j < 4; ++j) {
    const int u = tid + 256 * j;
    if (u < ns * 56) {
      const int s = u / 56, q = u % 56;
      g.st[j] = *(const uint4*)(scan + ((size_t)(tok0 + c * 16 + s) * 12 + h) * 896 + q * 16);
    }
  }
  if (tid >= 128 && tid < 128 + ns) g.cst = *(const float4*)(cbuf + ((size_t)(tok0 + c * 16 + (tid - 128)) * 12 + h) * 4);
}
__device__ __forceinline__ void wkv_stage_write(const WkvStage& g, char* buf, int tid, int c, int T) {
  const int ns = min(16, T - c * 16);
#pragma unroll
  for (int j = 0; j < 4; ++j) {
    const int u = tid + 256 * j;
    if (u < ns * 56) {
      const int s = u / 56, q = u % 56;
      char* base = buf + s * STEP_B;
      if (q < 16) {
        *(uint4*)(base + q * 16) = g.st[j];
      } else {
        float4 lo, hi;
        lo.x = __uint_as_float(g.st[j].x << 16); lo.y = __uint_as_float(g.st[j].x & 0xffff0000u);
        lo.z = __uint_as_float(g.st[j].y << 16); lo.w = __uint_as_float(g.st[j].y & 0xffff0000u);
        hi.x = __uint_as_float(g.st[j].z << 16); hi.y = __uint_as_float(g.st[j].z & 0xffff0000u);
        hi.z = __uint_as_float(g.st[j].w << 16); hi.w = __uint_as_float(g.st[j].w & 0xffff0000u);
        const int off = 256 + (q - 16) * 32;
        *(float4*)(base + off) = lo;
        *(float4*)(base + off + 16) = hi;
      }
    }
  }
  if (tid >= 128 && tid < 128 + ns) *(float2*)(buf + (tid - 128) * STEP_B + 1536) = make_float2(g.cst.x, g.cst.y);
}
__device__ __forceinline__ void wkv_chunk16(const char* buf, int kq, int vrow, float& S0, float& S1, float& S2, float& S3, float& ykeep) {
  WkvOps oa, ob;
  wkv_load(oa, buf, kq, vrow);
#pragma unroll
  for (int s = 0; s < 16; s += 2) {
    wkv_load(ob, buf + (s + 1) * STEP_B, kq, vrow);
    wkv_step(oa, S0, S1, S2, S3, ykeep, kq == s);
    if (s + 2 < 16) wkv_load(oa, buf + (s + 2) * STEP_B, kq, vrow);
    wkv_step(ob, S0, S1, S2, S3, ykeep, kq == s + 1);
  }
}

__device__ void wkv_scan_item(const Params& p, int l, int seq, int h, int qt, char* lds) {
  const int TX = tid_();
  char* ws = p.ws;
  const int tid = TX, lane = tid & 63, wv = tid >> 6;
  const int kq = lane & 15, rl = lane >> 4;
  const int T = (seq < 8) ? 2048 : 4;
  const int tok0 = seq_tok0(seq);
  const char* scan = ws + B_SCAN;
  const float* cbuf = (const float*)(ws + B_CBUF);
  float* ybuf = (float*)(ws + B_YBUF);
  WkvStage ga, gb;
  float4 sin[4];
  if (seq >= 8) {
#pragma unroll
    for (int q4 = 0; q4 < 4; ++q4)
      sin[q4] = *(const float4*)(p.in[I_SWKV] + ((((size_t)l * 128 + (seq - 8)) * 12 + h) * 64 + q4 * 16 + wv * 4 + rl) * 64 + kq * 4);
  }
  __syncthreads();
  wkv_stage_load(ga, scan, cbuf, tid, tok0, h, 0, T);
  if (seq < 8) wkv_stage_load(gb, scan, cbuf, tid, tok0, h, 1, T);
  wkv_stage_write(ga, lds, tid, 0, T);
  __syncthreads();
  if (seq < 8) {
    constexpr int NCH = 128;
    const int vrow = qt * 16 + wv * 4 + rl;
    float S0 = 0.f, S1 = 0.f, S2 = 0.f, S3 = 0.f;
    char* buf0 = lds;
    char* buf1 = lds + 16 * STEP_B;
#pragma unroll 1
    for (int c = 0; c < NCH; c += 2) {
      if (c + 2 < NCH) wkv_stage_load(ga, scan, cbuf, tid, tok0, h, c + 2, T);
      float ykeep = 0.f;
      wkv_chunk16(buf0, kq, vrow, S0, S1, S2, S3, ykeep);
      ybuf[(size_t)(tok0 + c * 16 + kq) * DRW + h * 64 + vrow] = ykeep;
      wkv_stage_write(gb, buf1, tid, c + 1, T);
      __syncthreads();
      if (c + 3 < NCH) wkv_stage_load(gb, scan, cbuf, tid, tok0, h, c + 3, T);
      ykeep = 0.f;
      wkv_chunk16(buf1, kq, vrow, S0, S1, S2, S3, ykeep);
      ybuf[(size_t)(tok0 + (c + 1) * 16 + kq) * DRW + h * 64 + vrow] = ykeep;
      if (c + 2 < NCH) wkv_stage_write(ga, buf0, tid, c + 2, T);
      __syncthreads();
    }
    *(float4*)(p.out + O_WKVP + ((((size_t)l * 8 + seq) * 12 + h) * 64 + vrow) * 64 + kq * 4) = make_float4(S0, S1, S2, S3);
  } else {
    const int b = seq - 8;
#pragma unroll
    for (int q4 = 0; q4 < 4; ++q4) {
      const int vrow = q4 * 16 + wv * 4 + rl;
      float S0 = sin[q4].x, S1 = sin[q4].y, S2 = sin[q4].z, S3 = sin[q4].w;
      float ykeep = 0.f;
      WkvOps oa, ob;
      wkv_load(oa, lds, kq, vrow);
#pragma unroll
      for (int s2 = 0; s2 < 4; s2 += 2) {
        wkv_load(ob, lds + (s2 + 1) * STEP_B, kq, vrow);
        wkv_step(oa, S0, S1, S2, S3, ykeep, kq == s2);
        if (s2 + 2 < 4) wkv_load(oa, lds + (s2 + 2) * STEP_B, kq, vrow);
        wkv_step(ob, S0, S1, S2, S3, ykeep, kq == s2 + 1);
      }
      if (kq < 4) ybuf[(size_t)(tok0 + kq) * DRW + h * 64 + vrow] = ykeep;
      *(float4*)(p.out + O_WKVS + ((((size_t)l * 128 + b) * 12 + h) * 64 + vrow) * 64 + kq * 4) = make_float4(S0, S1, S2, S3);
    }
    __syncthreads();
  }
}

__device__ void lru_scan_prompt_item(const Params& p, int l, int seq, int cg, char* lds) {
  const int TX = tid_();
  char* ws = p.ws;
  const int ts = TX >> 5, ch = cg * 32 + (TX & 31);
  const float* abuf = (const float*)(ws + B_ABUF);
  float* ubuf = (float*)(ws + B_UBUF);
  const size_t base = ((size_t)seq * 2048 + ts * 256) * DLRU + ch;
  float* sA = (float*)lds;
  float* sU = sA + 256;
  __syncthreads();
  float A = 1.f, U = 0.f;
  for (int t0 = 0; t0 < 256; t0 += 16) {
    float a[16], u[16];
#pragma unroll
    for (int j = 0; j < 16; ++j) {
      a[j] = abuf[base + (size_t)(t0 + j) * DLRU];
      u[j] = ubuf[base + (size_t)(t0 + j) * DLRU];
    }
#pragma unroll
    for (int j = 0; j < 16; ++j) { U = a[j] * U + u[j]; A *= a[j]; }
  }
  sA[TX] = A;
  sU[TX] = U;
  __syncthreads();
  float h = 0.f;
  for (int j = 0; j < ts; ++j) h = sA[j * 32 + (TX & 31)] * h + sU[j * 32 + (TX & 31)];
  {
    float a[16], u[16], an[16], un[16];
#pragma unroll
    for (int j = 0; j < 16; ++j) {
      a[j] = abuf[base + (size_t)j * DLRU];
      u[j] = ubuf[base + (size_t)j * DLRU];
    }
    for (int t0 = 0; t0 < 256; t0 += 16) {
      if (t0 + 16 < 256) {
#pragma unroll
        for (int j = 0; j < 16; ++j) {
          an[j] = abuf[base + (size_t)(t0 + 16 + j) * DLRU];
          un[j] = ubuf[base + (size_t)(t0 + 16 + j) * DLRU];
        }
      }
#pragma unroll
      for (int j = 0; j < 16; ++j) {
        h = a[j] * h + u[j];
        ubuf[base + (size_t)(t0 + j) * DLRU] = h;
      }
#pragma unroll
      for (int j = 0; j < 16; ++j) { a[j] = an[j]; u[j] = un[j]; }
    }
  }
  if (ts == 7) p.out[O_HP + ((size_t)l * 8 + seq) * DLRU + ch] = h;
  __syncthreads();
}

__device__ void lru_scan_item(const Params& p, int l, int seq, int cg3) {
  const int TX = tid_();
  char* ws = p.ws;
  const int ch = cg3 * 256 + TX;
  const int tok0 = seq_tok0(seq);
  const float* abuf = (const float*)(ws + B_ABUF);
  float* ubuf = (float*)(ws + B_UBUF);
  float h = p.in[I_SH][((size_t)l * 128 + (seq - 8)) * DLRU + ch];
  float a[4], u[4];
#pragma unroll
  for (int j = 0; j < 4; ++j) {
    a[j] = abuf[(size_t)(tok0 + j) * DLRU + ch];
    u[j] = ubuf[(size_t)(tok0 + j) * DLRU + ch];
  }
#pragma unroll
  for (int j = 0; j < 4; ++j) {
    h = a[j] * h + u[j];
    ubuf[(size_t)(tok0 + j) * DLRU + ch] = h;
  }
  p.out[O_HS + ((size_t)l * 128 + (seq - 8)) * DLRU + ch] = h;
}

__device__ void attn_prompt_item(const Params& p, int l, int b, int h, int qt, char* lds) {
  const int TX = tid_();
  char* ws = p.ws;
  const int lane = TX & 63, wv = TX >> 6, fr = lane & 15, fq = lane >> 4;
  const bf16_t* proj = (const bf16_t*)(ws + B_PROJ);
  const bf16_t* kb = (const bf16_t*)(ws + B_KB) + ((size_t)(l * 8 + b) * 256) * 512 + h * 128;
  const bf16_t* vt = (const bf16_t*)(ws + B_VTB) + (((size_t)(l * 8 + b) * 4 + h) * 128) * 256;
  bf16_t* axa = (bf16_t*)(ws + B_AXA);
  const int tok0 = b * 2048 + qt * 64 + wv * 16;
  bf16x8 aq[4];
#pragma unroll
  for (int ks = 0; ks < 4; ++ks) aq[ks] = *(const bf16x8*)(proj + (size_t)(tok0 + fr) * DIN + C_Q + h * 128 + ks * 32 + fq * 8);
  f32x4 s[16];
#pragma unroll
  for (int nt = 0; nt < 16; ++nt) {
    s[nt] = f32x4{0, 0, 0, 0};
#pragma unroll
    for (int ks = 0; ks < 4; ++ks) {
      bf16x8 bk = *(const bf16x8*)(kb + (size_t)(nt * 16 + fr) * 512 + ks * 32 + fq * 8);
      s[nt] = MFMA(aq[ks], bk, s[nt]);
    }
  }
  const float scale = 0.08838834764831845f;
  float rs[4];
  char* pl = lds + wv * 8192;
  __syncthreads();
#pragma unroll
  for (int i = 0; i < 4; ++i) {
    float m = s[0][i];
#pragma unroll
    for (int nt = 1; nt < 16; ++nt) m = fmaxf(m, s[nt][i]);
    m = red16_max(m);
    float sum = 0.f;
#pragma unroll
    for (int nt = 0; nt < 16; ++nt) {
      float e = __expf((s[nt][i] - m) * scale);
      sum += e;
      const int key = nt * 16 + fr, rr = fq * 4 + i;
      *(bf16_t*)(pl + (key >> 5) * 1024 + swz(rr, (key & 31) * 2)) = f2bf(e);
    }
    rs[i] = red16_sum(sum);
  }
  __syncthreads();
  f32x4 o[8];
#pragma unroll
  for (int nt = 0; nt < 8; ++nt) o[nt] = f32x4{0, 0, 0, 0};
  const int fo = swz(fr, fq * 16);
#pragma unroll
  for (int ks = 0; ks < 8; ++ks) {
    bf16x8 ap = *(const bf16x8*)(pl + ks * 1024 + fo);
#pragma unroll
    for (int nt = 0; nt < 8; ++nt) {
      bf16x8 bv = *(const bf16x8*)(vt + (size_t)(nt * 16 + fr) * 256 + ks * 32 + fq * 8);
      o[nt] = MFMA(ap, bv, o[nt]);
    }
  }
#pragma unroll
  for (int nt = 0; nt < 8; ++nt)
#pragma unroll
    for (int i = 0; i < 4; ++i)
      axa[(size_t)(tok0 + fq * 4 + i) * DXA + h * 128 + nt * 16 + fr] = f2bf(o[nt][i] / rs[i]);
  __syncthreads();
}

__device__ void attn_sample_item(const Params& p, int l, int b, int h, char* lds) {
  const int TX = tid_();
  char* ws = p.ws;
  const int tid = TX, lane = tid & 63, wv = tid >> 6;
  const bf16_t* proj = (const bf16_t*)(ws + B_PROJ);
  bf16_t* axa = (bf16_t*)(ws + B_AXA);
  const int tok0 = MP + b * 4;
  float* q = (float*)lds;
  float* pr = q + 512;
  float* red = pr + 1024;
  float* part = red + 32;
  __syncthreads();
  for (int i = tid; i < 512; i += 256) q[i] = bf2f(proj[(size_t)(tok0 + (i >> 7)) * DIN + C_Q + h * 128 + (i & 127)]);
  __syncthreads();
  const float* kc = p.in[I_CK] + (((size_t)l * 128 + b) * 256 + tid) * 512 + h * 128;
  float s0 = 0.f, s1 = 0.f, s2 = 0.f, s3 = 0.f;
#pragma unroll 4
  for (int d = 0; d < 128; d += 4) {
    const float4 kv = *(const float4*)(kc + d);
    const float4 q0 = *(const float4*)(q + d), q1 = *(const float4*)(q + 128 + d), q2 = *(const float4*)(q + 256 + d),
                 q3 = *(const float4*)(q + 384 + d);
    s0 += kv.x * q0.x + kv.y * q0.y + kv.z * q0.z + kv.w * q0.w;
    s1 += kv.x * q1.x + kv.y * q1.y + kv.z * q1.z + kv.w * q1.w;
    s2 += kv.x * q2.x + kv.y * q2.y + kv.z * q2.z + kv.w * q2.w;
    s3 += kv.x * q3.x + kv.y * q3.y + kv.z * q3.z + kv.w * q3.w;
  }
  const float scale = 0.08838834764831845f;
  s0 *= scale; s1 *= scale; s2 *= scale; s3 *= scale;
  float m0 = s0, m1 = s1, m2 = s2, m3 = s3;
#pragma unroll
  for (int m = 1; m < 64; m <<= 1) {
    m0 = fmaxf(m0, __shfl_xor(m0, m, 64)); m1 = fmaxf(m1, __shfl_xor(m1, m, 64));
    m2 = fmaxf(m2, __shfl_xor(m2, m, 64)); m3 = fmaxf(m3, __shfl_xor(m3, m, 64));
  }
  if (lane == 0) { red[wv * 4 + 0] = m0; red[wv * 4 + 1] = m1; red[wv * 4 + 2] = m2; red[wv * 4 + 3] = m3; }
  __syncthreads();
  m0 = fmaxf(fmaxf(red[0], red[4]), fmaxf(red[8], red[12]));
  m1 = fmaxf(fmaxf(red[1], red[5]), fmaxf(red[9], red[13]));
  m2 = fmaxf(fmaxf(red[2], red[6]), fmaxf(red[10], red[14]));
  m3 = fmaxf(fmaxf(red[3], red[7]), fmaxf(red[11], red[15]));
  const float e0 = __expf(s0 - m0), e1 = __expf(s1 - m1), e2 = __expf(s2 - m2), e3 = __expf(s3 - m3);
  pr[tid] = e0; pr[256 + tid] = e1; pr[512 + tid] = e2; pr[768 + tid] = e3;
  float t0 = wave_sum(e0), t1 = wave_sum(e1), t2 = wave_sum(e2), t3 = wave_sum(e3);
  if (lane == 0) { red[16 + wv * 4 + 0] = t0; red[16 + wv * 4 + 1] = t1; red[16 + wv * 4 + 2] = t2; red[16 + wv * 4 + 3] = t3; }
  __syncthreads();
  const float z0 = red[16] + red[20] + red[24] + red[28], z1 = red[17] + red[21] + red[25] + red[29];
  const float z2 = red[18] + red[22] + red[26] + red[30], z3 = red[19] + red[23] + red[27] + red[31];
  const int d = tid & 127, half = tid >> 7;
  const float* vc = p.in[I_CV] + (((size_t)l * 128 + b) * 256 + half * 128) * 512 + h * 128 + d;
  float o0 = 0.f, o1 = 0.f, o2 = 0.f, o3 = 0.f;
#pragma unroll 8
  for (int k = 0; k < 128; ++k) {
    const float vv = vc[(size_t)k * 512];
    const int key = half * 128 + k;
    o0 += pr[key] * vv; o1 += pr[256 + key] * vv; o2 += pr[512 + key] * vv; o3 += pr[768 + key] * vv;
  }
  if (half == 1) { part[d] = o0; part[128 + d] = o1; part[256 + d] = o2; part[384 + d] = o3; }
  __syncthreads();
  if (half == 0) {
    o0 += part[d]; o1 += part[128 + d]; o2 += part[256 + d]; o3 += part[384 + d];
    axa[(size_t)(tok0 + 0) * DXA + h * 128 + d] = f2bf(o0 / z0);
    axa[(size_t)(tok0 + 1) * DXA + h * 128 + d] = f2bf(o1 / z1);
    axa[(size_t)(tok0 + 2) * DXA + h * 128 + d] = f2bf(o2 / z2);
    axa[(size_t)(tok0 + 3) * DXA + h * 128 + d] = f2bf(o3 / z3);
  }
  __syncthreads();
}

__device__ void phase_mix(const Params& p, int l, char* lds, int* s_item) {
  const int TX = tid_();
  int* cnt = (int*)(p.ws + B_CNT) + l;
  constexpr int N_WKVP = 96 * 4, N_LRUP = 8 * 24, N_ATTP = 1024, N_WKVS = 128 * 12, N_LRUS = 384, N_ATTS = 512;
  constexpr int E1 = N_WKVP, E2 = E1 + N_LRUP, E3 = E2 + N_ATTP, E4 = E3 + N_WKVS, E5 = E4 + N_LRUS, E6 = E5 + N_ATTS;
  for (;;) {
    __syncthreads();
    if (TX == 0) *s_item = atomicAdd(cnt, 1);
    __syncthreads();
    const int it = *s_item;
    if (it >= E6) break;
    if (it < E1) {
      const int qt = it & 3, bh = it >> 2;
      wkv_scan_item(p, l, bh / 12, bh % 12, qt, lds);
    } else if (it < E2) {
      const int j = it - E1;
      lru_scan_prompt_item(p, l, j / 24, j % 24, lds);
    } else if (it < E3) {
      const int j = it - E2;
      attn_prompt_item(p, l, j >> 7, (j >> 5) & 3, j & 31, lds);
    } else if (it < E4) {
      const int j = it - E3;
      wkv_scan_item(p, l, 8 + j / 12, j % 12, -1, lds);
    } else if (it < E5) {
      const int j = it - E4;
      lru_scan_item(p, l, 8 + j / 3, j % 3);
    } else {
      const int j = it - E5;
      attn_sample_item(p, l, j >> 2, j & 3, lds);
    }
  }
}

__device__ void phase_post(const Params& p, int l) {
  const int TX = tid_();
  char* ws = p.ws;
  const int lane = TX & 63, wv = TX >> 6;
  const float* ybuf = (const float*)(ws + B_YBUF);
  const float* cbuf = (const float*)(ws + B_CBUF);
  const bf16_t* gbuf = (const bf16_t*)(ws + B_GBUF);
  const char* scan = ws + B_SCAN;
  const float* hbuf = (const float*)(ws + B_UBUF);
  const bf16_t* proj = (const bf16_t*)(ws + B_PROJ);
  bf16_t* arw = (bf16_t*)(ws + B_ARW);
  bf16_t* alru = (bf16_t*)(ws + B_ALRU);
  const float* gng = p.in[I_GNG] + (size_t)l * DRW;
  const float* gnb = p.in[I_GNB] + (size_t)l * DRW;
  for (int t4 = blockIdx.x; t4 < MT / 4; t4 += gridDim.x) {
    const int tok = t4 * 4 + wv;
#pragma unroll
    for (int ps = 0; ps < 3; ++ps) {
      const int c = ps * 256 + lane * 4, h = c >> 6;
      const float4 y = *(const float4*)(ybuf + (size_t)tok * DRW + c);
      const float mean = red16_sum(y.x + y.y + y.z + y.w) * (1.f / 64.f);
      const float d0 = y.x - mean, d1 = y.y - mean, d2 = y.z - mean, d3 = y.w - mean;
      const float var = red16_sum(d0 * d0 + d1 * d1 + d2 * d2 + d3 * d3) * (1.f / 64.f);
      const float rs = rsqrtf(var + 64e-5f);
      const float4 gg = *(const float4*)(gng + c), gb = *(const float4*)(gnb + c);
      const float c3 = cbuf[((size_t)tok * 12 + h) * 4 + 2];
      const uint2 vq = *(const uint2*)(scan + ((size_t)tok * 12 + h) * 896 + 768 + (c & 63) * 2);
      const uint2 gq = *(const uint2*)(gbuf + (size_t)tok * DRW + c);
      const float v0 = __uint_as_float(vq.x << 16), v1 = __uint_as_float(vq.x & 0xffff0000u);
      const float v2 = __uint_as_float(vq.y << 16), v3 = __uint_as_float(vq.y & 0xffff0000u);
      const float g0 = __uint_as_float(gq.x << 16), g1 = __uint_as_float(gq.x & 0xffff0000u);
      const float g2 = __uint_as_float(gq.y << 16), g3 = __uint_as_float(gq.y & 0xffff0000u);
      uint2 o;
      o.x = pk_bf2((d0 * rs * gg.x + gb.x + c3 * v0) * g0, (d1 * rs * gg.y + gb.y + c3 * v1) * g1);
      o.y = pk_bf2((d2 * rs * gg.z + gb.z + c3 * v2) * g2, (d3 * rs * gg.w + gb.w + c3 * v3) * g3);
      *(uint2*)(arw + (size_t)tok * DRW + c) = o;
      const float4 hv = *(const float4*)(hbuf + (size_t)tok * DLRU + c);
      const uint2 xq = *(const uint2*)(proj + (size_t)tok * DIN + C_LG + c);
      float x[4] = {__uint_as_float(xq.x << 16), __uint_as_float(xq.x & 0xffff0000u), __uint_as_float(xq.y << 16), __uint_as_float(xq.y & 0xffff0000u)};
      float ge[4];
#pragma unroll
      for (int i = 0; i < 4; ++i) {
        const float u = 0.7978845608028654f * (x[i] + 0.044715f * x[i] * x[i] * x[i]);
        const float th = 1.f - 2.f / (1.f + __expf(2.f * u));
        ge[i] = 0.5f * x[i] * (1.f + th);
      }
      uint2 o2;
      o2.x = pk_bf2(hv.x * ge[0], hv.y * ge[1]);
      o2.y = pk_bf2(hv.z * ge[2], hv.w * ge[3]);
      *(uint2*)(alru + (size_t)tok * DLRU + c) = o2;
    }
  }
}

__device__ __forceinline__ void merge_ops(char* ws, int l, int br, const bf16_t*& A, const bf16_t*& Bt, int& K) {
  if (br == 0) { A = (const bf16_t*)(ws + B_ARW); Bt = (const bf16_t*)(ws + W_RWOUT) + (size_t)l * D * DRW; K = DRW; }
  else if (br == 1) { A = (const bf16_t*)(ws + B_ALRU); Bt = (const bf16_t*)(ws + W_LRUOUT) + (size_t)l * D * DLRU; K = DLRU; }
  else { A = (const bf16_t*)(ws + B_AXA); Bt = (const bf16_t*)(ws + W_XAOUT) + (size_t)l * D * DXA; K = DXA; }
}

__device__ void phase_merge(const Params& p, int l, char* lds) {
  const int TX = tid_();
  char* ws = p.ws;
  const bf16_t* proj = (const bf16_t*)(ws + B_PROJ);
  bf16_t* mixin = (bf16_t*)(ws + B_MIXIN);
  const int lane = TX & 63, wv = TX >> 6, wr = wv >> 1, wc = wv & 1, fr = lane & 15, fq = lane >> 4;
  const int ntiles = (MT / 128) * 16;
  TileIter it = tile_iter(ntiles);
  int L = it.L, br = 0;
  bool have = L < it.Lend;
  int m0 = 0, n0 = 0;
  const bf16_t* A = nullptr; const bf16_t* Bt = nullptr; int K = 0;
  if (have) {
    int tm, tn; tile_mn(L, MT / 128, 16, tm, tn); m0 = tm * 128; n0 = tn * 64;
    merge_ops(ws, l, 0, A, Bt, K);
    gemm_prologue<4, 2>(A, K, Bt, K, m0, n0, lds);
  }
  f32x4 sum[4][2];
  zero_acc(sum);
  while (have) {
    f32x4 acc[4][2];
    zero_acc(acc);
    gemm_loop<4, 2>(A, K, Bt, K, K, m0, n0, lds, acc);
    uint4 gq[4];
#pragma unroll
    for (int mt = 0; mt < 4; ++mt)
      gq[mt] = *(const uint4*)(proj + (size_t)(m0 + wr * 64 + mt * 16 + fr) * DIN + C_G + br * D + n0 + wc * 32 + fq * 8);
    int nbr = br + 1, nL = L;
    if (nbr == 3) { nbr = 0; nL = L + it.step; }
    const bool hn = nL < it.Lend;
    int m1 = m0, n1 = n0;
    const bf16_t* A1 = A; const bf16_t* Bt1 = Bt; int K1 = K;
    if (hn) {
      if (nbr == 0) { int tm, tn; tile_mn(nL, MT / 128, 16, tm, tn); m1 = tm * 128; n1 = tn * 64; }
      merge_ops(ws, l, nbr, A1, Bt1, K1);
      gemm_prologue<4, 2>(A1, K1, Bt1, K1, m1, n1, lds);
    }
#pragma unroll
    for (int mt = 0; mt < 4; ++mt) {
      const unsigned gw[4] = {gq[mt].x, gq[mt].y, gq[mt].z, gq[mt].w};
#pragma unroll
      for (int nt = 0; nt < 2; ++nt)
#pragma unroll
        for (int i = 0; i < 4; ++i) {
          const unsigned w = gw[nt * 2 + (i >> 1)];
          const float gv = __uint_as_float((i & 1) ? (w & 0xffff0000u) : (w << 16));
          sum[mt][nt][i] += sigmoidf_(gv) * acc[mt][nt][i];
        }
    }
    if (br == 2) {
#pragma unroll
      for (int mt = 0; mt < 4; ++mt) {
        const int row = m0 + wr * 64 + mt * 16 + fr, col = n0 + wc * 32 + fq * 8;
        *(uint4*)(mixin + (size_t)row * D + col) = pack8(sum[mt][0], sum[mt][1]);
      }
      zero_acc(sum);
    }
    L = nL; br = nbr; have = hn; m0 = m1; n0 = n1; A = A1; Bt = Bt1; K = K1;
  }
}

__device__ void phase_resid_gemm(const Params& p, const bf16_t* A, const bf16_t* Bt, int K, char* lds) {
  const int TX = tid_();
  char* ws = p.ws;
  const bf16_t* xb = (const bf16_t*)(ws + B_XB);
  bf16_t* t = (bf16_t*)(ws + B_XF);
  const int lane = TX & 63, wv = TX >> 6, wr = wv >> 1, wc = wv & 1, fr = lane & 15, fq = lane >> 4;
  const int ntiles = (MT / 128) * 8;
  TileIter it = tile_iter(ntiles);
  bool have = it.L < it.Lend;
  int m0 = 0, n0 = 0;
  if (have) { int tm, tn; tile_mn(it.L, MT / 128, 8, tm, tn); m0 = tm * 128; n0 = tn * 128; gemm_prologue<4, 4>(A, K, Bt, K, m0, n0, lds); }
  while (have) {
    f32x4 acc[4][4];
    zero_acc(acc);
    gemm_loop<4, 4>(A, K, Bt, K, K, m0, n0, lds, acc);
    uint4 xq[4][2];
#pragma unroll
    for (int mt = 0; mt < 4; ++mt) {
      const uint4* xs = (const uint4*)(xb + (size_t)(m0 + wr * 64 + mt * 16 + fr) * D + n0 + wc * 64 + fq * 16);
      xq[mt][0] = xs[0];
      xq[mt][1] = xs[1];
    }
    const int Ln = it.L + it.step;
    const bool hn = Ln < it.Lend;
    int m1 = m0, n1 = n0;
    if (hn) { int tm, tn; tile_mn(Ln, MT / 128, 8, tm, tn); m1 = tm * 128; n1 = tn * 128; gemm_prologue<4, 4>(A, K, Bt, K, m1, n1, lds); }
#pragma unroll
    for (int mt = 0; mt < 4; ++mt) {
      uint4* ts = (uint4*)(t + (size_t)(m0 + wr * 64 + mt * 16 + fr) * D + n0 + wc * 64 + fq * 16);
      f32x4 o[4];
#pragma unroll
      for (int nt = 0; nt < 4; ++nt) {
        const uint4 q = xq[mt][nt >> 1];
        const unsigned w0 = (nt & 1) ? q.z : q.x, w1 = (nt & 1) ? q.w : q.y;
        o[nt][0] = ALPHA * __uint_as_float(w0 << 16) + acc[mt][nt][0];
        o[nt][1] = ALPHA * __uint_as_float(w0 & 0xffff0000u) + acc[mt][nt][1];
        o[nt][2] = ALPHA * __uint_as_float(w1 << 16) + acc[mt][nt][2];
        o[nt][3] = ALPHA * __uint_as_float(w1 & 0xffff0000u) + acc[mt][nt][3];
      }
      ts[0] = pack8(o[0], o[1]);
      ts[1] = pack8(o[2], o[3]);
    }
    it.L = Ln; have = hn; m0 = m1; n0 = n1;
  }
}

__device__ void phase_ln(const Params& p, const float* g, const float* bta, bool final_out) {
  const int TX = tid_();
  char* ws = p.ws;
  const int lane = TX & 63, wv = TX >> 6;
  const bf16_t* t = (const bf16_t*)(ws + B_XF);
  float* yout = p.out + O_Y;
  bf16_t* xb = (bf16_t*)(ws + B_XB);
  for (int r4 = blockIdx.x; r4 < MT / 4; r4 += gridDim.x) {
    const int row = r4 * 4 + wv;
    float4 v[4];
    float s = 0.f;
#pragma unroll
    for (int j = 0; j < 4; ++j) {
      const uint2 q = *(const uint2*)(t + (size_t)row * D + j * 256 + lane * 4);
      v[j] = make_float4(__uint_as_float(q.x << 16), __uint_as_float(q.x & 0xffff0000u), __uint_as_float(q.y << 16), __uint_as_float(q.y & 0xffff0000u));
      s += v[j].x + v[j].y + v[j].z + v[j].w;
    }
    const float mean = wave_sum(s) * (1.f / 1024.f);
    float q = 0.f;
#pragma unroll
    for (int j = 0; j < 4; ++j) {
      v[j].x -= mean; v[j].y -= mean; v[j].z -= mean; v[j].w -= mean;
      q += v[j].x * v[j].x + v[j].y * v[j].y + v[j].z * v[j].z + v[j].w * v[j].w;
    }
    const float rstd = rsqrtf(wave_sum(q) * (1.f / 1024.f) + 1e-5f);
#pragma unroll
    for (int j = 0; j < 4; ++j) {
      const int c = j * 256 + lane * 4;
      const float4 gg = *(const float4*)(g + c), bb = *(const float4*)(bta + c);
      float4 o;
      o.x = v[j].x * rstd * gg.x + bb.x; o.y = v[j].y * rstd * gg.y + bb.y;
      o.z = v[j].z * rstd * gg.z + bb.z; o.w = v[j].w * rstd * gg.w + bb.w;
      if (final_out) {
        *(float4*)(yout + (size_t)row * D + c) = o;
      } else {
        uint2 ob;
        ob.x = (unsigned)f2bf(o.x) | ((unsigned)f2bf(o.y) << 16);
        ob.y = (unsigned)f2bf(o.z) | ((unsigned)f2bf(o.w) << 16);
        *(uint2*)(xb + (size_t)row * D + c) = ob;
      }
    }
  }
}

__device__ void phase_ffn_in(const Params& p, int l, char* lds) {
  const int TX = tid_();
  char* ws = p.ws;
  const bf16_t* xb = (const bf16_t*)(ws + B_XB);
  const bf16_t* wt = (const bf16_t*)(ws + W_FFNIN) + (size_t)l * 2 * DFF * D;
  bf16_t* act = (bf16_t*)(ws + B_ACT);
  const int lane = TX & 63, wv = TX >> 6, wr = wv >> 1, wc = wv & 1, fr = lane & 15, fq = lane >> 4;
  const int nN = 2 * DFF / 128, ntiles = (MT / 128) * nN;
  TileIter it = tile_iter(ntiles);
  bool have = it.L < it.Lend;
  int m0 = 0, n0 = 0;
  if (have) { int tm, tn; tile_mn(it.L, MT / 128, nN, tm, tn); m0 = tm * 128; n0 = tn * 128; gemm_prologue<4, 4>(xb, D, wt, D, m0, n0, lds); }
  while (have) {
    f32x4 acc[4][4];
    zero_acc(acc);
    gemm_loop<4, 4>(xb, D, wt, D, D, m0, n0, lds, acc);
    const int Ln = it.L + it.step;
    const bool hn = Ln < it.Lend;
    int m1 = m0, n1 = n0;
    if (hn) { int tm, tn; tile_mn(Ln, MT / 128, nN, tm, tn); m1 = tm * 128; n1 = tn * 128; gemm_prologue<4, 4>(xb, D, wt, D, m1, n1, lds); }
    const int jb = (n0 + wc * 64 + fq * 16) / 2;
#pragma unroll
    for (int mt = 0; mt < 4; ++mt) {
      const int row = m0 + wr * 64 + mt * 16 + fr;
      f32x4 o0, o1;
#pragma unroll
      for (int i = 0; i < 4; ++i) {
        const float g0 = acc[mt][2][i], g1 = acc[mt][3][i];
        o0[i] = g0 * sigmoidf_(g0) * acc[mt][0][i];
        o1[i] = g1 * sigmoidf_(g1) * acc[mt][1][i];
      }
      *(uint4*)(act + (size_t)row * DFF + jb) = pack8(o0, o1);
    }
    it.L = Ln; have = hn; m0 = m1; n0 = n1;
  }
}

__global__ void __launch_bounds__(256, 2) fwd_megakernel(Params p) {
  cg::grid_group grid = cg::this_grid();
  __shared__ __attribute__((aligned(1024))) char lds[LDS_BYTES];
  __shared__ int s_item;
  __shared__ uint4 xb_words;
  char* ws = p.ws;
  if (threadIdx.x == 0) xb_words = make_uint4(0u, 0u, 0u, 0u);
  __syncthreads();
  XcdBarrier xb = xcd_barrier_post((unsigned*)(ws + B_BAR), (volatile LAS unsigned*)&xb_words);
  constexpr int NPH = 1 + NL * 11;
#pragma unroll 1
  for (int ph = 0; ph < NPH; ++ph) {
    int phl = ph;
    asm volatile("" : "+s"(phl));
    if (phl == 0) {
      phase_convert(p, lds);
    } else {
      const int l = (phl - 1) / 11, k = (phl - 1) % 11;
      switch (k) {
        case 0: phase_proj(p, l, lds); break;
        case 1: phase_prep(p, l, lds); break;
        case 2: phase_lora(p, l, lds); break;
        case 3: phase_mix(p, l, lds, &s_item); break;
        case 4: phase_post(p, l); break;
        case 5: phase_merge(p, l, lds); break;
        case 6: phase_resid_gemm(p, (const bf16_t*)(ws + B_MIXIN), (const bf16_t*)(ws + W_O) + (size_t)l * D * D, D, lds); break;
        case 7: phase_ln(p, p.in[I_LN1G] + (size_t)l * D, p.in[I_LN1B] + (size_t)l * D, false); break;
        case 8: phase_ffn_in(p, l, lds); break;
        case 9: phase_resid_gemm(p, (const bf16_t*)(ws + B_ACT), (const bf16_t*)(ws + W_FFNOUT) + (size_t)l * D * DFF, DFF, lds); break;
        default: phase_ln(p, p.in[I_LN2G] + (size_t)l * D, p.in[I_LN2B] + (size_t)l * D, l == NL - 1); break;
      }
    }
    if (ph + 1 < NPH) { if (ph == 0) grid.sync(); else xcd_barrier(xb); }
  }
}

extern "C" void kernel_launch(void* const* d_in, const int* in_sizes, int n_in, void* d_out, int out_size, void* d_ws,
                              size_t ws_size, hipStream_t stream) {
  static int grid_blocks = 0;
  if (!grid_blocks) {
    int dev = 0, cus = 0, per_cu = 0;
    (void)hipGetDevice(&dev);
    (void)hipDeviceGetAttribute(&cus, hipDeviceAttributeMultiprocessorCount, dev);
    (void)hipOccupancyMaxActiveBlocksPerMultiprocessor(&per_cu, fwd_megakernel, 256, 0);
    if (per_cu > 2) per_cu = 2;
    if (per_cu < 1) per_cu = 1;
    grid_blocks = cus * per_cu;
  }
  if (ws_size < WS_NEED || n_in < 42) {
    fprintf(stderr, "workspace too small: %zu < %zu\n", ws_size, (size_t)WS_NEED);
    return;
  }
  (void)hipMemsetAsync((char*)d_ws + B_CNT, 0, 256 + BAR_BYTES, stream);
  Params p{};
  for (int i = 0; i < 42; ++i) p.in[i] = (const float*)d_in[i];
  p.out = (float*)d_out;
  p.ws = (char*)d_ws;
  void* args[] = {&p};
  hipError_t e = hipLaunchCooperativeKernel((void*)fwd_megakernel, dim3(grid_blocks), dim3(256), args, 0, stream);
  if (e != hipSuccess) fprintf(stderr, "cooperative launch failed: %s (grid %d)\n", hipGetErrorString(e), grid_blocks);
}
```

```cpp
#include <hip/hip_runtime.h>
#include <hip/hip_cooperative_groups.h>
#include <cstdio>
#include <type_traits>
namespace cg = cooperative_groups;

typedef unsigned short bf16_t;
typedef __attribute__((ext_vector_type(8))) short bf16x8;
typedef __attribute__((ext_vector_type(4))) float f32x4;

constexpr int D = 1024, MP = 16384, MS = 512, MT = 16896, NL = 4;
constexpr int DIN = 7680, DRW = 768, DLRU = 768, DXA = 512, DFF = 2816, RWC = 2560;
constexpr int C_LX = 2560, C_LG = 3328, C_Q = 4096, C_G = 4608;
constexpr int NSEQ = 136;
constexpr float ALPHA = 1.681792830507429f;

constexpr size_t O_Y = 0;
constexpr size_t O_SHP = O_Y + (size_t)MT * D;
constexpr size_t O_WKVP = O_SHP + (size_t)NL * 8 * RWC;
constexpr size_t O_CONVP = O_WKVP + (size_t)NL * 8 * 12 * 64 * 64;
constexpr size_t O_HP = O_CONVP + (size_t)NL * 8 * 3 * DLRU;
constexpr size_t O_MKP = O_HP + (size_t)NL * 8 * DLRU;
constexpr size_t O_MVP = O_MKP + (size_t)NL * 8 * 256 * 512;
constexpr size_t O_SHS = O_MVP + (size_t)NL * 8 * 256 * 512;
constexpr size_t O_WKVS = O_SHS + (size_t)NL * 128 * RWC;
constexpr size_t O_CONVS = O_WKVS + (size_t)NL * 128 * 12 * 64 * 64;
constexpr size_t O_HS = O_CONVS + (size_t)NL * 128 * 3 * DLRU;
constexpr size_t O_END = O_HS + (size_t)NL * 128 * DLRU;

constexpr size_t al256(size_t x) { return (x + 255) & ~(size_t)255; }
constexpr size_t W_IN = 0;
constexpr size_t W_RWOUT = W_IN + al256((size_t)NL * DIN * D * 2);
constexpr size_t W_LRUOUT = W_RWOUT + al256((size_t)NL * D * DRW * 2);
constexpr size_t W_XAOUT = W_LRUOUT + al256((size_t)NL * D * DLRU * 2);
constexpr size_t W_O = W_XAOUT + al256((size_t)NL * D * DXA * 2);
constexpr size_t W_FFNIN = W_O + al256((size_t)NL * D * D * 2);
constexpr size_t W_FFNOUT = W_FFNIN + al256((size_t)NL * 2 * DFF * D * 2);
constexpr size_t W_MEMKV = W_FFNOUT + al256((size_t)NL * D * DFF * 2);
constexpr size_t W_W2T = W_MEMKV + al256((size_t)NL * D * D * 2);
constexpr size_t W_A2T = W_W2T + al256((size_t)NL * DRW * 64 * 2);
constexpr size_t W_G2T = W_A2T + al256((size_t)NL * DRW * 64 * 2);
constexpr size_t W_V2T = W_G2T + al256((size_t)NL * DRW * 128 * 2);
constexpr size_t W_RGT = W_V2T + al256((size_t)3 * DRW * 32 * 2);
constexpr size_t W_IGT = W_RGT + al256((size_t)NL * 12 * 64 * 64 * 2);
constexpr size_t B_XF = W_IGT + al256((size_t)NL * 12 * 64 * 64 * 2);
constexpr size_t B_XB = B_XF + al256((size_t)MT * D * 4);
constexpr size_t B_MEMB = B_XB + al256((size_t)MT * D * 2);
constexpr size_t B_KB = B_MEMB + al256((size_t)2048 * D * 2);
constexpr size_t B_VTB = B_KB + al256((size_t)NL * 8 * 256 * 512 * 2);
constexpr size_t B_VFIRST = B_VTB + al256((size_t)NL * 8 * 256 * 512 * 2);
constexpr size_t B_PROJ = B_VFIRST + al256((size_t)MT * DRW * 2);
constexpr size_t B_SCAN = B_PROJ + al256((size_t)MT * DIN * 2);
constexpr size_t SCAN_BYTES = (size_t)MT * 12 * 896;
constexpr size_t B_MIXIN = B_SCAN;
constexpr size_t B_ACT = B_SCAN + al256((size_t)MT * D * 2);
constexpr size_t B_CBUF = B_SCAN + al256(SCAN_BYTES);
constexpr size_t B_YBUF = B_CBUF + al256((size_t)MT * 12 * 16);
constexpr size_t B_GBUF = B_YBUF + al256((size_t)MT * DRW * 4);
constexpr size_t B_ABUF = B_GBUF + al256((size_t)MT * DRW * 2);
constexpr size_t B_UBUF = B_ABUF + al256((size_t)MT * DLRU * 4);
constexpr size_t B_LBUF = B_UBUF + al256((size_t)MT * DLRU * 4);
constexpr size_t B_VMID = B_LBUF + al256((size_t)MT * 256 * 2);
constexpr size_t B_ARW = B_VMID + al256((size_t)MT * 32 * 2);
constexpr size_t B_ALRU = B_ARW + al256((size_t)MT * DRW * 2);
constexpr size_t B_AXA = B_ALRU + al256((size_t)MT * DLRU * 2);
constexpr size_t B_CNT = B_AXA + al256((size_t)MT * DXA * 2);
constexpr size_t B_BAR = B_CNT + 256;
constexpr size_t BAR_BYTES = 16384;
constexpr size_t W_V1T = B_BAR + BAR_BYTES;
constexpr size_t WS_NEED = W_V1T + al256((size_t)3 * 32 * DRW * 2);
static_assert(al256((size_t)MT * D * 2) + (size_t)MT * DFF * 2 <= SCAN_BYTES, "alias overflow");

enum { I_XP = 0, I_XS, I_MEM, I_SSHIFT, I_SWKV, I_SCONV, I_SH, I_CK, I_CV, I_WIN, I_MU, I_W0, I_W2, I_A0, I_A2,
       I_G2, I_V0, I_V1, I_V2, I_KK, I_KA, I_RK, I_GNG, I_GNB, I_WRWOUT, I_CONVW, I_CONVB, I_WRG, I_BRG, I_WIG,
       I_BIG, I_LAMBDA, I_WLRUOUT, I_WMEMKV, I_WXAOUT, I_WO, I_LN1G, I_LN1B, I_WFFNIN, I_WFFNOUT, I_LN2G, I_LN2B };

struct Params {
  const float* in[42];
  float* out;
  char* ws;
};

constexpr int LDS_BYTES = 65536;

__device__ __forceinline__ bf16_t f2bf(float f) {
  unsigned u = __float_as_uint(f);
  u += 0x7fffu + ((u >> 16) & 1u);
  return (bf16_t)(u >> 16);
}
__device__ __forceinline__ float bf2f(bf16_t h) { return __uint_as_float(((unsigned)h) << 16); }
__device__ __forceinline__ float sigmoidf_(float x) { return 1.f / (1.f + __expf(-x)); }
__device__ __forceinline__ float softplusf_(float x) { return fmaxf(x, 0.f) + log1pf(__expf(-fabsf(x))); }
__device__ __forceinline__ int swz(int rr, int b) { int ob = rr * 64 + b; return ob ^ (((ob >> 9) & 1) << 5); }

__device__ __forceinline__ int tid_() {
  int t = threadIdx.x;
  asm volatile("" : "+v"(t));
  return t;
}
template <int CTRL>
__device__ __forceinline__ float dppf(float x) {
  return __int_as_float(__builtin_amdgcn_update_dpp(0, __float_as_int(x), CTRL, 0xf, 0xf, true));
}
__device__ __forceinline__ float red16_sum(float x) {
  x += dppf<0xB1>(x);
  x += dppf<0x4E>(x);
  x += dppf<0x141>(x);
  x += dppf<0x140>(x);
  return x;
}
__device__ __forceinline__ float red16_max(float x) {
  x = fmaxf(x, dppf<0xB1>(x));
  x = fmaxf(x, dppf<0x4E>(x));
  x = fmaxf(x, dppf<0x141>(x));
  x = fmaxf(x, dppf<0x140>(x));
  return x;
}
__device__ __forceinline__ float wave_sum(float x) {
#pragma unroll
  for (int m = 1; m < 64; m <<= 1) x += __shfl_xor(x, m, 64);
  return x;
}

__device__ __forceinline__ void tok_info(int tok, int& seq, int& t, int& T) {
  if (tok < MP) { seq = tok >> 11; t = tok & 2047; T = 2048; }
  else { int s = tok - MP; seq = 8 + (s >> 2); t = s & 3; T = 4; }
}
__device__ __forceinline__ int seq_tok0(int seq) { return seq < 8 ? seq * 2048 : MP + (seq - 8) * 4; }


#define XB_TMO      128
#define XB_XCNT(j)  (256  + 64 * (j))
#define XB_XSUB(j)  (1280 + 64 * (j))
#define XB_XGEN(j)  (2304 + 64 * (j))
#define XB_TOP      3328
#define XB_TOPGEN   3392
#define XCD_BAR_WORDS 3456
#define XB_SPIN_CAP (1u << 22)
#define LAS __attribute__((address_space(3)))
__device__ __forceinline__ unsigned xb_ld(unsigned* p) { return __hip_atomic_load(p, __ATOMIC_RELAXED, __HIP_MEMORY_SCOPE_AGENT); }
__device__ __forceinline__ unsigned xb_add(unsigned* p, unsigned v) { return __hip_atomic_fetch_add(p, v, __ATOMIC_RELAXED, __HIP_MEMORY_SCOPE_AGENT); }
__device__ __forceinline__ unsigned xb_xcc_id() { return (unsigned)__builtin_amdgcn_s_getreg((3 << 11) | 20) & 0xFu; }
#define XB_SPIN(cond, bar) do { unsigned _sp = 0; while (cond) { __builtin_amdgcn_s_sleep(1); \
    if ((++_sp & 255u) == 0u) { if (xb_ld(&(bar)[XB_TMO])) break; if (_sp > XB_SPIN_CAP) { atomicAdd(&(bar)[XB_TMO], 1u); break; } } } } while (0)
struct XcdBarrier { unsigned* bar; unsigned x; volatile LAS unsigned* st; };
__device__ __forceinline__ XcdBarrier xcd_barrier_post(unsigned* bar, volatile LAS unsigned* st) {
  XcdBarrier b; b.bar = bar; b.x = xb_xcc_id(); b.st = st;
  if (threadIdx.x == 0) (void)xb_add(&bar[XB_XCNT(b.x)], 1u);
  return b;
}
__device__ __forceinline__ void xcd_barrier_complete(unsigned* bar, unsigned x, unsigned& nloc, unsigned& nx) {
  const unsigned G = gridDim.x * gridDim.y * gridDim.z;
  unsigned sum, cnt, mine, sp = 0u;
  for (;;) {
    sum = 0u; cnt = 0u; mine = 0u;
#pragma unroll
    for (unsigned j = 0; j < 16; ++j) { const unsigned c = xb_ld(&bar[XB_XCNT(j)]); sum += c; cnt += (c > 0u) ? 1u : 0u; mine = (j == x) ? c : mine; }
    if (sum == G) break;
    __builtin_amdgcn_s_sleep(1);
    if ((++sp & 255u) == 0u) { if (xb_ld(&bar[XB_TMO])) break; if (sp > XB_SPIN_CAP) { atomicAdd(&bar[XB_TMO], 1u); break; } }
  }
  nloc = mine > 0u ? mine : 1u; nx = cnt > 0u ? cnt : 1u;
}
__device__ __forceinline__ void xcd_barrier(const XcdBarrier& b) {
  asm volatile("s_waitcnt vmcnt(0)" ::: "memory");
  __syncthreads();
  if (threadIdx.x == 0) {
    unsigned* bar = b.bar;
    __builtin_amdgcn_s_waitcnt(0);
    unsigned nloc = b.st[0], nx = b.st[1];
    if (nloc == 0u) { xcd_barrier_complete(bar, b.x, nloc, nx); b.st[0] = nloc; b.st[1] = nx; }
    const unsigned old = xb_add(&bar[XB_XSUB(b.x)], 1u);
    const unsigned gen = old / nloc;
    if (old + 1u == (gen + 1u) * nloc) {
      __builtin_amdgcn_fence(__ATOMIC_RELEASE, "agent");
      asm volatile("s_waitcnt vmcnt(0)" ::: "memory");
      const unsigned og = xb_add(&bar[XB_TOP], 1u);
      const unsigned tg = og / nx;
      if (og + 1u == (tg + 1u) * nx) xb_add(&bar[XB_TOPGEN], 1u);
      else XB_SPIN(xb_ld(&bar[XB_TOPGEN]) == tg, bar);
      __builtin_amdgcn_fence(__ATOMIC_ACQUIRE, "agent");
      xb_add(&bar[XB_XGEN(b.x)], 1u);
      asm volatile("s_waitcnt vmcnt(0)" ::: "memory");
    } else {
      XB_SPIN(xb_ld(&bar[XB_XGEN(b.x)]) == gen, bar);
      __builtin_amdgcn_fence(__ATOMIC_ACQUIRE, "agent");
      asm volatile("s_waitcnt vmcnt(0)" ::: "memory");
    }
  }
  __syncthreads();
}

#define MFMA(a, b, c) __builtin_amdgcn_mfma_f32_16x16x32_bf16((a), (b), (c), 0, 0, 0)

template <int OFF>
__device__ __forceinline__ bf16x8 lds_rd128(unsigned addr) {
  bf16x8 v;
  asm volatile("ds_read_b128 %0, %1 offset:%2" : "=v"(v) : "v"(addr), "n"(OFF));
  return v;
}
template <int MTW, int NTW>
struct GemmCtx {
  const bf16_t* ga;
  const bf16_t* gb;
  int lda, ldb;
};
#define GEMM_STAGE_BYTES(MTW, NTW) (2048 * ((MTW) + (NTW)))
#define GEMM_NLD(MTW, NTW) (((MTW) + (NTW)) / 2)

template <int NTW>
__device__ __forceinline__ int gemm_brow(int s  , int rr  ) {
  return (s / NTW) * (16 * NTW) + (rr >> 2) * (4 * NTW) + (s % NTW) * 4 + (rr & 3);
}
template <int MTW, int NTW>
__device__ __forceinline__ void gemm_issue(const bf16_t* ga, int lda, const bf16_t* gb0, const bf16_t* gb1, int kt, char* wstage) {
#pragma unroll
  for (int j = 0; j < MTW / 2; ++j)
    __builtin_amdgcn_global_load_lds((const unsigned*)(ga + (size_t)(64 * j) * lda + kt * 32), (unsigned*)(wstage + j * 4096), 16, 0, 0);
  __builtin_amdgcn_global_load_lds((const unsigned*)(gb0 + kt * 32), (unsigned*)(wstage + MTW * 2048), 16, 0, 0);
  if constexpr (NTW == 4)
    __builtin_amdgcn_global_load_lds((const unsigned*)(gb1 + kt * 32), (unsigned*)(wstage + MTW * 2048 + 4096), 16, 0, 0);
}

template <int MTW, int NTW>
__device__ __forceinline__ void gemm_prologue(const bf16_t* __restrict__ A, int lda, const bf16_t* __restrict__ Bt, int ldb,
                                              int m0, int n0, char* lds) {
  constexpr int SB = GEMM_STAGE_BYTES(MTW, NTW);
  const int TX = tid_();
  const int lane = TX & 63, wv = TX >> 6;
  const int obs = lane * 16;
  const int ob = obs ^ (((obs >> 9) & 1) << 5);
  const int srow = wv * 16 + (ob >> 6), scol = (ob & 63) >> 1;
  const bf16_t* ga = A + (size_t)(m0 + srow) * lda + scol;
  const bf16_t* gb0 = Bt + (size_t)(n0 + gemm_brow<NTW>(wv, ob >> 6)) * ldb + scol;
  const bf16_t* gb1 = Bt + (size_t)(n0 + gemm_brow<NTW>(wv + 4, ob >> 6)) * ldb + scol;
  char* wbase = lds + wv * 1024;
#pragma unroll
  for (int t = 0; t < 3; ++t) gemm_issue<MTW, NTW>(ga, lda, gb0, gb1, t, wbase + t * SB);
}

template <int MTW, int NTW>
__device__ __forceinline__ void gemm_loop(const bf16_t* __restrict__ A, int lda, const bf16_t* __restrict__ Bt, int ldb,
                                          int K, int m0, int n0, char* lds, f32x4 (&acc)[MTW][NTW]) {
  constexpr int SB = GEMM_STAGE_BYTES(MTW, NTW), NLD = GEMM_NLD(MTW, NTW);
  static_assert(NLD == 4 || NLD == 3, "vmcnt immediates below assume 3 or 4 loads per k-step");
  const int TX = tid_();
  const int lane = TX & 63, wv = TX >> 6;
  const int wr = wv >> 1, wc = wv & 1, fr = lane & 15, fq = lane >> 4;
  const int obs = lane * 16;
  const int ob = obs ^ (((obs >> 9) & 1) << 5);
  const int srow = wv * 16 + (ob >> 6), scol = (ob & 63) >> 1;
  const bf16_t* ga = A + (size_t)(m0 + srow) * lda + scol;
  const bf16_t* gb0 = Bt + (size_t)(n0 + gemm_brow<NTW>(wv, ob >> 6)) * ldb + scol;
  const bf16_t* gb1 = Bt + (size_t)(n0 + gemm_brow<NTW>(wv + 4, ob >> 6)) * ldb + scol;
  char* wbase = lds + wv * 1024;
  const int fo = swz(fr, fq * 16);
  const unsigned lbase = (unsigned)(unsigned long)((__attribute__((address_space(3))) char*)lds);
  const unsigned a_off = lbase + (wr * MTW) * 1024 + fo, b_off = lbase + MTW * 2048 + (wc * NTW) * 1024 + fo;
  const int nk = K >> 5;
  for (int kt = 0; kt < nk; ++kt) {
    if (kt + 2 < nk) { if (NLD == 4) asm volatile("s_waitcnt vmcnt(8)" ::: "memory"); else asm volatile("s_waitcnt vmcnt(6)" ::: "memory"); }
    else if (kt + 1 < nk) { if (NLD == 4) asm volatile("s_waitcnt vmcnt(4)" ::: "memory"); else asm volatile("s_waitcnt vmcnt(3)" ::: "memory"); }
    else asm volatile("s_waitcnt vmcnt(0)" ::: "memory");
    __builtin_amdgcn_s_barrier();
    asm volatile("" ::: "memory");
    static_assert(MTW == 4, "fragment read block below is written for 4 m-tiles per wave");
    const unsigned sa_ = a_off + (kt & 3) * SB, sb_ = b_off + (kt & 3) * SB;
    bf16x8 af[MTW], bfr[NTW];
    af[0] = lds_rd128<0>(sa_); af[1] = lds_rd128<1024>(sa_); af[2] = lds_rd128<2048>(sa_); af[3] = lds_rd128<3072>(sa_);
    bfr[0] = lds_rd128<0>(sb_); bfr[1] = lds_rd128<1024>(sb_);
    if constexpr (NTW == 4) { bfr[2] = lds_rd128<2048>(sb_); bfr[3] = lds_rd128<3072>(sb_); }
    if (kt + 3 < nk) gemm_issue<MTW, NTW>(ga, lda, gb0, gb1, kt + 3, wbase + ((kt + 3) & 3) * SB);
    if constexpr (NTW == 4)
      asm volatile("s_waitcnt lgkmcnt(0)" : "+v"(af[0]), "+v"(af[1]), "+v"(af[2]), "+v"(af[3]), "+v"(bfr[0]), "+v"(bfr[1]), "+v"(bfr[2]), "+v"(bfr[3]) :: "memory");
    else
      asm volatile("s_waitcnt lgkmcnt(0)" : "+v"(af[0]), "+v"(af[1]), "+v"(af[2]), "+v"(af[3]), "+v"(bfr[0]), "+v"(bfr[1]) :: "memory");
#pragma unroll
    for (int mt = 0; mt < MTW; ++mt)
#pragma unroll
      for (int nt = 0; nt < NTW; ++nt) acc[mt][nt] = MFMA(bfr[nt], af[mt], acc[mt][nt]);
  }
  asm volatile("s_waitcnt lgkmcnt(0)" ::: "memory");
  __builtin_amdgcn_s_barrier();
  asm volatile("" ::: "memory");
}

template <int MTW, int NTW>
__device__ __forceinline__ void gemm_main(const bf16_t* __restrict__ A, int lda, const bf16_t* __restrict__ Bt, int ldb,
                                          int K, int m0, int n0, char* lds, f32x4 (&acc)[MTW][NTW]) {
  gemm_prologue<MTW, NTW>(A, lda, Bt, ldb, m0, n0, lds);
  gemm_loop<MTW, NTW>(A, lda, Bt, ldb, K, m0, n0, lds, acc);
}

__device__ __forceinline__ uint4 pack8(const f32x4& a, const f32x4& b) {
  uint4 o;
  o.x = (unsigned)f2bf(a[0]) | ((unsigned)f2bf(a[1]) << 16);
  o.y = (unsigned)f2bf(a[2]) | ((unsigned)f2bf(a[3]) << 16);
  o.z = (unsigned)f2bf(b[0]) | ((unsigned)f2bf(b[1]) << 16);
  o.w = (unsigned)f2bf(b[2]) | ((unsigned)f2bf(b[3]) << 16);
  return o;
}

struct TileIter {
  int L, Lend, step;
};
__device__ __forceinline__ TileIter tile_iter(int ntiles) {
  const int G = (int)gridDim.x, b = (int)blockIdx.x;
  TileIter it;
  if ((G & 7) == 0) {
    const int tpx = (ntiles + 7) >> 3, x = b & 7;
    it.L = x * tpx + (b >> 3);
    it.Lend = min(ntiles, (x + 1) * tpx);
    it.step = G >> 3;
  } else {
    it.L = b; it.Lend = ntiles; it.step = G;
  }
  return it;
}
__device__ __forceinline__ void tile_mn(int L, int nM, int nN, int& m, int& n) {
  const int full = (nM >> 3) * 8 * nN;
  if (L < full) {
    const int band = L / (8 * nN), r = L % (8 * nN);
    n = r >> 3; m = band * 8 + (r & 7);
  } else {
    const int rem = nM & 7, r = L - full;
    n = r / rem; m = (nM >> 3) * 8 + r % rem;
  }
}

template <int MTW, int NTW>
__device__ __forceinline__ void zero_acc(f32x4 (&acc)[MTW][NTW]) {
#pragma unroll
  for (int a = 0; a < MTW; ++a)
#pragma unroll
    for (int b = 0; b < NTW; ++b) acc[a][b] = f32x4{0.f, 0.f, 0.f, 0.f};
}

__device__ void transpose_tile(const float* __restrict__ W, int ldw, bf16_t* __restrict__ Wt, int ldt, int k0, int n0,
                               int perm, char* lds) {
  const int TX = tid_();
  float* tile = (float*)lds;
  const int tid = TX;
  const int c = tid & 63, r0 = tid >> 6;
#pragma unroll
  for (int r = 0; r < 16; ++r) {
    int row = r * 4 + r0;
    tile[row * 65 + c] = W[(size_t)(k0 + row) * ldw + n0 + c];
  }
  __syncthreads();
#pragma unroll
  for (int r = 0; r < 16; ++r) {
    int n = n0 + r * 4 + r0;
    int np = n;
    if (perm) {
      if (n < DFF) np = (n >> 3) * 16 + (n & 7);
      else { int j = n - DFF; np = (j >> 3) * 16 + 8 + (j & 7); }
    }
    Wt[(size_t)np * ldt + k0 + c] = f2bf(tile[c * 65 + (r * 4 + r0)]);
  }
  __syncthreads();
}

__device__ __forceinline__ void convert_job(const float* __restrict__ src, bf16_t* __restrict__ dst, int K, int N, int nmat,
                                            int perm, int& start, char* lds) {
  const int tk = K / 64, tn = N / 64;
  const int ntiles = nmat * tk * tn;
  const int G = (int)gridDim.x;
  const int first = (((int)blockIdx.x - start) % G + G) % G;
  for (int i = first; i < ntiles; i += G) {
    const int mat = i / (tk * tn), r = i % (tk * tn);
    const int kt = r / tn, nt = r % tn;
    transpose_tile(src + (size_t)mat * K * N, N, dst + (size_t)mat * K * N, K, kt * 64, nt * 64, perm, lds);
  }
  start += ntiles;
}

__device__ void phase_convert(const Params& p, char* lds) {
  const int TX = tid_();
  char* ws = p.ws;
  int start = 0;
  convert_job(p.in[I_WIN], (bf16_t*)(ws + W_IN), 1024, 7680, NL, 0, start, lds);
  convert_job(p.in[I_WFFNIN], (bf16_t*)(ws + W_FFNIN), 1024, 5632, NL, 1, start, lds);
  convert_job(p.in[I_WFFNOUT], (bf16_t*)(ws + W_FFNOUT), 2816, 1024, NL, 0, start, lds);
  convert_job(p.in[I_WRWOUT], (bf16_t*)(ws + W_RWOUT), 768, 1024, NL, 0, start, lds);
  convert_job(p.in[I_WLRUOUT], (bf16_t*)(ws + W_LRUOUT), 768, 1024, NL, 0, start, lds);
  convert_job(p.in[I_WXAOUT], (bf16_t*)(ws + W_XAOUT), 512, 1024, NL, 0, start, lds);
  convert_job(p.in[I_WO], (bf16_t*)(ws + W_O), 1024, 1024, NL, 0, start, lds);
  convert_job(p.in[I_WMEMKV], (bf16_t*)(ws + W_MEMKV), 1024, 1024, NL, 0, start, lds);
  convert_job(p.in[I_W2], (bf16_t*)(ws + W_W2T), 64, 768, NL, 0, start, lds);
  convert_job(p.in[I_A2], (bf16_t*)(ws + W_A2T), 64, 768, NL, 0, start, lds);
  convert_job(p.in[I_G2], (bf16_t*)(ws + W_G2T), 128, 768, NL, 0, start, lds);
  convert_job(p.in[I_WRG], (bf16_t*)(ws + W_RGT), 64, 64, NL * 12, 0, start, lds);
  convert_job(p.in[I_WIG], (bf16_t*)(ws + W_IGT), 64, 64, NL * 12, 0, start, lds);
  const size_t gtid = (size_t)blockIdx.x * 256 + TX, gsz = (size_t)gridDim.x * 256;
  {
    uint2* xb = (uint2*)(ws + B_XB);
    const float4* xp = (const float4*)p.in[I_XP];
    const float4* xs = (const float4*)p.in[I_XS];
    const size_t np4 = (size_t)MP * D / 4, nt4 = (size_t)MT * D / 4;
    for (size_t i = gtid; i < nt4; i += gsz) {
      float4 v = (i < np4) ? xp[i] : xs[i - np4];
      uint2 o;
      o.x = (unsigned)f2bf(v.x) | ((unsigned)f2bf(v.y) << 16);
      o.y = (unsigned)f2bf(v.z) | ((unsigned)f2bf(v.w) << 16);
      xb[i] = o;
    }
  }
  {
    uint2* mb = (uint2*)(ws + B_MEMB);
    const float4* m = (const float4*)p.in[I_MEM];
    const size_t n4 = (size_t)2048 * D / 4;
    for (size_t i = gtid; i < n4; i += gsz) {
      float4 v = m[i];
      uint2 o;
      o.x = (unsigned)f2bf(v.x) | ((unsigned)f2bf(v.y) << 16);
      o.y = (unsigned)f2bf(v.z) | ((unsigned)f2bf(v.w) << 16);
      mb[i] = o;
    }
  }
  {
    bf16_t* v1t = (bf16_t*)(ws + W_V1T);
    const float* v1 = p.in[I_V1];
    for (size_t i = gtid; i < (size_t)3 * 768 * 32; i += gsz) {
      int j = (int)(i / (768 * 32)), r = (int)(i % (768 * 32));
      int n = r / 768, k = r % 768;
      v1t[i] = f2bf(v1[(size_t)j * 768 * 32 + (size_t)k * 32 + n]);
    }
  }
  {
    bf16_t* v2t = (bf16_t*)(ws + W_V2T);
    const float* v2 = p.in[I_V2];
    for (size_t i = gtid; i < (size_t)3 * 768 * 32; i += gsz) {
      int j = (int)(i / (768 * 32)), r = (int)(i % (768 * 32));
      int n = r / 32, k = r % 32;
      v2t[i] = f2bf(v2[(size_t)j * 32 * 768 + (size_t)k * 768 + n]);
    }
  }
}

struct ProjTile { const bf16_t* A; const bf16_t* Bt; int m0, n0, ll; bool main; };
__device__ __forceinline__ ProjTile proj_tile(const Params& p, int l, int tile, int nextra) {
  char* ws = p.ws;
  ProjTile t;
  if (tile >= nextra) {
    int tm, tn;
    tile_mn(tile - nextra, MT / 128, DIN / 128, tm, tn);
    t.A = (const bf16_t*)(ws + B_XB); t.Bt = (const bf16_t*)(ws + W_IN) + (size_t)l * DIN * D;
    t.m0 = tm * 128; t.n0 = tn * 128; t.ll = l; t.main = true;
  } else {
    const int ll = tile / 128, r = tile % 128;
    t.A = (const bf16_t*)(ws + B_MEMB); t.Bt = (const bf16_t*)(ws + W_MEMKV) + (size_t)ll * D * D;
    t.m0 = (r / 8) * 128; t.n0 = (r % 8) * 128; t.ll = ll; t.main = false;
  }
  return t;
}

__device__ void phase_proj(const Params& p, int l, char* lds) {
  const int TX = tid_();
  char* ws = p.ws;
  bf16_t* proj = (bf16_t*)(ws + B_PROJ);
  const int lane = TX & 63, wv = TX >> 6, wr = wv >> 1, wc = wv & 1, fr = lane & 15, fq = lane >> 4;
  const int ntiles = (MT / 128) * (DIN / 128);
  const int nextra = (l == 0) ? NL * 16 * 8 : 0;
  TileIter it = tile_iter(ntiles + nextra);
  bool have = it.L < it.Lend;
  ProjTile cur;
  if (have) { cur = proj_tile(p, l, it.L, nextra); gemm_prologue<4, 4>(cur.A, D, cur.Bt, D, cur.m0, cur.n0, lds); }
  while (have) {
    f32x4 acc[4][4];
    zero_acc(acc);
    gemm_loop<4, 4>(cur.A, D, cur.Bt, D, D, cur.m0, cur.n0, lds, acc);
    const int Ln = it.L + it.step;
    const bool hn = Ln < it.Lend;
    ProjTile nxt = cur;
    if (hn) { nxt = proj_tile(p, l, Ln, nextra); gemm_prologue<4, 4>(nxt.A, D, nxt.Bt, D, nxt.m0, nxt.n0, lds); }
    const int m0 = cur.m0, n0 = cur.n0;
    if (cur.main) {
#pragma unroll
      for (int mt = 0; mt < 4; ++mt) {
        const int row = m0 + wr * 64 + mt * 16 + fr, col = n0 + wc * 64 + fq * 16;
        uint4* dst = (uint4*)(proj + (size_t)row * DIN + col);
        dst[0] = pack8(acc[mt][0], acc[mt][1]);
        dst[1] = pack8(acc[mt][2], acc[mt][3]);
      }
    } else {
      const int ll = cur.ll;
      bf16_t* kb = (bf16_t*)(ws + B_KB);
      bf16_t* vtb = (bf16_t*)(ws + B_VTB);
#pragma unroll
      for (int mt = 0; mt < 4; ++mt)
#pragma unroll
        for (int nt = 0; nt < 4; ++nt)
#pragma unroll
          for (int i = 0; i < 4; ++i) {
            int row = m0 + wr * 64 + mt * 16 + fr, col = n0 + wc * 64 + fq * 16 + nt * 4 + i;
            int b = row >> 8, key = row & 255;
            float v = acc[mt][nt][i];
            if (col < 512) {
              p.out[O_MKP + ((size_t)(ll * 8 + b) * 256 + key) * 512 + col] = v;
              kb[((size_t)(ll * 8 + b) * 256 + key) * 512 + col] = f2bf(v);
            } else {
              int c2 = col - 512, h = c2 >> 7, d = c2 & 127;
              p.out[O_MVP + ((size_t)(ll * 8 + b) * 256 + key) * 512 + c2] = v;
              vtb[(((size_t)(ll * 8 + b) * 4 + h) * 128 + d) * 256 + key] = f2bf(v);
            }
          }
    }
    it.L = Ln; have = hn; cur = nxt;
  }
}

__device__ __forceinline__ float prw_prev(const Params& p, const bf16_t* proj, int l, int tok, int seq, int t, int c) {
  if (t > 0) return bf2f(proj[(size_t)(tok - 1) * DIN + c]);
  if (seq >= 8) return p.in[I_SSHIFT][((size_t)l * 128 + (seq - 8)) * RWC + c];
  return 0.f;
}
__device__ __forceinline__ float plx_back(const Params& p, const bf16_t* proj, int l, int tok, int seq, int t, int j, int ch) {
  if (t - j >= 0) return bf2f(proj[(size_t)(tok - j) * DIN + C_LX + ch]);
  if (seq >= 8) return p.in[I_SCONV][(((size_t)l * 128 + (seq - 8)) * 3 + (3 + t - j)) * DLRU + ch];
  return 0.f;
}

__device__ __forceinline__ float2 ld_bf2(const bf16_t* p) {
  const unsigned u = *(const unsigned*)p;
  return make_float2(__uint_as_float(u << 16), __uint_as_float(u & 0xffff0000u));
}
__device__ __forceinline__ unsigned pk_bf2(float a, float b) { return (unsigned)f2bf(a) | ((unsigned)f2bf(b) << 16); }
__device__ __forceinline__ float2 prw_prev2(const Params& p, const bf16_t* proj, int l, int tok, int seq, int t, int c) {
  if (t > 0) return ld_bf2(proj + (size_t)(tok - 1) * DIN + c);
  if (seq >= 8) return *(const float2*)(p.in[I_SSHIFT] + ((size_t)l * 128 + (seq - 8)) * RWC + c);
  return make_float2(0.f, 0.f);
}
__device__ __forceinline__ float2 plx_back2(const Params& p, const bf16_t* proj, int l, int tok, int seq, int t, int j, int ch) {
  if (t - j >= 0) return ld_bf2(proj + (size_t)(tok - j) * DIN + C_LX + ch);
  if (seq >= 8) return *(const float2*)(p.in[I_SCONV] + (((size_t)l * 128 + (seq - 8)) * 3 + (3 + t - j)) * DLRU + ch);
  return make_float2(0.f, 0.f);
}

__device__ void phase_prep(const Params& p, int l, char* lds) {
  const int TX = tid_();
  char* ws = p.ws;
  const bf16_t* proj = (const bf16_t*)(ws + B_PROJ);
  bf16_t* L = (bf16_t*)(ws + B_LBUF);
  bf16_t* XC = (bf16_t*)(ws + B_ALRU);
  float* ubuf = (float*)(ws + B_UBUF);
  bf16_t* vmid = (bf16_t*)(ws + B_VMID);
  const float* mu = p.in[I_MU] + (size_t)l * RWC;
  const float* cw = p.in[I_CONVW] + (size_t)l * 4 * DLRU;
  const float* cb = p.in[I_CONVB] + (size_t)l * DLRU;
  const int tid = TX, lane = tid & 63, wv = tid >> 6, fr = lane & 15, fq = lane >> 4;
  constexpr int TK = 4;
  for (int item = blockIdx.x; item < MT / TK; item += gridDim.x) {
    const int tokb = item * TK;
    auto body = [&](auto interior_tag) {
    constexpr bool INTR = decltype(interior_tag)::value;
#pragma unroll 4
    for (int u = tid; u < TK * 128; u += 256) {
      const int tk = u >> 7, cp = (u & 127) * 2, tok = tokb + tk, c = 2304 + cp;
      int seq = 0, t = 16, T = 2048;
      if constexpr (!INTR) tok_info(tok, seq, t, T);
      const float2 pc = ld_bf2(proj + (size_t)tok * DIN + c);
      float2 pp;
      if constexpr (INTR) pp = ld_bf2(proj + (size_t)(tok - 1) * DIN + c); else pp = prw_prev2(p, proj, l, tok, seq, t, c);
      const float2 m2 = *(const float2*)(mu + c);
      const float x0 = pc.x + (pp.x - pc.x) * m2.x, x1 = pc.y + (pp.y - pc.y) * m2.y;
      float o0, o1;
      if (cp < 64) { o0 = tanhf(x0); o1 = tanhf(x1); }
      else if (cp < 128) { o0 = x0; o1 = x1; }
      else { o0 = sigmoidf_(x0); o1 = sigmoidf_(x1); }
      *(unsigned*)(L + (size_t)tok * 256 + cp) = pk_bf2(o0, o1);
    }
#pragma unroll 4
    for (int u = tid; u < TK * 384; u += 256) {
      const int tk = u / 384, ch = (u % 384) * 2, tok = tokb + tk;
      int seq = 0, t = 16, T = 2048;
      if constexpr (INTR) { seq = tok >> 11; t = tok & 2047; } else tok_info(tok, seq, t, T);
      const float2 x0 = ld_bf2(proj + (size_t)tok * DIN + C_LX + ch);
      float2 x1, x2, x3;
      if constexpr (INTR) {
        x1 = ld_bf2(proj + (size_t)(tok - 1) * DIN + C_LX + ch);
        x2 = ld_bf2(proj + (size_t)(tok - 2) * DIN + C_LX + ch);
        x3 = ld_bf2(proj + (size_t)(tok - 3) * DIN + C_LX + ch);
      } else {
        x1 = plx_back2(p, proj, l, tok, seq, t, 1, ch);
        x2 = plx_back2(p, proj, l, tok, seq, t, 2, ch);
        x3 = plx_back2(p, proj, l, tok, seq, t, 3, ch);
      }
      const float2 b2 = *(const float2*)(cb + ch), w3 = *(const float2*)(cw + 3 * DLRU + ch), w2 = *(const float2*)(cw + 2 * DLRU + ch),
                   w1 = *(const float2*)(cw + DLRU + ch), w0 = *(const float2*)(cw + ch);
      const float xa = b2.x + w3.x * x0.x + w2.x * x1.x + w1.x * x2.x + w0.x * x3.x;
      const float xb_ = b2.y + w3.y * x0.y + w2.y * x1.y + w1.y * x2.y + w0.y * x3.y;
      *(unsigned*)(XC + (size_t)tok * DLRU + ch) = pk_bf2(xa, xb_);
      if (t >= T - 3) {
        const size_t o = (seq < 8) ? O_CONVP + (((size_t)l * 8 + seq) * 3 + (t - (T - 3))) * DLRU
                                   : O_CONVS + (((size_t)l * 128 + (seq - 8)) * 3 + (t - (T - 3))) * DLRU;
        *(float2*)(p.out + o + ch) = x0;
      }
      if (l > 0) {
        const int c = 1536 + ch;
        const float2 pc = ld_bf2(proj + (size_t)tok * DIN + c);
        float2 pp;
        if constexpr (INTR) pp = ld_bf2(proj + (size_t)(tok - 1) * DIN + c); else pp = prw_prev2(p, proj, l, tok, seq, t, c);
        const float2 m2 = *(const float2*)(mu + c);
        const float v0 = pc.x + (pp.x - pc.x) * m2.x, v1 = pc.y + (pp.y - pc.y) * m2.y;
        *(unsigned*)(lds + (ch >> 5) * 1024 + swz(tk, (ch & 31) * 2)) = pk_bf2(v0, v1);
      }
    }
    };
    if (tokb < MP && (tokb & 2047) != 0) body(std::true_type{}); else body(std::false_type{});
    for (int tk = 0; tk < TK; ++tk) {
      const int tok = tokb + tk;
      int seq, t, T;
      tok_info(tok, seq, t, T);
      if (t == T - 1) {
        const size_t o = (seq < 8) ? O_SHP + ((size_t)l * 8 + seq) * RWC : O_SHS + ((size_t)l * 128 + (seq - 8)) * RWC;
        for (int c = tid * 2; c < RWC; c += 512) *(float2*)(p.out + o + c) = ld_bf2(proj + (size_t)tok * DIN + c);
      }
    }
    if (l > 0) {
      __syncthreads();
      const bf16_t* v1t = (const bf16_t*)(ws + W_V1T) + (size_t)(l - 1) * 32 * DRW;
      f32x4 acc0 = f32x4{0, 0, 0, 0}, acc1 = acc0;
      const int fo = swz(fr, fq * 16);
#pragma unroll
      for (int kk = 0; kk < 6; ++kk) {
        const int ks = wv * 6 + kk;
        const bf16x8 af = *(const bf16x8*)(lds + ks * 1024 + fo);
        const bf16x8 b0 = *(const bf16x8*)(v1t + (size_t)fr * DRW + ks * 32 + fq * 8);
        const bf16x8 b1 = *(const bf16x8*)(v1t + (size_t)(16 + fr) * DRW + ks * 32 + fq * 8);
        acc0 = MFMA(af, b0, acc0);
        acc1 = MFMA(af, b1, acc1);
      }
      float* red = (float*)(lds + 24576);
#pragma unroll
      for (int i = 0; i < 4; ++i) {
        red[(wv * 16 + fq * 4 + i) * 32 + fr] = acc0[i];
        red[(wv * 16 + fq * 4 + i) * 32 + 16 + fr] = acc1[i];
      }
      __syncthreads();
      {
        const int row = tid >> 4, c2 = (tid & 15) * 2;
        if (row < TK) {
          float s0 = 0.f, s1 = 0.f;
#pragma unroll
          for (int w = 0; w < 4; ++w) { s0 += red[(w * 16 + row) * 32 + c2]; s1 += red[(w * 16 + row) * 32 + c2 + 1]; }
          *(unsigned*)(vmid + (size_t)(tokb + row) * 32 + c2) = pk_bf2(s0, s1);
        }
      }
      __syncthreads();
    }
  }
}

__device__ __forceinline__ void unpack4(const uint2 q, float (&o)[4]) {
  o[0] = __uint_as_float(q.x << 16); o[1] = __uint_as_float(q.x & 0xffff0000u);
  o[2] = __uint_as_float(q.y << 16); o[3] = __uint_as_float(q.y & 0xffff0000u);
}
__device__ __forceinline__ void prw_prev4(const Params& p, const bf16_t* proj, int l, int tok, int seq, int t, int c, float (&o)[4]) {
  if (t > 0) { unpack4(*(const uint2*)(proj + (size_t)(tok - 1) * DIN + c), o); return; }
  if (seq >= 8) {
    const float4 s = *(const float4*)(p.in[I_SSHIFT] + ((size_t)l * 128 + (seq - 8)) * RWC + c);
    o[0] = s.x; o[1] = s.y; o[2] = s.z; o[3] = s.w;
    return;
  }
  o[0] = 0.f; o[1] = 0.f; o[2] = 0.f; o[3] = 0.f;
}

__device__ void phase_lora(const Params& p, int l, char* lds) {
  const int TX = tid_();
  char* ws = p.ws;
  const bf16_t* proj = (const bf16_t*)(ws + B_PROJ);
  const bf16_t* L = (const bf16_t*)(ws + B_LBUF);
  const bf16_t* vmid = (const bf16_t*)(ws + B_VMID);
  const bf16_t* XC = (const bf16_t*)(ws + B_ALRU);
  const int NRW = (MT / 128) * 12;
  for (int item = blockIdx.x; item < NRW; item += gridDim.x) {
    int txl = TX;
    asm volatile("" : "+v"(txl));
    const int lane = txl & 63, wv = txl >> 6, fr = lane & 15, fq = lane >> 4;
    {
      const int h = item % 12, tb = (item / 12) * 128 + wv * 32;
      const bf16_t* w2t = (const bf16_t*)(ws + W_W2T) + ((size_t)l * DRW + h * 64) * 64;
      const bf16_t* a2t = (const bf16_t*)(ws + W_A2T) + ((size_t)l * DRW + h * 64) * 64;
      const bf16_t* g2t = (const bf16_t*)(ws + W_G2T) + ((size_t)l * DRW + h * 64) * 128;
      bf16_t* gbuf = (bf16_t*)(ws + B_GBUF);
      {
        f32x4 ag[2][4];
#pragma unroll
        for (int a = 0; a < 2; ++a)
#pragma unroll
          for (int b = 0; b < 4; ++b) ag[a][b] = f32x4{0, 0, 0, 0};
#pragma unroll
        for (int ks = 0; ks < 4; ++ks) {
          bf16x8 af[2], bf_[4];
#pragma unroll
          for (int mt = 0; mt < 2; ++mt) af[mt] = *(const bf16x8*)(L + (size_t)(tb + mt * 16 + fr) * 256 + 128 + ks * 32 + fq * 8);
#pragma unroll
          for (int nt = 0; nt < 4; ++nt) bf_[nt] = *(const bf16x8*)(g2t + (size_t)(nt * 16 + fr) * 128 + ks * 32 + fq * 8);
#pragma unroll
          for (int mt = 0; mt < 2; ++mt)
#pragma unroll
            for (int nt = 0; nt < 4; ++nt) ag[mt][nt] = MFMA(af[mt], bf_[nt], ag[mt][nt]);
        }
#pragma unroll
        for (int mt = 0; mt < 2; ++mt)
#pragma unroll
          for (int nt = 0; nt < 4; ++nt)
#pragma unroll
            for (int i = 0; i < 4; ++i)
              gbuf[(size_t)(tb + mt * 16 + fq * 4 + i) * DRW + h * 64 + nt * 16 + fr] = f2bf(ag[mt][nt][i]);
      }
      f32x4 aw[2][4], aa[2][4], av[2][4];
#pragma unroll
      for (int a = 0; a < 2; ++a)
#pragma unroll
        for (int b = 0; b < 4; ++b) { aw[a][b] = f32x4{0, 0, 0, 0}; aa[a][b] = aw[a][b]; av[a][b] = aw[a][b]; }
#pragma unroll
      for (int ks = 0; ks < 2; ++ks) {
        bf16x8 af[2], bf_[4];
#pragma unroll
        for (int mt = 0; mt < 2; ++mt) af[mt] = *(const bf16x8*)(L + (size_t)(tb + mt * 16 + fr) * 256 + ks * 32 + fq * 8);
#pragma unroll
        for (int nt = 0; nt < 4; ++nt) bf_[nt] = *(const bf16x8*)(w2t + (size_t)(nt * 16 + fr) * 64 + ks * 32 + fq * 8);
#pragma unroll
        for (int mt = 0; mt < 2; ++mt)
#pragma unroll
          for (int nt = 0; nt < 4; ++nt) aw[mt][nt] = MFMA(af[mt], bf_[nt], aw[mt][nt]);
#pragma unroll
        for (int mt = 0; mt < 2; ++mt) af[mt] = *(const bf16x8*)(L + (size_t)(tb + mt * 16 + fr) * 256 + 64 + ks * 32 + fq * 8);
#pragma unroll
        for (int nt = 0; nt < 4; ++nt) bf_[nt] = *(const bf16x8*)(a2t + (size_t)(nt * 16 + fr) * 64 + ks * 32 + fq * 8);
#pragma unroll
        for (int mt = 0; mt < 2; ++mt)
#pragma unroll
          for (int nt = 0; nt < 4; ++nt) aa[mt][nt] = MFMA(af[mt], bf_[nt], aa[mt][nt]);
      }
      if (l > 0) {
        const bf16_t* v2t = (const bf16_t*)(ws + W_V2T) + ((size_t)(l - 1) * DRW + h * 64) * 32;
        bf16x8 af[2], bf_[4];
#pragma unroll
        for (int mt = 0; mt < 2; ++mt) af[mt] = *(const bf16x8*)(vmid + (size_t)(tb + mt * 16 + fr) * 32 + fq * 8);
#pragma unroll
        for (int nt = 0; nt < 4; ++nt) bf_[nt] = *(const bf16x8*)(v2t + (size_t)(nt * 16 + fr) * 32 + fq * 8);
#pragma unroll
        for (int mt = 0; mt < 2; ++mt)
#pragma unroll
          for (int nt = 0; nt < 4; ++nt) av[mt][nt] = MFMA(af[mt], bf_[nt], av[mt][nt]);
      }
      const float* mu = p.in[I_MU] + (size_t)l * RWC;
      float mur[4], muk[4], muv[4], w0[4], a0[4], v0[4], kkp[4], kap[4], rkp[4];
#pragma unroll
      for (int nt = 0; nt < 4; ++nt) {
        int c = h * 64 + nt * 16 + fr;
        mur[nt] = mu[c]; muk[nt] = mu[768 + c]; muv[nt] = mu[1536 + c];
        w0[nt] = p.in[I_W0][(size_t)l * DRW + c];
        a0[nt] = p.in[I_A0][(size_t)l * DRW + c];
        v0[nt] = (l > 0) ? p.in[I_V0][(size_t)(l - 1) * DRW + c] : 0.f;
        kkp[nt] = p.in[I_KK][(size_t)l * DRW + c];
        kap[nt] = p.in[I_KA][(size_t)l * DRW + c];
        rkp[nt] = p.in[I_RK][(size_t)l * DRW + c];
      }
      bf16_t* vfirst = (bf16_t*)(ws + B_VFIRST);
      float* cbuf = (float*)(ws + B_CBUF);
      char* scan = ws + B_SCAN;
      auto epi = [&](auto interior_tag) {
      constexpr bool INTR = decltype(interior_tag)::value;
#pragma unroll
      for (int mt = 0; mt < 2; ++mt)
#pragma unroll
        for (int i = 0; i < 4; ++i) {
          const int tok = tb + mt * 16 + fq * 4 + i;
          int seq = 0, t = 1, T = 2048;
          if constexpr (!INTR) tok_info(tok, seq, t, T);
          const bf16_t* pr = proj + (size_t)tok * DIN;
          float rr[4], kx[4], vv[4], aval[4], dec[4], kkr[4], kmod[4];
          float ss = 0.f, s1 = 0.f, s2 = 0.f, s3 = 0.f;
#pragma unroll
          for (int nt = 0; nt < 4; ++nt) {
            const int cc = nt * 16 + fr, c = h * 64 + cc;
            float pc, pp;
            pc = bf2f(pr[c]);
            if constexpr (INTR) pp = bf2f(pr[c - DIN]); else pp = prw_prev(p, proj, l, tok, seq, t, c);
            rr[nt] = pc + (pp - pc) * mur[nt];
            pc = bf2f(pr[768 + c]);
            if constexpr (INTR) pp = bf2f(pr[768 + c - DIN]); else pp = prw_prev(p, proj, l, tok, seq, t, 768 + c);
            kx[nt] = pc + (pp - pc) * muk[nt];
            pc = bf2f(pr[1536 + c]);
            if constexpr (INTR) pp = bf2f(pr[1536 + c - DIN]); else pp = prw_prev(p, proj, l, tok, seq, t, 1536 + c);
            float vx = pc + (pp - pc) * muv[nt];
            float wraw = -softplusf_(-(w0[nt] + aw[mt][nt][i])) - 0.5f;
            dec[nt] = __expf(-__expf(wraw));
            aval[nt] = sigmoidf_(a0[nt] + aa[mt][nt][i]);
            if (l > 0) {
              float vf = bf2f(vfirst[(size_t)tok * DRW + c]);
              vv[nt] = vx + (vf - vx) * sigmoidf_(v0[nt] + av[mt][nt][i]);
            } else {
              vfirst[(size_t)tok * DRW + c] = f2bf(vx);
              vv[nt] = vx;
            }
            kkr[nt] = kx[nt] * kkp[nt];
            kmod[nt] = kx[nt] * (1.f + (aval[nt] - 1.f) * kap[nt]);
            ss += kkr[nt] * kkr[nt];
            s1 += kkr[nt] * aval[nt] * rr[nt];
            s2 += kmod[nt] * rr[nt];
            s3 += rr[nt] * kmod[nt] * rkp[nt];
          }
          ss = red16_sum(ss); s1 = red16_sum(s1); s2 = red16_sum(s2); s3 = red16_sum(s3);
          const float inv = 1.f / fmaxf(sqrtf(ss), 1e-12f);
          char* so = scan + ((size_t)tok * 12 + h) * 896;
#pragma unroll
          for (int nt = 0; nt < 4; ++nt) {
            const int cc = nt * 16 + fr;
            float kkn = kkr[nt] * inv;
            ((float*)so)[cc] = dec[nt];
            ((bf16_t*)(so + 256))[cc] = f2bf(dec[nt] * rr[nt]);
            ((bf16_t*)(so + 384))[cc] = f2bf(-kkn);
            ((bf16_t*)(so + 512))[cc] = f2bf(kkn * aval[nt]);
            ((bf16_t*)(so + 640))[cc] = f2bf(kmod[nt]);
            ((bf16_t*)(so + 768))[cc] = f2bf(vv[nt]);
          }
          if (fr == 0) {
            float4 cv = make_float4(s1 * inv, s2, s3, 0.f);
            *(float4*)(cbuf + ((size_t)tok * 12 + h) * 4) = cv;
          }
        }
      };
      const int tbu = __builtin_amdgcn_readfirstlane(tb);
      if (tbu < MP && (tbu & 2047) != 0) epi(std::true_type{}); else epi(std::false_type{});
    }
  }
  for (int item = NRW + ((int)gridDim.x - 1 - (int)blockIdx.x); item < 2 * NRW; item += gridDim.x) {
    int txl = TX;
    asm volatile("" : "+v"(txl));
    const int lane = txl & 63, wv = txl >> 6, fr = lane & 15, fq = lane >> 4;
    {
      const int it = item - NRW;
      const int nb = it % 12, tb = (it / 12) * 128 + wv * 32;
      const bf16_t* rgt = (const bf16_t*)(ws + W_RGT) + ((size_t)l * 12 + nb) * 4096;
      const bf16_t* igt = (const bf16_t*)(ws + W_IGT) + ((size_t)l * 12 + nb) * 4096;
      const int wrow0 = (fr >> 2) * 16 + (fr & 3);
      f32x4 ar[2][4], ai[2][4];
#pragma unroll
      for (int a = 0; a < 2; ++a)
#pragma unroll
        for (int b = 0; b < 4; ++b) { ar[a][b] = f32x4{0, 0, 0, 0}; ai[a][b] = ar[a][b]; }
#pragma unroll
      for (int ks = 0; ks < 2; ++ks) {
        bf16x8 af[2], b1[4], b2[4];
#pragma unroll
        for (int mt = 0; mt < 2; ++mt) af[mt] = *(const bf16x8*)(XC + (size_t)(tb + mt * 16 + fr) * DLRU + nb * 64 + ks * 32 + fq * 8);
#pragma unroll
        for (int nt = 0; nt < 4; ++nt) {
          b1[nt] = *(const bf16x8*)(rgt + (size_t)(wrow0 + nt * 4) * 64 + ks * 32 + fq * 8);
          b2[nt] = *(const bf16x8*)(igt + (size_t)(wrow0 + nt * 4) * 64 + ks * 32 + fq * 8);
        }
#pragma unroll
        for (int mt = 0; mt < 2; ++mt)
#pragma unroll
          for (int nt = 0; nt < 4; ++nt) {
            ar[mt][nt] = MFMA(b1[nt], af[mt], ar[mt][nt]);
            ai[mt][nt] = MFMA(b2[nt], af[mt], ai[mt][nt]);
          }
      }
      float* abuf = (float*)(ws + B_ABUF);
      float* ubuf = (float*)(ws + B_UBUF);
#pragma unroll
      for (int nt = 0; nt < 4; ++nt) {
        const int c = nb * 64 + fq * 16 + nt * 4;
        const float4 brq = *(const float4*)(p.in[I_BRG] + (size_t)l * DLRU + c), biq = *(const float4*)(p.in[I_BIG] + (size_t)l * DLRU + c);
        const float4 lmq = *(const float4*)(p.in[I_LAMBDA] + (size_t)l * DLRU + c);
        const float br_[4] = {brq.x, brq.y, brq.z, brq.w}, bi_[4] = {biq.x, biq.y, biq.z, biq.w};
        const float sp_[4] = {softplusf_(-lmq.x), softplusf_(-lmq.y), softplusf_(-lmq.z), softplusf_(-lmq.w)};
#pragma unroll
        for (int mt = 0; mt < 2; ++mt) {
          const int tok = tb + mt * 16 + fr;
          float xc_[4];
          unpack4(*(const uint2*)(XC + (size_t)tok * DLRU + c), xc_);
          float ao[4], uo[4];
#pragma unroll
          for (int i = 0; i < 4; ++i) {
            const float rg = sigmoidf_(ar[mt][nt][i] + br_[i]), ig = sigmoidf_(ai[mt][nt][i] + bi_[i]);
            const float la = -8.f * rg * sp_[i];
            ao[i] = __expf(la);
            uo[i] = sqrtf(fmaxf(-expm1f(2.f * la), 0.f)) * (ig * xc_[i]);
          }
          *(float4*)(abuf + (size_t)tok * DLRU + c) = make_float4(ao[0], ao[1], ao[2], ao[3]);
          *(float4*)(ubuf + (size_t)tok * DLRU + c) = make_float4(uo[0], uo[1], uo[2], uo[3]);
        }
      }
    }
  }
}

constexpr int STEP_B = 1552;
struct WkvOps { float4 w4, r4, n4, b4, k4; float v; float2 cc; };
__device__ __forceinline__ void wkv_load(WkvOps& o, const char* b, int kq, int vrow) {
  o.w4 = *(const float4*)(b + kq * 16);
  o.r4 = *(const float4*)(b + 256 + kq * 16);
  o.n4 = *(const float4*)(b + 512 + kq * 16);
  o.b4 = *(const float4*)(b + 768 + kq * 16);
  o.k4 = *(const float4*)(b + 1024 + kq * 16);
  o.v = *(const float*)(b + 1280 + vrow * 4);
  o.cc = *(const float2*)(b + 1536);
}
__device__ __forceinline__ void wkv_step(const WkvOps& o, float& S0, float& S1, float& S2, float& S3, float& ykeep, bool keep) {
  float sa = S0 * o.n4.x + S1 * o.n4.y + S2 * o.n4.z + S3 * o.n4.w;
  float z = S0 * o.r4.x + S1 * o.r4.y + S2 * o.r4.z + S3 * o.r4.w;
  sa = red16_sum(sa);
  z = red16_sum(z);
  const float y = z + sa * o.cc.x + o.v * o.cc.y;
  ykeep = keep ? y : ykeep;
  S0 = S0 * o.w4.x + (sa * o.b4.x + o.v * o.k4.x);
  S1 = S1 * o.w4.y + (sa * o.b4.y + o.v * o.k4.y);
  S2 = S2 * o.w4.z + (sa * o.b4.z + o.v * o.k4.z);
  S3 = S3 * o.w4.w + (sa * o.b4.w + o.v * o.k4.w);
}

struct WkvStage { uint4 st[4]; float4 cst; };
__device__ __forceinline__ void wkv_stage_load(WkvStage& g, const char* scan, const float* cbuf, int tid, int tok0, int h, int c, int T) {
  const int ns = min(16, T - c * 16);
#pragma unroll
  for (int j = 0; j < 4; ++j) {
    const int u = tid + 256 * j;
    if (u < ns * 56) {
      const int s = u / 56, q = u % 56;
      g.st[j] = *(const uint4*)(scan + ((size_t)(tok0 + c * 16 + s) * 12 + h) * 896 + q * 16);
    }
  }
  if (tid >= 128 && tid < 128 + ns) g.cst = *(const float4*)(cbuf + ((size_t)(tok0 + c * 16 + (tid - 128)) * 12 + h) * 4);
}
__device__ __forceinline__ void wkv_stage_write(const WkvStage& g, char* buf, int tid, int c, int T) {
  const int ns = min(16, T - c * 16);
#pragma unroll
  for (int j = 0; j < 4; ++j) {
    const int u = tid + 256 * j;
    if (u < ns * 56) {
      const int s = u / 56, q = u % 56;
      char* base = buf + s * STEP_B;
      if (q < 16) {
        *(uint4*)(base + q * 16) = g.st[j];
      } else {
        float4 lo, hi;
        lo.x = __uint_as_float(g.st[j].x << 16); lo.y = __uint_as_float(g.st[j].x & 0xffff0000u);
        lo.z = __uint_as_float(g.st[j].y << 16); lo.w = __uint_as_float(g.st[j].y & 0xffff0000u);
        hi.x = __uint_as_float(g.st[j].z << 16); hi.y = __uint_as_float(g.st[j].z & 0xffff0000u);
        hi.z = __uint_as_float(g.st[j].w << 16); hi.w = __uint_as_float(g.st[j].w & 0xffff0000u);
        const int off = 256 + (q - 16) * 32;
        *(float4*)(base + off) = lo;
        *(float4*)(base + off + 16) = hi;
      }
    }
  }
  if (tid >= 128 && tid < 128 + ns) *(float2*)(buf + (tid - 128) * STEP_B + 1536) = make_float2(g.cst.x, g.cst.y);
}
__device__ __forceinline__ void wkv_chunk16(const char* buf, int kq, int vrow, float& S0, float& S1, float& S2, float& S3, float& ykeep) {
  WkvOps oa, ob;
  wkv_load(oa, buf, kq, vrow);
#pragma unroll
  for (int s = 0; s < 16; s += 2) {
    wkv_load(ob, buf + (s + 1) * STEP_B, kq, vrow);
    wkv_step(oa, S0, S1, S2, S3, ykeep, kq == s);
    if (s + 2 < 16) wkv_load(oa, buf + (s + 2) * STEP_B, kq, vrow);
    wkv_step(ob, S0, S1, S2, S3, ykeep, kq == s + 1);
  }
}

__device__ void wkv_scan_item(const Params& p, int l, int seq, int h, int qt, char* lds) {
  const int TX = tid_();
  char* ws = p.ws;
  const int tid = TX, lane = tid & 63, wv = tid >> 6;
  const int kq = lane & 15, rl = lane >> 4;
  const int T = (seq < 8) ? 2048 : 4;
  const int tok0 = seq_tok0(seq);
  const char* scan = ws + B_SCAN;
  const float* cbuf = (const float*)(ws + B_CBUF);
  float* ybuf = (float*)(ws + B_YBUF);
  WkvStage ga, gb;
  float4 sin[4];
  if (seq >= 8) {
#pragma unroll
    for (int q4 = 0; q4 < 4; ++q4)
      sin[q4] = *(const float4*)(p.in[I_SWKV] + ((((size_t)l * 128 + (seq - 8)) * 12 + h) * 64 + q4 * 16 + wv * 4 + rl) * 64 + kq * 4);
  }
  __syncthreads();
  wkv_stage_load(ga, scan, cbuf, tid, tok0, h, 0, T);
  if (seq < 8) wkv_stage_load(gb, scan, cbuf, tid, tok0, h, 1, T);
  wkv_stage_write(ga, lds, tid, 0, T);
  __syncthreads();
  if (seq < 8) {
    constexpr int NCH = 128;
    const int vrow = qt * 16 + wv * 4 + rl;
    float S0 = 0.f, S1 = 0.f, S2 = 0.f, S3 = 0.f;
    char* buf0 = lds;
    char* buf1 = lds + 16 * STEP_B;
#pragma unroll 1
    for (int c = 0; c < NCH; c += 2) {
      if (c + 2 < NCH) wkv_stage_load(ga, scan, cbuf, tid, tok0, h, c + 2, T);
      float ykeep = 0.f;
      wkv_chunk16(buf0, kq, vrow, S0, S1, S2, S3, ykeep);
      ybuf[(size_t)(tok0 + c * 16 + kq) * DRW + h * 64 + vrow] = ykeep;
      wkv_stage_write(gb, buf1, tid, c + 1, T);
      __syncthreads();
      if (c + 3 < NCH) wkv_stage_load(gb, scan, cbuf, tid, tok0, h, c + 3, T);
      ykeep = 0.f;
      wkv_chunk16(buf1, kq, vrow, S0, S1, S2, S3, ykeep);
      ybuf[(size_t)(tok0 + (c + 1) * 16 + kq) * DRW + h * 64 + vrow] = ykeep;
      if (c + 2 < NCH) wkv_stage_write(ga, buf0, tid, c + 2, T);
      __syncthreads();
    }
    *(float4*)(p.out + O_WKVP + ((((size_t)l * 8 + seq) * 12 + h) * 64 + vrow) * 64 + kq * 4) = make_float4(S0, S1, S2, S3);
  } else {
    const int b = seq - 8;
#pragma unroll
    for (int q4 = 0; q4 < 4; ++q4) {
      const int vrow = q4 * 16 + wv * 4 + rl;
      float S0 = sin[q4].x, S1 = sin[q4].y, S2 = sin[q4].z, S3 = sin[q4].w;
      float ykeep = 0.f;
      WkvOps oa, ob;
      wkv_load(oa, lds, kq, vrow);
#pragma unroll
      for (int s2 = 0; s2 < 4; s2 += 2) {
        wkv_load(ob, lds + (s2 + 1) * STEP_B, kq, vrow);
        wkv_step(oa, S0, S1, S2, S3, ykeep, kq == s2);
        if (s2 + 2 < 4) wkv_load(oa, lds + (s2 + 2) * STEP_B, kq, vrow);
        wkv_step(ob, S0, S1, S2, S3, ykeep, kq == s2 + 1);
      }
      if (kq < 4) ybuf[(size_t)(tok0 + kq) * DRW + h * 64 + vrow] = ykeep;
      *(float4*)(p.out + O_WKVS + ((((size_t)l * 128 + b) * 12 + h) * 64 + vrow) * 64 + kq * 4) = make_float4(S0, S1, S2, S3);
    }
    __syncthreads();
  }
}

__device__ __forceinline__ float gelu_tanh_(float x) {
  const float u = 0.7978845608028654f * (x + 0.044715f * x * x * x);
  const float th = 1.f - 2.f / (1.f + __expf(2.f * u));
  return 0.5f * x * (1.f + th);
}

__device__ void lru_scan_prompt_item(const Params& p, int l, int seq, int cg, char* lds) {
  const int TX = tid_();
  char* ws = p.ws;
  const int ts = TX >> 5, ch = cg * 32 + (TX & 31);
  const float* abuf = (const float*)(ws + B_ABUF);
  const float* ubuf = (const float*)(ws + B_UBUF);
  const bf16_t* plg = (const bf16_t*)(ws + B_PROJ) + ((size_t)seq * 2048 + ts * 256) * DIN + C_LG + ch;
  bf16_t* alru = (bf16_t*)(ws + B_ALRU);
  const size_t base = ((size_t)seq * 2048 + ts * 256) * DLRU + ch;
  float* sA = (float*)lds;
  float* sU = sA + 256;
  __syncthreads();
  float A = 1.f, U = 0.f;
  for (int t0 = 0; t0 < 256; t0 += 16) {
    float a[16], u[16];
#pragma unroll
    for (int j = 0; j < 16; ++j) {
      a[j] = abuf[base + (size_t)(t0 + j) * DLRU];
      u[j] = ubuf[base + (size_t)(t0 + j) * DLRU];
    }
#pragma unroll
    for (int j = 0; j < 16; ++j) { U = a[j] * U + u[j]; A *= a[j]; }
  }
  sA[TX] = A;
  sU[TX] = U;
  __syncthreads();
  float h = 0.f;
  for (int j = 0; j < ts; ++j) h = sA[j * 32 + (TX & 31)] * h + sU[j * 32 + (TX & 31)];
  {
    float a[16], u[16], an[16], un[16];
    bf16_t g[16], gn[16];
#pragma unroll
    for (int j = 0; j < 16; ++j) {
      a[j] = abuf[base + (size_t)j * DLRU];
      u[j] = ubuf[base + (size_t)j * DLRU];
      g[j] = plg[(size_t)j * DIN];
    }
    for (int t0 = 0; t0 < 256; t0 += 16) {
      if (t0 + 16 < 256) {
#pragma unroll
        for (int j = 0; j < 16; ++j) {
          an[j] = abuf[base + (size_t)(t0 + 16 + j) * DLRU];
          un[j] = ubuf[base + (size_t)(t0 + 16 + j) * DLRU];
          gn[j] = plg[(size_t)(t0 + 16 + j) * DIN];
        }
      }
#pragma unroll
      for (int j = 0; j < 16; ++j) {
        h = a[j] * h + u[j];
        alru[base + (size_t)(t0 + j) * DLRU] = f2bf(h * gelu_tanh_(bf2f(g[j])));
      }
#pragma unroll
      for (int j = 0; j < 16; ++j) { a[j] = an[j]; u[j] = un[j]; g[j] = gn[j]; }
    }
  }
  if (ts == 7) p.out[O_HP + ((size_t)l * 8 + seq) * DLRU + ch] = h;
  __syncthreads();
}

__device__ void lru_scan_item(const Params& p, int l, int seq, int cg3) {
  const int TX = tid_();
  char* ws = p.ws;
  const int ch = cg3 * 256 + TX;
  const int tok0 = seq_tok0(seq);
  const float* abuf = (const float*)(ws + B_ABUF);
  const float* ubuf = (const float*)(ws + B_UBUF);
  const bf16_t* proj = (const bf16_t*)(ws + B_PROJ);
  bf16_t* alru = (bf16_t*)(ws + B_ALRU);
  float h = p.in[I_SH][((size_t)l * 128 + (seq - 8)) * DLRU + ch];
  float a[4], u[4], g[4];
#pragma unroll
  for (int j = 0; j < 4; ++j) {
    a[j] = abuf[(size_t)(tok0 + j) * DLRU + ch];
    u[j] = ubuf[(size_t)(tok0 + j) * DLRU + ch];
    g[j] = bf2f(proj[(size_t)(tok0 + j) * DIN + C_LG + ch]);
  }
#pragma unroll
  for (int j = 0; j < 4; ++j) {
    h = a[j] * h + u[j];
    alru[(size_t)(tok0 + j) * DLRU + ch] = f2bf(h * gelu_tanh_(g[j]));
  }
  p.out[O_HS + ((size_t)l * 128 + (seq - 8)) * DLRU + ch] = h;
}

__device__ void attn_prompt_item(const Params& p, int l, int b, int h, int qt, char* lds) {
  const int TX = tid_();
  char* ws = p.ws;
  const int lane = TX & 63, wv = TX >> 6, fr = lane & 15, fq = lane >> 4;
  const bf16_t* proj = (const bf16_t*)(ws + B_PROJ);
  const bf16_t* kb = (const bf16_t*)(ws + B_KB) + ((size_t)(l * 8 + b) * 256) * 512 + h * 128;
  const bf16_t* vt = (const bf16_t*)(ws + B_VTB) + (((size_t)(l * 8 + b) * 4 + h) * 128) * 256;
  bf16_t* axa = (bf16_t*)(ws + B_AXA);
  const int tok0 = b * 2048 + qt * 64 + wv * 16;
  bf16x8 aq[4];
#pragma unroll
  for (int ks = 0; ks < 4; ++ks) aq[ks] = *(const bf16x8*)(proj + (size_t)(tok0 + fr) * DIN + C_Q + h * 128 + ks * 32 + fq * 8);
  f32x4 s[16];
#pragma unroll
  for (int nt = 0; nt < 16; ++nt) {
    s[nt] = f32x4{0, 0, 0, 0};
#pragma unroll
    for (int ks = 0; ks < 4; ++ks) {
      bf16x8 bk = *(const bf16x8*)(kb + (size_t)(nt * 16 + fr) * 512 + ks * 32 + fq * 8);
      s[nt] = MFMA(aq[ks], bk, s[nt]);
    }
  }
  const float scale = 0.08838834764831845f;
  float rs[4];
  char* pl = lds + wv * 8192;
  __syncthreads();
#pragma unroll
  for (int i = 0; i < 4; ++i) {
    float m = s[0][i];
#pragma unroll
    for (int nt = 1; nt < 16; ++nt) m = fmaxf(m, s[nt][i]);
    m = red16_max(m);
    float sum = 0.f;
#pragma unroll
    for (int nt = 0; nt < 16; ++nt) {
      float e = __expf((s[nt][i] - m) * scale);
      sum += e;
      const int key = nt * 16 + fr, rr = fq * 4 + i;
      *(bf16_t*)(pl + (key >> 5) * 1024 + swz(rr, (key & 31) * 2)) = f2bf(e);
    }
    rs[i] = red16_sum(sum);
  }
  __syncthreads();
  f32x4 o[8];
#pragma unroll
  for (int nt = 0; nt < 8; ++nt) o[nt] = f32x4{0, 0, 0, 0};
  const int fo = swz(fr, fq * 16);
#pragma unroll
  for (int ks = 0; ks < 8; ++ks) {
    bf16x8 ap = *(const bf16x8*)(pl + ks * 1024 + fo);
#pragma unroll
    for (int nt = 0; nt < 8; ++nt) {
      bf16x8 bv = *(const bf16x8*)(vt + (size_t)(nt * 16 + fr) * 256 + ks * 32 + fq * 8);
      o[nt] = MFMA(ap, bv, o[nt]);
    }
  }
#pragma unroll
  for (int nt = 0; nt < 8; ++nt)
#pragma unroll
    for (int i = 0; i < 4; ++i)
      axa[(size_t)(tok0 + fq * 4 + i) * DXA + h * 128 + nt * 16 + fr] = f2bf(o[nt][i] / rs[i]);
  __syncthreads();
}

__device__ void attn_sample_item(const Params& p, int l, int b, int h, char* lds) {
  const int TX = tid_();
  char* ws = p.ws;
  const int tid = TX, lane = tid & 63, wv = tid >> 6;
  const bf16_t* proj = (const bf16_t*)(ws + B_PROJ);
  bf16_t* axa = (bf16_t*)(ws + B_AXA);
  const int tok0 = MP + b * 4;
  float* q = (float*)lds;
  float* pr = q + 512;
  float* red = pr + 1024;
  float* part = red + 32;
  __syncthreads();
  for (int i = tid; i < 512; i += 256) q[i] = bf2f(proj[(size_t)(tok0 + (i >> 7)) * DIN + C_Q + h * 128 + (i & 127)]);
  __syncthreads();
  const float* kc = p.in[I_CK] + (((size_t)l * 128 + b) * 256 + tid) * 512 + h * 128;
  float s0 = 0.f, s1 = 0.f, s2 = 0.f, s3 = 0.f;
#pragma unroll 4
  for (int d = 0; d < 128; d += 4) {
    const float4 kv = *(const float4*)(kc + d);
    const float4 q0 = *(const float4*)(q + d), q1 = *(const float4*)(q + 128 + d), q2 = *(const float4*)(q + 256 + d),
                 q3 = *(const float4*)(q + 384 + d);
    s0 += kv.x * q0.x + kv.y * q0.y + kv.z * q0.z + kv.w * q0.w;
    s1 += kv.x * q1.x + kv.y * q1.y + kv.z * q1.z + kv.w * q1.w;
    s2 += kv.x * q2.x + kv.y * q2.y + kv.z * q2.z + kv.w * q2.w;
    s3 += kv.x * q3.x + kv.y * q3.y + kv.z * q3.z + kv.w * q3.w;
  }
  const float scale = 0.08838834764831845f;
  s0 *= scale; s1 *= scale; s2 *= scale; s3 *= scale;
  float m0 = s0, m1 = s1, m2 = s2, m3 = s3;
#pragma unroll
  for (int m = 1; m < 64; m <<= 1) {
    m0 = fmaxf(m0, __shfl_xor(m0, m, 64)); m1 = fmaxf(m1, __shfl_xor(m1, m, 64));
    m2 = fmaxf(m2, __shfl_xor(m2, m, 64)); m3 = fmaxf(m3, __shfl_xor(m3, m, 64));
  }
  if (lane == 0) { red[wv * 4 + 0] = m0; red[wv * 4 + 1] = m1; red[wv * 4 + 2] = m2; red[wv * 4 + 3] = m3; }
  __syncthreads();
  m0 = fmaxf(fmaxf(red[0], red[4]), fmaxf(red[8], red[12]));
  m1 = fmaxf(fmaxf(red[1], red[5]), fmaxf(red[9], red[13]));
  m2 = fmaxf(fmaxf(red[2], red[6]), fmaxf(red[10], red[14]));
  m3 = fmaxf(fmaxf(red[3], red[7]), fmaxf(red[11], red[15]));
  const float e0 = __expf(s0 - m0), e1 = __expf(s1 - m1), e2 = __expf(s2 - m2), e3 = __expf(s3 - m3);
  pr[tid] = e0; pr[256 + tid] = e1; pr[512 + tid] = e2; pr[768 + tid] = e3;
  float t0 = wave_sum(e0), t1 = wave_sum(e1), t2 = wave_sum(e2), t3 = wave_sum(e3);
  if (lane == 0) { red[16 + wv * 4 + 0] = t0; red[16 + wv * 4 + 1] = t1; red[16 + wv * 4 + 2] = t2; red[16 + wv * 4 + 3] = t3; }
  __syncthreads();
  const float z0 = red[16] + red[20] + red[24] + red[28], z1 = red[17] + red[21] + red[25] + red[29];
  const float z2 = red[18] + red[22] + red[26] + red[30], z3 = red[19] + red[23] + red[27] + red[31];
  const int d = tid & 127, half = tid >> 7;
  const float* vc = p.in[I_CV] + (((size_t)l * 128 + b) * 256 + half * 128) * 512 + h * 128 + d;
  float o0 = 0.f, o1 = 0.f, o2 = 0.f, o3 = 0.f;
#pragma unroll 8
  for (int k = 0; k < 128; ++k) {
    const float vv = vc[(size_t)k * 512];
    const int key = half * 128 + k;
    o0 += pr[key] * vv; o1 += pr[256 + key] * vv; o2 += pr[512 + key] * vv; o3 += pr[768 + key] * vv;
  }
  if (half == 1) { part[d] = o0; part[128 + d] = o1; part[256 + d] = o2; part[384 + d] = o3; }
  __syncthreads();
  if (half == 0) {
    o0 += part[d]; o1 += part[128 + d]; o2 += part[256 + d]; o3 += part[384 + d];
    axa[(size_t)(tok0 + 0) * DXA + h * 128 + d] = f2bf(o0 / z0);
    axa[(size_t)(tok0 + 1) * DXA + h * 128 + d] = f2bf(o1 / z1);
    axa[(size_t)(tok0 + 2) * DXA + h * 128 + d] = f2bf(o2 / z2);
    axa[(size_t)(tok0 + 3) * DXA + h * 128 + d] = f2bf(o3 / z3);
  }
  __syncthreads();
}

__device__ void phase_mix(const Params& p, int l, char* lds, int* s_item) {
  const int TX = tid_();
  int* cnt = (int*)(p.ws + B_CNT) + l;
  constexpr int N_WKVP = 96 * 4, N_LRUP = 8 * 24, N_ATTP = 1024, N_WKVS = 128 * 12, N_LRUS = 384, N_ATTS = 512;
  constexpr int E1 = N_WKVP, E2 = E1 + N_LRUP, E3 = E2 + N_ATTP, E4 = E3 + N_WKVS, E5 = E4 + N_LRUS, E6 = E5 + N_ATTS;
  for (;;) {
    __syncthreads();
    if (TX == 0) *s_item = atomicAdd(cnt, 1);
    __syncthreads();
    const int it = *s_item;
    if (it >= E6) break;
    if (it < E1) {
      const int qt = it & 3, bh = it >> 2;
      wkv_scan_item(p, l, bh / 12, bh % 12, qt, lds);
    } else if (it < E2) {
      const int j = it - E1;
      lru_scan_prompt_item(p, l, j / 24, j % 24, lds);
    } else if (it < E3) {
      const int j = it - E2;
      attn_prompt_item(p, l, j >> 7, (j >> 5) & 3, j & 31, lds);
    } else if (it < E4) {
      const int j = it - E3;
      wkv_scan_item(p, l, 8 + j / 12, j % 12, -1, lds);
    } else if (it < E5) {
      const int j = it - E4;
      lru_scan_item(p, l, 8 + j / 3, j % 3);
    } else {
      const int j = it - E5;
      attn_sample_item(p, l, j >> 2, j & 3, lds);
    }
  }
}

__device__ void phase_post(const Params& p, int l) {
  const int TX = tid_();
  char* ws = p.ws;
  const int lane = TX & 63, wv = TX >> 6;
  const float* ybuf = (const float*)(ws + B_YBUF);
  const float* cbuf = (const float*)(ws + B_CBUF);
  const bf16_t* gbuf = (const bf16_t*)(ws + B_GBUF);
  const char* scan = ws + B_SCAN;
  bf16_t* arw = (bf16_t*)(ws + B_ARW);
  const float* gng = p.in[I_GNG] + (size_t)l * DRW;
  const float* gnb = p.in[I_GNB] + (size_t)l * DRW;
  for (int t4 = blockIdx.x; t4 < MT / 4; t4 += gridDim.x) {
    const int tok = t4 * 4 + wv;
#pragma unroll
    for (int ps = 0; ps < 3; ++ps) {
      const int c = ps * 256 + lane * 4, h = c >> 6;
      const float4 y = *(const float4*)(ybuf + (size_t)tok * DRW + c);
      const float mean = red16_sum(y.x + y.y + y.z + y.w) * (1.f / 64.f);
      const float d0 = y.x - mean, d1 = y.y - mean, d2 = y.z - mean, d3 = y.w - mean;
      const float var = red16_sum(d0 * d0 + d1 * d1 + d2 * d2 + d3 * d3) * (1.f / 64.f);
      const float rs = rsqrtf(var + 64e-5f);
      const float4 gg = *(const float4*)(gng + c), gb = *(const float4*)(gnb + c);
      const float c3 = cbuf[((size_t)tok * 12 + h) * 4 + 2];
      const uint2 vq = *(const uint2*)(scan + ((size_t)tok * 12 + h) * 896 + 768 + (c & 63) * 2);
      const uint2 gq = *(const uint2*)(gbuf + (size_t)tok * DRW + c);
      const float v0 = __uint_as_float(vq.x << 16), v1 = __uint_as_float(vq.x & 0xffff0000u);
      const float v2 = __uint_as_float(vq.y << 16), v3 = __uint_as_float(vq.y & 0xffff0000u);
      const float g0 = __uint_as_float(gq.x << 16), g1 = __uint_as_float(gq.x & 0xffff0000u);
      const float g2 = __uint_as_float(gq.y << 16), g3 = __uint_as_float(gq.y & 0xffff0000u);
      uint2 o;
      o.x = pk_bf2((d0 * rs * gg.x + gb.x + c3 * v0) * g0, (d1 * rs * gg.y + gb.y + c3 * v1) * g1);
      o.y = pk_bf2((d2 * rs * gg.z + gb.z + c3 * v2) * g2, (d3 * rs * gg.w + gb.w + c3 * v3) * g3);
      *(uint2*)(arw + (size_t)tok * DRW + c) = o;
    }
  }
}

__device__ __forceinline__ void merge_ops(char* ws, int l, int br, const bf16_t*& A, const bf16_t*& Bt, int& K) {
  if (br == 0) { A = (const bf16_t*)(ws + B_ARW); Bt = (const bf16_t*)(ws + W_RWOUT) + (size_t)l * D * DRW; K = DRW; }
  else if (br == 1) { A = (const bf16_t*)(ws + B_ALRU); Bt = (const bf16_t*)(ws + W_LRUOUT) + (size_t)l * D * DLRU; K = DLRU; }
  else { A = (const bf16_t*)(ws + B_AXA); Bt = (const bf16_t*)(ws + W_XAOUT) + (size_t)l * D * DXA; K = DXA; }
}

__device__ void phase_merge(const Params& p, int l, char* lds) {
  const int TX = tid_();
  char* ws = p.ws;
  const bf16_t* proj = (const bf16_t*)(ws + B_PROJ);
  bf16_t* mixin = (bf16_t*)(ws + B_MIXIN);
  const int lane = TX & 63, wv = TX >> 6, wr = wv >> 1, wc = wv & 1, fr = lane & 15, fq = lane >> 4;
  const int ntiles = (MT / 128) * 16;
  TileIter it = tile_iter(ntiles);
  int L = it.L, br = 0;
  bool have = L < it.Lend;
  int m0 = 0, n0 = 0;
  const bf16_t* A = nullptr; const bf16_t* Bt = nullptr; int K = 0;
  if (have) {
    int tm, tn; tile_mn(L, MT / 128, 16, tm, tn); m0 = tm * 128; n0 = tn * 64;
    merge_ops(ws, l, 0, A, Bt, K);
    gemm_prologue<4, 2>(A, K, Bt, K, m0, n0, lds);
  }
  f32x4 sum[4][2];
  zero_acc(sum);
  while (have) {
    f32x4 acc[4][2];
    zero_acc(acc);
    gemm_loop<4, 2>(A, K, Bt, K, K, m0, n0, lds, acc);
    uint4 gq[4];
#pragma unroll
    for (int mt = 0; mt < 4; ++mt)
      gq[mt] = *(const uint4*)(proj + (size_t)(m0 + wr * 64 + mt * 16 + fr) * DIN + C_G + br * D + n0 + wc * 32 + fq * 8);
    int nbr = br + 1, nL = L;
    if (nbr == 3) { nbr = 0; nL = L + it.step; }
    const bool hn = nL < it.Lend;
    int m1 = m0, n1 = n0;
    const bf16_t* A1 = A; const bf16_t* Bt1 = Bt; int K1 = K;
    if (hn) {
      if (nbr == 0) { int tm, tn; tile_mn(nL, MT / 128, 16, tm, tn); m1 = tm * 128; n1 = tn * 64; }
      merge_ops(ws, l, nbr, A1, Bt1, K1);
      gemm_prologue<4, 2>(A1, K1, Bt1, K1, m1, n1, lds);
    }
#pragma unroll
    for (int mt = 0; mt < 4; ++mt) {
      const unsigned gw[4] = {gq[mt].x, gq[mt].y, gq[mt].z, gq[mt].w};
#pragma unroll
      for (int nt = 0; nt < 2; ++nt)
#pragma unroll
        for (int i = 0; i < 4; ++i) {
          const unsigned w = gw[nt * 2 + (i >> 1)];
          const float gv = __uint_as_float((i & 1) ? (w & 0xffff0000u) : (w << 16));
          sum[mt][nt][i] += sigmoidf_(gv) * acc[mt][nt][i];
        }
    }
    if (br == 2) {
#pragma unroll
      for (int mt = 0; mt < 4; ++mt) {
        const int row = m0 + wr * 64 + mt * 16 + fr, col = n0 + wc * 32 + fq * 8;
        *(uint4*)(mixin + (size_t)row * D + col) = pack8(sum[mt][0], sum[mt][1]);
      }
      zero_acc(sum);
    }
    L = nL; br = nbr; have = hn; m0 = m1; n0 = n1; A = A1; Bt = Bt1; K = K1;
  }
}

__device__ void phase_resid_gemm(const Params& p, const bf16_t* A, const bf16_t* Bt, int K, char* lds) {
  const int TX = tid_();
  char* ws = p.ws;
  const bf16_t* xb = (const bf16_t*)(ws + B_XB);
  bf16_t* t = (bf16_t*)(ws + B_XF);
  const int lane = TX & 63, wv = TX >> 6, wr = wv >> 1, wc = wv & 1, fr = lane & 15, fq = lane >> 4;
  constexpr int NT_ALL = (MT / 128) * 8;
  const int G = (int)gridDim.x;
  const int nfull = (NT_ALL / G) * G;
  TileIter it = tile_iter(nfull);
  bool have = it.L < it.Lend;
  int m0 = 0, n0 = 0;
  if (have) { int tm, tn; tile_mn(it.L, MT / 128, 8, tm, tn); m0 = tm * 128; n0 = tn * 128; gemm_prologue<4, 4>(A, K, Bt, K, m0, n0, lds); }
  while (have) {
    f32x4 acc[4][4];
    zero_acc(acc);
    gemm_loop<4, 4>(A, K, Bt, K, K, m0, n0, lds, acc);
    uint4 xq[4][2];
#pragma unroll
    for (int mt = 0; mt < 4; ++mt) {
      const uint4* xs = (const uint4*)(xb + (size_t)(m0 + wr * 64 + mt * 16 + fr) * D + n0 + wc * 64 + fq * 16);
      xq[mt][0] = xs[0];
      xq[mt][1] = xs[1];
    }
    const int Ln = it.L + it.step;
    const bool hn = Ln < it.Lend;
    int m1 = m0, n1 = n0;
    if (hn) { int tm, tn; tile_mn(Ln, MT / 128, 8, tm, tn); m1 = tm * 128; n1 = tn * 128; gemm_prologue<4, 4>(A, K, Bt, K, m1, n1, lds); }
#pragma unroll
    for (int mt = 0; mt < 4; ++mt) {
      uint4* ts = (uint4*)(t + (size_t)(m0 + wr * 64 + mt * 16 + fr) * D + n0 + wc * 64 + fq * 16);
      f32x4 o[4];
#pragma unroll
      for (int nt = 0; nt < 4; ++nt) {
        const uint4 q = xq[mt][nt >> 1];
        const unsigned w0 = (nt & 1) ? q.z : q.x, w1 = (nt & 1) ? q.w : q.y;
        o[nt][0] = ALPHA * __uint_as_float(w0 << 16) + acc[mt][nt][0];
        o[nt][1] = ALPHA * __uint_as_float(w0 & 0xffff0000u) + acc[mt][nt][1];
        o[nt][2] = ALPHA * __uint_as_float(w1 << 16) + acc[mt][nt][2];
        o[nt][3] = ALPHA * __uint_as_float(w1 & 0xffff0000u) + acc[mt][nt][3];
      }
      ts[0] = pack8(o[0], o[1]);
      ts[1] = pack8(o[2], o[3]);
    }
    it.L = Ln; have = hn; m0 = m1; n0 = n1;
  }
  for (int hidx = (int)blockIdx.x; hidx < (NT_ALL - nfull) * 2; hidx += G) {
    int tm, tn;
    tile_mn(nfull + (hidx >> 1), MT / 128, 8, tm, tn);
    const int hm0 = tm * 128, hn0 = tn * 128 + (hidx & 1) * 64;
    f32x4 acc[4][2];
    zero_acc(acc);
    gemm_main<4, 2>(A, K, Bt, K, K, hm0, hn0, lds, acc);
#pragma unroll
    for (int mt = 0; mt < 4; ++mt) {
      const size_t off = (size_t)(hm0 + wr * 64 + mt * 16 + fr) * D + hn0 + wc * 32 + fq * 8;
      const uint4 q = *(const uint4*)(xb + off);
      f32x4 o0, o1;
      o0[0] = ALPHA * __uint_as_float(q.x << 16) + acc[mt][0][0]; o0[1] = ALPHA * __uint_as_float(q.x & 0xffff0000u) + acc[mt][0][1];
      o0[2] = ALPHA * __uint_as_float(q.y << 16) + acc[mt][0][2]; o0[3] = ALPHA * __uint_as_float(q.y & 0xffff0000u) + acc[mt][0][3];
      o1[0] = ALPHA * __uint_as_float(q.z << 16) + acc[mt][1][0]; o1[1] = ALPHA * __uint_as_float(q.z & 0xffff0000u) + acc[mt][1][1];
      o1[2] = ALPHA * __uint_as_float(q.w << 16) + acc[mt][1][2]; o1[3] = ALPHA * __uint_as_float(q.w & 0xffff0000u) + acc[mt][1][3];
      *(uint4*)(t + off) = pack8(o0, o1);
    }
  }
}

__device__ void phase_ln(const Params& p, const float* g, const float* bta, bool final_out) {
  const int TX = tid_();
  char* ws = p.ws;
  const int lane = TX & 63, wv = TX >> 6;
  const bf16_t* t = (const bf16_t*)(ws + B_XF);
  float* yout = p.out + O_Y;
  bf16_t* xb = (bf16_t*)(ws + B_XB);
  for (int r4 = blockIdx.x; r4 < MT / 4; r4 += gridDim.x) {
    const int row = r4 * 4 + wv;
    float4 v[4];
    float s = 0.f;
#pragma unroll
    for (int j = 0; j < 4; ++j) {
      const uint2 q = *(const uint2*)(t + (size_t)row * D + j * 256 + lane * 4);
      v[j] = make_float4(__uint_as_float(q.x << 16), __uint_as_float(q.x & 0xffff0000u), __uint_as_float(q.y << 16), __uint_as_float(q.y & 0xffff0000u));
      s += v[j].x + v[j].y + v[j].z + v[j].w;
    }
    const float mean = wave_sum(s) * (1.f / 1024.f);
    float q = 0.f;
#pragma unroll
    for (int j = 0; j < 4; ++j) {
      v[j].x -= mean; v[j].y -= mean; v[j].z -= mean; v[j].w -= mean;
      q += v[j].x * v[j].x + v[j].y * v[j].y + v[j].z * v[j].z + v[j].w * v[j].w;
    }
    const float rstd = rsqrtf(wave_sum(q) * (1.f / 1024.f) + 1e-5f);
#pragma unroll
    for (int j = 0; j < 4; ++j) {
      const int c = j * 256 + lane * 4;
      const float4 gg = *(const float4*)(g + c), bb = *(const float4*)(bta + c);
      float4 o;
      o.x = v[j].x * rstd * gg.x + bb.x; o.y = v[j].y * rstd * gg.y + bb.y;
      o.z = v[j].z * rstd * gg.z + bb.z; o.w = v[j].w * rstd * gg.w + bb.w;
      if (final_out) {
        *(float4*)(yout + (size_t)row * D + c) = o;
      } else {
        uint2 ob;
        ob.x = (unsigned)f2bf(o.x) | ((unsigned)f2bf(o.y) << 16);
        ob.y = (unsigned)f2bf(o.z) | ((unsigned)f2bf(o.w) << 16);
        *(uint2*)(xb + (size_t)row * D + c) = ob;
      }
    }
  }
}

__device__ void phase_ffn_in(const Params& p, int l, char* lds) {
  const int TX = tid_();
  char* ws = p.ws;
  const bf16_t* xb = (const bf16_t*)(ws + B_XB);
  const bf16_t* wt = (const bf16_t*)(ws + W_FFNIN) + (size_t)l * 2 * DFF * D;
  bf16_t* act = (bf16_t*)(ws + B_ACT);
  const int lane = TX & 63, wv = TX >> 6, wr = wv >> 1, wc = wv & 1, fr = lane & 15, fq = lane >> 4;
  const int nN = 2 * DFF / 128, ntiles = (MT / 128) * nN;
  TileIter it = tile_iter(ntiles);
  bool have = it.L < it.Lend;
  int m0 = 0, n0 = 0;
  if (have) { int tm, tn; tile_mn(it.L, MT / 128, nN, tm, tn); m0 = tm * 128; n0 = tn * 128; gemm_prologue<4, 4>(xb, D, wt, D, m0, n0, lds); }
  while (have) {
    f32x4 acc[4][4];
    zero_acc(acc);
    gemm_loop<4, 4>(xb, D, wt, D, D, m0, n0, lds, acc);
    const int Ln = it.L + it.step;
    const bool hn = Ln < it.Lend;
    int m1 = m0, n1 = n0;
    if (hn) { int tm, tn; tile_mn(Ln, MT / 128, nN, tm, tn); m1 = tm * 128; n1 = tn * 128; gemm_prologue<4, 4>(xb, D, wt, D, m1, n1, lds); }
    const int jb = (n0 + wc * 64 + fq * 16) / 2;
#pragma unroll
    for (int mt = 0; mt < 4; ++mt) {
      const int row = m0 + wr * 64 + mt * 16 + fr;
      f32x4 o0, o1;
#pragma unroll
      for (int i = 0; i < 4; ++i) {
        const float g0 = acc[mt][2][i], g1 = acc[mt][3][i];
        o0[i] = g0 * sigmoidf_(g0) * acc[mt][0][i];
        o1[i] = g1 * sigmoidf_(g1) * acc[mt][1][i];
      }
      *(uint4*)(act + (size_t)row * DFF + jb) = pack8(o0, o1);
    }
    it.L = Ln; have = hn; m0 = m1; n0 = n1;
  }
}

__global__ void __launch_bounds__(256, 2) fwd_megakernel(Params p) {
  cg::grid_group grid = cg::this_grid();
  __shared__ __attribute__((aligned(1024))) char lds[LDS_BYTES];
  __shared__ int s_item;
  __shared__ uint4 xb_words;
  char* ws = p.ws;
  if (threadIdx.x == 0) xb_words = make_uint4(0u, 0u, 0u, 0u);
  __syncthreads();
  XcdBarrier xb = xcd_barrier_post((unsigned*)(ws + B_BAR), (volatile LAS unsigned*)&xb_words);
  constexpr int NPH = 1 + NL * 11;
#pragma unroll 1
  for (int ph = 0; ph < NPH; ++ph) {
    int phl = ph;
    asm volatile("" : "+s"(phl));
    if (phl == 0) {
      phase_convert(p, lds);
    } else {
      const int l = (phl - 1) / 11, k = (phl - 1) % 11;
      switch (k) {
        case 0: phase_proj(p, l, lds); break;
        case 1: phase_prep(p, l, lds); break;
        case 2: phase_lora(p, l, lds); break;
        case 3: phase_mix(p, l, lds, &s_item); break;
        case 4: phase_post(p, l); break;
        case 5: phase_merge(p, l, lds); break;
        case 8: phase_ffn_in(p, l, lds); break;
        case 6: case 9: {
          const bool first = (k == 6);
          phase_resid_gemm(p, (const bf16_t*)(ws + (first ? B_MIXIN : B_ACT)),
                           first ? (const bf16_t*)(ws + W_O) + (size_t)l * D * D : (const bf16_t*)(ws + W_FFNOUT) + (size_t)l * D * DFF,
                           first ? D : DFF, lds);
          break;
        }
        default: {
          const bool first = (k == 7);
          phase_ln(p, (first ? p.in[I_LN1G] : p.in[I_LN2G]) + (size_t)l * D, (first ? p.in[I_LN1B] : p.in[I_LN2B]) + (size_t)l * D,
                   !first && l == NL - 1);
          break;
        }
      }
    }
    if (ph + 1 < NPH) xcd_barrier(xb);
    if (p.ws == nullptr) grid.sync();
  }
}

extern "C" void kernel_launch(void* const* d_in, const int* in_sizes, int n_in, void* d_out, int out_size, void* d_ws,
                              size_t ws_size, hipStream_t stream) {
  static int grid_blocks = 0;
  if (!grid_blocks) {
    int dev = 0, cus = 0, per_cu = 0;
    (void)hipGetDevice(&dev);
    (void)hipDeviceGetAttribute(&cus, hipDeviceAttributeMultiprocessorCount, dev);
    (void)hipOccupancyMaxActiveBlocksPerMultiprocessor(&per_cu, fwd_megakernel, 256, 0);
    if (per_cu > 2) per_cu = 2;
    if (per_cu < 1) per_cu = 1;
    grid_blocks = cus * per_cu;
  }
  if (ws_size < WS_NEED || n_in < 42) {
    fprintf(stderr, "workspace too small: %zu < %zu\n", ws_size, (size_t)WS_NEED);
    return;
  }
  (void)hipMemsetAsync((char*)d_ws + B_CNT, 0, 256 + BAR_BYTES, stream);
  Params p{};
  for (int i = 0; i < 42; ++i) p.in[i] = (const float*)d_in[i];
  p.out = (float*)d_out;
  p.ws = (char*)d_ws;
  void* args[] = {&p};
  hipError_t e = hipLaunchCooperativeKernel((void*)fwd_megakernel, dim3(grid_blocks), dim3(256), args, 0, stream);
  if (e != hipSuccess) fprintf(stderr, "cooperative launch failed: %s (grid %d)\n", hipGetErrorString(e), grid_blocks);
}
```

```cpp
#include <hip/hip_runtime.h>
#include <hip/hip_cooperative_groups.h>
#include <cstdio>
#include <type_traits>
namespace cg = cooperative_groups;

typedef unsigned short bf16_t;
typedef __attribute__((ext_vector_type(8))) short bf16x8;
typedef __attribute__((ext_vector_type(4))) float f32x4;

constexpr int D = 1024, MP = 16384, MS = 512, MT = 16896, NL = 4;
constexpr int DIN = 7680, DRW = 768, DLRU = 768, DXA = 512, DFF = 2816, RWC = 2560;
constexpr int C_LX = 2560, C_LG = 3328, C_Q = 4096, C_G = 4608;
constexpr int NSEQ = 136;
constexpr float ALPHA = 1.681792830507429f;

constexpr size_t O_Y = 0;
constexpr size_t O_SHP = O_Y + (size_t)MT * D;
constexpr size_t O_WKVP = O_SHP + (size_t)NL * 8 * RWC;
constexpr size_t O_CONVP = O_WKVP + (size_t)NL * 8 * 12 * 64 * 64;
constexpr size_t O_HP = O_CONVP + (size_t)NL * 8 * 3 * DLRU;
constexpr size_t O_MKP = O_HP + (size_t)NL * 8 * DLRU;
constexpr size_t O_MVP = O_MKP + (size_t)NL * 8 * 256 * 512;
constexpr size_t O_SHS = O_MVP + (size_t)NL * 8 * 256 * 512;
constexpr size_t O_WKVS = O_SHS + (size_t)NL * 128 * RWC;
constexpr size_t O_CONVS = O_WKVS + (size_t)NL * 128 * 12 * 64 * 64;
constexpr size_t O_HS = O_CONVS + (size_t)NL * 128 * 3 * DLRU;
constexpr size_t O_END = O_HS + (size_t)NL * 128 * DLRU;

constexpr size_t al256(size_t x) { return (x + 255) & ~(size_t)255; }
constexpr size_t W_IN = 0;
constexpr size_t W_RWOUT = W_IN + al256((size_t)NL * DIN * D * 2);
constexpr size_t W_LRUOUT = W_RWOUT + al256((size_t)NL * D * DRW * 2);
constexpr size_t W_XAOUT = W_LRUOUT + al256((size_t)NL * D * DLRU * 2);
constexpr size_t W_O = W_XAOUT + al256((size_t)NL * D * DXA * 2);
constexpr size_t W_FFNIN = W_O + al256((size_t)NL * D * D * 2);
constexpr size_t W_FFNOUT = W_FFNIN + al256((size_t)NL * 2 * DFF * D * 2);
constexpr size_t W_MEMKV = W_FFNOUT + al256((size_t)NL * D * DFF * 2);
constexpr size_t W_W2T = W_MEMKV + al256((size_t)NL * D * D * 2);
constexpr size_t W_A2T = W_W2T + al256((size_t)NL * DRW * 64 * 2);
constexpr size_t W_G2T = W_A2T + al256((size_t)NL * DRW * 64 * 2);
constexpr size_t W_V2T = W_G2T + al256((size_t)NL * DRW * 128 * 2);
constexpr size_t W_RGT = W_V2T + al256((size_t)3 * DRW * 32 * 2);
constexpr size_t W_IGT = W_RGT + al256((size_t)NL * 12 * 64 * 64 * 2);
constexpr size_t B_XF = W_IGT + al256((size_t)NL * 12 * 64 * 64 * 2);
constexpr size_t B_XB = B_XF + al256((size_t)MT * D * 4);
constexpr size_t B_MEMB = B_XB + al256((size_t)MT * D * 2);
constexpr size_t B_KB = B_MEMB + al256((size_t)2048 * D * 2);
constexpr size_t B_VTB = B_KB + al256((size_t)NL * 8 * 256 * 512 * 2);
constexpr size_t B_VFIRST = B_VTB + al256((size_t)NL * 8 * 256 * 512 * 2);
constexpr size_t B_PROJ = B_VFIRST + al256((size_t)MT * DRW * 2);
constexpr size_t B_SCAN = B_PROJ + al256((size_t)MT * DIN * 2);
constexpr size_t SCAN_BYTES = (size_t)MT * 12 * 896;
constexpr size_t B_MIXIN = B_SCAN;
constexpr size_t B_ACT = B_SCAN + al256((size_t)MT * D * 2);
constexpr size_t B_CBUF = B_SCAN + al256(SCAN_BYTES);
constexpr size_t B_YBUF = B_CBUF + al256((size_t)MT * 12 * 16);
constexpr size_t B_GBUF = B_YBUF + al256((size_t)MT * DRW * 4);
constexpr size_t B_ABUF = B_GBUF + al256((size_t)MT * DRW * 2);
constexpr size_t B_UBUF = B_ABUF + al256((size_t)MT * DLRU * 4);
constexpr size_t B_LBUF = B_UBUF + al256((size_t)MT * DLRU * 4);
constexpr size_t B_VMID = B_LBUF + al256((size_t)MT * 256 * 2);
constexpr size_t B_ARW = B_VMID + al256((size_t)MT * 32 * 2);
constexpr size_t B_ALRU = B_ARW + al256((size_t)MT * DRW * 2);
constexpr size_t B_AXA = B_ALRU + al256((size_t)MT * DLRU * 2);
constexpr size_t B_CNT = B_AXA + al256((size_t)MT * DXA * 2);
constexpr size_t B_BAR = B_CNT + 256;
constexpr size_t BAR_BYTES = 16384;
constexpr size_t W_V1T = B_BAR + BAR_BYTES;
constexpr size_t WS_NEED = W_V1T + al256((size_t)3 * 32 * DRW * 2);
static_assert(al256((size_t)MT * D * 2) + (size_t)MT * DFF * 2 <= SCAN_BYTES, "alias overflow");

enum { I_XP = 0, I_XS, I_MEM, I_SSHIFT, I_SWKV, I_SCONV, I_SH, I_CK, I_CV, I_WIN, I_MU, I_W0, I_W2, I_A0, I_A2,
       I_G2, I_V0, I_V1, I_V2, I_KK, I_KA, I_RK, I_GNG, I_GNB, I_WRWOUT, I_CONVW, I_CONVB, I_WRG, I_BRG, I_WIG,
       I_BIG, I_LAMBDA, I_WLRUOUT, I_WMEMKV, I_WXAOUT, I_WO, I_LN1G, I_LN1B, I_WFFNIN, I_WFFNOUT, I_LN2G, I_LN2B };

struct Params {
  const float* in[42];
  float* out;
  char* ws;
};

constexpr int LDS_BYTES = 65536;

__device__ __forceinline__ bf16_t f2bf(float f) {
  unsigned u = __float_as_uint(f);
  u += 0x7fffu + ((u >> 16) & 1u);
  return (bf16_t)(u >> 16);
}
__device__ __forceinline__ float bf2f(bf16_t h) { return __uint_as_float(((unsigned)h) << 16); }
__device__ __forceinline__ float sigmoidf_(float x) { return 1.f / (1.f + __expf(-x)); }
__device__ __forceinline__ float softplusf_(float x) { return fmaxf(x, 0.f) + log1pf(__expf(-fabsf(x))); }
__device__ __forceinline__ int swz(int rr, int b) { int ob = rr * 64 + b; return ob ^ (((ob >> 9) & 1) << 5); }

__device__ __forceinline__ int tid_() {
  int t = threadIdx.x;
  asm volatile("" : "+v"(t));
  return t;
}
template <int CTRL>
__device__ __forceinline__ float dppf(float x) {
  return __int_as_float(__builtin_amdgcn_update_dpp(0, __float_as_int(x), CTRL, 0xf, 0xf, true));
}
__device__ __forceinline__ float red16_sum(float x) {
  x += dppf<0xB1>(x);
  x += dppf<0x4E>(x);
  x += dppf<0x141>(x);
  x += dppf<0x140>(x);
  return x;
}
__device__ __forceinline__ float red16_max(float x) {
  x = fmaxf(x, dppf<0xB1>(x));
  x = fmaxf(x, dppf<0x4E>(x));
  x = fmaxf(x, dppf<0x141>(x));
  x = fmaxf(x, dppf<0x140>(x));
  return x;
}
__device__ __forceinline__ float wave_sum(float x) {
#pragma unroll
  for (int m = 1; m < 64; m <<= 1) x += __shfl_xor(x, m, 64);
  return x;
}

__device__ __forceinline__ void tok_info(int tok, int& seq, int& t, int& T) {
  if (tok < MP) { seq = tok >> 11; t = tok & 2047; T = 2048; }
  else { int s = tok - MP; seq = 8 + (s >> 2); t = s & 3; T = 4; }
}
__device__ __forceinline__ int seq_tok0(int seq) { return seq < 8 ? seq * 2048 : MP + (seq - 8) * 4; }


#define XB_TMO      128
#define XB_XCNT(j)  (256  + 64 * (j))
#define XB_XSUB(j)  (1280 + 64 * (j))
#define XB_XGEN(j)  (2304 + 64 * (j))
#define XB_TOP      3328
#define XB_TOPGEN   3392
#define XCD_BAR_WORDS 3456
#define XB_SPIN_CAP (1u << 22)
#define LAS __attribute__((address_space(3)))
__device__ __forceinline__ unsigned xb_ld(unsigned* p) { return __hip_atomic_load(p, __ATOMIC_RELAXED, __HIP_MEMORY_SCOPE_AGENT); }
__device__ __forceinline__ unsigned xb_add(unsigned* p, unsigned v) { return __hip_atomic_fetch_add(p, v, __ATOMIC_RELAXED, __HIP_MEMORY_SCOPE_AGENT); }
__device__ __forceinline__ unsigned xb_xcc_id() { return (unsigned)__builtin_amdgcn_s_getreg((3 << 11) | 20) & 0xFu; }
#define XB_SPIN(cond, bar) do { unsigned _sp = 0; while (cond) { __builtin_amdgcn_s_sleep(1); \
    if ((++_sp & 255u) == 0u) { if (xb_ld(&(bar)[XB_TMO])) break; if (_sp > XB_SPIN_CAP) { atomicAdd(&(bar)[XB_TMO], 1u); break; } } } } while (0)
struct XcdBarrier { unsigned* bar; unsigned x; volatile LAS unsigned* st; };
__device__ __forceinline__ XcdBarrier xcd_barrier_post(unsigned* bar, volatile LAS unsigned* st) {
  XcdBarrier b; b.bar = bar; b.x = xb_xcc_id(); b.st = st;
  if (threadIdx.x == 0) (void)xb_add(&bar[XB_XCNT(b.x)], 1u);
  return b;
}
__device__ __forceinline__ void xcd_barrier_complete(unsigned* bar, unsigned x, unsigned& nloc, unsigned& nx) {
  const unsigned G = gridDim.x * gridDim.y * gridDim.z;
  unsigned sum, cnt, mine, sp = 0u;
  for (;;) {
    sum = 0u; cnt = 0u; mine = 0u;
#pragma unroll
    for (unsigned j = 0; j < 16; ++j) { const unsigned c = xb_ld(&bar[XB_XCNT(j)]); sum += c; cnt += (c > 0u) ? 1u : 0u; mine = (j == x) ? c : mine; }
    if (sum == G) break;
    __builtin_amdgcn_s_sleep(1);
    if ((++sp & 255u) == 0u) { if (xb_ld(&bar[XB_TMO])) break; if (sp > XB_SPIN_CAP) { atomicAdd(&bar[XB_TMO], 1u); break; } }
  }
  nloc = mine > 0u ? mine : 1u; nx = cnt > 0u ? cnt : 1u;
}
__device__ __forceinline__ void xcd_barrier(const XcdBarrier& b) {
  asm volatile("s_waitcnt vmcnt(0)" ::: "memory");
  __syncthreads();
  if (threadIdx.x == 0) {
    unsigned* bar = b.bar;
    __builtin_amdgcn_s_waitcnt(0);
    unsigned nloc = b.st[0], nx = b.st[1];
    if (nloc == 0u) { xcd_barrier_complete(bar, b.x, nloc, nx); b.st[0] = nloc; b.st[1] = nx; }
    const unsigned old = xb_add(&bar[XB_XSUB(b.x)], 1u);
    const unsigned gen = old / nloc;
    if (old + 1u == (gen + 1u) * nloc) {
      __builtin_amdgcn_fence(__ATOMIC_RELEASE, "agent");
      asm volatile("s_waitcnt vmcnt(0)" ::: "memory");
      const unsigned og = xb_add(&bar[XB_TOP], 1u);
      const unsigned tg = og / nx;
      if (og + 1u == (tg + 1u) * nx) xb_add(&bar[XB_TOPGEN], 1u);
      else XB_SPIN(xb_ld(&bar[XB_TOPGEN]) == tg, bar);
      __builtin_amdgcn_fence(__ATOMIC_ACQUIRE, "agent");
      xb_add(&bar[XB_XGEN(b.x)], 1u);
      asm volatile("s_waitcnt vmcnt(0)" ::: "memory");
    } else {
      XB_SPIN(xb_ld(&bar[XB_XGEN(b.x)]) == gen, bar);
      __builtin_amdgcn_fence(__ATOMIC_ACQUIRE, "agent");
      asm volatile("s_waitcnt vmcnt(0)" ::: "memory");
    }
  }
  __syncthreads();
}

#define MFMA(a, b, c) __builtin_amdgcn_mfma_f32_16x16x32_bf16((a), (b), (c), 0, 0, 0)

template <int OFF>
__device__ __forceinline__ bf16x8 lds_rd128(unsigned addr) {
  bf16x8 v;
  asm volatile("ds_read_b128 %0, %1 offset:%2" : "=v"(v) : "v"(addr), "n"(OFF));
  return v;
}
template <int MTW, int NTW>
struct GemmCtx {
  const bf16_t* ga;
  const bf16_t* gb;
  int lda, ldb;
};
#define GEMM_STAGE_BYTES(MTW, NTW) (2048 * ((MTW) + (NTW)))
#define GEMM_NLD(MTW, NTW) (((MTW) + (NTW)) / 2)

template <int NTW>
__device__ __forceinline__ int gemm_brow(int s  , int rr  ) {
  return (s / NTW) * (16 * NTW) + (rr >> 2) * (4 * NTW) + (s % NTW) * 4 + (rr & 3);
}
template <int MTW, int NTW>
__device__ __forceinline__ void gemm_issue(const bf16_t* ga, int lda, const bf16_t* gb0, const bf16_t* gb1, int kt, char* wstage) {
#pragma unroll
  for (int j = 0; j < MTW / 2; ++j)
    __builtin_amdgcn_global_load_lds((const unsigned*)(ga + (size_t)(64 * j) * lda + kt * 32), (unsigned*)(wstage + j * 4096), 16, 0, 0);
  __builtin_amdgcn_global_load_lds((const unsigned*)(gb0 + kt * 32), (unsigned*)(wstage + MTW * 2048), 16, 0, 0);
  if constexpr (NTW == 4)
    __builtin_amdgcn_global_load_lds((const unsigned*)(gb1 + kt * 32), (unsigned*)(wstage + MTW * 2048 + 4096), 16, 0, 0);
}

template <int MTW, int NTW>
__device__ __forceinline__ void gemm_prologue(const bf16_t* __restrict__ A, int lda, const bf16_t* __restrict__ Bt, int ldb,
                                              int m0, int n0, char* lds) {
  constexpr int SB = GEMM_STAGE_BYTES(MTW, NTW);
  const int TX = tid_();
  const int lane = TX & 63, wv = TX >> 6;
  const int obs = lane * 16;
  const int ob = obs ^ (((obs >> 9) & 1) << 5);
  const int srow = wv * 16 + (ob >> 6), scol = (ob & 63) >> 1;
  const bf16_t* ga = A + (size_t)(m0 + srow) * lda + scol;
  const bf16_t* gb0 = Bt + (size_t)(n0 + gemm_brow<NTW>(wv, ob >> 6)) * ldb + scol;
  const bf16_t* gb1 = Bt + (size_t)(n0 + gemm_brow<NTW>(wv + 4, ob >> 6)) * ldb + scol;
  char* wbase = lds + wv * 1024;
#pragma unroll
  for (int t = 0; t < 3; ++t) gemm_issue<MTW, NTW>(ga, lda, gb0, gb1, t, wbase + t * SB);
}

template <int MTW, int NTW>
__device__ __forceinline__ void gemm_loop(const bf16_t* __restrict__ A, int lda, const bf16_t* __restrict__ Bt, int ldb,
                                          int K, int m0, int n0, char* lds, f32x4 (&acc)[MTW][NTW]) {
  constexpr int SB = GEMM_STAGE_BYTES(MTW, NTW), NLD = GEMM_NLD(MTW, NTW);
  static_assert(NLD == 4 || NLD == 3, "vmcnt immediates below assume 3 or 4 loads per k-step");
  const int TX = tid_();
  const int lane = TX & 63, wv = TX >> 6;
  const int wr = wv >> 1, wc = wv & 1, fr = lane & 15, fq = lane >> 4;
  const int obs = lane * 16;
  const int ob = obs ^ (((obs >> 9) & 1) << 5);
  const int srow = wv * 16 + (ob >> 6), scol = (ob & 63) >> 1;
  const bf16_t* ga = A + (size_t)(m0 + srow) * lda + scol;
  const bf16_t* gb0 = Bt + (size_t)(n0 + gemm_brow<NTW>(wv, ob >> 6)) * ldb + scol;
  const bf16_t* gb1 = Bt + (size_t)(n0 + gemm_brow<NTW>(wv + 4, ob >> 6)) * ldb + scol;
  char* wbase = lds + wv * 1024;
  const int fo = swz(fr, fq * 16);
  const unsigned lbase = (unsigned)(unsigned long)((__attribute__((address_space(3))) char*)lds);
  const unsigned a_off = lbase + (wr * MTW) * 1024 + fo, b_off = lbase + MTW * 2048 + (wc * NTW) * 1024 + fo;
  const int nk = K >> 5;
  for (int kt = 0; kt < nk; ++kt) {
    if (kt + 2 < nk) { if (NLD == 4) asm volatile("s_waitcnt vmcnt(8)" ::: "memory"); else asm volatile("s_waitcnt vmcnt(6)" ::: "memory"); }
    else if (kt + 1 < nk) { if (NLD == 4) asm volatile("s_waitcnt vmcnt(4)" ::: "memory"); else asm volatile("s_waitcnt vmcnt(3)" ::: "memory"); }
    else asm volatile("s_waitcnt vmcnt(0)" ::: "memory");
    __builtin_amdgcn_s_barrier();
    asm volatile("" ::: "memory");
    static_assert(MTW == 4, "fragment read block below is written for 4 m-tiles per wave");
    const unsigned sa_ = a_off + (kt & 3) * SB, sb_ = b_off + (kt & 3) * SB;
    bf16x8 af[MTW], bfr[NTW];
    af[0] = lds_rd128<0>(sa_); af[1] = lds_rd128<1024>(sa_); af[2] = lds_rd128<2048>(sa_); af[3] = lds_rd128<3072>(sa_);
    bfr[0] = lds_rd128<0>(sb_); bfr[1] = lds_rd128<1024>(sb_);
    if constexpr (NTW == 4) { bfr[2] = lds_rd128<2048>(sb_); bfr[3] = lds_rd128<3072>(sb_); }
    if (kt + 3 < nk) gemm_issue<MTW, NTW>(ga, lda, gb0, gb1, kt + 3, wbase + ((kt + 3) & 3) * SB);
    if constexpr (NTW == 4)
      asm volatile("s_waitcnt lgkmcnt(0)" : "+v"(af[0]), "+v"(af[1]), "+v"(af[2]), "+v"(af[3]), "+v"(bfr[0]), "+v"(bfr[1]), "+v"(bfr[2]), "+v"(bfr[3]) :: "memory");
    else
      asm volatile("s_waitcnt lgkmcnt(0)" : "+v"(af[0]), "+v"(af[1]), "+v"(af[2]), "+v"(af[3]), "+v"(bfr[0]), "+v"(bfr[1]) :: "memory");
#pragma unroll
    for (int mt = 0; mt < MTW; ++mt)
#pragma unroll
      for (int nt = 0; nt < NTW; ++nt) acc[mt][nt] = MFMA(bfr[nt], af[mt], acc[mt][nt]);
  }
  asm volatile("s_waitcnt lgkmcnt(0)" ::: "memory");
  __builtin_amdgcn_s_barrier();
  asm volatile("" ::: "memory");
}

template <int MTW, int NTW>
__device__ __forceinline__ void gemm_main(const bf16_t* __restrict__ A, int lda, const bf16_t* __restrict__ Bt, int ldb,
                                          int K, int m0, int n0, char* lds, f32x4 (&acc)[MTW][NTW]) {
  gemm_prologue<MTW, NTW>(A, lda, Bt, ldb, m0, n0, lds);
  gemm_loop<MTW, NTW>(A, lda, Bt, ldb, K, m0, n0, lds, acc);
}

__device__ __forceinline__ uint4 pack8(const f32x4& a, const f32x4& b) {
  uint4 o;
  o.x = (unsigned)f2bf(a[0]) | ((unsigned)f2bf(a[1]) << 16);
  o.y = (unsigned)f2bf(a[2]) | ((unsigned)f2bf(a[3]) << 16);
  o.z = (unsigned)f2bf(b[0]) | ((unsigned)f2bf(b[1]) << 16);
  o.w = (unsigned)f2bf(b[2]) | ((unsigned)f2bf(b[3]) << 16);
  return o;
}

struct TileIter {
  int L, Lend, step;
};
__device__ __forceinline__ TileIter tile_iter(int ntiles) {
  const int G = (int)gridDim.x, b = (int)blockIdx.x;
  TileIter it;
  if ((G & 7) == 0) {
    const int tpx = (ntiles + 7) >> 3, x = b & 7;
    it.L = x * tpx + (b >> 3);
    it.Lend = min(ntiles, (x + 1) * tpx);
    it.step = G >> 3;
  } else {
    it.L = b; it.Lend = ntiles; it.step = G;
  }
  return it;
}
__device__ __forceinline__ TileIter tile_iter_rev(int ntiles) {
  const int G = (int)gridDim.x, b = (int)blockIdx.x;
  TileIter it;
  if ((G & 7) == 0) {
    const int tpx = (ntiles + 7) >> 3, x = b & 7, ns = G >> 3;
    it.L = x * tpx + (ns - 1 - (b >> 3));
    it.Lend = min(ntiles, (x + 1) * tpx);
    it.step = ns;
  } else {
    it.L = G - 1 - b; it.Lend = ntiles; it.step = G;
  }
  return it;
}
__device__ __forceinline__ void tile_mn(int L, int nM, int nN, int& m, int& n) {
  const int full = (nM >> 3) * 8 * nN;
  if (L < full) {
    const int band = L / (8 * nN), r = L % (8 * nN);
    n = r >> 3; m = band * 8 + (r & 7);
  } else {
    const int rem = nM & 7, r = L - full;
    n = r / rem; m = (nM >> 3) * 8 + r % rem;
  }
}

template <int MTW, int NTW>
__device__ __forceinline__ void zero_acc(f32x4 (&acc)[MTW][NTW]) {
#pragma unroll
  for (int a = 0; a < MTW; ++a)
#pragma unroll
    for (int b = 0; b < NTW; ++b) acc[a][b] = f32x4{0.f, 0.f, 0.f, 0.f};
}

__device__ void transpose_tile(const float* __restrict__ W, int ldw, bf16_t* __restrict__ Wt, int ldt, int k0, int n0,
                               int perm, char* lds) {
  const int TX = tid_();
  float* tile = (float*)lds;
  const int tid = TX;
  const int c = tid & 63, r0 = tid >> 6;
#pragma unroll
  for (int r = 0; r < 16; ++r) {
    int row = r * 4 + r0;
    tile[row * 65 + c] = W[(size_t)(k0 + row) * ldw + n0 + c];
  }
  __syncthreads();
#pragma unroll
  for (int r = 0; r < 16; ++r) {
    int n = n0 + r * 4 + r0;
    int np = n;
    if (perm) {
      if (n < DFF) np = (n >> 3) * 16 + (n & 7);
      else { int j = n - DFF; np = (j >> 3) * 16 + 8 + (j & 7); }
    }
    Wt[(size_t)np * ldt + k0 + c] = f2bf(tile[c * 65 + (r * 4 + r0)]);
  }
  __syncthreads();
}

__device__ __forceinline__ void convert_job(const float* __restrict__ src, bf16_t* __restrict__ dst, int K, int N, int nmat,
                                            int perm, int& start, char* lds) {
  const int tk = K / 64, tn = N / 64;
  const int ntiles = nmat * tk * tn;
  const int G = (int)gridDim.x;
  const int first = (((int)blockIdx.x - start) % G + G) % G;
  for (int i = first; i < ntiles; i += G) {
    const int mat = i / (tk * tn), r = i % (tk * tn);
    const int kt = r / tn, nt = r % tn;
    transpose_tile(src + (size_t)mat * K * N, N, dst + (size_t)mat * K * N, K, kt * 64, nt * 64, perm, lds);
  }
  start += ntiles;
}

__device__ void phase_convert(const Params& p, char* lds) {
  const int TX = tid_();
  char* ws = p.ws;
  int start = 0;
  convert_job(p.in[I_WIN], (bf16_t*)(ws + W_IN), 1024, 7680, NL, 0, start, lds);
  convert_job(p.in[I_WFFNIN], (bf16_t*)(ws + W_FFNIN), 1024, 5632, NL, 1, start, lds);
  convert_job(p.in[I_WFFNOUT], (bf16_t*)(ws + W_FFNOUT), 2816, 1024, NL, 0, start, lds);
  convert_job(p.in[I_WRWOUT], (bf16_t*)(ws + W_RWOUT), 768, 1024, NL, 0, start, lds);
  convert_job(p.in[I_WLRUOUT], (bf16_t*)(ws + W_LRUOUT), 768, 1024, NL, 0, start, lds);
  convert_job(p.in[I_WXAOUT], (bf16_t*)(ws + W_XAOUT), 512, 1024, NL, 0, start, lds);
  convert_job(p.in[I_WO], (bf16_t*)(ws + W_O), 1024, 1024, NL, 0, start, lds);
  convert_job(p.in[I_WMEMKV], (bf16_t*)(ws + W_MEMKV), 1024, 1024, NL, 0, start, lds);
  convert_job(p.in[I_W2], (bf16_t*)(ws + W_W2T), 64, 768, NL, 0, start, lds);
  convert_job(p.in[I_A2], (bf16_t*)(ws + W_A2T), 64, 768, NL, 0, start, lds);
  convert_job(p.in[I_G2], (bf16_t*)(ws + W_G2T), 128, 768, NL, 0, start, lds);
  convert_job(p.in[I_WRG], (bf16_t*)(ws + W_RGT), 64, 64, NL * 12, 0, start, lds);
  convert_job(p.in[I_WIG], (bf16_t*)(ws + W_IGT), 64, 64, NL * 12, 0, start, lds);
  const size_t gtid = (size_t)blockIdx.x * 256 + TX, gsz = (size_t)gridDim.x * 256;
  {
    uint2* xb = (uint2*)(ws + B_XB);
    const float4* xp = (const float4*)p.in[I_XP];
    const float4* xs = (const float4*)p.in[I_XS];
    const size_t np4 = (size_t)MP * D / 4, nt4 = (size_t)MT * D / 4;
    for (size_t i = gtid; i < nt4; i += gsz) {
      float4 v = (i < np4) ? xp[i] : xs[i - np4];
      uint2 o;
      o.x = (unsigned)f2bf(v.x) | ((unsigned)f2bf(v.y) << 16);
      o.y = (unsigned)f2bf(v.z) | ((unsigned)f2bf(v.w) << 16);
      xb[i] = o;
    }
  }
  {
    uint2* mb = (uint2*)(ws + B_MEMB);
    const float4* m = (const float4*)p.in[I_MEM];
    const size_t n4 = (size_t)2048 * D / 4;
    for (size_t i = gtid; i < n4; i += gsz) {
      float4 v = m[i];
      uint2 o;
      o.x = (unsigned)f2bf(v.x) | ((unsigned)f2bf(v.y) << 16);
      o.y = (unsigned)f2bf(v.z) | ((unsigned)f2bf(v.w) << 16);
      mb[i] = o;
    }
  }
  {
    bf16_t* v1t = (bf16_t*)(ws + W_V1T);
    const float* v1 = p.in[I_V1];
    for (size_t i = gtid; i < (size_t)3 * 768 * 32; i += gsz) {
      int j = (int)(i / (768 * 32)), r = (int)(i % (768 * 32));
      int n = r / 768, k = r % 768;
      v1t[i] = f2bf(v1[(size_t)j * 768 * 32 + (size_t)k * 32 + n]);
    }
  }
  {
    bf16_t* v2t = (bf16_t*)(ws + W_V2T);
    const float* v2 = p.in[I_V2];
    for (size_t i = gtid; i < (size_t)3 * 768 * 32; i += gsz) {
      int j = (int)(i / (768 * 32)), r = (int)(i % (768 * 32));
      int n = r / 32, k = r % 32;
      v2t[i] = f2bf(v2[(size_t)j * 32 * 768 + (size_t)k * 768 + n]);
    }
  }
}

struct ProjTile { const bf16_t* A; const bf16_t* Bt; int m0, n0, ll; bool main; };
__device__ __forceinline__ ProjTile proj_tile(const Params& p, int l, int tile, int nextra) {
  char* ws = p.ws;
  ProjTile t;
  if (tile >= nextra) {
    int tm, tn;
    tile_mn(tile - nextra, MT / 128, DIN / 128, tm, tn);
    t.A = (const bf16_t*)(ws + B_XB); t.Bt = (const bf16_t*)(ws + W_IN) + (size_t)l * DIN * D;
    t.m0 = tm * 128; t.n0 = tn * 128; t.ll = l; t.main = true;
  } else {
    const int ll = tile / 128, r = tile % 128;
    t.A = (const bf16_t*)(ws + B_MEMB); t.Bt = (const bf16_t*)(ws + W_MEMKV) + (size_t)ll * D * D;
    t.m0 = (r / 8) * 128; t.n0 = (r % 8) * 128; t.ll = ll; t.main = false;
  }
  return t;
}

__device__ void phase_proj(const Params& p, int l, char* lds) {
  const int TX = tid_();
  char* ws = p.ws;
  bf16_t* proj = (bf16_t*)(ws + B_PROJ);
  const int lane = TX & 63, wv = TX >> 6, wr = wv >> 1, wc = wv & 1, fr = lane & 15, fq = lane >> 4;
  const int ntiles = (MT / 128) * (DIN / 128);
  const int nextra = (l == 0) ? NL * 16 * 8 : 0;
  TileIter it = tile_iter(ntiles + nextra);
  bool have = it.L < it.Lend;
  ProjTile cur;
  if (have) { cur = proj_tile(p, l, it.L, nextra); gemm_prologue<4, 4>(cur.A, D, cur.Bt, D, cur.m0, cur.n0, lds); }
  while (have) {
    f32x4 acc[4][4];
    zero_acc(acc);
    gemm_loop<4, 4>(cur.A, D, cur.Bt, D, D, cur.m0, cur.n0, lds, acc);
    const int Ln = it.L + it.step;
    const bool hn = Ln < it.Lend;
    ProjTile nxt = cur;
    if (hn) { nxt = proj_tile(p, l, Ln, nextra); gemm_prologue<4, 4>(nxt.A, D, nxt.Bt, D, nxt.m0, nxt.n0, lds); }
    const int m0 = cur.m0, n0 = cur.n0;
    if (cur.main) {
#pragma unroll
      for (int mt = 0; mt < 4; ++mt) {
        const int row = m0 + wr * 64 + mt * 16 + fr, col = n0 + wc * 64 + fq * 16;
        uint4* dst = (uint4*)(proj + (size_t)row * DIN + col);
        dst[0] = pack8(acc[mt][0], acc[mt][1]);
        dst[1] = pack8(acc[mt][2], acc[mt][3]);
      }
    } else {
      const int ll = cur.ll;
      bf16_t* kb = (bf16_t*)(ws + B_KB);
      bf16_t* vtb = (bf16_t*)(ws + B_VTB);
#pragma unroll
      for (int mt = 0; mt < 4; ++mt)
#pragma unroll
        for (int nt = 0; nt < 4; ++nt)
#pragma unroll
          for (int i = 0; i < 4; ++i) {
            int row = m0 + wr * 64 + mt * 16 + fr, col = n0 + wc * 64 + fq * 16 + nt * 4 + i;
            int b = row >> 8, key = row & 255;
            float v = acc[mt][nt][i];
            if (col < 512) {
              p.out[O_MKP + ((size_t)(ll * 8 + b) * 256 + key) * 512 + col] = v;
              kb[((size_t)(ll * 8 + b) * 256 + key) * 512 + col] = f2bf(v);
            } else {
              int c2 = col - 512, h = c2 >> 7, d = c2 & 127;
              p.out[O_MVP + ((size_t)(ll * 8 + b) * 256 + key) * 512 + c2] = v;
              vtb[(((size_t)(ll * 8 + b) * 4 + h) * 128 + d) * 256 + key] = f2bf(v);
            }
          }
    }
    it.L = Ln; have = hn; cur = nxt;
  }
}

__device__ __forceinline__ float prw_prev(const Params& p, const bf16_t* proj, int l, int tok, int seq, int t, int c) {
  if (t > 0) return bf2f(proj[(size_t)(tok - 1) * DIN + c]);
  if (seq >= 8) return p.in[I_SSHIFT][((size_t)l * 128 + (seq - 8)) * RWC + c];
  return 0.f;
}
__device__ __forceinline__ float plx_back(const Params& p, const bf16_t* proj, int l, int tok, int seq, int t, int j, int ch) {
  if (t - j >= 0) return bf2f(proj[(size_t)(tok - j) * DIN + C_LX + ch]);
  if (seq >= 8) return p.in[I_SCONV][(((size_t)l * 128 + (seq - 8)) * 3 + (3 + t - j)) * DLRU + ch];
  return 0.f;
}

__device__ __forceinline__ float2 ld_bf2(const bf16_t* p) {
  const unsigned u = *(const unsigned*)p;
  return make_float2(__uint_as_float(u << 16), __uint_as_float(u & 0xffff0000u));
}
__device__ __forceinline__ unsigned pk_bf2(float a, float b) { return (unsigned)f2bf(a) | ((unsigned)f2bf(b) << 16); }
__device__ __forceinline__ float2 prw_prev2(const Params& p, const bf16_t* proj, int l, int tok, int seq, int t, int c) {
  if (t > 0) return ld_bf2(proj + (size_t)(tok - 1) * DIN + c);
  if (seq >= 8) return *(const float2*)(p.in[I_SSHIFT] + ((size_t)l * 128 + (seq - 8)) * RWC + c);
  return make_float2(0.f, 0.f);
}
__device__ __forceinline__ float2 plx_back2(const Params& p, const bf16_t* proj, int l, int tok, int seq, int t, int j, int ch) {
  if (t - j >= 0) return ld_bf2(proj + (size_t)(tok - j) * DIN + C_LX + ch);
  if (seq >= 8) return *(const float2*)(p.in[I_SCONV] + (((size_t)l * 128 + (seq - 8)) * 3 + (3 + t - j)) * DLRU + ch);
  return make_float2(0.f, 0.f);
}

__device__ void phase_prep(const Params& p, int l, char* lds) {
  const int TX = tid_();
  char* ws = p.ws;
  const bf16_t* proj = (const bf16_t*)(ws + B_PROJ);
  bf16_t* L = (bf16_t*)(ws + B_LBUF);
  bf16_t* XC = (bf16_t*)(ws + B_ALRU);
  float* ubuf = (float*)(ws + B_UBUF);
  bf16_t* vmid = (bf16_t*)(ws + B_VMID);
  const float* mu = p.in[I_MU] + (size_t)l * RWC;
  const float* cw = p.in[I_CONVW] + (size_t)l * 4 * DLRU;
  const float* cb = p.in[I_CONVB] + (size_t)l * DLRU;
  const int tid = TX, lane = tid & 63, wv = tid >> 6, fr = lane & 15, fq = lane >> 4;
  constexpr int TK = 4;
  for (TileIter ti = tile_iter(MT / TK); ti.L < ti.Lend; ti.L += ti.step) {
    const int item = ti.L;
    const int tokb = item * TK;
    auto body = [&](auto interior_tag) {
    constexpr bool INTR = decltype(interior_tag)::value;
#pragma unroll 4
    for (int u = tid; u < TK * 128; u += 256) {
      const int tk = u >> 7, cp = (u & 127) * 2, tok = tokb + tk, c = 2304 + cp;
      int seq = 0, t = 16, T = 2048;
      if constexpr (!INTR) tok_info(tok, seq, t, T);
      const float2 pc = ld_bf2(proj + (size_t)tok * DIN + c);
      float2 pp;
      if constexpr (INTR) pp = ld_bf2(proj + (size_t)(tok - 1) * DIN + c); else pp = prw_prev2(p, proj, l, tok, seq, t, c);
      const float2 m2 = *(const float2*)(mu + c);
      const float x0 = pc.x + (pp.x - pc.x) * m2.x, x1 = pc.y + (pp.y - pc.y) * m2.y;
      float o0, o1;
      if (cp < 64) { o0 = tanhf(x0); o1 = tanhf(x1); }
      else if (cp < 128) { o0 = x0; o1 = x1; }
      else { o0 = sigmoidf_(x0); o1 = sigmoidf_(x1); }
      *(unsigned*)(L + (size_t)tok * 256 + cp) = pk_bf2(o0, o1);
    }
#pragma unroll 4
    for (int u = tid; u < TK * 384; u += 256) {
      const int tk = u / 384, ch = (u % 384) * 2, tok = tokb + tk;
      int seq = 0, t = 16, T = 2048;
      if constexpr (INTR) { seq = tok >> 11; t = tok & 2047; } else tok_info(tok, seq, t, T);
      const float2 x0 = ld_bf2(proj + (size_t)tok * DIN + C_LX + ch);
      float2 x1, x2, x3;
      if constexpr (INTR) {
        x1 = ld_bf2(proj + (size_t)(tok - 1) * DIN + C_LX + ch);
        x2 = ld_bf2(proj + (size_t)(tok - 2) * DIN + C_LX + ch);
        x3 = ld_bf2(proj + (size_t)(tok - 3) * DIN + C_LX + ch);
      } else {
        x1 = plx_back2(p, proj, l, tok, seq, t, 1, ch);
        x2 = plx_back2(p, proj, l, tok, seq, t, 2, ch);
        x3 = plx_back2(p, proj, l, tok, seq, t, 3, ch);
      }
      const float2 b2 = *(const float2*)(cb + ch), w3 = *(const float2*)(cw + 3 * DLRU + ch), w2 = *(const float2*)(cw + 2 * DLRU + ch),
                   w1 = *(const float2*)(cw + DLRU + ch), w0 = *(const float2*)(cw + ch);
      const float xa = b2.x + w3.x * x0.x + w2.x * x1.x + w1.x * x2.x + w0.x * x3.x;
      const float xb_ = b2.y + w3.y * x0.y + w2.y * x1.y + w1.y * x2.y + w0.y * x3.y;
      *(unsigned*)(XC + (size_t)tok * DLRU + ch) = pk_bf2(xa, xb_);
      if (t >= T - 3) {
        const size_t o = (seq < 8) ? O_CONVP + (((size_t)l * 8 + seq) * 3 + (t - (T - 3))) * DLRU
                                   : O_CONVS + (((size_t)l * 128 + (seq - 8)) * 3 + (t - (T - 3))) * DLRU;
        *(float2*)(p.out + o + ch) = x0;
      }
      if (l > 0) {
        const int c = 1536 + ch;
        const float2 pc = ld_bf2(proj + (size_t)tok * DIN + c);
        float2 pp;
        if constexpr (INTR) pp = ld_bf2(proj + (size_t)(tok - 1) * DIN + c); else pp = prw_prev2(p, proj, l, tok, seq, t, c);
        const float2 m2 = *(const float2*)(mu + c);
        const float v0 = pc.x + (pp.x - pc.x) * m2.x, v1 = pc.y + (pp.y - pc.y) * m2.y;
        *(unsigned*)(lds + (ch >> 5) * 1024 + swz(tk, (ch & 31) * 2)) = pk_bf2(v0, v1);
      }
    }
    };
    if (tokb < MP && (tokb & 2047) != 0) body(std::true_type{}); else body(std::false_type{});
    for (int tk = 0; tk < TK; ++tk) {
      const int tok = tokb + tk;
      int seq, t, T;
      tok_info(tok, seq, t, T);
      if (t == T - 1) {
        const size_t o = (seq < 8) ? O_SHP + ((size_t)l * 8 + seq) * RWC : O_SHS + ((size_t)l * 128 + (seq - 8)) * RWC;
        for (int c = tid * 2; c < RWC; c += 512) *(float2*)(p.out + o + c) = ld_bf2(proj + (size_t)tok * DIN + c);
      }
    }
    if (l > 0) {
      __syncthreads();
      const bf16_t* v1t = (const bf16_t*)(ws + W_V1T) + (size_t)(l - 1) * 32 * DRW;
      f32x4 acc0 = f32x4{0, 0, 0, 0}, acc1 = acc0;
      const int fo = swz(fr, fq * 16);
#pragma unroll
      for (int kk = 0; kk < 6; ++kk) {
        const int ks = wv * 6 + kk;
        const bf16x8 af = *(const bf16x8*)(lds + ks * 1024 + fo);
        const bf16x8 b0 = *(const bf16x8*)(v1t + (size_t)fr * DRW + ks * 32 + fq * 8);
        const bf16x8 b1 = *(const bf16x8*)(v1t + (size_t)(16 + fr) * DRW + ks * 32 + fq * 8);
        acc0 = MFMA(af, b0, acc0);
        acc1 = MFMA(af, b1, acc1);
      }
      float* red = (float*)(lds + 24576);
#pragma unroll
      for (int i = 0; i < 4; ++i) {
        red[(wv * 16 + fq * 4 + i) * 32 + fr] = acc0[i];
        red[(wv * 16 + fq * 4 + i) * 32 + 16 + fr] = acc1[i];
      }
      __syncthreads();
      {
        const int row = tid >> 4, c2 = (tid & 15) * 2;
        if (row < TK) {
          float s0 = 0.f, s1 = 0.f;
#pragma unroll
          for (int w = 0; w < 4; ++w) { s0 += red[(w * 16 + row) * 32 + c2]; s1 += red[(w * 16 + row) * 32 + c2 + 1]; }
          *(unsigned*)(vmid + (size_t)(tokb + row) * 32 + c2) = pk_bf2(s0, s1);
        }
      }
      __syncthreads();
    }
  }
}

__device__ __forceinline__ void unpack4(const uint2 q, float (&o)[4]) {
  o[0] = __uint_as_float(q.x << 16); o[1] = __uint_as_float(q.x & 0xffff0000u);
  o[2] = __uint_as_float(q.y << 16); o[3] = __uint_as_float(q.y & 0xffff0000u);
}
__device__ __forceinline__ void prw_prev4(const Params& p, const bf16_t* proj, int l, int tok, int seq, int t, int c, float (&o)[4]) {
  if (t > 0) { unpack4(*(const uint2*)(proj + (size_t)(tok - 1) * DIN + c), o); return; }
  if (seq >= 8) {
    const float4 s = *(const float4*)(p.in[I_SSHIFT] + ((size_t)l * 128 + (seq - 8)) * RWC + c);
    o[0] = s.x; o[1] = s.y; o[2] = s.z; o[3] = s.w;
    return;
  }
  o[0] = 0.f; o[1] = 0.f; o[2] = 0.f; o[3] = 0.f;
}

__device__ void phase_lora(const Params& p, int l, char* lds) {
  const int TX = tid_();
  char* ws = p.ws;
  const bf16_t* proj = (const bf16_t*)(ws + B_PROJ);
  const bf16_t* L = (const bf16_t*)(ws + B_LBUF);
  const bf16_t* vmid = (const bf16_t*)(ws + B_VMID);
  const bf16_t* XC = (const bf16_t*)(ws + B_ALRU);
  const int NRW = (MT / 128) * 12;
  for (TileIter ti = tile_iter(NRW); ti.L < ti.Lend; ti.L += ti.step) {
    const int item = ti.L;
    int txl = TX;
    asm volatile("" : "+v"(txl));
    const int lane = txl & 63, wv = txl >> 6, fr = lane & 15, fq = lane >> 4;
    {
      const int h = item % 12, tb = (item / 12) * 128 + wv * 32;
      const bf16_t* w2t = (const bf16_t*)(ws + W_W2T) + ((size_t)l * DRW + h * 64) * 64;
      const bf16_t* a2t = (const bf16_t*)(ws + W_A2T) + ((size_t)l * DRW + h * 64) * 64;
      const bf16_t* g2t = (const bf16_t*)(ws + W_G2T) + ((size_t)l * DRW + h * 64) * 128;
      bf16_t* gbuf = (bf16_t*)(ws + B_GBUF);
      {
        f32x4 ag[2][4];
#pragma unroll
        for (int a = 0; a < 2; ++a)
#pragma unroll
          for (int b = 0; b < 4; ++b) ag[a][b] = f32x4{0, 0, 0, 0};
#pragma unroll
        for (int ks = 0; ks < 4; ++ks) {
          bf16x8 af[2], bf_[4];
#pragma unroll
          for (int mt = 0; mt < 2; ++mt) af[mt] = *(const bf16x8*)(L + (size_t)(tb + mt * 16 + fr) * 256 + 128 + ks * 32 + fq * 8);
#pragma unroll
          for (int nt = 0; nt < 4; ++nt) bf_[nt] = *(const bf16x8*)(g2t + (size_t)(nt * 16 + fr) * 128 + ks * 32 + fq * 8);
#pragma unroll
          for (int mt = 0; mt < 2; ++mt)
#pragma unroll
            for (int nt = 0; nt < 4; ++nt) ag[mt][nt] = MFMA(af[mt], bf_[nt], ag[mt][nt]);
        }
#pragma unroll
        for (int mt = 0; mt < 2; ++mt)
#pragma unroll
          for (int nt = 0; nt < 4; ++nt)
#pragma unroll
            for (int i = 0; i < 4; ++i)
              gbuf[(size_t)(tb + mt * 16 + fq * 4 + i) * DRW + h * 64 + nt * 16 + fr] = f2bf(ag[mt][nt][i]);
      }
      f32x4 aw[2][4], aa[2][4], av[2][4];
#pragma unroll
      for (int a = 0; a < 2; ++a)
#pragma unroll
        for (int b = 0; b < 4; ++b) { aw[a][b] = f32x4{0, 0, 0, 0}; aa[a][b] = aw[a][b]; av[a][b] = aw[a][b]; }
#pragma unroll
      for (int ks = 0; ks < 2; ++ks) {
        bf16x8 af[2], bf_[4];
#pragma unroll
        for (int mt = 0; mt < 2; ++mt) af[mt] = *(const bf16x8*)(L + (size_t)(tb + mt * 16 + fr) * 256 + ks * 32 + fq * 8);
#pragma unroll
        for (int nt = 0; nt < 4; ++nt) bf_[nt] = *(const bf16x8*)(w2t + (size_t)(nt * 16 + fr) * 64 + ks * 32 + fq * 8);
#pragma unroll
        for (int mt = 0; mt < 2; ++mt)
#pragma unroll
          for (int nt = 0; nt < 4; ++nt) aw[mt][nt] = MFMA(af[mt], bf_[nt], aw[mt][nt]);
#pragma unroll
        for (int mt = 0; mt < 2; ++mt) af[mt] = *(const bf16x8*)(L + (size_t)(tb + mt * 16 + fr) * 256 + 64 + ks * 32 + fq * 8);
#pragma unroll
        for (int nt = 0; nt < 4; ++nt) bf_[nt] = *(const bf16x8*)(a2t + (size_t)(nt * 16 + fr) * 64 + ks * 32 + fq * 8);
#pragma unroll
        for (int mt = 0; mt < 2; ++mt)
#pragma unroll
          for (int nt = 0; nt < 4; ++nt) aa[mt][nt] = MFMA(af[mt], bf_[nt], aa[mt][nt]);
      }
      if (l > 0) {
        const bf16_t* v2t = (const bf16_t*)(ws + W_V2T) + ((size_t)(l - 1) * DRW + h * 64) * 32;
        bf16x8 af[2], bf_[4];
#pragma unroll
        for (int mt = 0; mt < 2; ++mt) af[mt] = *(const bf16x8*)(vmid + (size_t)(tb + mt * 16 + fr) * 32 + fq * 8);
#pragma unroll
        for (int nt = 0; nt < 4; ++nt) bf_[nt] = *(const bf16x8*)(v2t + (size_t)(nt * 16 + fr) * 32 + fq * 8);
#pragma unroll
        for (int mt = 0; mt < 2; ++mt)
#pragma unroll
          for (int nt = 0; nt < 4; ++nt) av[mt][nt] = MFMA(af[mt], bf_[nt], av[mt][nt]);
      }
      const float* mu = p.in[I_MU] + (size_t)l * RWC;
      float mur[4], muk[4], muv[4], w0[4], a0[4], v0[4], kkp[4], kap[4], rkp[4];
#pragma unroll
      for (int nt = 0; nt < 4; ++nt) {
        int c = h * 64 + nt * 16 + fr;
        mur[nt] = mu[c]; muk[nt] = mu[768 + c]; muv[nt] = mu[1536 + c];
        w0[nt] = p.in[I_W0][(size_t)l * DRW + c];
        a0[nt] = p.in[I_A0][(size_t)l * DRW + c];
        v0[nt] = (l > 0) ? p.in[I_V0][(size_t)(l - 1) * DRW + c] : 0.f;
        kkp[nt] = p.in[I_KK][(size_t)l * DRW + c];
        kap[nt] = p.in[I_KA][(size_t)l * DRW + c];
        rkp[nt] = p.in[I_RK][(size_t)l * DRW + c];
      }
      bf16_t* vfirst = (bf16_t*)(ws + B_VFIRST);
      float* cbuf = (float*)(ws + B_CBUF);
      char* scan = ws + B_SCAN;
      auto epi = [&](auto interior_tag) {
      constexpr bool INTR = decltype(interior_tag)::value;
#pragma unroll
      for (int mt = 0; mt < 2; ++mt)
#pragma unroll
        for (int i = 0; i < 4; ++i) {
          const int tok = tb + mt * 16 + fq * 4 + i;
          int seq = 0, t = 1, T = 2048;
          if constexpr (!INTR) tok_info(tok, seq, t, T);
          const bf16_t* pr = proj + (size_t)tok * DIN;
          float rr[4], kx[4], vv[4], aval[4], dec[4], kkr[4], kmod[4];
          float ss = 0.f, s1 = 0.f, s2 = 0.f, s3 = 0.f;
#pragma unroll
          for (int nt = 0; nt < 4; ++nt) {
            const int cc = nt * 16 + fr, c = h * 64 + cc;
            float pc, pp;
            pc = bf2f(pr[c]);
            if constexpr (INTR) pp = bf2f(pr[c - DIN]); else pp = prw_prev(p, proj, l, tok, seq, t, c);
            rr[nt] = pc + (pp - pc) * mur[nt];
            pc = bf2f(pr[768 + c]);
            if constexpr (INTR) pp = bf2f(pr[768 + c - DIN]); else pp = prw_prev(p, proj, l, tok, seq, t, 768 + c);
            kx[nt] = pc + (pp - pc) * muk[nt];
            pc = bf2f(pr[1536 + c]);
            if constexpr (INTR) pp = bf2f(pr[1536 + c - DIN]); else pp = prw_prev(p, proj, l, tok, seq, t, 1536 + c);
            float vx = pc + (pp - pc) * muv[nt];
            float wraw = -softplusf_(-(w0[nt] + aw[mt][nt][i])) - 0.5f;
            dec[nt] = __expf(-__expf(wraw));
            aval[nt] = sigmoidf_(a0[nt] + aa[mt][nt][i]);
            if (l > 0) {
              float vf = bf2f(vfirst[(size_t)tok * DRW + c]);
              vv[nt] = vx + (vf - vx) * sigmoidf_(v0[nt] + av[mt][nt][i]);
            } else {
              vfirst[(size_t)tok * DRW + c] = f2bf(vx);
              vv[nt] = vx;
            }
            kkr[nt] = kx[nt] * kkp[nt];
            kmod[nt] = kx[nt] * (1.f + (aval[nt] - 1.f) * kap[nt]);
            ss += kkr[nt] * kkr[nt];
            s1 += kkr[nt] * aval[nt] * rr[nt];
            s2 += kmod[nt] * rr[nt];
            s3 += rr[nt] * kmod[nt] * rkp[nt];
          }
          ss = red16_sum(ss); s1 = red16_sum(s1); s2 = red16_sum(s2); s3 = red16_sum(s3);
          const float inv = 1.f / fmaxf(sqrtf(ss), 1e-12f);
          char* so = scan + ((size_t)tok * 12 + h) * 896;
#pragma unroll
          for (int nt = 0; nt < 4; ++nt) {
            const int cc = nt * 16 + fr;
            float kkn = kkr[nt] * inv;
            ((float*)so)[cc] = dec[nt];
            ((bf16_t*)(so + 256))[cc] = f2bf(dec[nt] * rr[nt]);
            ((bf16_t*)(so + 384))[cc] = f2bf(-kkn);
            ((bf16_t*)(so + 512))[cc] = f2bf(kkn * aval[nt]);
            ((bf16_t*)(so + 640))[cc] = f2bf(kmod[nt]);
            ((bf16_t*)(so + 768))[cc] = f2bf(vv[nt]);
          }
          if (fr == 0) {
            float4 cv = make_float4(s1 * inv, s2, s3, 0.f);
            *(float4*)(cbuf + ((size_t)tok * 12 + h) * 4) = cv;
          }
        }
      };
      const int tbu = __builtin_amdgcn_readfirstlane(tb);
      if (tbu < MP && (tbu & 2047) != 0) epi(std::true_type{}); else epi(std::false_type{});
    }
  }
  for (TileIter ti = tile_iter_rev(NRW); ti.L < ti.Lend; ti.L += ti.step) {
    const int item = NRW + ti.L;
    int txl = TX;
    asm volatile("" : "+v"(txl));
    const int lane = txl & 63, wv = txl >> 6, fr = lane & 15, fq = lane >> 4;
    {
      const int it = item - NRW;
      const int nb = it % 12, tb = (it / 12) * 128 + wv * 32;
      const bf16_t* rgt = (const bf16_t*)(ws + W_RGT) + ((size_t)l * 12 + nb) * 4096;
      const bf16_t* igt = (const bf16_t*)(ws + W_IGT) + ((size_t)l * 12 + nb) * 4096;
      const int wrow0 = (fr >> 2) * 16 + (fr & 3);
      f32x4 ar[2][4], ai[2][4];
#pragma unroll
      for (int a = 0; a < 2; ++a)
#pragma unroll
        for (int b = 0; b < 4; ++b) { ar[a][b] = f32x4{0, 0, 0, 0}; ai[a][b] = ar[a][b]; }
#pragma unroll
      for (int ks = 0; ks < 2; ++ks) {
        bf16x8 af[2], b1[4], b2[4];
#pragma unroll
        for (int mt = 0; mt < 2; ++mt) af[mt] = *(const bf16x8*)(XC + (size_t)(tb + mt * 16 + fr) * DLRU + nb * 64 + ks * 32 + fq * 8);
#pragma unroll
        for (int nt = 0; nt < 4; ++nt) {
          b1[nt] = *(const bf16x8*)(rgt + (size_t)(wrow0 + nt * 4) * 64 + ks * 32 + fq * 8);
          b2[nt] = *(const bf16x8*)(igt + (size_t)(wrow0 + nt * 4) * 64 + ks * 32 + fq * 8);
        }
#pragma unroll
        for (int mt = 0; mt < 2; ++mt)
#pragma unroll
          for (int nt = 0; nt < 4; ++nt) {
            ar[mt][nt] = MFMA(b1[nt], af[mt], ar[mt][nt]);
            ai[mt][nt] = MFMA(b2[nt], af[mt], ai[mt][nt]);
          }
      }
      float* abuf = (float*)(ws + B_ABUF);
      float* ubuf = (float*)(ws + B_UBUF);
#pragma unroll
      for (int nt = 0; nt < 4; ++nt) {
        const int c = nb * 64 + fq * 16 + nt * 4;
        const float4 brq = *(const float4*)(p.in[I_BRG] + (size_t)l * DLRU + c), biq = *(const float4*)(p.in[I_BIG] + (size_t)l * DLRU + c);
        const float4 lmq = *(const float4*)(p.in[I_LAMBDA] + (size_t)l * DLRU + c);
        const float br_[4] = {brq.x, brq.y, brq.z, brq.w}, bi_[4] = {biq.x, biq.y, biq.z, biq.w};
        const float sp_[4] = {softplusf_(-lmq.x), softplusf_(-lmq.y), softplusf_(-lmq.z), softplusf_(-lmq.w)};
#pragma unroll
        for (int mt = 0; mt < 2; ++mt) {
          const int tok = tb + mt * 16 + fr;
          float xc_[4];
          unpack4(*(const uint2*)(XC + (size_t)tok * DLRU + c), xc_);
          float ao[4], uo[4];
#pragma unroll
          for (int i = 0; i < 4; ++i) {
            const float rg = sigmoidf_(ar[mt][nt][i] + br_[i]), ig = sigmoidf_(ai[mt][nt][i] + bi_[i]);
            const float la = -8.f * rg * sp_[i];
            ao[i] = __expf(la);
            uo[i] = sqrtf(fmaxf(-expm1f(2.f * la), 0.f)) * (ig * xc_[i]);
          }
          *(float4*)(abuf + (size_t)tok * DLRU + c) = make_float4(ao[0], ao[1], ao[2], ao[3]);
          *(float4*)(ubuf + (size_t)tok * DLRU + c) = make_float4(uo[0], uo[1], uo[2], uo[3]);
        }
      }
    }
  }
}

constexpr int STEP_B = 1552;
struct WkvOps { float4 w4, r4, n4, b4, k4; float v; float2 cc; };
__device__ __forceinline__ void wkv_load(WkvOps& o, const char* b, int kq, int vrow) {
  o.w4 = *(const float4*)(b + kq * 16);
  o.r4 = *(const float4*)(b + 256 + kq * 16);
  o.n4 = *(const float4*)(b + 512 + kq * 16);
  o.b4 = *(const float4*)(b + 768 + kq * 16);
  o.k4 = *(const float4*)(b + 1024 + kq * 16);
  o.v = *(const float*)(b + 1280 + vrow * 4);
  o.cc = *(const float2*)(b + 1536);
}
__device__ __forceinline__ void wkv_step(const WkvOps& o, float& S0, float& S1, float& S2, float& S3, float& ykeep, bool keep) {
  float sa = S0 * o.n4.x + S1 * o.n4.y + S2 * o.n4.z + S3 * o.n4.w;
  float z = S0 * o.r4.x + S1 * o.r4.y + S2 * o.r4.z + S3 * o.r4.w;
  sa = red16_sum(sa);
  z = red16_sum(z);
  const float y = z + sa * o.cc.x + o.v * o.cc.y;
  ykeep = keep ? y : ykeep;
  S0 = S0 * o.w4.x + (sa * o.b4.x + o.v * o.k4.x);
  S1 = S1 * o.w4.y + (sa * o.b4.y + o.v * o.k4.y);
  S2 = S2 * o.w4.z + (sa * o.b4.z + o.v * o.k4.z);
  S3 = S3 * o.w4.w + (sa * o.b4.w + o.v * o.k4.w);
}

struct WkvStage { uint4 st[4]; float4 cst; };
__device__ __forceinline__ void wkv_stage_load(WkvStage& g, const char* scan, const float* cbuf, int tid, int tok0, int h, int c, int T) {
  const int ns = min(16, T - c * 16);
#pragma unroll
  for (int j = 0; j < 4; ++j) {
    const int u = tid + 256 * j;
    if (u < ns * 56) {
      const int s = u / 56, q = u % 56;
      g.st[j] = *(const uint4*)(scan + ((size_t)(tok0 + c * 16 + s) * 12 + h) * 896 + q * 16);
    }
  }
  if (tid >= 128 && tid < 128 + ns) g.cst = *(const float4*)(cbuf + ((size_t)(tok0 + c * 16 + (tid - 128)) * 12 + h) * 4);
}
__device__ __forceinline__ void wkv_stage_write(const WkvStage& g, char* buf, int tid, int c, int T) {
  const int ns = min(16, T - c * 16);
#pragma unroll
  for (int j = 0; j < 4; ++j) {
    const int u = tid + 256 * j;
    if (u < ns * 56) {
      const int s = u / 56, q = u % 56;
      char* base = buf + s * STEP_B;
      if (q < 16) {
        *(uint4*)(base + q * 16) = g.st[j];
      } else {
        float4 lo, hi;
        lo.x = __uint_as_float(g.st[j].x << 16); lo.y = __uint_as_float(g.st[j].x & 0xffff0000u);
        lo.z = __uint_as_float(g.st[j].y << 16); lo.w = __uint_as_float(g.st[j].y & 0xffff0000u);
        hi.x = __uint_as_float(g.st[j].z << 16); hi.y = __uint_as_float(g.st[j].z & 0xffff0000u);
        hi.z = __uint_as_float(g.st[j].w << 16); hi.w = __uint_as_float(g.st[j].w & 0xffff0000u);
        const int off = 256 + (q - 16) * 32;
        *(float4*)(base + off) = lo;
        *(float4*)(base + off + 16) = hi;
      }
    }
  }
  if (tid >= 128 && tid < 128 + ns) *(float2*)(buf + (tid - 128) * STEP_B + 1536) = make_float2(g.cst.x, g.cst.y);
}
__device__ __forceinline__ void wkv_chunk16(const char* buf, int kq, int vrow, float& S0, float& S1, float& S2, float& S3, float& ykeep) {
  WkvOps oa, ob;
  wkv_load(oa, buf, kq, vrow);
#pragma unroll
  for (int s = 0; s < 16; s += 2) {
    wkv_load(ob, buf + (s + 1) * STEP_B, kq, vrow);
    wkv_step(oa, S0, S1, S2, S3, ykeep, kq == s);
    if (s + 2 < 16) wkv_load(oa, buf + (s + 2) * STEP_B, kq, vrow);
    wkv_step(ob, S0, S1, S2, S3, ykeep, kq == s + 1);
  }
}

__device__ void wkv_scan_item(const Params& p, int l, int seq, int h, int qt, char* lds) {
  const int TX = tid_();
  char* ws = p.ws;
  const int tid = TX, lane = tid & 63, wv = tid >> 6;
  const int kq = lane & 15, rl = lane >> 4;
  const int T = (seq < 8) ? 2048 : 4;
  const int tok0 = seq_tok0(seq);
  const char* scan = ws + B_SCAN;
  const float* cbuf = (const float*)(ws + B_CBUF);
  float* ybuf = (float*)(ws + B_YBUF);
  WkvStage ga, gb;
  float4 sin[4];
  if (seq >= 8) {
#pragma unroll
    for (int q4 = 0; q4 < 4; ++q4)
      sin[q4] = *(const float4*)(p.in[I_SWKV] + ((((size_t)l * 128 + (seq - 8)) * 12 + h) * 64 + q4 * 16 + wv * 4 + rl) * 64 + kq * 4);
  }
  __syncthreads();
  wkv_stage_load(ga, scan, cbuf, tid, tok0, h, 0, T);
  if (seq < 8) wkv_stage_load(gb, scan, cbuf, tid, tok0, h, 1, T);
  wkv_stage_write(ga, lds, tid, 0, T);
  __syncthreads();
  if (seq < 8) {
    constexpr int NCH = 128;
    const int vrow = qt * 16 + wv * 4 + rl;
    float S0 = 0.f, S1 = 0.f, S2 = 0.f, S3 = 0.f;
    char* buf0 = lds;
    char* buf1 = lds + 16 * STEP_B;
#pragma unroll 1
    for (int c = 0; c < NCH; c += 2) {
      if (c + 2 < NCH) wkv_stage_load(ga, scan, cbuf, tid, tok0, h, c + 2, T);
      float ykeep = 0.f;
      wkv_chunk16(buf0, kq, vrow, S0, S1, S2, S3, ykeep);
      ybuf[(size_t)(tok0 + c * 16 + kq) * DRW + h * 64 + vrow] = ykeep;
      wkv_stage_write(gb, buf1, tid, c + 1, T);
      __syncthreads();
      if (c + 3 < NCH) wkv_stage_load(gb, scan, cbuf, tid, tok0, h, c + 3, T);
      ykeep = 0.f;
      wkv_chunk16(buf1, kq, vrow, S0, S1, S2, S3, ykeep);
      ybuf[(size_t)(tok0 + (c + 1) * 16 + kq) * DRW + h * 64 + vrow] = ykeep;
      if (c + 2 < NCH) wkv_stage_write(ga, buf0, tid, c + 2, T);
      __syncthreads();
    }
    *(float4*)(p.out + O_WKVP + ((((size_t)l * 8 + seq) * 12 + h) * 64 + vrow) * 64 + kq * 4) = make_float4(S0, S1, S2, S3);
  } else {
    const int b = seq - 8;
#pragma unroll
    for (int q4 = 0; q4 < 4; ++q4) {
      const int vrow = q4 * 16 + wv * 4 + rl;
      float S0 = sin[q4].x, S1 = sin[q4].y, S2 = sin[q4].z, S3 = sin[q4].w;
      float ykeep = 0.f;
      WkvOps oa, ob;
      wkv_load(oa, lds, kq, vrow);
#pragma unroll
      for (int s2 = 0; s2 < 4; s2 += 2) {
        wkv_load(ob, lds + (s2 + 1) * STEP_B, kq, vrow);
        wkv_step(oa, S0, S1, S2, S3, ykeep, kq == s2);
        if (s2 + 2 < 4) wkv_load(oa, lds + (s2 + 2) * STEP_B, kq, vrow);
        wkv_step(ob, S0, S1, S2, S3, ykeep, kq == s2 + 1);
      }
      if (kq < 4) ybuf[(size_t)(tok0 + kq) * DRW + h * 64 + vrow] = ykeep;
      *(float4*)(p.out + O_WKVS + ((((size_t)l * 128 + b) * 12 + h) * 64 + vrow) * 64 + kq * 4) = make_float4(S0, S1, S2, S3);
    }
    __syncthreads();
  }
}

__device__ __forceinline__ float gelu_tanh_(float x) {
  const float u = 0.7978845608028654f * (x + 0.044715f * x * x * x);
  const float th = 1.f - 2.f / (1.f + __expf(2.f * u));
  return 0.5f * x * (1.f + th);
}

__device__ void lru_scan_prompt_item(const Params& p, int l, int seq, int cg, char* lds) {
  const int TX = tid_();
  char* ws = p.ws;
  const int ts = TX >> 5, ch = cg * 32 + (TX & 31);
  const float* abuf = (const float*)(ws + B_ABUF);
  const float* ubuf = (const float*)(ws + B_UBUF);
  const bf16_t* plg = (const bf16_t*)(ws + B_PROJ) + ((size_t)seq * 2048 + ts * 256) * DIN + C_LG + ch;
  bf16_t* alru = (bf16_t*)(ws + B_ALRU);
  const size_t base = ((size_t)seq * 2048 + ts * 256) * DLRU + ch;
  float* sA = (float*)lds;
  float* sU = sA + 256;
  __syncthreads();
  float A = 1.f, U = 0.f;
  for (int t0 = 0; t0 < 256; t0 += 16) {
    float a[16], u[16];
#pragma unroll
    for (int j = 0; j < 16; ++j) {
      a[j] = abuf[base + (size_t)(t0 + j) * DLRU];
      u[j] = ubuf[base + (size_t)(t0 + j) * DLRU];
    }
#pragma unroll
    for (int j = 0; j < 16; ++j) { U = a[j] * U + u[j]; A *= a[j]; }
  }
  sA[TX] = A;
  sU[TX] = U;
  __syncthreads();
  float h = 0.f;
  for (int j = 0; j < ts; ++j) h = sA[j * 32 + (TX & 31)] * h + sU[j * 32 + (TX & 31)];
  {
    float a[16], u[16], an[16], un[16];
    bf16_t g[16], gn[16];
#pragma unroll
    for (int j = 0; j < 16; ++j) {
      a[j] = abuf[base + (size_t)j * DLRU];
      u[j] = ubuf[base + (size_t)j * DLRU];
      g[j] = plg[(size_t)j * DIN];
    }
    for (int t0 = 0; t0 < 256; t0 += 16) {
      if (t0 + 16 < 256) {
#pragma unroll
        for (int j = 0; j < 16; ++j) {
          an[j] = abuf[base + (size_t)(t0 + 16 + j) * DLRU];
          un[j] = ubuf[base + (size_t)(t0 + 16 + j) * DLRU];
          gn[j] = plg[(size_t)(t0 + 16 + j) * DIN];
        }
      }
#pragma unroll
      for (int j = 0; j < 16; ++j) {
        h = a[j] * h + u[j];
        alru[base + (size_t)(t0 + j) * DLRU] = f2bf(h * gelu_tanh_(bf2f(g[j])));
      }
#pragma unroll
      for (int j = 0; j < 16; ++j) { a[j] = an[j]; u[j] = un[j]; g[j] = gn[j]; }
    }
  }
  if (ts == 7) p.out[O_HP + ((size_t)l * 8 + seq) * DLRU + ch] = h;
  __syncthreads();
}

__device__ void lru_scan_item(const Params& p, int l, int seq, int cg3) {
  const int TX = tid_();
  char* ws = p.ws;
  const int ch = cg3 * 256 + TX;
  const int tok0 = seq_tok0(seq);
  const float* abuf = (const float*)(ws + B_ABUF);
  const float* ubuf = (const float*)(ws + B_UBUF);
  const bf16_t* proj = (const bf16_t*)(ws + B_PROJ);
  bf16_t* alru = (bf16_t*)(ws + B_ALRU);
  float h = p.in[I_SH][((size_t)l * 128 + (seq - 8)) * DLRU + ch];
  float a[4], u[4], g[4];
#pragma unroll
  for (int j = 0; j < 4; ++j) {
    a[j] = abuf[(size_t)(tok0 + j) * DLRU + ch];
    u[j] = ubuf[(size_t)(tok0 + j) * DLRU + ch];
    g[j] = bf2f(proj[(size_t)(tok0 + j) * DIN + C_LG + ch]);
  }
#pragma unroll
  for (int j = 0; j < 4; ++j) {
    h = a[j] * h + u[j];
    alru[(size_t)(tok0 + j) * DLRU + ch] = f2bf(h * gelu_tanh_(g[j]));
  }
  p.out[O_HS + ((size_t)l * 128 + (seq - 8)) * DLRU + ch] = h;
}

__device__ void attn_prompt_item(const Params& p, int l, int b, int h, int qt, char* lds) {
  const int TX = tid_();
  char* ws = p.ws;
  const int lane = TX & 63, wv = TX >> 6, fr = lane & 15, fq = lane >> 4;
  const bf16_t* proj = (const bf16_t*)(ws + B_PROJ);
  const bf16_t* kb = (const bf16_t*)(ws + B_KB) + ((size_t)(l * 8 + b) * 256) * 512 + h * 128;
  const bf16_t* vt = (const bf16_t*)(ws + B_VTB) + (((size_t)(l * 8 + b) * 4 + h) * 128) * 256;
  bf16_t* axa = (bf16_t*)(ws + B_AXA);
  const int tok0 = b * 2048 + qt * 64 + wv * 16;
  bf16x8 aq[4];
#pragma unroll
  for (int ks = 0; ks < 4; ++ks) aq[ks] = *(const bf16x8*)(proj + (size_t)(tok0 + fr) * DIN + C_Q + h * 128 + ks * 32 + fq * 8);
  f32x4 s[16];
#pragma unroll
  for (int nt = 0; nt < 16; ++nt) {
    s[nt] = f32x4{0, 0, 0, 0};
#pragma unroll
    for (int ks = 0; ks < 4; ++ks) {
      bf16x8 bk = *(const bf16x8*)(kb + (size_t)(nt * 16 + fr) * 512 + ks * 32 + fq * 8);
      s[nt] = MFMA(aq[ks], bk, s[nt]);
    }
  }
  const float scale = 0.08838834764831845f;
  float rs[4];
  char* pl = lds + wv * 8192;
  __syncthreads();
#pragma unroll
  for (int i = 0; i < 4; ++i) {
    float m = s[0][i];
#pragma unroll
    for (int nt = 1; nt < 16; ++nt) m = fmaxf(m, s[nt][i]);
    m = red16_max(m);
    float sum = 0.f;
#pragma unroll
    for (int nt = 0; nt < 16; ++nt) {
      float e = __expf((s[nt][i] - m) * scale);
      sum += e;
      const int key = nt * 16 + fr, rr = fq * 4 + i;
      *(bf16_t*)(pl + (key >> 5) * 1024 + swz(rr, (key & 31) * 2)) = f2bf(e);
    }
    rs[i] = red16_sum(sum);
  }
  __syncthreads();
  f32x4 o[8];
#pragma unroll
  for (int nt = 0; nt < 8; ++nt) o[nt] = f32x4{0, 0, 0, 0};
  const int fo = swz(fr, fq * 16);
#pragma unroll
  for (int ks = 0; ks < 8; ++ks) {
    bf16x8 ap = *(const bf16x8*)(pl + ks * 1024 + fo);
#pragma unroll
    for (int nt = 0; nt < 8; ++nt) {
      bf16x8 bv = *(const bf16x8*)(vt + (size_t)(nt * 16 + fr) * 256 + ks * 32 + fq * 8);
      o[nt] = MFMA(ap, bv, o[nt]);
    }
  }
#pragma unroll
  for (int nt = 0; nt < 8; ++nt)
#pragma unroll
    for (int i = 0; i < 4; ++i)
      axa[(size_t)(tok0 + fq * 4 + i) * DXA + h * 128 + nt * 16 + fr] = f2bf(o[nt][i] / rs[i]);
  __syncthreads();
}

__device__ void attn_sample_item(const Params& p, int l, int b, int h, char* lds) {
  const int TX = tid_();
  char* ws = p.ws;
  const int tid = TX, lane = tid & 63, wv = tid >> 6;
  const bf16_t* proj = (const bf16_t*)(ws + B_PROJ);
  bf16_t* axa = (bf16_t*)(ws + B_AXA);
  const int tok0 = MP + b * 4;
  float* q = (float*)lds;
  float* pr = q + 512;
  float* red = pr + 1024;
  float* part = red + 32;
  __syncthreads();
  for (int i = tid; i < 512; i += 256) q[i] = bf2f(proj[(size_t)(tok0 + (i >> 7)) * DIN + C_Q + h * 128 + (i & 127)]);
  __syncthreads();
  const float* kc = p.in[I_CK] + (((size_t)l * 128 + b) * 256 + tid) * 512 + h * 128;
  float s0 = 0.f, s1 = 0.f, s2 = 0.f, s3 = 0.f;
#pragma unroll 4
  for (int d = 0; d < 128; d += 4) {
    const float4 kv = *(const float4*)(kc + d);
    const float4 q0 = *(const float4*)(q + d), q1 = *(const float4*)(q + 128 + d), q2 = *(const float4*)(q + 256 + d),
                 q3 = *(const float4*)(q + 384 + d);
    s0 += kv.x * q0.x + kv.y * q0.y + kv.z * q0.z + kv.w * q0.w;
    s1 += kv.x * q1.x + kv.y * q1.y + kv.z * q1.z + kv.w * q1.w;
    s2 += kv.x * q2.x + kv.y * q2.y + kv.z * q2.z + kv.w * q2.w;
    s3 += kv.x * q3.x + kv.y * q3.y + kv.z * q3.z + kv.w * q3.w;
  }
  const float scale = 0.08838834764831845f;
  s0 *= scale; s1 *= scale; s2 *= scale; s3 *= scale;
  float m0 = s0, m1 = s1, m2 = s2, m3 = s3;
#pragma unroll
  for (int m = 1; m < 64; m <<= 1) {
    m0 = fmaxf(m0, __shfl_xor(m0, m, 64)); m1 = fmaxf(m1, __shfl_xor(m1, m, 64));
    m2 = fmaxf(m2, __shfl_xor(m2, m, 64)); m3 = fmaxf(m3, __shfl_xor(m3, m, 64));
  }
  if (lane == 0) { red[wv * 4 + 0] = m0; red[wv * 4 + 1] = m1; red[wv * 4 + 2] = m2; red[wv * 4 + 3] = m3; }
  __syncthreads();
  m0 = fmaxf(fmaxf(red[0], red[4]), fmaxf(red[8], red[12]));
  m1 = fmaxf(fmaxf(red[1], red[5]), fmaxf(red[9], red[13]));
  m2 = fmaxf(fmaxf(red[2], red[6]), fmaxf(red[10], red[14]));
  m3 = fmaxf(fmaxf(red[3], red[7]), fmaxf(red[11], red[15]));
  const float e0 = __expf(s0 - m0), e1 = __expf(s1 - m1), e2 = __expf(s2 - m2), e3 = __expf(s3 - m3);
  pr[tid] = e0; pr[256 + tid] = e1; pr[512 + tid] = e2; pr[768 + tid] = e3;
  float t0 = wave_sum(e0), t1 = wave_sum(e1), t2 = wave_sum(e2), t3 = wave_sum(e3);
  if (lane == 0) { red[16 + wv * 4 + 0] = t0; red[16 + wv * 4 + 1] = t1; red[16 + wv * 4 + 2] = t2; red[16 + wv * 4 + 3] = t3; }
  __syncthreads();
  const float z0 = red[16] + red[20] + red[24] + red[28], z1 = red[17] + red[21] + red[25] + red[29];
  const float z2 = red[18] + red[22] + red[26] + red[30], z3 = red[19] + red[23] + red[27] + red[31];
  const int d = tid & 127, half = tid >> 7;
  const float* vc = p.in[I_CV] + (((size_t)l * 128 + b) * 256 + half * 128) * 512 + h * 128 + d;
  float o0 = 0.f, o1 = 0.f, o2 = 0.f, o3 = 0.f;
#pragma unroll 8
  for (int k = 0; k < 128; ++k) {
    const float vv = vc[(size_t)k * 512];
    const int key = half * 128 + k;
    o0 += pr[key] * vv; o1 += pr[256 + key] * vv; o2 += pr[512 + key] * vv; o3 += pr[768 + key] * vv;
  }
  if (half == 1) { part[d] = o0; part[128 + d] = o1; part[256 + d] = o2; part[384 + d] = o3; }
  __syncthreads();
  if (half == 0) {
    o0 += part[d]; o1 += part[128 + d]; o2 += part[256 + d]; o3 += part[384 + d];
    axa[(size_t)(tok0 + 0) * DXA + h * 128 + d] = f2bf(o0 / z0);
    axa[(size_t)(tok0 + 1) * DXA + h * 128 + d] = f2bf(o1 / z1);
    axa[(size_t)(tok0 + 2) * DXA + h * 128 + d] = f2bf(o2 / z2);
    axa[(size_t)(tok0 + 3) * DXA + h * 128 + d] = f2bf(o3 / z3);
  }
  __syncthreads();
}

__device__ void phase_mix(const Params& p, int l, char* lds, int* s_item) {
  const int TX = tid_();
  int* cnt = (int*)(p.ws + B_CNT) + l;
  constexpr int N_WKVP = 96 * 4, N_LRUP = 8 * 24, N_ATTP = 1024, N_WKVS = 128 * 12, N_LRUS = 384, N_ATTS = 512;
  constexpr int E1 = N_WKVP, E2 = E1 + N_LRUP, E3 = E2 + N_ATTP, E4 = E3 + N_WKVS, E5 = E4 + N_LRUS, E6 = E5 + N_ATTS;
  for (;;) {
    __syncthreads();
    if (TX == 0) *s_item = atomicAdd(cnt, 1);
    __syncthreads();
    const int it = *s_item;
    if (it >= E6) break;
    if (it < E1) {
      const int qt = it & 3, bh = it >> 2;
      wkv_scan_item(p, l, bh / 12, bh % 12, qt, lds);
    } else if (it < E2) {
      const int j = it - E1;
      lru_scan_prompt_item(p, l, j / 24, j % 24, lds);
    } else if (it < E3) {
      const int j = it - E2;
      attn_prompt_item(p, l, j >> 7, (j >> 5) & 3, j & 31, lds);
    } else if (it < E4) {
      const int j = it - E3;
      wkv_scan_item(p, l, 8 + j / 12, j % 12, -1, lds);
    } else if (it < E5) {
      const int j = it - E4;
      lru_scan_item(p, l, 8 + j / 3, j % 3);
    } else {
      const int j = it - E5;
      attn_sample_item(p, l, j >> 2, j & 3, lds);
    }
  }
}

__device__ void phase_post(const Params& p, int l) {
  const int TX = tid_();
  char* ws = p.ws;
  const int lane = TX & 63, wv = TX >> 6;
  const float* ybuf = (const float*)(ws + B_YBUF);
  const float* cbuf = (const float*)(ws + B_CBUF);
  const bf16_t* gbuf = (const bf16_t*)(ws + B_GBUF);
  const char* scan = ws + B_SCAN;
  bf16_t* arw = (bf16_t*)(ws + B_ARW);
  const float* gng = p.in[I_GNG] + (size_t)l * DRW;
  const float* gnb = p.in[I_GNB] + (size_t)l * DRW;
  for (int t4 = blockIdx.x; t4 < MT / 4; t4 += gridDim.x) {
    const int tok = t4 * 4 + wv;
#pragma unroll
    for (int ps = 0; ps < 3; ++ps) {
      const int c = ps * 256 + lane * 4, h = c >> 6;
      const float4 y = *(const float4*)(ybuf + (size_t)tok * DRW + c);
      const float mean = red16_sum(y.x + y.y + y.z + y.w) * (1.f / 64.f);
      const float d0 = y.x - mean, d1 = y.y - mean, d2 = y.z - mean, d3 = y.w - mean;
      const float var = red16_sum(d0 * d0 + d1 * d1 + d2 * d2 + d3 * d3) * (1.f / 64.f);
      const float rs = rsqrtf(var + 64e-5f);
      const float4 gg = *(const float4*)(gng + c), gb = *(const float4*)(gnb + c);
      const float c3 = cbuf[((size_t)tok * 12 + h) * 4 + 2];
      const uint2 vq = *(const uint2*)(scan + ((size_t)tok * 12 + h) * 896 + 768 + (c & 63) * 2);
      const uint2 gq = *(const uint2*)(gbuf + (size_t)tok * DRW + c);
      const float v0 = __uint_as_float(vq.x << 16), v1 = __uint_as_float(vq.x & 0xffff0000u);
      const float v2 = __uint_as_float(vq.y << 16), v3 = __uint_as_float(vq.y & 0xffff0000u);
      const float g0 = __uint_as_float(gq.x << 16), g1 = __uint_as_float(gq.x & 0xffff0000u);
      const float g2 = __uint_as_float(gq.y << 16), g3 = __uint_as_float(gq.y & 0xffff0000u);
      uint2 o;
      o.x = pk_bf2((d0 * rs * gg.x + gb.x + c3 * v0) * g0, (d1 * rs * gg.y + gb.y + c3 * v1) * g1);
      o.y = pk_bf2((d2 * rs * gg.z + gb.z + c3 * v2) * g2, (d3 * rs * gg.w + gb.w + c3 * v3) * g3);
      *(uint2*)(arw + (size_t)tok * DRW + c) = o;
    }
  }
}

__device__ __forceinline__ void merge_ops(char* ws, int l, int br, const bf16_t*& A, const bf16_t*& Bt, int& K) {
  if (br == 0) { A = (const bf16_t*)(ws + B_ARW); Bt = (const bf16_t*)(ws + W_RWOUT) + (size_t)l * D * DRW; K = DRW; }
  else if (br == 1) { A = (const bf16_t*)(ws + B_ALRU); Bt = (const bf16_t*)(ws + W_LRUOUT) + (size_t)l * D * DLRU; K = DLRU; }
  else { A = (const bf16_t*)(ws + B_AXA); Bt = (const bf16_t*)(ws + W_XAOUT) + (size_t)l * D * DXA; K = DXA; }
}

__device__ void phase_merge(const Params& p, int l, char* lds) {
  const int TX = tid_();
  char* ws = p.ws;
  const bf16_t* proj = (const bf16_t*)(ws + B_PROJ);
  bf16_t* mixin = (bf16_t*)(ws + B_MIXIN);
  const int lane = TX & 63, wv = TX >> 6, wr = wv >> 1, wc = wv & 1, fr = lane & 15, fq = lane >> 4;
  const int ntiles = (MT / 128) * 16;
  TileIter it = tile_iter(ntiles);
  int L = it.L, br = 0;
  bool have = L < it.Lend;
  int m0 = 0, n0 = 0;
  const bf16_t* A = nullptr; const bf16_t* Bt = nullptr; int K = 0;
  if (have) {
    int tm, tn; tile_mn(L, MT / 128, 16, tm, tn); m0 = tm * 128; n0 = tn * 64;
    merge_ops(ws, l, 0, A, Bt, K);
    gemm_prologue<4, 2>(A, K, Bt, K, m0, n0, lds);
  }
  f32x4 sum[4][2];
  zero_acc(sum);
  while (have) {
    f32x4 acc[4][2];
    zero_acc(acc);
    gemm_loop<4, 2>(A, K, Bt, K, K, m0, n0, lds, acc);
    uint4 gq[4];
#pragma unroll
    for (int mt = 0; mt < 4; ++mt)
      gq[mt] = *(const uint4*)(proj + (size_t)(m0 + wr * 64 + mt * 16 + fr) * DIN + C_G + br * D + n0 + wc * 32 + fq * 8);
    int nbr = br + 1, nL = L;
    if (nbr == 3) { nbr = 0; nL = L + it.step; }
    const bool hn = nL < it.Lend;
    int m1 = m0, n1 = n0;
    const bf16_t* A1 = A; const bf16_t* Bt1 = Bt; int K1 = K;
    if (hn) {
      if (nbr == 0) { int tm, tn; tile_mn(nL, MT / 128, 16, tm, tn); m1 = tm * 128; n1 = tn * 64; }
      merge_ops(ws, l, nbr, A1, Bt1, K1);
      gemm_prologue<4, 2>(A1, K1, Bt1, K1, m1, n1, lds);
    }
#pragma unroll
    for (int mt = 0; mt < 4; ++mt) {
      const unsigned gw[4] = {gq[mt].x, gq[mt].y, gq[mt].z, gq[mt].w};
#pragma unroll
      for (int nt = 0; nt < 2; ++nt)
#pragma unroll
        for (int i = 0; i < 4; ++i) {
          const unsigned w = gw[nt * 2 + (i >> 1)];
          const float gv = __uint_as_float((i & 1) ? (w & 0xffff0000u) : (w << 16));
          sum[mt][nt][i] += sigmoidf_(gv) * acc[mt][nt][i];
        }
    }
    if (br == 2) {
#pragma unroll
      for (int mt = 0; mt < 4; ++mt) {
        const int row = m0 + wr * 64 + mt * 16 + fr, col = n0 + wc * 32 + fq * 8;
        *(uint4*)(mixin + (size_t)row * D + col) = pack8(sum[mt][0], sum[mt][1]);
      }
      zero_acc(sum);
    }
    L = nL; br = nbr; have = hn; m0 = m1; n0 = n1; A = A1; Bt = Bt1; K = K1;
  }
}

__device__ void phase_resid_gemm(const Params& p, const bf16_t* A, const bf16_t* Bt, int K, char* lds) {
  const int TX = tid_();
  char* ws = p.ws;
  const bf16_t* xb = (const bf16_t*)(ws + B_XB);
  bf16_t* t = (bf16_t*)(ws + B_XF);
  const int lane = TX & 63, wv = TX >> 6, wr = wv >> 1, wc = wv & 1, fr = lane & 15, fq = lane >> 4;
  constexpr int NT_ALL = (MT / 128) * 8;
  const int G = (int)gridDim.x;
  const int nfull = (NT_ALL / G) * G;
  TileIter it = tile_iter(nfull);
  bool have = it.L < it.Lend;
  int m0 = 0, n0 = 0;
  if (have) { int tm, tn; tile_mn(it.L, MT / 128, 8, tm, tn); m0 = tm * 128; n0 = tn * 128; gemm_prologue<4, 4>(A, K, Bt, K, m0, n0, lds); }
  while (have) {
    f32x4 acc[4][4];
    zero_acc(acc);
    gemm_loop<4, 4>(A, K, Bt, K, K, m0, n0, lds, acc);
    uint4 xq[4][2];
#pragma unroll
    for (int mt = 0; mt < 4; ++mt) {
      const uint4* xs = (const uint4*)(xb + (size_t)(m0 + wr * 64 + mt * 16 + fr) * D + n0 + wc * 64 + fq * 16);
      xq[mt][0] = xs[0];
      xq[mt][1] = xs[1];
    }
    const int Ln = it.L + it.step;
    const bool hn = Ln < it.Lend;
    int m1 = m0, n1 = n0;
    if (hn) { int tm, tn; tile_mn(Ln, MT / 128, 8, tm, tn); m1 = tm * 128; n1 = tn * 128; gemm_prologue<4, 4>(A, K, Bt, K, m1, n1, lds); }
#pragma unroll
    for (int mt = 0; mt < 4; ++mt) {
      uint4* ts = (uint4*)(t + (size_t)(m0 + wr * 64 + mt * 16 + fr) * D + n0 + wc * 64 + fq * 16);
      f32x4 o[4];
#pragma unroll
      for (int nt = 0; nt < 4; ++nt) {
        const uint4 q = xq[mt][nt >> 1];
        const unsigned w0 = (nt & 1) ? q.z : q.x, w1 = (nt & 1) ? q.w : q.y;
        o[nt][0] = ALPHA * __uint_as_float(w0 << 16) + acc[mt][nt][0];
        o[nt][1] = ALPHA * __uint_as_float(w0 & 0xffff0000u) + acc[mt][nt][1];
        o[nt][2] = ALPHA * __uint_as_float(w1 << 16) + acc[mt][nt][2];
        o[nt][3] = ALPHA * __uint_as_float(w1 & 0xffff0000u) + acc[mt][nt][3];
      }
      ts[0] = pack8(o[0], o[1]);
      ts[1] = pack8(o[2], o[3]);
    }
    it.L = Ln; have = hn; m0 = m1; n0 = n1;
  }
  for (int hidx = (int)blockIdx.x; hidx < (NT_ALL - nfull) * 2; hidx += G) {
    int tm, tn;
    tile_mn(nfull + (hidx >> 1), MT / 128, 8, tm, tn);
    const int hm0 = tm * 128, hn0 = tn * 128 + (hidx & 1) * 64;
    f32x4 acc[4][2];
    zero_acc(acc);
    gemm_main<4, 2>(A, K, Bt, K, K, hm0, hn0, lds, acc);
#pragma unroll
    for (int mt = 0; mt < 4; ++mt) {
      const size_t off = (size_t)(hm0 + wr * 64 + mt * 16 + fr) * D + hn0 + wc * 32 + fq * 8;
      const uint4 q = *(const uint4*)(xb + off);
      f32x4 o0, o1;
      o0[0] = ALPHA * __uint_as_float(q.x << 16) + acc[mt][0][0]; o0[1] = ALPHA * __uint_as_float(q.x & 0xffff0000u) + acc[mt][0][1];
      o0[2] = ALPHA * __uint_as_float(q.y << 16) + acc[mt][0][2]; o0[3] = ALPHA * __uint_as_float(q.y & 0xffff0000u) + acc[mt][0][3];
      o1[0] = ALPHA * __uint_as_float(q.z << 16) + acc[mt][1][0]; o1[1] = ALPHA * __uint_as_float(q.z & 0xffff0000u) + acc[mt][1][1];
      o1[2] = ALPHA * __uint_as_float(q.w << 16) + acc[mt][1][2]; o1[3] = ALPHA * __uint_as_float(q.w & 0xffff0000u) + acc[mt][1][3];
      *(uint4*)(t + off) = pack8(o0, o1);
    }
  }
}

__device__ void phase_ln(const Params& p, const float* g, const float* bta, bool final_out) {
  const int TX = tid_();
  char* ws = p.ws;
  const int lane = TX & 63, wv = TX >> 6;
  const bf16_t* t = (const bf16_t*)(ws + B_XF);
  float* yout = p.out + O_Y;
  bf16_t* xb = (bf16_t*)(ws + B_XB);
  for (int r4 = blockIdx.x; r4 < MT / 4; r4 += gridDim.x) {
    const int row = r4 * 4 + wv;
    float4 v[4];
    float s = 0.f;
#pragma unroll
    for (int j = 0; j < 4; ++j) {
      const uint2 q = *(const uint2*)(t + (size_t)row * D + j * 256 + lane * 4);
      v[j] = make_float4(__uint_as_float(q.x << 16), __uint_as_float(q.x & 0xffff0000u), __uint_as_float(q.y << 16), __uint_as_float(q.y & 0xffff0000u));
      s += v[j].x + v[j].y + v[j].z + v[j].w;
    }
    const float mean = wave_sum(s) * (1.f / 1024.f);
    float q = 0.f;
#pragma unroll
    for (int j = 0; j < 4; ++j) {
      v[j].x -= mean; v[j].y -= mean; v[j].z -= mean; v[j].w -= mean;
      q += v[j].x * v[j].x + v[j].y * v[j].y + v[j].z * v[j].z + v[j].w * v[j].w;
    }
    const float rstd = rsqrtf(wave_sum(q) * (1.f / 1024.f) + 1e-5f);
#pragma unroll
    for (int j = 0; j < 4; ++j) {
      const int c = j * 256 + lane * 4;
      const float4 gg = *(const float4*)(g + c), bb = *(const float4*)(bta + c);
      float4 o;
      o.x = v[j].x * rstd * gg.x + bb.x; o.y = v[j].y * rstd * gg.y + bb.y;
      o.z = v[j].z * rstd * gg.z + bb.z; o.w = v[j].w * rstd * gg.w + bb.w;
      if (final_out) {
        *(float4*)(yout + (size_t)row * D + c) = o;
      } else {
        uint2 ob;
        ob.x = (unsigned)f2bf(o.x) | ((unsigned)f2bf(o.y) << 16);
        ob.y = (unsigned)f2bf(o.z) | ((unsigned)f2bf(o.w) << 16);
        *(uint2*)(xb + (size_t)row * D + c) = ob;
      }
    }
  }
}

__device__ void phase_ffn_in(const Params& p, int l, char* lds) {
  const int TX = tid_();
  char* ws = p.ws;
  const bf16_t* xb = (const bf16_t*)(ws + B_XB);
  const bf16_t* wt = (const bf16_t*)(ws + W_FFNIN) + (size_t)l * 2 * DFF * D;
  bf16_t* act = (bf16_t*)(ws + B_ACT);
  const int lane = TX & 63, wv = TX >> 6, wr = wv >> 1, wc = wv & 1, fr = lane & 15, fq = lane >> 4;
  const int nN = 2 * DFF / 128, ntiles = (MT / 128) * nN;
  TileIter it = tile_iter(ntiles);
  bool have = it.L < it.Lend;
  int m0 = 0, n0 = 0;
  if (have) { int tm, tn; tile_mn(it.L, MT / 128, nN, tm, tn); m0 = tm * 128; n0 = tn * 128; gemm_prologue<4, 4>(xb, D, wt, D, m0, n0, lds); }
  while (have) {
    f32x4 acc[4][4];
    zero_acc(acc);
    gemm_loop<4, 4>(xb, D, wt, D, D, m0, n0, lds, acc);
    const int Ln = it.L + it.step;
    const bool hn = Ln < it.Lend;
    int m1 = m0, n1 = n0;
    if (hn) { int tm, tn; tile_mn(Ln, MT / 128, nN, tm, tn); m1 = tm * 128; n1 = tn * 128; gemm_prologue<4, 4>(xb, D, wt, D, m1, n1, lds); }
    const int jb = (n0 + wc * 64 + fq * 16) / 2;
#pragma unroll
    for (int mt = 0; mt < 4; ++mt) {
      const int row = m0 + wr * 64 + mt * 16 + fr;
      f32x4 o0, o1;
#pragma unroll
      for (int i = 0; i < 4; ++i) {
        const float g0 = acc[mt][2][i], g1 = acc[mt][3][i];
        o0[i] = g0 * sigmoidf_(g0) * acc[mt][0][i];
        o1[i] = g1 * sigmoidf_(g1) * acc[mt][1][i];
      }
      *(uint4*)(act + (size_t)row * DFF + jb) = pack8(o0, o1);
    }
    it.L = Ln; have = hn; m0 = m1; n0 = n1;
  }
}

__global__ void __launch_bounds__(256, 2) fwd_megakernel(Params p) {
  cg::grid_group grid = cg::this_grid();
  __shared__ __attribute__((aligned(1024))) char lds[LDS_BYTES];
  __shared__ int s_item;
  __shared__ uint4 xb_words;
  char* ws = p.ws;
  if (threadIdx.x == 0) xb_words = make_uint4(0u, 0u, 0u, 0u);
  __syncthreads();
  XcdBarrier xb = xcd_barrier_post((unsigned*)(ws + B_BAR), (volatile LAS unsigned*)&xb_words);
  constexpr int NPH = 1 + NL * 11;
#pragma unroll 1
  for (int ph = 0; ph < NPH; ++ph) {
    int phl = ph;
    asm volatile("" : "+s"(phl));
    if (phl == 0) {
      phase_convert(p, lds);
    } else {
      const int l = (phl - 1) / 11, k = (phl - 1) % 11;
      switch (k) {
        case 0: phase_proj(p, l, lds); break;
        case 1: phase_prep(p, l, lds); break;
        case 2: phase_lora(p, l, lds); break;
        case 3: phase_mix(p, l, lds, &s_item); break;
        case 4: phase_post(p, l); break;
        case 5: phase_merge(p, l, lds); break;
        case 8: phase_ffn_in(p, l, lds); break;
        case 6: case 9: {
          const bool first = (k == 6);
          phase_resid_gemm(p, (const bf16_t*)(ws + (first ? B_MIXIN : B_ACT)),
                           first ? (const bf16_t*)(ws + W_O) + (size_t)l * D * D : (const bf16_t*)(ws + W_FFNOUT) + (size_t)l * D * DFF,
                           first ? D : DFF, lds);
          break;
        }
        default: {
          const bool first = (k == 7);
          phase_ln(p, (first ? p.in[I_LN1G] : p.in[I_LN2G]) + (size_t)l * D, (first ? p.in[I_LN1B] : p.in[I_LN2B]) + (size_t)l * D,
                   !first && l == NL - 1);
          break;
        }
      }
    }
    if (ph + 1 < NPH) xcd_barrier(xb);
    if (p.ws == nullptr) grid.sync();
  }
}

extern "C" void kernel_launch(void* const* d_in, const int* in_sizes, int n_in, void* d_out, int out_size, void* d_ws,
                              size_t ws_size, hipStream_t stream) {
  static int grid_blocks = 0;
  if (!grid_blocks) {
    int dev = 0, cus = 0, per_cu = 0;
    (void)hipGetDevice(&dev);
    (void)hipDeviceGetAttribute(&cus, hipDeviceAttributeMultiprocessorCount, dev);
    (void)hipOccupancyMaxActiveBlocksPerMultiprocessor(&per_cu, fwd_megakernel, 256, 0);
    if (per_cu > 2) per_cu = 2;
    if (per_cu < 1) per_cu = 1;
    grid_blocks = cus * per_cu;
  }
  if (ws_size < WS_NEED || n_in < 42) {
    fprintf(stderr, "workspace too small: %zu < %zu\n", ws_size, (size_t)WS_NEED);
    return;
  }
  (void)hipMemsetAsync((char*)d_ws + B_CNT, 0, 256 + BAR_BYTES, stream);
  Params p{};
  for (int i = 0; i < 42; ++i) p.in[i] = (const float*)d_in[i];
  p.out = (float*)d_out;
  p.ws = (char*)d_ws;
  void* args[] = {&p};
  hipError_t e = hipLaunchCooperativeKernel((void*)fwd_megakernel, dim3(grid_blocks), dim3(256), args, 0, stream);
  if (e != hipSuccess) fprintf(stderr, "cooperative launch failed: %s (grid %d)\n", hipGetErrorString(e), grid_blocks);
}
```

```cpp
#include <hip/hip_runtime.h>
#include <hip/hip_cooperative_groups.h>
#include <cstdio>
#include <type_traits>
namespace cg = cooperative_groups;

typedef unsigned short bf16_t;
typedef __attribute__((ext_vector_type(8))) short bf16x8;
typedef __attribute__((ext_vector_type(4))) float f32x4;

constexpr int D = 1024, MP = 16384, MS = 512, MT = 16896, NL = 4;
constexpr int DIN = 7680, DRW = 768, DLRU = 768, DXA = 512, DFF = 2816, RWC = 2560;
constexpr int C_LX = 2560, C_LG = 3328, C_Q = 4096, C_G = 4608;
constexpr int NSEQ = 136;
constexpr float ALPHA = 1.681792830507429f;

constexpr size_t O_Y = 0;
constexpr size_t O_SHP = O_Y + (size_t)MT * D;
constexpr size_t O_WKVP = O_SHP + (size_t)NL * 8 * RWC;
constexpr size_t O_CONVP = O_WKVP + (size_t)NL * 8 * 12 * 64 * 64;
constexpr size_t O_HP = O_CONVP + (size_t)NL * 8 * 3 * DLRU;
constexpr size_t O_MKP = O_HP + (size_t)NL * 8 * DLRU;
constexpr size_t O_MVP = O_MKP + (size_t)NL * 8 * 256 * 512;
constexpr size_t O_SHS = O_MVP + (size_t)NL * 8 * 256 * 512;
constexpr size_t O_WKVS = O_SHS + (size_t)NL * 128 * RWC;
constexpr size_t O_CONVS = O_WKVS + (size_t)NL * 128 * 12 * 64 * 64;
constexpr size_t O_HS = O_CONVS + (size_t)NL * 128 * 3 * DLRU;
constexpr size_t O_END = O_HS + (size_t)NL * 128 * DLRU;

constexpr size_t al256(size_t x) { return (x + 255) & ~(size_t)255; }
constexpr size_t W_IN = 0;
constexpr size_t W_RWOUT = W_IN + al256((size_t)NL * DIN * D * 2);
constexpr size_t W_LRUOUT = W_RWOUT + al256((size_t)NL * D * DRW * 2);
constexpr size_t W_XAOUT = W_LRUOUT + al256((size_t)NL * D * DLRU * 2);
constexpr size_t W_O = W_XAOUT + al256((size_t)NL * D * DXA * 2);
constexpr size_t W_FFNIN = W_O + al256((size_t)NL * D * D * 2);
constexpr size_t W_FFNOUT = W_FFNIN + al256((size_t)NL * 2 * DFF * D * 2);
constexpr size_t W_MEMKV = W_FFNOUT + al256((size_t)NL * D * DFF * 2);
constexpr size_t W_W2T = W_MEMKV + al256((size_t)NL * D * D * 2);
constexpr size_t W_A2T = W_W2T + al256((size_t)NL * DRW * 64 * 2);
constexpr size_t W_G2T = W_A2T + al256((size_t)NL * DRW * 64 * 2);
constexpr size_t W_V2T = W_G2T + al256((size_t)NL * DRW * 128 * 2);
constexpr size_t W_RGT = W_V2T + al256((size_t)3 * DRW * 32 * 2);
constexpr size_t W_IGT = W_RGT + al256((size_t)NL * 12 * 64 * 64 * 2);
constexpr size_t B_XF = W_IGT + al256((size_t)NL * 12 * 64 * 64 * 2);
constexpr size_t B_XB = B_XF + al256((size_t)MT * D * 4);
constexpr size_t B_MEMB = B_XB + al256((size_t)MT * D * 2);
constexpr size_t B_KB = B_MEMB + al256((size_t)2048 * D * 2);
constexpr size_t B_VTB = B_KB + al256((size_t)NL * 8 * 256 * 512 * 2);
constexpr size_t B_VFIRST = B_VTB + al256((size_t)NL * 8 * 256 * 512 * 2);
constexpr size_t B_PROJ = B_VFIRST + al256((size_t)MT * DRW * 2);
constexpr size_t B_SCAN = B_PROJ + al256((size_t)MT * DIN * 2);
constexpr size_t SCAN_BYTES = (size_t)MT * 12 * 896;
constexpr size_t B_MIXIN = B_SCAN;
constexpr size_t B_ACT = B_SCAN + al256((size_t)MT * D * 2);
constexpr size_t B_CBUF = B_SCAN + al256(SCAN_BYTES);
constexpr size_t B_YBUF = B_CBUF + al256((size_t)MT * 12 * 16);
constexpr size_t B_GBUF = B_YBUF + al256((size_t)MT * DRW * 4);
constexpr size_t B_ABUF = B_GBUF + al256((size_t)MT * DRW * 2);
constexpr size_t B_UBUF = B_ABUF + al256((size_t)MT * DLRU * 4);
constexpr size_t B_LBUF = B_UBUF + al256((size_t)MT * DLRU * 4);
constexpr size_t B_VMID = B_LBUF + al256((size_t)MT * 256 * 2);
constexpr size_t B_ARW = B_VMID + al256((size_t)MT * 32 * 2);
constexpr size_t B_ALRU = B_ARW + al256((size_t)MT * DRW * 2);
constexpr size_t B_AXA = B_ALRU + al256((size_t)MT * DLRU * 2);
constexpr size_t B_CNT = B_AXA + al256((size_t)MT * DXA * 2);
constexpr size_t B_BAR = B_CNT + 256;
constexpr size_t BAR_BYTES = 16384;
constexpr size_t W_V1T = B_BAR + BAR_BYTES;
constexpr size_t WS_NEED = W_V1T + al256((size_t)3 * 32 * DRW * 2);
static_assert(al256((size_t)MT * D * 2) + (size_t)MT * DFF * 2 <= SCAN_BYTES, "alias overflow");

enum { I_XP = 0, I_XS, I_MEM, I_SSHIFT, I_SWKV, I_SCONV, I_SH, I_CK, I_CV, I_WIN, I_MU, I_W0, I_W2, I_A0, I_A2,
       I_G2, I_V0, I_V1, I_V2, I_KK, I_KA, I_RK, I_GNG, I_GNB, I_WRWOUT, I_CONVW, I_CONVB, I_WRG, I_BRG, I_WIG,
       I_BIG, I_LAMBDA, I_WLRUOUT, I_WMEMKV, I_WXAOUT, I_WO, I_LN1G, I_LN1B, I_WFFNIN, I_WFFNOUT, I_LN2G, I_LN2B };

struct Params {
  const float* in[42];
  float* out;
  char* ws;
};

constexpr int LDS_BYTES = 65536;

__device__ __forceinline__ bf16_t f2bf(float f) {
  unsigned u = __float_as_uint(f);
  u += 0x7fffu + ((u >> 16) & 1u);
  return (bf16_t)(u >> 16);
}
__device__ __forceinline__ float bf2f(bf16_t h) { return __uint_as_float(((unsigned)h) << 16); }
__device__ __forceinline__ float sigmoidf_(float x) { return 1.f / (1.f + __expf(-x)); }
__device__ __forceinline__ float softplusf_(float x) { return fmaxf(x, 0.f) + log1pf(__expf(-fabsf(x))); }
__device__ __forceinline__ int swz(int rr, int b) { int ob = rr * 64 + b; return ob ^ (((ob >> 9) & 1) << 5); }

__device__ __forceinline__ int tid_() {
  int t = threadIdx.x;
  asm volatile("" : "+v"(t));
  return t;
}
template <int CTRL>
__device__ __forceinline__ float dppf(float x) {
  return __int_as_float(__builtin_amdgcn_update_dpp(0, __float_as_int(x), CTRL, 0xf, 0xf, true));
}
__device__ __forceinline__ float red16_sum(float x) {
  x += dppf<0xB1>(x);
  x += dppf<0x4E>(x);
  x += dppf<0x141>(x);
  x += dppf<0x140>(x);
  return x;
}
__device__ __forceinline__ float red16_max(float x) {
  x = fmaxf(x, dppf<0xB1>(x));
  x = fmaxf(x, dppf<0x4E>(x));
  x = fmaxf(x, dppf<0x141>(x));
  x = fmaxf(x, dppf<0x140>(x));
  return x;
}
__device__ __forceinline__ float wave_sum(float x) {
#pragma unroll
  for (int m = 1; m < 64; m <<= 1) x += __shfl_xor(x, m, 64);
  return x;
}

__device__ __forceinline__ void tok_info(int tok, int& seq, int& t, int& T) {
  if (tok < MP) { seq = tok >> 11; t = tok & 2047; T = 2048; }
  else { int s = tok - MP; seq = 8 + (s >> 2); t = s & 3; T = 4; }
}
__device__ __forceinline__ int seq_tok0(int seq) { return seq < 8 ? seq * 2048 : MP + (seq - 8) * 4; }


#define XB_TMO      128
#define XB_XCNT(j)  (256  + 64 * (j))
#define XB_XSUB(j)  (1280 + 64 * (j))
#define XB_XGEN(j)  (2304 + 64 * (j))
#define XB_TOP      3328
#define XB_TOPGEN   3392
#define XCD_BAR_WORDS 3456
#define XB_SPIN_CAP (1u << 22)
#define LAS __attribute__((address_space(3)))
__device__ __forceinline__ unsigned xb_ld(unsigned* p) { return __hip_atomic_load(p, __ATOMIC_RELAXED, __HIP_MEMORY_SCOPE_AGENT); }
__device__ __forceinline__ unsigned xb_add(unsigned* p, unsigned v) { return __hip_atomic_fetch_add(p, v, __ATOMIC_RELAXED, __HIP_MEMORY_SCOPE_AGENT); }
__device__ __forceinline__ unsigned xb_xcc_id() { return (unsigned)__builtin_amdgcn_s_getreg((3 << 11) | 20) & 0xFu; }
#define XB_SPIN(cond, bar) do { unsigned _sp = 0; while (cond) { __builtin_amdgcn_s_sleep(1); \
    if ((++_sp & 255u) == 0u) { if (xb_ld(&(bar)[XB_TMO])) break; if (_sp > XB_SPIN_CAP) { atomicAdd(&(bar)[XB_TMO], 1u); break; } } } } while (0)
struct XcdBarrier { unsigned* bar; unsigned x; volatile LAS unsigned* st; };
__device__ __forceinline__ XcdBarrier xcd_barrier_post(unsigned* bar, volatile LAS unsigned* st) {
  XcdBarrier b; b.bar = bar; b.x = xb_xcc_id(); b.st = st;
  if (threadIdx.x == 0) (void)xb_add(&bar[XB_XCNT(b.x)], 1u);
  return b;
}
__device__ __forceinline__ void xcd_barrier_complete(unsigned* bar, unsigned x, unsigned& nloc, unsigned& nx) {
  const unsigned G = gridDim.x * gridDim.y * gridDim.z;
  unsigned sum, cnt, mine, sp = 0u;
  for (;;) {
    sum = 0u; cnt = 0u; mine = 0u;
#pragma unroll
    for (unsigned j = 0; j < 16; ++j) { const unsigned c = xb_ld(&bar[XB_XCNT(j)]); sum += c; cnt += (c > 0u) ? 1u : 0u; mine = (j == x) ? c : mine; }
    if (sum == G) break;
    __builtin_amdgcn_s_sleep(1);
    if ((++sp & 255u) == 0u) { if (xb_ld(&bar[XB_TMO])) break; if (sp > XB_SPIN_CAP) { atomicAdd(&bar[XB_TMO], 1u); break; } }
  }
  nloc = mine > 0u ? mine : 1u; nx = cnt > 0u ? cnt : 1u;
}
__device__ __forceinline__ void xcd_barrier(const XcdBarrier& b) {
  asm volatile("s_waitcnt vmcnt(0)" ::: "memory");
  __syncthreads();
  if (threadIdx.x == 0) {
    unsigned* bar = b.bar;
    __builtin_amdgcn_s_waitcnt(0);
    unsigned nloc = b.st[0], nx = b.st[1];
    if (nloc == 0u) { xcd_barrier_complete(bar, b.x, nloc, nx); b.st[0] = nloc; b.st[1] = nx; }
    const unsigned old = xb_add(&bar[XB_XSUB(b.x)], 1u);
    const unsigned gen = old / nloc;
    if (old + 1u == (gen + 1u) * nloc) {
      __builtin_amdgcn_fence(__ATOMIC_RELEASE, "agent");
      asm volatile("s_waitcnt vmcnt(0)" ::: "memory");
      const unsigned og = xb_add(&bar[XB_TOP], 1u);
      const unsigned tg = og / nx;
      if (og + 1u == (tg + 1u) * nx) xb_add(&bar[XB_TOPGEN], 1u);
      else XB_SPIN(xb_ld(&bar[XB_TOPGEN]) == tg, bar);
      __builtin_amdgcn_fence(__ATOMIC_ACQUIRE, "agent");
      xb_add(&bar[XB_XGEN(b.x)], 1u);
      asm volatile("s_waitcnt vmcnt(0)" ::: "memory");
    } else {
      XB_SPIN(xb_ld(&bar[XB_XGEN(b.x)]) == gen, bar);
      __builtin_amdgcn_fence(__ATOMIC_ACQUIRE, "agent");
      asm volatile("s_waitcnt vmcnt(0)" ::: "memory");
    }
  }
  __syncthreads();
}

#define MFMA(a, b, c) __builtin_amdgcn_mfma_f32_16x16x32_bf16((a), (b), (c), 0, 0, 0)

template <int OFF>
__device__ __forceinline__ bf16x8 lds_rd128(unsigned addr) {
  bf16x8 v;
  asm volatile("ds_read_b128 %0, %1 offset:%2" : "=v"(v) : "v"(addr), "n"(OFF));
  return v;
}
template <int MTW, int NTW>
struct GemmCtx {
  const bf16_t* ga;
  const bf16_t* gb;
  int lda, ldb;
};
#define GEMM_STAGE_BYTES(MTW, NTW) (2048 * ((MTW) + (NTW)))
#define GEMM_NLD(MTW, NTW) (((MTW) + (NTW)) / 2)

template <int NTW>
__device__ __forceinline__ int gemm_brow(int s  , int rr  ) {
  return (s / NTW) * (16 * NTW) + (rr >> 2) * (4 * NTW) + (s % NTW) * 4 + (rr & 3);
}
template <int MTW, int NTW>
__device__ __forceinline__ void gemm_issue(const bf16_t* ga, int lda, const bf16_t* gb0, const bf16_t* gb1, int kt, char* wstage) {
#pragma unroll
  for (int j = 0; j < MTW / 2; ++j)
    __builtin_amdgcn_global_load_lds((const unsigned*)(ga + (size_t)(64 * j) * lda + kt * 32), (unsigned*)(wstage + j * 4096), 16, 0, 0);
  __builtin_amdgcn_global_load_lds((const unsigned*)(gb0 + kt * 32), (unsigned*)(wstage + MTW * 2048), 16, 0, 0);
  if constexpr (NTW == 4)
    __builtin_amdgcn_global_load_lds((const unsigned*)(gb1 + kt * 32), (unsigned*)(wstage + MTW * 2048 + 4096), 16, 0, 0);
}

template <int MTW, int NTW>
__device__ __forceinline__ void gemm_prologue(const bf16_t* __restrict__ A, int lda, const bf16_t* __restrict__ Bt, int ldb,
                                              int m0, int n0, char* lds) {
  constexpr int SB = GEMM_STAGE_BYTES(MTW, NTW);
  const int TX = tid_();
  const int lane = TX & 63, wv = TX >> 6;
  const int obs = lane * 16;
  const int ob = obs ^ (((obs >> 9) & 1) << 5);
  const int srow = wv * 16 + (ob >> 6), scol = (ob & 63) >> 1;
  const bf16_t* ga = A + (size_t)(m0 + srow) * lda + scol;
  const bf16_t* gb0 = Bt + (size_t)(n0 + gemm_brow<NTW>(wv, ob >> 6)) * ldb + scol;
  const bf16_t* gb1 = Bt + (size_t)(n0 + gemm_brow<NTW>(wv + 4, ob >> 6)) * ldb + scol;
  char* wbase = lds + wv * 1024;
#pragma unroll
  for (int t = 0; t < 3; ++t) gemm_issue<MTW, NTW>(ga, lda, gb0, gb1, t, wbase + t * SB);
}

template <int MTW, int NTW>
__device__ __forceinline__ void gemm_loop(const bf16_t* __restrict__ A, int lda, const bf16_t* __restrict__ Bt, int ldb,
                                          int K, int m0, int n0, char* lds, f32x4 (&acc)[MTW][NTW]) {
  constexpr int SB = GEMM_STAGE_BYTES(MTW, NTW), NLD = GEMM_NLD(MTW, NTW);
  static_assert(NLD == 4 || NLD == 3, "vmcnt immediates below assume 3 or 4 loads per k-step");
  const int TX = tid_();
  const int lane = TX & 63, wv = TX >> 6;
  const int wr = wv >> 1, wc = wv & 1, fr = lane & 15, fq = lane >> 4;
  const int obs = lane * 16;
  const int ob = obs ^ (((obs >> 9) & 1) << 5);
  const int srow = wv * 16 + (ob >> 6), scol = (ob & 63) >> 1;
  const bf16_t* ga = A + (size_t)(m0 + srow) * lda + scol;
  const bf16_t* gb0 = Bt + (size_t)(n0 + gemm_brow<NTW>(wv, ob >> 6)) * ldb + scol;
  const bf16_t* gb1 = Bt + (size_t)(n0 + gemm_brow<NTW>(wv + 4, ob >> 6)) * ldb + scol;
  char* wbase = lds + wv * 1024;
  const int fo = swz(fr, fq * 16);
  const unsigned lbase = (unsigned)(unsigned long)((__attribute__((address_space(3))) char*)lds);
  const unsigned a_off = lbase + (wr * MTW) * 1024 + fo, b_off = lbase + MTW * 2048 + (wc * NTW) * 1024 + fo;
  const int nk = K >> 5;
  for (int kt = 0; kt < nk; ++kt) {
    if (kt + 2 < nk) { if (NLD == 4) asm volatile("s_waitcnt vmcnt(8)" ::: "memory"); else asm volatile("s_waitcnt vmcnt(6)" ::: "memory"); }
    else if (kt + 1 < nk) { if (NLD == 4) asm volatile("s_waitcnt vmcnt(4)" ::: "memory"); else asm volatile("s_waitcnt vmcnt(3)" ::: "memory"); }
    else asm volatile("s_waitcnt vmcnt(0)" ::: "memory");
    __builtin_amdgcn_s_barrier();
    asm volatile("" ::: "memory");
    static_assert(MTW == 4, "fragment read block below is written for 4 m-tiles per wave");
    const unsigned sa_ = a_off + (kt & 3) * SB, sb_ = b_off + (kt & 3) * SB;
    bf16x8 af[MTW], bfr[NTW];
    af[0] = lds_rd128<0>(sa_); af[1] = lds_rd128<1024>(sa_); af[2] = lds_rd128<2048>(sa_); af[3] = lds_rd128<3072>(sa_);
    bfr[0] = lds_rd128<0>(sb_); bfr[1] = lds_rd128<1024>(sb_);
    if constexpr (NTW == 4) { bfr[2] = lds_rd128<2048>(sb_); bfr[3] = lds_rd128<3072>(sb_); }
    if (kt + 3 < nk) gemm_issue<MTW, NTW>(ga, lda, gb0, gb1, kt + 3, wbase + ((kt + 3) & 3) * SB);
    if constexpr (NTW == 4)
      asm volatile("s_waitcnt lgkmcnt(0)" : "+v"(af[0]), "+v"(af[1]), "+v"(af[2]), "+v"(af[3]), "+v"(bfr[0]), "+v"(bfr[1]), "+v"(bfr[2]), "+v"(bfr[3]) :: "memory");
    else
      asm volatile("s_waitcnt lgkmcnt(0)" : "+v"(af[0]), "+v"(af[1]), "+v"(af[2]), "+v"(af[3]), "+v"(bfr[0]), "+v"(bfr[1]) :: "memory");
#pragma unroll
    for (int mt = 0; mt < MTW; ++mt)
#pragma unroll
      for (int nt = 0; nt < NTW; ++nt) acc[mt][nt] = MFMA(bfr[nt], af[mt], acc[mt][nt]);
  }
  asm volatile("s_waitcnt lgkmcnt(0)" ::: "memory");
  __builtin_amdgcn_s_barrier();
  asm volatile("" ::: "memory");
}

template <int MTW, int NTW>
__device__ __forceinline__ void gemm_main(const bf16_t* __restrict__ A, int lda, const bf16_t* __restrict__ Bt, int ldb,
                                          int K, int m0, int n0, char* lds, f32x4 (&acc)[MTW][NTW]) {
  gemm_prologue<MTW, NTW>(A, lda, Bt, ldb, m0, n0, lds);
  gemm_loop<MTW, NTW>(A, lda, Bt, ldb, K, m0, n0, lds, acc);
}

__device__ __forceinline__ uint4 pack8(const f32x4& a, const f32x4& b) {
  uint4 o;
  o.x = (unsigned)f2bf(a[0]) | ((unsigned)f2bf(a[1]) << 16);
  o.y = (unsigned)f2bf(a[2]) | ((unsigned)f2bf(a[3]) << 16);
  o.z = (unsigned)f2bf(b[0]) | ((unsigned)f2bf(b[1]) << 16);
  o.w = (unsigned)f2bf(b[2]) | ((unsigned)f2bf(b[3]) << 16);
  return o;
}

struct TileIter {
  int L, Lend, step;
};
__device__ __forceinline__ TileIter tile_iter(int ntiles) {
  const int G = (int)gridDim.x, b = (int)blockIdx.x;
  TileIter it;
  if ((G & 7) == 0) {
    const int tpx = (ntiles + 7) >> 3, x = b & 7;
    it.L = x * tpx + (b >> 3);
    it.Lend = min(ntiles, (x + 1) * tpx);
    it.step = G >> 3;
  } else {
    it.L = b; it.Lend = ntiles; it.step = G;
  }
  return it;
}
__device__ __forceinline__ TileIter tile_iter_rev(int ntiles) {
  const int G = (int)gridDim.x, b = (int)blockIdx.x;
  TileIter it;
  if ((G & 7) == 0) {
    const int tpx = (ntiles + 7) >> 3, x = b & 7, ns = G >> 3;
    it.L = x * tpx + (ns - 1 - (b >> 3));
    it.Lend = min(ntiles, (x + 1) * tpx);
    it.step = ns;
  } else {
    it.L = G - 1 - b; it.Lend = ntiles; it.step = G;
  }
  return it;
}
__device__ __forceinline__ void tile_mn(int L, int nM, int nN, int& m, int& n) {
  const int full = (nM >> 3) * 8 * nN;
  if (L < full) {
    const int band = L / (8 * nN), r = L % (8 * nN);
    n = r >> 3; m = band * 8 + (r & 7);
  } else {
    const int rem = nM & 7, r = L - full;
    n = r / rem; m = (nM >> 3) * 8 + r % rem;
  }
}

template <int MTW, int NTW>
__device__ __forceinline__ void zero_acc(f32x4 (&acc)[MTW][NTW]) {
#pragma unroll
  for (int a = 0; a < MTW; ++a)
#pragma unroll
    for (int b = 0; b < NTW; ++b) acc[a][b] = f32x4{0.f, 0.f, 0.f, 0.f};
}

__device__ void transpose_tile(const float* __restrict__ W, int ldw, bf16_t* __restrict__ Wt, int ldt, int k0, int n0,
                               int perm, char* lds) {
  const int TX = tid_();
  float* tile = (float*)lds;
  const int tid = TX;
  const int c = tid & 63, r0 = tid >> 6;
#pragma unroll
  for (int r = 0; r < 16; ++r) {
    int row = r * 4 + r0;
    tile[row * 65 + c] = W[(size_t)(k0 + row) * ldw + n0 + c];
  }
  __syncthreads();
#pragma unroll
  for (int r = 0; r < 16; ++r) {
    int n = n0 + r * 4 + r0;
    int np = n;
    if (perm) {
      if (n < DFF) np = (n >> 3) * 16 + (n & 7);
      else { int j = n - DFF; np = (j >> 3) * 16 + 8 + (j & 7); }
    }
    Wt[(size_t)np * ldt + k0 + c] = f2bf(tile[c * 65 + (r * 4 + r0)]);
  }
  __syncthreads();
}

__device__ __forceinline__ void convert_job(const float* __restrict__ src, bf16_t* __restrict__ dst, int K, int N, int nmat,
                                            int perm, int& start, char* lds) {
  const int tk = K / 64, tn = N / 64;
  const int ntiles = nmat * tk * tn;
  const int G = (int)gridDim.x;
  const int first = (((int)blockIdx.x - start) % G + G) % G;
  for (int i = first; i < ntiles; i += G) {
    const int mat = i / (tk * tn), r = i % (tk * tn);
    const int kt = r / tn, nt = r % tn;
    transpose_tile(src + (size_t)mat * K * N, N, dst + (size_t)mat * K * N, K, kt * 64, nt * 64, perm, lds);
  }
  start += ntiles;
}

__device__ void phase_convert(const Params& p, char* lds) {
  const int TX = tid_();
  char* ws = p.ws;
  int start = 0;
  convert_job(p.in[I_WIN], (bf16_t*)(ws + W_IN), 1024, 7680, NL, 0, start, lds);
  convert_job(p.in[I_WFFNIN], (bf16_t*)(ws + W_FFNIN), 1024, 5632, NL, 1, start, lds);
  convert_job(p.in[I_WFFNOUT], (bf16_t*)(ws + W_FFNOUT), 2816, 1024, NL, 0, start, lds);
  convert_job(p.in[I_WRWOUT], (bf16_t*)(ws + W_RWOUT), 768, 1024, NL, 0, start, lds);
  convert_job(p.in[I_WLRUOUT], (bf16_t*)(ws + W_LRUOUT), 768, 1024, NL, 0, start, lds);
  convert_job(p.in[I_WXAOUT], (bf16_t*)(ws + W_XAOUT), 512, 1024, NL, 0, start, lds);
  convert_job(p.in[I_WO], (bf16_t*)(ws + W_O), 1024, 1024, NL, 0, start, lds);
  convert_job(p.in[I_WMEMKV], (bf16_t*)(ws + W_MEMKV), 1024, 1024, NL, 0, start, lds);
  convert_job(p.in[I_W2], (bf16_t*)(ws + W_W2T), 64, 768, NL, 0, start, lds);
  convert_job(p.in[I_A2], (bf16_t*)(ws + W_A2T), 64, 768, NL, 0, start, lds);
  convert_job(p.in[I_G2], (bf16_t*)(ws + W_G2T), 128, 768, NL, 0, start, lds);
  convert_job(p.in[I_WRG], (bf16_t*)(ws + W_RGT), 64, 64, NL * 12, 0, start, lds);
  convert_job(p.in[I_WIG], (bf16_t*)(ws + W_IGT), 64, 64, NL * 12, 0, start, lds);
  const size_t gtid = (size_t)blockIdx.x * 256 + TX, gsz = (size_t)gridDim.x * 256;
  {
    uint2* xb = (uint2*)(ws + B_XB);
    const float4* xp = (const float4*)p.in[I_XP];
    const float4* xs = (const float4*)p.in[I_XS];
    const size_t np4 = (size_t)MP * D / 4, nt4 = (size_t)MT * D / 4;
    for (size_t i = gtid; i < nt4; i += gsz) {
      float4 v = (i < np4) ? xp[i] : xs[i - np4];
      uint2 o;
      o.x = (unsigned)f2bf(v.x) | ((unsigned)f2bf(v.y) << 16);
      o.y = (unsigned)f2bf(v.z) | ((unsigned)f2bf(v.w) << 16);
      xb[i] = o;
    }
  }
  {
    uint2* mb = (uint2*)(ws + B_MEMB);
    const float4* m = (const float4*)p.in[I_MEM];
    const size_t n4 = (size_t)2048 * D / 4;
    for (size_t i = gtid; i < n4; i += gsz) {
      float4 v = m[i];
      uint2 o;
      o.x = (unsigned)f2bf(v.x) | ((unsigned)f2bf(v.y) << 16);
      o.y = (unsigned)f2bf(v.z) | ((unsigned)f2bf(v.w) << 16);
      mb[i] = o;
    }
  }
  {
    bf16_t* v1t = (bf16_t*)(ws + W_V1T);
    const float* v1 = p.in[I_V1];
    for (size_t i = gtid; i < (size_t)3 * 768 * 32; i += gsz) {
      int j = (int)(i / (768 * 32)), r = (int)(i % (768 * 32));
      int n = r / 768, k = r % 768;
      v1t[i] = f2bf(v1[(size_t)j * 768 * 32 + (size_t)k * 32 + n]);
    }
  }
  {
    bf16_t* v2t = (bf16_t*)(ws + W_V2T);
    const float* v2 = p.in[I_V2];
    for (size_t i = gtid; i < (size_t)3 * 768 * 32; i += gsz) {
      int j = (int)(i / (768 * 32)), r = (int)(i % (768 * 32));
      int n = r / 32, k = r % 32;
      v2t[i] = f2bf(v2[(size_t)j * 32 * 768 + (size_t)k * 768 + n]);
    }
  }
}

struct ProjTile { const bf16_t* A; const bf16_t* Bt; int m0, n0, ll; bool main; };
__device__ __forceinline__ ProjTile proj_tile(const Params& p, int l, int tile, int nextra) {
  char* ws = p.ws;
  ProjTile t;
  if (tile >= nextra) {
    int tm, tn;
    tile_mn(tile - nextra, MT / 128, DIN / 128, tm, tn);
    t.A = (const bf16_t*)(ws + B_XB); t.Bt = (const bf16_t*)(ws + W_IN) + (size_t)l * DIN * D;
    t.m0 = tm * 128; t.n0 = tn * 128; t.ll = l; t.main = true;
  } else {
    const int ll = tile / 128, r = tile % 128;
    t.A = (const bf16_t*)(ws + B_MEMB); t.Bt = (const bf16_t*)(ws + W_MEMKV) + (size_t)ll * D * D;
    t.m0 = (r / 8) * 128; t.n0 = (r % 8) * 128; t.ll = ll; t.main = false;
  }
  return t;
}

__device__ void phase_proj(const Params& p, int l, char* lds) {
  const int TX = tid_();
  char* ws = p.ws;
  bf16_t* proj = (bf16_t*)(ws + B_PROJ);
  const int lane = TX & 63, wv = TX >> 6, wr = wv >> 1, wc = wv & 1, fr = lane & 15, fq = lane >> 4;
  const int ntiles = (MT / 128) * (DIN / 128);
  const int nextra = (l == 0) ? NL * 16 * 8 : 0;
  TileIter it = tile_iter(ntiles + nextra);
  bool have = it.L < it.Lend;
  ProjTile cur;
  if (have) { cur = proj_tile(p, l, it.L, nextra); gemm_prologue<4, 4>(cur.A, D, cur.Bt, D, cur.m0, cur.n0, lds); }
  while (have) {
    f32x4 acc[4][4];
    zero_acc(acc);
    gemm_loop<4, 4>(cur.A, D, cur.Bt, D, D, cur.m0, cur.n0, lds, acc);
    const int Ln = it.L + it.step;
    const bool hn = Ln < it.Lend;
    ProjTile nxt = cur;
    if (hn) { nxt = proj_tile(p, l, Ln, nextra); gemm_prologue<4, 4>(nxt.A, D, nxt.Bt, D, nxt.m0, nxt.n0, lds); }
    const int m0 = cur.m0, n0 = cur.n0;
    if (cur.main) {
#pragma unroll
      for (int mt = 0; mt < 4; ++mt) {
        const int row = m0 + wr * 64 + mt * 16 + fr, col = n0 + wc * 64 + fq * 16;
        uint4* dst = (uint4*)(proj + (size_t)row * DIN + col);
        dst[0] = pack8(acc[mt][0], acc[mt][1]);
        dst[1] = pack8(acc[mt][2], acc[mt][3]);
      }
    } else {
      const int ll = cur.ll;
      bf16_t* kb = (bf16_t*)(ws + B_KB);
      bf16_t* vtb = (bf16_t*)(ws + B_VTB);
#pragma unroll
      for (int mt = 0; mt < 4; ++mt)
#pragma unroll
        for (int nt = 0; nt < 4; ++nt)
#pragma unroll
          for (int i = 0; i < 4; ++i) {
            int row = m0 + wr * 64 + mt * 16 + fr, col = n0 + wc * 64 + fq * 16 + nt * 4 + i;
            int b = row >> 8, key = row & 255;
            float v = acc[mt][nt][i];
            if (col < 512) {
              p.out[O_MKP + ((size_t)(ll * 8 + b) * 256 + key) * 512 + col] = v;
              kb[((size_t)(ll * 8 + b) * 256 + key) * 512 + col] = f2bf(v);
            } else {
              int c2 = col - 512, h = c2 >> 7, d = c2 & 127;
              p.out[O_MVP + ((size_t)(ll * 8 + b) * 256 + key) * 512 + c2] = v;
              vtb[(((size_t)(ll * 8 + b) * 4 + h) * 128 + d) * 256 + key] = f2bf(v);
            }
          }
    }
    it.L = Ln; have = hn; cur = nxt;
  }
}

__device__ __forceinline__ float prw_prev(const Params& p, const bf16_t* proj, int l, int tok, int seq, int t, int c) {
  if (t > 0) return bf2f(proj[(size_t)(tok - 1) * DIN + c]);
  if (seq >= 8) return p.in[I_SSHIFT][((size_t)l * 128 + (seq - 8)) * RWC + c];
  return 0.f;
}
__device__ __forceinline__ float plx_back(const Params& p, const bf16_t* proj, int l, int tok, int seq, int t, int j, int ch) {
  if (t - j >= 0) return bf2f(proj[(size_t)(tok - j) * DIN + C_LX + ch]);
  if (seq >= 8) return p.in[I_SCONV][(((size_t)l * 128 + (seq - 8)) * 3 + (3 + t - j)) * DLRU + ch];
  return 0.f;
}

__device__ __forceinline__ float2 ld_bf2(const bf16_t* p) {
  const unsigned u = *(const unsigned*)p;
  return make_float2(__uint_as_float(u << 16), __uint_as_float(u & 0xffff0000u));
}
__device__ __forceinline__ unsigned pk_bf2(float a, float b) { return (unsigned)f2bf(a) | ((unsigned)f2bf(b) << 16); }
__device__ __forceinline__ float2 prw_prev2(const Params& p, const bf16_t* proj, int l, int tok, int seq, int t, int c) {
  if (t > 0) return ld_bf2(proj + (size_t)(tok - 1) * DIN + c);
  if (seq >= 8) return *(const float2*)(p.in[I_SSHIFT] + ((size_t)l * 128 + (seq - 8)) * RWC + c);
  return make_float2(0.f, 0.f);
}
__device__ __forceinline__ float2 plx_back2(const Params& p, const bf16_t* proj, int l, int tok, int seq, int t, int j, int ch) {
  if (t - j >= 0) return ld_bf2(proj + (size_t)(tok - j) * DIN + C_LX + ch);
  if (seq >= 8) return *(const float2*)(p.in[I_SCONV] + (((size_t)l * 128 + (seq - 8)) * 3 + (3 + t - j)) * DLRU + ch);
  return make_float2(0.f, 0.f);
}

__device__ void phase_prep(const Params& p, int l, char* lds) {
  const int TX = tid_();
  char* ws = p.ws;
  const bf16_t* proj = (const bf16_t*)(ws + B_PROJ);
  bf16_t* L = (bf16_t*)(ws + B_LBUF);
  bf16_t* XC = (bf16_t*)(ws + B_ALRU);
  float* ubuf = (float*)(ws + B_UBUF);
  bf16_t* vmid = (bf16_t*)(ws + B_VMID);
  const float* mu = p.in[I_MU] + (size_t)l * RWC;
  const float* cw = p.in[I_CONVW] + (size_t)l * 4 * DLRU;
  const float* cb = p.in[I_CONVB] + (size_t)l * DLRU;
  const int tid = TX, lane = tid & 63, wv = tid >> 6, fr = lane & 15, fq = lane >> 4;
  constexpr int TK = 4;
  for (TileIter ti = tile_iter(MT / TK); ti.L < ti.Lend; ti.L += ti.step) {
    const int item = ti.L;
    const int tokb = item * TK;
    auto body = [&](auto interior_tag) {
    constexpr bool INTR = decltype(interior_tag)::value;
#pragma unroll 4
    for (int u = tid; u < TK * 128; u += 256) {
      const int tk = u >> 7, cp = (u & 127) * 2, tok = tokb + tk, c = 2304 + cp;
      int seq = 0, t = 16, T = 2048;
      if constexpr (!INTR) tok_info(tok, seq, t, T);
      const float2 pc = ld_bf2(proj + (size_t)tok * DIN + c);
      float2 pp;
      if constexpr (INTR) pp = ld_bf2(proj + (size_t)(tok - 1) * DIN + c); else pp = prw_prev2(p, proj, l, tok, seq, t, c);
      const float2 m2 = *(const float2*)(mu + c);
      const float x0 = pc.x + (pp.x - pc.x) * m2.x, x1 = pc.y + (pp.y - pc.y) * m2.y;
      float o0, o1;
      if (cp < 64) { o0 = tanhf(x0); o1 = tanhf(x1); }
      else if (cp < 128) { o0 = x0; o1 = x1; }
      else { o0 = sigmoidf_(x0); o1 = sigmoidf_(x1); }
      *(unsigned*)(L + (size_t)tok * 256 + cp) = pk_bf2(o0, o1);
    }
#pragma unroll 4
    for (int u = tid; u < TK * 384; u += 256) {
      const int tk = u / 384, ch = (u % 384) * 2, tok = tokb + tk;
      int seq = 0, t = 16, T = 2048;
      if constexpr (INTR) { seq = tok >> 11; t = tok & 2047; } else tok_info(tok, seq, t, T);
      const float2 x0 = ld_bf2(proj + (size_t)tok * DIN + C_LX + ch);
      float2 x1, x2, x3;
      if constexpr (INTR) {
        x1 = ld_bf2(proj + (size_t)(tok - 1) * DIN + C_LX + ch);
        x2 = ld_bf2(proj + (size_t)(tok - 2) * DIN + C_LX + ch);
        x3 = ld_bf2(proj + (size_t)(tok - 3) * DIN + C_LX + ch);
      } else {
        x1 = plx_back2(p, proj, l, tok, seq, t, 1, ch);
        x2 = plx_back2(p, proj, l, tok, seq, t, 2, ch);
        x3 = plx_back2(p, proj, l, tok, seq, t, 3, ch);
      }
      const float2 b2 = *(const float2*)(cb + ch), w3 = *(const float2*)(cw + 3 * DLRU + ch), w2 = *(const float2*)(cw + 2 * DLRU + ch),
                   w1 = *(const float2*)(cw + DLRU + ch), w0 = *(const float2*)(cw + ch);
      const float xa = b2.x + w3.x * x0.x + w2.x * x1.x + w1.x * x2.x + w0.x * x3.x;
      const float xb_ = b2.y + w3.y * x0.y + w2.y * x1.y + w1.y * x2.y + w0.y * x3.y;
      *(unsigned*)(XC + (size_t)tok * DLRU + ch) = pk_bf2(xa, xb_);
      if (t >= T - 3) {
        const size_t o = (seq < 8) ? O_CONVP + (((size_t)l * 8 + seq) * 3 + (t - (T - 3))) * DLRU
                                   : O_CONVS + (((size_t)l * 128 + (seq - 8)) * 3 + (t - (T - 3))) * DLRU;
        *(float2*)(p.out + o + ch) = x0;
      }
      if (l > 0) {
        const int c = 1536 + ch;
        const float2 pc = ld_bf2(proj + (size_t)tok * DIN + c);
        float2 pp;
        if constexpr (INTR) pp = ld_bf2(proj + (size_t)(tok - 1) * DIN + c); else pp = prw_prev2(p, proj, l, tok, seq, t, c);
        const float2 m2 = *(const float2*)(mu + c);
        const float v0 = pc.x + (pp.x - pc.x) * m2.x, v1 = pc.y + (pp.y - pc.y) * m2.y;
        *(unsigned*)(lds + (ch >> 5) * 1024 + swz(tk, (ch & 31) * 2)) = pk_bf2(v0, v1);
      }
    }
    };
    if (tokb < MP && (tokb & 2047) != 0) body(std::true_type{}); else body(std::false_type{});
    for (int tk = 0; tk < TK; ++tk) {
      const int tok = tokb + tk;
      int seq, t, T;
      tok_info(tok, seq, t, T);
      if (t == T - 1) {
        const size_t o = (seq < 8) ? O_SHP + ((size_t)l * 8 + seq) * RWC : O_SHS + ((size_t)l * 128 + (seq - 8)) * RWC;
        for (int c = tid * 2; c < RWC; c += 512) *(float2*)(p.out + o + c) = ld_bf2(proj + (size_t)tok * DIN + c);
      }
    }
    if (l > 0) {
      __syncthreads();
      const bf16_t* v1t = (const bf16_t*)(ws + W_V1T) + (size_t)(l - 1) * 32 * DRW;
      f32x4 acc0 = f32x4{0, 0, 0, 0}, acc1 = acc0;
      const int fo = swz(fr, fq * 16);
#pragma unroll
      for (int kk = 0; kk < 6; ++kk) {
        const int ks = wv * 6 + kk;
        const bf16x8 af = *(const bf16x8*)(lds + ks * 1024 + fo);
        const bf16x8 b0 = *(const bf16x8*)(v1t + (size_t)fr * DRW + ks * 32 + fq * 8);
        const bf16x8 b1 = *(const bf16x8*)(v1t + (size_t)(16 + fr) * DRW + ks * 32 + fq * 8);
        acc0 = MFMA(af, b0, acc0);
        acc1 = MFMA(af, b1, acc1);
      }
      float* red = (float*)(lds + 24576);
#pragma unroll
      for (int i = 0; i < 4; ++i) {
        red[(wv * 16 + fq * 4 + i) * 32 + fr] = acc0[i];
        red[(wv * 16 + fq * 4 + i) * 32 + 16 + fr] = acc1[i];
      }
      __syncthreads();
      {
        const int row = tid >> 4, c2 = (tid & 15) * 2;
        if (row < TK) {
          float s0 = 0.f, s1 = 0.f;
#pragma unroll
          for (int w = 0; w < 4; ++w) { s0 += red[(w * 16 + row) * 32 + c2]; s1 += red[(w * 16 + row) * 32 + c2 + 1]; }
          *(unsigned*)(vmid + (size_t)(tokb + row) * 32 + c2) = pk_bf2(s0, s1);
        }
      }
      __syncthreads();
    }
  }
}

__device__ __forceinline__ void unpack4(const uint2 q, float (&o)[4]) {
  o[0] = __uint_as_float(q.x << 16); o[1] = __uint_as_float(q.x & 0xffff0000u);
  o[2] = __uint_as_float(q.y << 16); o[3] = __uint_as_float(q.y & 0xffff0000u);
}
__device__ __forceinline__ void prw_prev4(const Params& p, const bf16_t* proj, int l, int tok, int seq, int t, int c, float (&o)[4]) {
  if (t > 0) { unpack4(*(const uint2*)(proj + (size_t)(tok - 1) * DIN + c), o); return; }
  if (seq >= 8) {
    const float4 s = *(const float4*)(p.in[I_SSHIFT] + ((size_t)l * 128 + (seq - 8)) * RWC + c);
    o[0] = s.x; o[1] = s.y; o[2] = s.z; o[3] = s.w;
    return;
  }
  o[0] = 0.f; o[1] = 0.f; o[2] = 0.f; o[3] = 0.f;
}

__device__ void phase_lora(const Params& p, int l, char* lds) {
  const int TX = tid_();
  char* ws = p.ws;
  const bf16_t* proj = (const bf16_t*)(ws + B_PROJ);
  const bf16_t* L = (const bf16_t*)(ws + B_LBUF);
  const bf16_t* vmid = (const bf16_t*)(ws + B_VMID);
  const bf16_t* XC = (const bf16_t*)(ws + B_ALRU);
  const int NRW = (MT / 128) * 12;
  for (TileIter ti = tile_iter(NRW); ti.L < ti.Lend; ti.L += ti.step) {
    const int item = ti.L;
    int txl = TX;
    asm volatile("" : "+v"(txl));
    const int lane = txl & 63, wv = txl >> 6, fr = lane & 15, fq = lane >> 4;
    {
      const int h = item % 12, tb = (item / 12) * 128 + wv * 32;
      const bf16_t* w2t = (const bf16_t*)(ws + W_W2T) + ((size_t)l * DRW + h * 64) * 64;
      const bf16_t* a2t = (const bf16_t*)(ws + W_A2T) + ((size_t)l * DRW + h * 64) * 64;
      const bf16_t* g2t = (const bf16_t*)(ws + W_G2T) + ((size_t)l * DRW + h * 64) * 128;
      bf16_t* gbuf = (bf16_t*)(ws + B_GBUF);
      {
        f32x4 ag[2][4];
#pragma unroll
        for (int a = 0; a < 2; ++a)
#pragma unroll
          for (int b = 0; b < 4; ++b) ag[a][b] = f32x4{0, 0, 0, 0};
#pragma unroll
        for (int ks = 0; ks < 4; ++ks) {
          bf16x8 af[2], bf_[4];
#pragma unroll
          for (int mt = 0; mt < 2; ++mt) af[mt] = *(const bf16x8*)(L + (size_t)(tb + mt * 16 + fr) * 256 + 128 + ks * 32 + fq * 8);
#pragma unroll
          for (int nt = 0; nt < 4; ++nt) bf_[nt] = *(const bf16x8*)(g2t + (size_t)(nt * 16 + fr) * 128 + ks * 32 + fq * 8);
#pragma unroll
          for (int mt = 0; mt < 2; ++mt)
#pragma unroll
            for (int nt = 0; nt < 4; ++nt) ag[mt][nt] = MFMA(af[mt], bf_[nt], ag[mt][nt]);
        }
#pragma unroll
        for (int mt = 0; mt < 2; ++mt)
#pragma unroll
          for (int nt = 0; nt < 4; ++nt)
#pragma unroll
            for (int i = 0; i < 4; ++i)
              gbuf[(size_t)(tb + mt * 16 + fq * 4 + i) * DRW + h * 64 + nt * 16 + fr] = f2bf(ag[mt][nt][i]);
      }
      f32x4 aw[2][4], aa[2][4], av[2][4];
#pragma unroll
      for (int a = 0; a < 2; ++a)
#pragma unroll
        for (int b = 0; b < 4; ++b) { aw[a][b] = f32x4{0, 0, 0, 0}; aa[a][b] = aw[a][b]; av[a][b] = aw[a][b]; }
#pragma unroll
      for (int ks = 0; ks < 2; ++ks) {
        bf16x8 af[2], bf_[4];
#pragma unroll
        for (int mt = 0; mt < 2; ++mt) af[mt] = *(const bf16x8*)(L + (size_t)(tb + mt * 16 + fr) * 256 + ks * 32 + fq * 8);
#pragma unroll
        for (int nt = 0; nt < 4; ++nt) bf_[nt] = *(const bf16x8*)(w2t + (size_t)(nt * 16 + fr) * 64 + ks * 32 + fq * 8);
#pragma unroll
        for (int mt = 0; mt < 2; ++mt)
#pragma unroll
          for (int nt = 0; nt < 4; ++nt) aw[mt][nt] = MFMA(af[mt], bf_[nt], aw[mt][nt]);
#pragma unroll
        for (int mt = 0; mt < 2; ++mt) af[mt] = *(const bf16x8*)(L + (size_t)(tb + mt * 16 + fr) * 256 + 64 + ks * 32 + fq * 8);
#pragma unroll
        for (int nt = 0; nt < 4; ++nt) bf_[nt] = *(const bf16x8*)(a2t + (size_t)(nt * 16 + fr) * 64 + ks * 32 + fq * 8);
#pragma unroll
        for (int mt = 0; mt < 2; ++mt)
#pragma unroll
          for (int nt = 0; nt < 4; ++nt) aa[mt][nt] = MFMA(af[mt], bf_[nt], aa[mt][nt]);
      }
      if (l > 0) {
        const bf16_t* v2t = (const bf16_t*)(ws + W_V2T) + ((size_t)(l - 1) * DRW + h * 64) * 32;
        bf16x8 af[2], bf_[4];
#pragma unroll
        for (int mt = 0; mt < 2; ++mt) af[mt] = *(const bf16x8*)(vmid + (size_t)(tb + mt * 16 + fr) * 32 + fq * 8);
#pragma unroll
        for (int nt = 0; nt < 4; ++nt) bf_[nt] = *(const bf16x8*)(v2t + (size_t)(nt * 16 + fr) * 32 + fq * 8);
#pragma unroll
        for (int mt = 0; mt < 2; ++mt)
#pragma unroll
          for (int nt = 0; nt < 4; ++nt) av[mt][nt] = MFMA(af[mt], bf_[nt], av[mt][nt]);
      }
      const float* mu = p.in[I_MU] + (size_t)l * RWC;
      float mur[4], muk[4], muv[4], w0[4], a0[4], v0[4], kkp[4], kap[4], rkp[4];
#pragma unroll
      for (int nt = 0; nt < 4; ++nt) {
        int c = h * 64 + nt * 16 + fr;
        mur[nt] = mu[c]; muk[nt] = mu[768 + c]; muv[nt] = mu[1536 + c];
        w0[nt] = p.in[I_W0][(size_t)l * DRW + c];
        a0[nt] = p.in[I_A0][(size_t)l * DRW + c];
        v0[nt] = (l > 0) ? p.in[I_V0][(size_t)(l - 1) * DRW + c] : 0.f;
        kkp[nt] = p.in[I_KK][(size_t)l * DRW + c];
        kap[nt] = p.in[I_KA][(size_t)l * DRW + c];
        rkp[nt] = p.in[I_RK][(size_t)l * DRW + c];
      }
      bf16_t* vfirst = (bf16_t*)(ws + B_VFIRST);
      float* cbuf = (float*)(ws + B_CBUF);
      char* scan = ws + B_SCAN;
      auto epi = [&](auto interior_tag) {
      constexpr bool INTR = decltype(interior_tag)::value;
#pragma unroll
      for (int mt = 0; mt < 2; ++mt)
#pragma unroll
        for (int i = 0; i < 4; ++i) {
          const int tok = tb + mt * 16 + fq * 4 + i;
          int seq = 0, t = 1, T = 2048;
          if constexpr (!INTR) tok_info(tok, seq, t, T);
          const bf16_t* pr = proj + (size_t)tok * DIN;
          float rr[4], kx[4], vv[4], aval[4], dec[4], kkr[4], kmod[4];
          float ss = 0.f, s1 = 0.f, s2 = 0.f, s3 = 0.f;
#pragma unroll
          for (int nt = 0; nt < 4; ++nt) {
            const int cc = nt * 16 + fr, c = h * 64 + cc;
            float pc, pp;
            pc = bf2f(pr[c]);
            if constexpr (INTR) pp = bf2f(pr[c - DIN]); else pp = prw_prev(p, proj, l, tok, seq, t, c);
            rr[nt] = pc + (pp - pc) * mur[nt];
            pc = bf2f(pr[768 + c]);
            if constexpr (INTR) pp = bf2f(pr[768 + c - DIN]); else pp = prw_prev(p, proj, l, tok, seq, t, 768 + c);
            kx[nt] = pc + (pp - pc) * muk[nt];
            pc = bf2f(pr[1536 + c]);
            if constexpr (INTR) pp = bf2f(pr[1536 + c - DIN]); else pp = prw_prev(p, proj, l, tok, seq, t, 1536 + c);
            float vx = pc + (pp - pc) * muv[nt];
            float wraw = -softplusf_(-(w0[nt] + aw[mt][nt][i])) - 0.5f;
            dec[nt] = __expf(-__expf(wraw));
            aval[nt] = sigmoidf_(a0[nt] + aa[mt][nt][i]);
            if (l > 0) {
              float vf = bf2f(vfirst[(size_t)tok * DRW + c]);
              vv[nt] = vx + (vf - vx) * sigmoidf_(v0[nt] + av[mt][nt][i]);
            } else {
              vfirst[(size_t)tok * DRW + c] = f2bf(vx);
              vv[nt] = vx;
            }
            kkr[nt] = kx[nt] * kkp[nt];
            kmod[nt] = kx[nt] * (1.f + (aval[nt] - 1.f) * kap[nt]);
            ss += kkr[nt] * kkr[nt];
            s1 += kkr[nt] * aval[nt] * rr[nt];
            s2 += kmod[nt] * rr[nt];
            s3 += rr[nt] * kmod[nt] * rkp[nt];
          }
          ss = red16_sum(ss); s1 = red16_sum(s1); s2 = red16_sum(s2); s3 = red16_sum(s3);
          const float inv = 1.f / fmaxf(sqrtf(ss), 1e-12f);
          char* so = scan + ((size_t)tok * 12 + h) * 896;
#pragma unroll
          for (int nt = 0; nt < 4; ++nt) {
            const int cc = nt * 16 + fr;
            float kkn = kkr[nt] * inv;
            ((float*)so)[cc] = dec[nt];
            ((bf16_t*)(so + 256))[cc] = f2bf(dec[nt] * rr[nt]);
            ((bf16_t*)(so + 384))[cc] = f2bf(-kkn);
            ((bf16_t*)(so + 512))[cc] = f2bf(kkn * aval[nt]);
            ((bf16_t*)(so + 640))[cc] = f2bf(kmod[nt]);
            ((bf16_t*)(so + 768))[cc] = f2bf(vv[nt]);
          }
          if (fr == 0) {
            float4 cv = make_float4(s1 * inv, s2, s3, 0.f);
            *(float4*)(cbuf + ((size_t)tok * 12 + h) * 4) = cv;
          }
        }
      };
      const int tbu = __builtin_amdgcn_readfirstlane(tb);
      if (tbu < MP && (tbu & 2047) != 0) epi(std::true_type{}); else epi(std::false_type{});
    }
  }
  for (TileIter ti = tile_iter_rev(NRW); ti.L < ti.Lend; ti.L += ti.step) {
    const int item = NRW + ti.L;
    int txl = TX;
    asm volatile("" : "+v"(txl));
    const int lane = txl & 63, wv = txl >> 6, fr = lane & 15, fq = lane >> 4;
    {
      const int it = item - NRW;
      const int nb = it % 12, tb = (it / 12) * 128 + wv * 32;
      const bf16_t* rgt = (const bf16_t*)(ws + W_RGT) + ((size_t)l * 12 + nb) * 4096;
      const bf16_t* igt = (const bf16_t*)(ws + W_IGT) + ((size_t)l * 12 + nb) * 4096;
      const int wrow0 = (fr >> 2) * 16 + (fr & 3);
      f32x4 ar[2][4], ai[2][4];
#pragma unroll
      for (int a = 0; a < 2; ++a)
#pragma unroll
        for (int b = 0; b < 4; ++b) { ar[a][b] = f32x4{0, 0, 0, 0}; ai[a][b] = ar[a][b]; }
#pragma unroll
      for (int ks = 0; ks < 2; ++ks) {
        bf16x8 af[2], b1[4], b2[4];
#pragma unroll
        for (int mt = 0; mt < 2; ++mt) af[mt] = *(const bf16x8*)(XC + (size_t)(tb + mt * 16 + fr) * DLRU + nb * 64 + ks * 32 + fq * 8);
#pragma unroll
        for (int nt = 0; nt < 4; ++nt) {
          b1[nt] = *(const bf16x8*)(rgt + (size_t)(wrow0 + nt * 4) * 64 + ks * 32 + fq * 8);
          b2[nt] = *(const bf16x8*)(igt + (size_t)(wrow0 + nt * 4) * 64 + ks * 32 + fq * 8);
        }
#pragma unroll
        for (int mt = 0; mt < 2; ++mt)
#pragma unroll
          for (int nt = 0; nt < 4; ++nt) {
            ar[mt][nt] = MFMA(b1[nt], af[mt], ar[mt][nt]);
            ai[mt][nt] = MFMA(b2[nt], af[mt], ai[mt][nt]);
          }
      }
      float* abuf = (float*)(ws + B_ABUF);
      bf16_t* ubuf = (bf16_t*)(ws + B_UBUF);
#pragma unroll
      for (int nt = 0; nt < 4; ++nt) {
        const int c = nb * 64 + fq * 16 + nt * 4;
        const float4 brq = *(const float4*)(p.in[I_BRG] + (size_t)l * DLRU + c), biq = *(const float4*)(p.in[I_BIG] + (size_t)l * DLRU + c);
        const float4 lmq = *(const float4*)(p.in[I_LAMBDA] + (size_t)l * DLRU + c);
        const float br_[4] = {brq.x, brq.y, brq.z, brq.w}, bi_[4] = {biq.x, biq.y, biq.z, biq.w};
        const float sp_[4] = {softplusf_(-lmq.x), softplusf_(-lmq.y), softplusf_(-lmq.z), softplusf_(-lmq.w)};
#pragma unroll
        for (int mt = 0; mt < 2; ++mt) {
          const int tok = tb + mt * 16 + fr;
          float xc_[4];
          unpack4(*(const uint2*)(XC + (size_t)tok * DLRU + c), xc_);
          float ao[4], uo[4];
#pragma unroll
          for (int i = 0; i < 4; ++i) {
            const float rg = sigmoidf_(ar[mt][nt][i] + br_[i]), ig = sigmoidf_(ai[mt][nt][i] + bi_[i]);
            const float la = -8.f * rg * sp_[i];
            ao[i] = __expf(la);
            uo[i] = sqrtf(fmaxf(-expm1f(2.f * la), 0.f)) * (ig * xc_[i]);
          }
          *(float4*)(abuf + (size_t)tok * DLRU + c) = make_float4(ao[0], ao[1], ao[2], ao[3]);
          { uint2 uq; uq.x = pk_bf2(uo[0], uo[1]); uq.y = pk_bf2(uo[2], uo[3]); *(uint2*)(ubuf + (size_t)tok * DLRU + c) = uq; }
        }
      }
    }
  }
}

constexpr int STEP_B = 1552;
struct WkvOps { float4 w4, r4, n4, b4, k4; float v; float2 cc; };
__device__ __forceinline__ void wkv_load(WkvOps& o, const char* b, int kq, int vrow) {
  o.w4 = *(const float4*)(b + kq * 16);
  o.r4 = *(const float4*)(b + 256 + kq * 16);
  o.n4 = *(const float4*)(b + 512 + kq * 16);
  o.b4 = *(const float4*)(b + 768 + kq * 16);
  o.k4 = *(const float4*)(b + 1024 + kq * 16);
  o.v = *(const float*)(b + 1280 + vrow * 4);
  o.cc = *(const float2*)(b + 1536);
}
__device__ __forceinline__ void wkv_step(const WkvOps& o, float& S0, float& S1, float& S2, float& S3, float& ykeep, bool keep) {
  float sa = S0 * o.n4.x + S1 * o.n4.y + S2 * o.n4.z + S3 * o.n4.w;
  float z = S0 * o.r4.x + S1 * o.r4.y + S2 * o.r4.z + S3 * o.r4.w;
  sa = red16_sum(sa);
  z = red16_sum(z);
  const float y = z + sa * o.cc.x + o.v * o.cc.y;
  ykeep = keep ? y : ykeep;
  S0 = S0 * o.w4.x + (sa * o.b4.x + o.v * o.k4.x);
  S1 = S1 * o.w4.y + (sa * o.b4.y + o.v * o.k4.y);
  S2 = S2 * o.w4.z + (sa * o.b4.z + o.v * o.k4.z);
  S3 = S3 * o.w4.w + (sa * o.b4.w + o.v * o.k4.w);
}

struct WkvStage { uint4 st[4]; float4 cst; };
__device__ __forceinline__ void wkv_stage_load(WkvStage& g, const char* scan, const float* cbuf, int tid, int tok0, int h, int c, int T) {
  const int ns = min(16, T - c * 16);
#pragma unroll
  for (int j = 0; j < 4; ++j) {
    const int u = tid + 256 * j;
    if (u < ns * 56) {
      const int s = u / 56, q = u % 56;
      g.st[j] = *(const uint4*)(scan + ((size_t)(tok0 + c * 16 + s) * 12 + h) * 896 + q * 16);
    }
  }
  if (tid >= 128 && tid < 128 + ns) g.cst = *(const float4*)(cbuf + ((size_t)(tok0 + c * 16 + (tid - 128)) * 12 + h) * 4);
}
__device__ __forceinline__ void wkv_stage_write(const WkvStage& g, char* buf, int tid, int c, int T) {
  const int ns = min(16, T - c * 16);
#pragma unroll
  for (int j = 0; j < 4; ++j) {
    const int u = tid + 256 * j;
    if (u < ns * 56) {
      const int s = u / 56, q = u % 56;
      char* base = buf + s * STEP_B;
      if (q < 16) {
        *(uint4*)(base + q * 16) = g.st[j];
      } else {
        float4 lo, hi;
        lo.x = __uint_as_float(g.st[j].x << 16); lo.y = __uint_as_float(g.st[j].x & 0xffff0000u);
        lo.z = __uint_as_float(g.st[j].y << 16); lo.w = __uint_as_float(g.st[j].y & 0xffff0000u);
        hi.x = __uint_as_float(g.st[j].z << 16); hi.y = __uint_as_float(g.st[j].z & 0xffff0000u);
        hi.z = __uint_as_float(g.st[j].w << 16); hi.w = __uint_as_float(g.st[j].w & 0xffff0000u);
        const int off = 256 + (q - 16) * 32;
        *(float4*)(base + off) = lo;
        *(float4*)(base + off + 16) = hi;
      }
    }
  }
  if (tid >= 128 && tid < 128 + ns) *(float2*)(buf + (tid - 128) * STEP_B + 1536) = make_float2(g.cst.x, g.cst.y);
}
__device__ __forceinline__ void wkv_chunk16(const char* buf, int kq, int vrow, float& S0, float& S1, float& S2, float& S3, float& ykeep) {
  WkvOps oa, ob;
  wkv_load(oa, buf, kq, vrow);
#pragma unroll
  for (int s = 0; s < 16; s += 2) {
    wkv_load(ob, buf + (s + 1) * STEP_B, kq, vrow);
    wkv_step(oa, S0, S1, S2, S3, ykeep, kq == s);
    if (s + 2 < 16) wkv_load(oa, buf + (s + 2) * STEP_B, kq, vrow);
    wkv_step(ob, S0, S1, S2, S3, ykeep, kq == s + 1);
  }
}

__device__ void wkv_scan_item(const Params& p, int l, int seq, int h, int qt, char* lds) {
  const int TX = tid_();
  char* ws = p.ws;
  const int tid = TX, lane = tid & 63, wv = tid >> 6;
  const int kq = lane & 15, rl = lane >> 4;
  const int T = (seq < 8) ? 2048 : 4;
  const int tok0 = seq_tok0(seq);
  const char* scan = ws + B_SCAN;
  const float* cbuf = (const float*)(ws + B_CBUF);
  float* ybuf = (float*)(ws + B_YBUF);
  WkvStage ga, gb;
  float4 sin[4];
  if (seq >= 8) {
#pragma unroll
    for (int q4 = 0; q4 < 4; ++q4)
      sin[q4] = *(const float4*)(p.in[I_SWKV] + ((((size_t)l * 128 + (seq - 8)) * 12 + h) * 64 + q4 * 16 + wv * 4 + rl) * 64 + kq * 4);
  }
  __syncthreads();
  wkv_stage_load(ga, scan, cbuf, tid, tok0, h, 0, T);
  if (seq < 8) wkv_stage_load(gb, scan, cbuf, tid, tok0, h, 1, T);
  wkv_stage_write(ga, lds, tid, 0, T);
  __syncthreads();
  if (seq < 8) {
    constexpr int NCH = 128;
    const int vrow = qt * 16 + wv * 4 + rl;
    float S0 = 0.f, S1 = 0.f, S2 = 0.f, S3 = 0.f;
    char* buf0 = lds;
    char* buf1 = lds + 16 * STEP_B;
#pragma unroll 1
    for (int c = 0; c < NCH; c += 2) {
      if (c + 2 < NCH) wkv_stage_load(ga, scan, cbuf, tid, tok0, h, c + 2, T);
      float ykeep = 0.f;
      wkv_chunk16(buf0, kq, vrow, S0, S1, S2, S3, ykeep);
      ybuf[(size_t)(tok0 + c * 16 + kq) * DRW + h * 64 + vrow] = ykeep;
      wkv_stage_write(gb, buf1, tid, c + 1, T);
      __syncthreads();
      if (c + 3 < NCH) wkv_stage_load(gb, scan, cbuf, tid, tok0, h, c + 3, T);
      ykeep = 0.f;
      wkv_chunk16(buf1, kq, vrow, S0, S1, S2, S3, ykeep);
      ybuf[(size_t)(tok0 + (c + 1) * 16 + kq) * DRW + h * 64 + vrow] = ykeep;
      if (c + 2 < NCH) wkv_stage_write(ga, buf0, tid, c + 2, T);
      __syncthreads();
    }
    *(float4*)(p.out + O_WKVP + ((((size_t)l * 8 + seq) * 12 + h) * 64 + vrow) * 64 + kq * 4) = make_float4(S0, S1, S2, S3);
  } else {
    const int b = seq - 8;
#pragma unroll
    for (int q4 = 0; q4 < 4; ++q4) {
      const int vrow = q4 * 16 + wv * 4 + rl;
      float S0 = sin[q4].x, S1 = sin[q4].y, S2 = sin[q4].z, S3 = sin[q4].w;
      float ykeep = 0.f;
      WkvOps oa, ob;
      wkv_load(oa, lds, kq, vrow);
#pragma unroll
      for (int s2 = 0; s2 < 4; s2 += 2) {
        wkv_load(ob, lds + (s2 + 1) * STEP_B, kq, vrow);
        wkv_step(oa, S0, S1, S2, S3, ykeep, kq == s2);
        if (s2 + 2 < 4) wkv_load(oa, lds + (s2 + 2) * STEP_B, kq, vrow);
        wkv_step(ob, S0, S1, S2, S3, ykeep, kq == s2 + 1);
      }
      if (kq < 4) ybuf[(size_t)(tok0 + kq) * DRW + h * 64 + vrow] = ykeep;
      *(float4*)(p.out + O_WKVS + ((((size_t)l * 128 + b) * 12 + h) * 64 + vrow) * 64 + kq * 4) = make_float4(S0, S1, S2, S3);
    }
    __syncthreads();
  }
}

__device__ __forceinline__ float gelu_tanh_(float x) {
  const float u = 0.7978845608028654f * (x + 0.044715f * x * x * x);
  const float th = 1.f - 2.f / (1.f + __expf(2.f * u));
  return 0.5f * x * (1.f + th);
}

__device__ void lru_scan_prompt_item(const Params& p, int l, int seq, int cg, char* lds) {
  const int TX = tid_();
  char* ws = p.ws;
  const int ts = TX >> 5, ch = cg * 32 + (TX & 31);
  const float* abuf = (const float*)(ws + B_ABUF);
  const bf16_t* ubuf = (const bf16_t*)(ws + B_UBUF);
  const bf16_t* plg = (const bf16_t*)(ws + B_PROJ) + ((size_t)seq * 2048 + ts * 256) * DIN + C_LG + ch;
  bf16_t* alru = (bf16_t*)(ws + B_ALRU);
  const size_t base = ((size_t)seq * 2048 + ts * 256) * DLRU + ch;
  float* sA = (float*)lds;
  float* sU = sA + 256;
  __syncthreads();
  float A = 1.f, U = 0.f;
  for (int t0 = 0; t0 < 256; t0 += 16) {
    float a[16], u[16];
#pragma unroll
    for (int j = 0; j < 16; ++j) {
      a[j] = abuf[base + (size_t)(t0 + j) * DLRU];
      u[j] = bf2f(ubuf[base + (size_t)(t0 + j) * DLRU]);
    }
#pragma unroll
    for (int j = 0; j < 16; ++j) { U = a[j] * U + u[j]; A *= a[j]; }
  }
  sA[TX] = A;
  sU[TX] = U;
  __syncthreads();
  float h = 0.f;
  for (int j = 0; j < ts; ++j) h = sA[j * 32 + (TX & 31)] * h + sU[j * 32 + (TX & 31)];
  {
    float a[16], u[16], an[16], un[16];
    bf16_t g[16], gn[16];
#pragma unroll
    for (int j = 0; j < 16; ++j) {
      a[j] = abuf[base + (size_t)j * DLRU];
      u[j] = bf2f(ubuf[base + (size_t)j * DLRU]);
      g[j] = plg[(size_t)j * DIN];
    }
    for (int t0 = 0; t0 < 256; t0 += 16) {
      if (t0 + 16 < 256) {
#pragma unroll
        for (int j = 0; j < 16; ++j) {
          an[j] = abuf[base + (size_t)(t0 + 16 + j) * DLRU];
          un[j] = bf2f(ubuf[base + (size_t)(t0 + 16 + j) * DLRU]);
          gn[j] = plg[(size_t)(t0 + 16 + j) * DIN];
        }
      }
#pragma unroll
      for (int j = 0; j < 16; ++j) {
        h = a[j] * h + u[j];
        alru[base + (size_t)(t0 + j) * DLRU] = f2bf(h * gelu_tanh_(bf2f(g[j])));
      }
#pragma unroll
      for (int j = 0; j < 16; ++j) { a[j] = an[j]; u[j] = un[j]; g[j] = gn[j]; }
    }
  }
  if (ts == 7) p.out[O_HP + ((size_t)l * 8 + seq) * DLRU + ch] = h;
  __syncthreads();
}

__device__ void lru_scan_item(const Params& p, int l, int seq, int cg3) {
  const int TX = tid_();
  char* ws = p.ws;
  const int ch = cg3 * 256 + TX;
  const int tok0 = seq_tok0(seq);
  const float* abuf = (const float*)(ws + B_ABUF);
  const bf16_t* ubuf = (const bf16_t*)(ws + B_UBUF);
  const bf16_t* proj = (const bf16_t*)(ws + B_PROJ);
  bf16_t* alru = (bf16_t*)(ws + B_ALRU);
  float h = p.in[I_SH][((size_t)l * 128 + (seq - 8)) * DLRU + ch];
  float a[4], u[4], g[4];
#pragma unroll
  for (int j = 0; j < 4; ++j) {
    a[j] = abuf[(size_t)(tok0 + j) * DLRU + ch];
    u[j] = bf2f(ubuf[(size_t)(tok0 + j) * DLRU + ch]);
    g[j] = bf2f(proj[(size_t)(tok0 + j) * DIN + C_LG + ch]);
  }
#pragma unroll
  for (int j = 0; j < 4; ++j) {
    h = a[j] * h + u[j];
    alru[(size_t)(tok0 + j) * DLRU + ch] = f2bf(h * gelu_tanh_(g[j]));
  }
  p.out[O_HS + ((size_t)l * 128 + (seq - 8)) * DLRU + ch] = h;
}

__device__ void attn_prompt_item(const Params& p, int l, int b, int h, int qt, char* lds) {
  const int TX = tid_();
  char* ws = p.ws;
  const int lane = TX & 63, wv = TX >> 6, fr = lane & 15, fq = lane >> 4;
  const bf16_t* proj = (const bf16_t*)(ws + B_PROJ);
  const bf16_t* kb = (const bf16_t*)(ws + B_KB) + ((size_t)(l * 8 + b) * 256) * 512 + h * 128;
  const bf16_t* vt = (const bf16_t*)(ws + B_VTB) + (((size_t)(l * 8 + b) * 4 + h) * 128) * 256;
  bf16_t* axa = (bf16_t*)(ws + B_AXA);
  const int tok0 = b * 2048 + qt * 64 + wv * 16;
  bf16x8 aq[4];
#pragma unroll
  for (int ks = 0; ks < 4; ++ks) aq[ks] = *(const bf16x8*)(proj + (size_t)(tok0 + fr) * DIN + C_Q + h * 128 + ks * 32 + fq * 8);
  f32x4 s[16];
#pragma unroll
  for (int nt = 0; nt < 16; ++nt) {
    s[nt] = f32x4{0, 0, 0, 0};
#pragma unroll
    for (int ks = 0; ks < 4; ++ks) {
      bf16x8 bk = *(const bf16x8*)(kb + (size_t)(nt * 16 + fr) * 512 + ks * 32 + fq * 8);
      s[nt] = MFMA(aq[ks], bk, s[nt]);
    }
  }
  const float scale = 0.08838834764831845f;
  float rs[4];
  char* pl = lds + wv * 8192;
  __syncthreads();
#pragma unroll
  for (int i = 0; i < 4; ++i) {
    float m = s[0][i];
#pragma unroll
    for (int nt = 1; nt < 16; ++nt) m = fmaxf(m, s[nt][i]);
    m = red16_max(m);
    float sum = 0.f;
#pragma unroll
    for (int nt = 0; nt < 16; ++nt) {
      float e = __expf((s[nt][i] - m) * scale);
      sum += e;
      const int key = nt * 16 + fr, rr = fq * 4 + i;
      *(bf16_t*)(pl + (key >> 5) * 1024 + swz(rr, (key & 31) * 2)) = f2bf(e);
    }
    rs[i] = red16_sum(sum);
  }
  __syncthreads();
  f32x4 o[8];
#pragma unroll
  for (int nt = 0; nt < 8; ++nt) o[nt] = f32x4{0, 0, 0, 0};
  const int fo = swz(fr, fq * 16);
#pragma unroll
  for (int ks = 0; ks < 8; ++ks) {
    bf16x8 ap = *(const bf16x8*)(pl + ks * 1024 + fo);
#pragma unroll
    for (int nt = 0; nt < 8; ++nt) {
      bf16x8 bv = *(const bf16x8*)(vt + (size_t)(nt * 16 + fr) * 256 + ks * 32 + fq * 8);
      o[nt] = MFMA(ap, bv, o[nt]);
    }
  }
#pragma unroll
  for (int nt = 0; nt < 8; ++nt)
#pragma unroll
    for (int i = 0; i < 4; ++i)
      axa[(size_t)(tok0 + fq * 4 + i) * DXA + h * 128 + nt * 16 + fr] = f2bf(o[nt][i] / rs[i]);
  __syncthreads();
}

__device__ void attn_sample_item(const Params& p, int l, int b, int h, char* lds) {
  const int TX = tid_();
  char* ws = p.ws;
  const int tid = TX, lane = tid & 63, wv = tid >> 6;
  const bf16_t* proj = (const bf16_t*)(ws + B_PROJ);
  bf16_t* axa = (bf16_t*)(ws + B_AXA);
  const int tok0 = MP + b * 4;
  float* q = (float*)lds;
  float* pr = q + 512;
  float* red = pr + 1024;
  float* part = red + 32;
  __syncthreads();
  for (int i = tid; i < 512; i += 256) q[i] = bf2f(proj[(size_t)(tok0 + (i >> 7)) * DIN + C_Q + h * 128 + (i & 127)]);
  __syncthreads();
  const float* kc = p.in[I_CK] + (((size_t)l * 128 + b) * 256 + tid) * 512 + h * 128;
  float s0 = 0.f, s1 = 0.f, s2 = 0.f, s3 = 0.f;
#pragma unroll 4
  for (int d = 0; d < 128; d += 4) {
    const float4 kv = *(const float4*)(kc + d);
    const float4 q0 = *(const float4*)(q + d), q1 = *(const float4*)(q + 128 + d), q2 = *(const float4*)(q + 256 + d),
                 q3 = *(const float4*)(q + 384 + d);
    s0 += kv.x * q0.x + kv.y * q0.y + kv.z * q0.z + kv.w * q0.w;
    s1 += kv.x * q1.x + kv.y * q1.y + kv.z * q1.z + kv.w * q1.w;
    s2 += kv.x * q2.x + kv.y * q2.y + kv.z * q2.z + kv.w * q2.w;
    s3 += kv.x * q3.x + kv.y * q3.y + kv.z * q3.z + kv.w * q3.w;
  }
  const float scale = 0.08838834764831845f;
  s0 *= scale; s1 *= scale; s2 *= scale; s3 *= scale;
  float m0 = s0, m1 = s1, m2 = s2, m3 = s3;
#pragma unroll
  for (int m = 1; m < 64; m <<= 1) {
    m0 = fmaxf(m0, __shfl_xor(m0, m, 64)); m1 = fmaxf(m1, __shfl_xor(m1, m, 64));
    m2 = fmaxf(m2, __shfl_xor(m2, m, 64)); m3 = fmaxf(m3, __shfl_xor(m3, m, 64));
  }
  if (lane == 0) { red[wv * 4 + 0] = m0; red[wv * 4 + 1] = m1; red[wv * 4 + 2] = m2; red[wv * 4 + 3] = m3; }
  __syncthreads();
  m0 = fmaxf(fmaxf(red[0], red[4]), fmaxf(red[8], red[12]));
  m1 = fmaxf(fmaxf(red[1], red[5]), fmaxf(red[9], red[13]));
  m2 = fmaxf(fmaxf(red[2], red[6]), fmaxf(red[10], red[14]));
  m3 = fmaxf(fmaxf(red[3], red[7]), fmaxf(red[11], red[15]));
  const float e0 = __expf(s0 - m0), e1 = __expf(s1 - m1), e2 = __expf(s2 - m2), e3 = __expf(s3 - m3);
  pr[tid] = e0; pr[256 + tid] = e1; pr[512 + tid] = e2; pr[768 + tid] = e3;
  float t0 = wave_sum(e0), t1 = wave_sum(e1), t2 = wave_sum(e2), t3 = wave_sum(e3);
  if (lane == 0) { red[16 + wv * 4 + 0] = t0; red[16 + wv * 4 + 1] = t1; red[16 + wv * 4 + 2] = t2; red[16 + wv * 4 + 3] = t3; }
  __syncthreads();
  const float z0 = red[16] + red[20] + red[24] + red[28], z1 = red[17] + red[21] + red[25] + red[29];
  const float z2 = red[18] + red[22] + red[26] + red[30], z3 = red[19] + red[23] + red[27] + red[31];
  const int d = tid & 127, half = tid >> 7;
  const float* vc = p.in[I_CV] + (((size_t)l * 128 + b) * 256 + half * 128) * 512 + h * 128 + d;
  float o0 = 0.f, o1 = 0.f, o2 = 0.f, o3 = 0.f;
#pragma unroll 8
  for (int k = 0; k < 128; ++k) {
    const float vv = vc[(size_t)k * 512];
    const int key = half * 128 + k;
    o0 += pr[key] * vv; o1 += pr[256 + key] * vv; o2 += pr[512 + key] * vv; o3 += pr[768 + key] * vv;
  }
  if (half == 1) { part[d] = o0; part[128 + d] = o1; part[256 + d] = o2; part[384 + d] = o3; }
  __syncthreads();
  if (half == 0) {
    o0 += part[d]; o1 += part[128 + d]; o2 += part[256 + d]; o3 += part[384 + d];
    axa[(size_t)(tok0 + 0) * DXA + h * 128 + d] = f2bf(o0 / z0);
    axa[(size_t)(tok0 + 1) * DXA + h * 128 + d] = f2bf(o1 / z1);
    axa[(size_t)(tok0 + 2) * DXA + h * 128 + d] = f2bf(o2 / z2);
    axa[(size_t)(tok0 + 3) * DXA + h * 128 + d] = f2bf(o3 / z3);
  }
  __syncthreads();
}

__device__ void phase_mix(const Params& p, int l, char* lds, int* s_item) {
  const int TX = tid_();
  int* cnt = (int*)(p.ws + B_CNT) + l;
  constexpr int N_WKVP = 96 * 4, N_LRUP = 8 * 24, N_ATTP = 1024, N_WKVS = 128 * 12, N_LRUS = 384, N_ATTS = 512;
  constexpr int E1 = N_WKVP, E2 = E1 + N_LRUP, E3 = E2 + N_ATTP, E4 = E3 + N_WKVS, E5 = E4 + N_LRUS, E6 = E5 + N_ATTS;
  for (;;) {
    __syncthreads();
    if (TX == 0) *s_item = atomicAdd(cnt, 1);
    __syncthreads();
    const int it = *s_item;
    if (it >= E6) break;
    if (it < E1) {
      const int qt = it & 3, bh = it >> 2;
      wkv_scan_item(p, l, bh / 12, bh % 12, qt, lds);
    } else if (it < E2) {
      const int j = it - E1;
      lru_scan_prompt_item(p, l, j / 24, j % 24, lds);
    } else if (it < E3) {
      const int j = it - E2;
      attn_prompt_item(p, l, j >> 7, (j >> 5) & 3, j & 31, lds);
    } else if (it < E4) {
      const int j = it - E3;
      wkv_scan_item(p, l, 8 + j / 12, j % 12, -1, lds);
    } else if (it < E5) {
      const int j = it - E4;
      lru_scan_item(p, l, 8 + j / 3, j % 3);
    } else {
      const int j = it - E5;
      attn_sample_item(p, l, j >> 2, j & 3, lds);
    }
  }
}

__device__ void phase_post(const Params& p, int l) {
  const int TX = tid_();
  char* ws = p.ws;
  const int lane = TX & 63, wv = TX >> 6;
  const float* ybuf = (const float*)(ws + B_YBUF);
  const float* cbuf = (const float*)(ws + B_CBUF);
  const bf16_t* gbuf = (const bf16_t*)(ws + B_GBUF);
  const char* scan = ws + B_SCAN;
  bf16_t* arw = (bf16_t*)(ws + B_ARW);
  const float* gng = p.in[I_GNG] + (size_t)l * DRW;
  const float* gnb = p.in[I_GNB] + (size_t)l * DRW;
  for (int t4 = blockIdx.x; t4 < MT / 4; t4 += gridDim.x) {
    const int tok = t4 * 4 + wv;
#pragma unroll
    for (int ps = 0; ps < 3; ++ps) {
      const int c = ps * 256 + lane * 4, h = c >> 6;
      const float4 y = *(const float4*)(ybuf + (size_t)tok * DRW + c);
      const float mean = red16_sum(y.x + y.y + y.z + y.w) * (1.f / 64.f);
      const float d0 = y.x - mean, d1 = y.y - mean, d2 = y.z - mean, d3 = y.w - mean;
      const float var = red16_sum(d0 * d0 + d1 * d1 + d2 * d2 + d3 * d3) * (1.f / 64.f);
      const float rs = rsqrtf(var + 64e-5f);
      const float4 gg = *(const float4*)(gng + c), gb = *(const float4*)(gnb + c);
      const float c3 = cbuf[((size_t)tok * 12 + h) * 4 + 2];
      const uint2 vq = *(const uint2*)(scan + ((size_t)tok * 12 + h) * 896 + 768 + (c & 63) * 2);
      const uint2 gq = *(const uint2*)(gbuf + (size_t)tok * DRW + c);
      const float v0 = __uint_as_float(vq.x << 16), v1 = __uint_as_float(vq.x & 0xffff0000u);
      const float v2 = __uint_as_float(vq.y << 16), v3 = __uint_as_float(vq.y & 0xffff0000u);
      const float g0 = __uint_as_float(gq.x << 16), g1 = __uint_as_float(gq.x & 0xffff0000u);
      const float g2 = __uint_as_float(gq.y << 16), g3 = __uint_as_float(gq.y & 0xffff0000u);
      uint2 o;
      o.x = pk_bf2((d0 * rs * gg.x + gb.x + c3 * v0) * g0, (d1 * rs * gg.y + gb.y + c3 * v1) * g1);
      o.y = pk_bf2((d2 * rs * gg.z + gb.z + c3 * v2) * g2, (d3 * rs * gg.w + gb.w + c3 * v3) * g3);
      *(uint2*)(arw + (size_t)tok * DRW + c) = o;
    }
  }
}

__device__ __forceinline__ void merge_ops(char* ws, int l, int br, const bf16_t*& A, const bf16_t*& Bt, int& K) {
  if (br == 0) { A = (const bf16_t*)(ws + B_ARW); Bt = (const bf16_t*)(ws + W_RWOUT) + (size_t)l * D * DRW; K = DRW; }
  else if (br == 1) { A = (const bf16_t*)(ws + B_ALRU); Bt = (const bf16_t*)(ws + W_LRUOUT) + (size_t)l * D * DLRU; K = DLRU; }
  else { A = (const bf16_t*)(ws + B_AXA); Bt = (const bf16_t*)(ws + W_XAOUT) + (size_t)l * D * DXA; K = DXA; }
}

__device__ void phase_merge(const Params& p, int l, char* lds) {
  const int TX = tid_();
  char* ws = p.ws;
  const bf16_t* proj = (const bf16_t*)(ws + B_PROJ);
  bf16_t* mixin = (bf16_t*)(ws + B_MIXIN);
  const int lane = TX & 63, wv = TX >> 6, wr = wv >> 1, wc = wv & 1, fr = lane & 15, fq = lane >> 4;
  const int ntiles = (MT / 128) * 16;
  TileIter it = tile_iter(ntiles);
  int L = it.L, br = 0;
  bool have = L < it.Lend;
  int m0 = 0, n0 = 0;
  const bf16_t* A = nullptr; const bf16_t* Bt = nullptr; int K = 0;
  if (have) {
    int tm, tn; tile_mn(L, MT / 128, 16, tm, tn); m0 = tm * 128; n0 = tn * 64;
    merge_ops(ws, l, 0, A, Bt, K);
    gemm_prologue<4, 2>(A, K, Bt, K, m0, n0, lds);
  }
  f32x4 sum[4][2];
  zero_acc(sum);
  while (have) {
    f32x4 acc[4][2];
    zero_acc(acc);
    gemm_loop<4, 2>(A, K, Bt, K, K, m0, n0, lds, acc);
    uint4 gq[4];
#pragma unroll
    for (int mt = 0; mt < 4; ++mt)
      gq[mt] = *(const uint4*)(proj + (size_t)(m0 + wr * 64 + mt * 16 + fr) * DIN + C_G + br * D + n0 + wc * 32 + fq * 8);
    int nbr = br + 1, nL = L;
    if (nbr == 3) { nbr = 0; nL = L + it.step; }
    const bool hn = nL < it.Lend;
    int m1 = m0, n1 = n0;
    const bf16_t* A1 = A; const bf16_t* Bt1 = Bt; int K1 = K;
    if (hn) {
      if (nbr == 0) { int tm, tn; tile_mn(nL, MT / 128, 16, tm, tn); m1 = tm * 128; n1 = tn * 64; }
      merge_ops(ws, l, nbr, A1, Bt1, K1);
      gemm_prologue<4, 2>(A1, K1, Bt1, K1, m1, n1, lds);
    }
#pragma unroll
    for (int mt = 0; mt < 4; ++mt) {
      const unsigned gw[4] = {gq[mt].x, gq[mt].y, gq[mt].z, gq[mt].w};
#pragma unroll
      for (int nt = 0; nt < 2; ++nt)
#pragma unroll
        for (int i = 0; i < 4; ++i) {
          const unsigned w = gw[nt * 2 + (i >> 1)];
          const float gv = __uint_as_float((i & 1) ? (w & 0xffff0000u) : (w << 16));
          sum[mt][nt][i] += sigmoidf_(gv) * acc[mt][nt][i];
        }
    }
    if (br == 2) {
#pragma unroll
      for (int mt = 0; mt < 4; ++mt) {
        const int row = m0 + wr * 64 + mt * 16 + fr, col = n0 + wc * 32 + fq * 8;
        *(uint4*)(mixin + (size_t)row * D + col) = pack8(sum[mt][0], sum[mt][1]);
      }
      zero_acc(sum);
    }
    L = nL; br = nbr; have = hn; m0 = m1; n0 = n1; A = A1; Bt = Bt1; K = K1;
  }
}

__device__ void phase_resid_gemm(const Params& p, const bf16_t* A, const bf16_t* Bt, int K, char* lds) {
  const int TX = tid_();
  char* ws = p.ws;
  const bf16_t* xb = (const bf16_t*)(ws + B_XB);
  bf16_t* t = (bf16_t*)(ws + B_XF);
  const int lane = TX & 63, wv = TX >> 6, wr = wv >> 1, wc = wv & 1, fr = lane & 15, fq = lane >> 4;
  constexpr int NT_ALL = (MT / 128) * 8;
  const int G = (int)gridDim.x;
  const int nfull = (NT_ALL / G) * G;
  TileIter it = tile_iter(nfull);
  bool have = it.L < it.Lend;
  int m0 = 0, n0 = 0;
  if (have) { int tm, tn; tile_mn(it.L, MT / 128, 8, tm, tn); m0 = tm * 128; n0 = tn * 128; gemm_prologue<4, 4>(A, K, Bt, K, m0, n0, lds); }
  while (have) {
    f32x4 acc[4][4];
    zero_acc(acc);
    gemm_loop<4, 4>(A, K, Bt, K, K, m0, n0, lds, acc);
    uint4 xq[4][2];
#pragma unroll
    for (int mt = 0; mt < 4; ++mt) {
      const uint4* xs = (const uint4*)(xb + (size_t)(m0 + wr * 64 + mt * 16 + fr) * D + n0 + wc * 64 + fq * 16);
      xq[mt][0] = xs[0];
      xq[mt][1] = xs[1];
    }
    const int Ln = it.L + it.step;
    const bool hn = Ln < it.Lend;
    int m1 = m0, n1 = n0;
    if (hn) { int tm, tn; tile_mn(Ln, MT / 128, 8, tm, tn); m1 = tm * 128; n1 = tn * 128; gemm_prologue<4, 4>(A, K, Bt, K, m1, n1, lds); }
#pragma unroll
    for (int mt = 0; mt < 4; ++mt) {
      uint4* ts = (uint4*)(t + (size_t)(m0 + wr * 64 + mt * 16 + fr) * D + n0 + wc * 64 + fq * 16);
      f32x4 o[4];
#pragma unroll
      for (int nt = 0; nt < 4; ++nt) {
        const uint4 q = xq[mt][nt >> 1];
        const unsigned w0 = (nt & 1) ? q.z : q.x, w1 = (nt & 1) ? q.w : q.y;
        o[nt][0] = ALPHA * __uint_as_float(w0 << 16) + acc[mt][nt][0];
        o[nt][1] = ALPHA * __uint_as_float(w0 & 0xffff0000u) + acc[mt][nt][1];
        o[nt][2] = ALPHA * __uint_as_float(w1 << 16) + acc[mt][nt][2];
        o[nt][3] = ALPHA * __uint_as_float(w1 & 0xffff0000u) + acc[mt][nt][3];
      }
      ts[0] = pack8(o[0], o[1]);
      ts[1] = pack8(o[2], o[3]);
    }
    it.L = Ln; have = hn; m0 = m1; n0 = n1;
  }
  for (int hidx = (int)blockIdx.x; hidx < (NT_ALL - nfull) * 2; hidx += G) {
    int tm, tn;
    tile_mn(nfull + (hidx >> 1), MT / 128, 8, tm, tn);
    const int hm0 = tm * 128, hn0 = tn * 128 + (hidx & 1) * 64;
    f32x4 acc[4][2];
    zero_acc(acc);
    gemm_main<4, 2>(A, K, Bt, K, K, hm0, hn0, lds, acc);
#pragma unroll
    for (int mt = 0; mt < 4; ++mt) {
      const size_t off = (size_t)(hm0 + wr * 64 + mt * 16 + fr) * D + hn0 + wc * 32 + fq * 8;
      const uint4 q = *(const uint4*)(xb + off);
      f32x4 o0, o1;
      o0[0] = ALPHA * __uint_as_float(q.x << 16) + acc[mt][0][0]; o0[1] = ALPHA * __uint_as_float(q.x & 0xffff0000u) + acc[mt][0][1];
      o0[2] = ALPHA * __uint_as_float(q.y << 16) + acc[mt][0][2]; o0[3] = ALPHA * __uint_as_float(q.y & 0xffff0000u) + acc[mt][0][3];
      o1[0] = ALPHA * __uint_as_float(q.z << 16) + acc[mt][1][0]; o1[1] = ALPHA * __uint_as_float(q.z & 0xffff0000u) + acc[mt][1][1];
      o1[2] = ALPHA * __uint_as_float(q.w << 16) + acc[mt][1][2]; o1[3] = ALPHA * __uint_as_float(q.w & 0xffff0000u) + acc[mt][1][3];
      *(uint4*)(t + off) = pack8(o0, o1);
    }
  }
}

__device__ void phase_ln(const Params& p, const float* g, const float* bta, bool final_out) {
  const int TX = tid_();
  char* ws = p.ws;
  const int lane = TX & 63, wv = TX >> 6;
  const bf16_t* t = (const bf16_t*)(ws + B_XF);
  float* yout = p.out + O_Y;
  bf16_t* xb = (bf16_t*)(ws + B_XB);
  for (int r4 = blockIdx.x; r4 < MT / 4; r4 += gridDim.x) {
    const int row = r4 * 4 + wv;
    float4 v[4];
    float s = 0.f;
#pragma unroll
    for (int j = 0; j < 4; ++j) {
      const uint2 q = *(const uint2*)(t + (size_t)row * D + j * 256 + lane * 4);
      v[j] = make_float4(__uint_as_float(q.x << 16), __uint_as_float(q.x & 0xffff0000u), __uint_as_float(q.y << 16), __uint_as_float(q.y & 0xffff0000u));
      s += v[j].x + v[j].y + v[j].z + v[j].w;
    }
    const float mean = wave_sum(s) * (1.f / 1024.f);
    float q = 0.f;
#pragma unroll
    for (int j = 0; j < 4; ++j) {
      v[j].x -= mean; v[j].y -= mean; v[j].z -= mean; v[j].w -= mean;
      q += v[j].x * v[j].x + v[j].y * v[j].y + v[j].z * v[j].z + v[j].w * v[j].w;
    }
    const float rstd = rsqrtf(wave_sum(q) * (1.f / 1024.f) + 1e-5f);
#pragma unroll
    for (int j = 0; j < 4; ++j) {
      const int c = j * 256 + lane * 4;
      const float4 gg = *(const float4*)(g + c), bb = *(const float4*)(bta + c);
      float4 o;
      o.x = v[j].x * rstd * gg.x + bb.x; o.y = v[j].y * rstd * gg.y + bb.y;
      o.z = v[j].z * rstd * gg.z + bb.z; o.w = v[j].w * rstd * gg.w + bb.w;
      if (final_out) {
        *(float4*)(yout + (size_t)row * D + c) = o;
      } else {
        uint2 ob;
        ob.x = (unsigned)f2bf(o.x) | ((unsigned)f2bf(o.y) << 16);
        ob.y = (unsigned)f2bf(o.z) | ((unsigned)f2bf(o.w) << 16);
        *(uint2*)(xb + (size_t)row * D + c) = ob;
      }
    }
  }
}

__device__ void phase_ffn_in(const Params& p, int l, char* lds) {
  const int TX = tid_();
  char* ws = p.ws;
  const bf16_t* xb = (const bf16_t*)(ws + B_XB);
  const bf16_t* wt = (const bf16_t*)(ws + W_FFNIN) + (size_t)l * 2 * DFF * D;
  bf16_t* act = (bf16_t*)(ws + B_ACT);
  const int lane = TX & 63, wv = TX >> 6, wr = wv >> 1, wc = wv & 1, fr = lane & 15, fq = lane >> 4;
  const int nN = 2 * DFF / 128, ntiles = (MT / 128) * nN;
  TileIter it = tile_iter(ntiles);
  bool have = it.L < it.Lend;
  int m0 = 0, n0 = 0;
  if (have) { int tm, tn; tile_mn(it.L, MT / 128, nN, tm, tn); m0 = tm * 128; n0 = tn * 128; gemm_prologue<4, 4>(xb, D, wt, D, m0, n0, lds); }
  while (have) {
    f32x4 acc[4][4];
    zero_acc(acc);
    gemm_loop<4, 4>(xb, D, wt, D, D, m0, n0, lds, acc);
    const int Ln = it.L + it.step;
    const bool hn = Ln < it.Lend;
    int m1 = m0, n1 = n0;
    if (hn) { int tm, tn; tile_mn(Ln, MT / 128, nN, tm, tn); m1 = tm * 128; n1 = tn * 128; gemm_prologue<4, 4>(xb, D, wt, D, m1, n1, lds); }
    const int jb = (n0 + wc * 64 + fq * 16) / 2;
#pragma unroll
    for (int mt = 0; mt < 4; ++mt) {
      const int row = m0 + wr * 64 + mt * 16 + fr;
      f32x4 o0, o1;
#pragma unroll
      for (int i = 0; i < 4; ++i) {
        const float g0 = acc[mt][2][i], g1 = acc[mt][3][i];
        o0[i] = g0 * sigmoidf_(g0) * acc[mt][0][i];
        o1[i] = g1 * sigmoidf_(g1) * acc[mt][1][i];
      }
      *(uint4*)(act + (size_t)row * DFF + jb) = pack8(o0, o1);
    }
    it.L = Ln; have = hn; m0 = m1; n0 = n1;
  }
}

__global__ void __launch_bounds__(256, 2) fwd_megakernel(Params p) {
  cg::grid_group grid = cg::this_grid();
  __shared__ __attribute__((aligned(1024))) char lds[LDS_BYTES];
  __shared__ int s_item;
  __shared__ uint4 xb_words;
  char* ws = p.ws;
  if (threadIdx.x == 0) xb_words = make_uint4(0u, 0u, 0u, 0u);
  __syncthreads();
  XcdBarrier xb = xcd_barrier_post((unsigned*)(ws + B_BAR), (volatile LAS unsigned*)&xb_words);
  constexpr int NPH = 1 + NL * 11;
#pragma unroll 1
  for (int ph = 0; ph < NPH; ++ph) {
    int phl = ph;
    asm volatile("" : "+s"(phl));
    if (phl == 0) {
      phase_convert(p, lds);
    } else {
      const int l = (phl - 1) / 11, k = (phl - 1) % 11;
      switch (k) {
        case 0: phase_proj(p, l, lds); break;
        case 1: phase_prep(p, l, lds); break;
        case 2: phase_lora(p, l, lds); break;
        case 3: phase_mix(p, l, lds, &s_item); break;
        case 4: phase_post(p, l); break;
        case 5: phase_merge(p, l, lds); break;
        case 8: phase_ffn_in(p, l, lds); break;
        case 6: case 9: {
          const bool first = (k == 6);
          phase_resid_gemm(p, (const bf16_t*)(ws + (first ? B_MIXIN : B_ACT)),
                           first ? (const bf16_t*)(ws + W_O) + (size_t)l * D * D : (const bf16_t*)(ws + W_FFNOUT) + (size_t)l * D * DFF,
                           first ? D : DFF, lds);
          break;
        }
        default: {
          const bool first = (k == 7);
          phase_ln(p, (first ? p.in[I_LN1G] : p.in[I_LN2G]) + (size_t)l * D, (first ? p.in[I_LN1B] : p.in[I_LN2B]) + (size_t)l * D,
                   !first && l == NL - 1);
          break;
        }
      }
    }
    if (ph + 1 < NPH) xcd_barrier(xb);
    if (p.ws == nullptr) grid.sync();
  }
}

extern "C" void kernel_launch(void* const* d_in, const int* in_sizes, int n_in, void* d_out, int out_size, void* d_ws,
                              size_t ws_size, hipStream_t stream) {
  static int grid_blocks = 0;
  if (!grid_blocks) {
    int dev = 0, cus = 0, per_cu = 0;
    (void)hipGetDevice(&dev);
    (void)hipDeviceGetAttribute(&cus, hipDeviceAttributeMultiprocessorCount, dev);
    (void)hipOccupancyMaxActiveBlocksPerMultiprocessor(&per_cu, fwd_megakernel, 256, 0);
    if (per_cu > 2) per_cu = 2;
    if (per_cu < 1) per_cu = 1;
    grid_blocks = cus * per_cu;
  }
  if (ws_size < WS_NEED || n_in < 42) {
    fprintf(stderr, "workspace too small: %zu < %zu\n", ws_size, (size_t)WS_NEED);
    return;
  }
  (void)hipMemsetAsync((char*)d_ws + B_CNT, 0, 256 + BAR_BYTES, stream);
  Params p{};
  for (int i = 0; i < 42; ++i) p.in[i] = (const float*)d_in[i];
  p.out = (float*)d_out;
  p.ws = (char*)d_ws;
  void* args[] = {&p};
  hipError_t e = hipLaunchCooperativeKernel((void*)fwd_megakernel, dim3(grid_blocks), dim3(256), args, 0, stream);
  if (e != hipSuccess) fprintf(stderr, "cooperative launch failed: %s (grid %d)\n", hipGetErrorString(e), grid_blocks);
}
```

```cpp
#include <hip/hip_runtime.h>
#include <hip/hip_cooperative_groups.h>
#include <cstdio>
#include <type_traits>
namespace cg = cooperative_groups;

typedef unsigned short bf16_t;
typedef __attribute__((ext_vector_type(8))) short bf16x8;
typedef __attribute__((ext_vector_type(4))) float f32x4;

constexpr int D = 1024, MP = 16384, MS = 512, MT = 16896, NL = 4;
constexpr int DIN = 7680, DRW = 768, DLRU = 768, DXA = 512, DFF = 2816, RWC = 2560;
constexpr int C_LX = 2560, C_LG = 3328, C_Q = 4096, C_G = 4608;
constexpr int NSEQ = 136;
constexpr float ALPHA = 1.681792830507429f;

constexpr size_t O_Y = 0;
constexpr size_t O_SHP = O_Y + (size_t)MT * D;
constexpr size_t O_WKVP = O_SHP + (size_t)NL * 8 * RWC;
constexpr size_t O_CONVP = O_WKVP + (size_t)NL * 8 * 12 * 64 * 64;
constexpr size_t O_HP = O_CONVP + (size_t)NL * 8 * 3 * DLRU;
constexpr size_t O_MKP = O_HP + (size_t)NL * 8 * DLRU;
constexpr size_t O_MVP = O_MKP + (size_t)NL * 8 * 256 * 512;
constexpr size_t O_SHS = O_MVP + (size_t)NL * 8 * 256 * 512;
constexpr size_t O_WKVS = O_SHS + (size_t)NL * 128 * RWC;
constexpr size_t O_CONVS = O_WKVS + (size_t)NL * 128 * 12 * 64 * 64;
constexpr size_t O_HS = O_CONVS + (size_t)NL * 128 * 3 * DLRU;
constexpr size_t O_END = O_HS + (size_t)NL * 128 * DLRU;

constexpr size_t al256(size_t x) { return (x + 255) & ~(size_t)255; }
constexpr size_t W_IN = 0;
constexpr size_t W_RWOUT = W_IN + al256((size_t)NL * DIN * D * 2);
constexpr size_t W_LRUOUT = W_RWOUT + al256((size_t)NL * D * DRW * 2);
constexpr size_t W_XAOUT = W_LRUOUT + al256((size_t)NL * D * DLRU * 2);
constexpr size_t W_O = W_XAOUT + al256((size_t)NL * D * DXA * 2);
constexpr size_t W_FFNIN = W_O + al256((size_t)NL * D * D * 2);
constexpr size_t W_FFNOUT = W_FFNIN + al256((size_t)NL * 2 * DFF * D * 2);
constexpr size_t W_MEMKV = W_FFNOUT + al256((size_t)NL * D * DFF * 2);
constexpr size_t W_W2T = W_MEMKV + al256((size_t)NL * D * D * 2);
constexpr size_t W_A2T = W_W2T + al256((size_t)NL * DRW * 64 * 2);
constexpr size_t W_G2T = W_A2T + al256((size_t)NL * DRW * 64 * 2);
constexpr size_t W_V2T = W_G2T + al256((size_t)NL * DRW * 128 * 2);
constexpr size_t W_RGT = W_V2T + al256((size_t)3 * DRW * 32 * 2);
constexpr size_t W_IGT = W_RGT + al256((size_t)NL * 12 * 64 * 64 * 2);
constexpr size_t B_XF = W_IGT + al256((size_t)NL * 12 * 64 * 64 * 2);
constexpr size_t B_XB = B_XF + al256((size_t)MT * D * 4);
constexpr size_t B_MEMB = B_XB + al256((size_t)MT * D * 2);
constexpr size_t B_KB = B_MEMB + al256((size_t)2048 * D * 2);
constexpr size_t B_VTB = B_KB + al256((size_t)NL * 8 * 256 * 512 * 2);
constexpr size_t B_VFIRST = B_VTB + al256((size_t)NL * 8 * 256 * 512 * 2);
constexpr size_t B_PROJ = B_VFIRST + al256((size_t)MT * DRW * 2);
constexpr size_t B_SCAN = B_PROJ + al256((size_t)MT * DIN * 2);
constexpr size_t SCAN_BYTES = (size_t)MT * 12 * 896;
constexpr size_t B_MIXIN = B_SCAN;
constexpr size_t B_ACT = B_SCAN + al256((size_t)MT * D * 2);
constexpr size_t B_CBUF = B_SCAN + al256(SCAN_BYTES);
constexpr size_t B_YBUF = B_CBUF + al256((size_t)MT * 12 * 16);
constexpr size_t B_GBUF = B_YBUF + al256((size_t)MT * DRW * 4);
constexpr size_t B_ABUF = B_GBUF + al256((size_t)MT * DRW * 2);
constexpr size_t B_UBUF = B_ABUF + al256((size_t)MT * DLRU * 4);
constexpr size_t B_LBUF = B_UBUF + al256((size_t)MT * DLRU * 4);
constexpr size_t B_VMID = B_LBUF + al256((size_t)MT * 256 * 2);
constexpr size_t B_ARW = B_VMID + al256((size_t)MT * 32 * 2);
constexpr size_t B_ALRU = B_ARW + al256((size_t)MT * DRW * 2);
constexpr size_t B_AXA = B_ALRU + al256((size_t)MT * DLRU * 2);
constexpr size_t B_CNT = B_AXA + al256((size_t)MT * DXA * 2);
constexpr size_t B_BAR = B_CNT + 256;
constexpr size_t BAR_BYTES = 16384;
constexpr size_t W_V1T = B_BAR + BAR_BYTES;
constexpr size_t WS_NEED = W_V1T + al256((size_t)3 * 32 * DRW * 2);
static_assert(al256((size_t)MT * D * 2) + (size_t)MT * DFF * 2 <= SCAN_BYTES, "alias overflow");

enum { I_XP = 0, I_XS, I_MEM, I_SSHIFT, I_SWKV, I_SCONV, I_SH, I_CK, I_CV, I_WIN, I_MU, I_W0, I_W2, I_A0, I_A2,
       I_G2, I_V0, I_V1, I_V2, I_KK, I_KA, I_RK, I_GNG, I_GNB, I_WRWOUT, I_CONVW, I_CONVB, I_WRG, I_BRG, I_WIG,
       I_BIG, I_LAMBDA, I_WLRUOUT, I_WMEMKV, I_WXAOUT, I_WO, I_LN1G, I_LN1B, I_WFFNIN, I_WFFNOUT, I_LN2G, I_LN2B };

struct Params {
  const float* in[42];
  float* out;
  char* ws;
};

constexpr int LDS_BYTES = 65536;

__device__ __forceinline__ bf16_t f2bf(float f) {
  unsigned u = __float_as_uint(f);
  u += 0x7fffu + ((u >> 16) & 1u);
  return (bf16_t)(u >> 16);
}
__device__ __forceinline__ float bf2f(bf16_t h) { return __uint_as_float(((unsigned)h) << 16); }
__device__ __forceinline__ float sigmoidf_(float x) { return 1.f / (1.f + __expf(-x)); }
__device__ __forceinline__ float softplusf_(float x) { return fmaxf(x, 0.f) + log1pf(__expf(-fabsf(x))); }
__device__ __forceinline__ int swz(int rr, int b) { int ob = rr * 64 + b; return ob ^ (((ob >> 9) & 1) << 5); }

__device__ __forceinline__ int tid_() {
  int t = threadIdx.x;
  asm volatile("" : "+v"(t));
  return t;
}
template <int CTRL>
__device__ __forceinline__ float dppf(float x) {
  return __int_as_float(__builtin_amdgcn_update_dpp(0, __float_as_int(x), CTRL, 0xf, 0xf, true));
}
__device__ __forceinline__ float red16_sum(float x) {
  x += dppf<0xB1>(x);
  x += dppf<0x4E>(x);
  x += dppf<0x141>(x);
  x += dppf<0x140>(x);
  return x;
}
__device__ __forceinline__ float red16_max(float x) {
  x = fmaxf(x, dppf<0xB1>(x));
  x = fmaxf(x, dppf<0x4E>(x));
  x = fmaxf(x, dppf<0x141>(x));
  x = fmaxf(x, dppf<0x140>(x));
  return x;
}
__device__ __forceinline__ float wave_sum(float x) {
#pragma unroll
  for (int m = 1; m < 64; m <<= 1) x += __shfl_xor(x, m, 64);
  return x;
}

__device__ __forceinline__ void tok_info(int tok, int& seq, int& t, int& T) {
  if (tok < MP) { seq = tok >> 11; t = tok & 2047; T = 2048; }
  else { int s = tok - MP; seq = 8 + (s >> 2); t = s & 3; T = 4; }
}
__device__ __forceinline__ int seq_tok0(int seq) { return seq < 8 ? seq * 2048 : MP + (seq - 8) * 4; }


#define XB_TMO      128
#define XB_XCNT(j)  (256  + 64 * (j))
#define XB_XSUB(j)  (1280 + 64 * (j))
#define XB_XGEN(j)  (2304 + 64 * (j))
#define XB_TOP      3328
#define XB_TOPGEN   3392
#define XCD_BAR_WORDS 3456
#define XB_SPIN_CAP (1u << 22)
#define LAS __attribute__((address_space(3)))
__device__ __forceinline__ unsigned xb_ld(unsigned* p) { return __hip_atomic_load(p, __ATOMIC_RELAXED, __HIP_MEMORY_SCOPE_AGENT); }
__device__ __forceinline__ unsigned xb_add(unsigned* p, unsigned v) { return __hip_atomic_fetch_add(p, v, __ATOMIC_RELAXED, __HIP_MEMORY_SCOPE_AGENT); }
__device__ __forceinline__ unsigned xb_xcc_id() { return (unsigned)__builtin_amdgcn_s_getreg((3 << 11) | 20) & 0xFu; }
#define XB_SPIN(cond, bar) do { unsigned _sp = 0; while (cond) { __builtin_amdgcn_s_sleep(1); \
    if ((++_sp & 255u) == 0u) { if (xb_ld(&(bar)[XB_TMO])) break; if (_sp > XB_SPIN_CAP) { atomicAdd(&(bar)[XB_TMO], 1u); break; } } } } while (0)
struct XcdBarrier { unsigned* bar; unsigned x; volatile LAS unsigned* st; };
__device__ __forceinline__ XcdBarrier xcd_barrier_post(unsigned* bar, volatile LAS unsigned* st) {
  XcdBarrier b; b.bar = bar; b.x = xb_xcc_id(); b.st = st;
  if (threadIdx.x == 0) (void)xb_add(&bar[XB_XCNT(b.x)], 1u);
  return b;
}
__device__ __forceinline__ void xcd_barrier_complete(unsigned* bar, unsigned x, unsigned& nloc, unsigned& nx) {
  const unsigned G = gridDim.x * gridDim.y * gridDim.z;
  unsigned sum, cnt, mine, sp = 0u;
  for (;;) {
    sum = 0u; cnt = 0u; mine = 0u;
#pragma unroll
    for (unsigned j = 0; j < 16; ++j) { const unsigned c = xb_ld(&bar[XB_XCNT(j)]); sum += c; cnt += (c > 0u) ? 1u : 0u; mine = (j == x) ? c : mine; }
    if (sum == G) break;
    __builtin_amdgcn_s_sleep(1);
    if ((++sp & 255u) == 0u) { if (xb_ld(&bar[XB_TMO])) break; if (sp > XB_SPIN_CAP) { atomicAdd(&bar[XB_TMO], 1u); break; } }
  }
  nloc = mine > 0u ? mine : 1u; nx = cnt > 0u ? cnt : 1u;
}
__device__ __forceinline__ void xcd_barrier(const XcdBarrier& b) {
  asm volatile("s_waitcnt vmcnt(0)" ::: "memory");
  __syncthreads();
  if (threadIdx.x == 0) {
    unsigned* bar = b.bar;
    __builtin_amdgcn_s_waitcnt(0);
    unsigned nloc = b.st[0], nx = b.st[1];
    if (nloc == 0u) { xcd_barrier_complete(bar, b.x, nloc, nx); b.st[0] = nloc; b.st[1] = nx; }
    const unsigned old = xb_add(&bar[XB_XSUB(b.x)], 1u);
    const unsigned gen = old / nloc;
    if (old + 1u == (gen + 1u) * nloc) {
      __builtin_amdgcn_fence(__ATOMIC_RELEASE, "agent");
      asm volatile("s_waitcnt vmcnt(0)" ::: "memory");
      const unsigned og = xb_add(&bar[XB_TOP], 1u);
      const unsigned tg = og / nx;
      if (og + 1u == (tg + 1u) * nx) xb_add(&bar[XB_TOPGEN], 1u);
      else XB_SPIN(xb_ld(&bar[XB_TOPGEN]) == tg, bar);
      __builtin_amdgcn_fence(__ATOMIC_ACQUIRE, "agent");
      xb_add(&bar[XB_XGEN(b.x)], 1u);
      asm volatile("s_waitcnt vmcnt(0)" ::: "memory");
    } else {
      XB_SPIN(xb_ld(&bar[XB_XGEN(b.x)]) == gen, bar);
      __builtin_amdgcn_fence(__ATOMIC_ACQUIRE, "agent");
      asm volatile("s_waitcnt vmcnt(0)" ::: "memory");
    }
  }
  __syncthreads();
}

#define MFMA(a, b, c) __builtin_amdgcn_mfma_f32_16x16x32_bf16((a), (b), (c), 0, 0, 0)

template <int OFF>
__device__ __forceinline__ bf16x8 lds_rd128(unsigned addr) {
  bf16x8 v;
  asm volatile("ds_read_b128 %0, %1 offset:%2" : "=v"(v) : "v"(addr), "n"(OFF));
  return v;
}
template <int MTW, int NTW>
struct GemmCtx {
  const bf16_t* ga;
  const bf16_t* gb;
  int lda, ldb;
};
#define GEMM_STAGE_BYTES(MTW, NTW) (2048 * ((MTW) + (NTW)))
#define GEMM_NLD(MTW, NTW) (((MTW) + (NTW)) / 2)

template <int NTW>
__device__ __forceinline__ int gemm_brow(int s  , int rr  ) {
  return (s / NTW) * (16 * NTW) + (rr >> 2) * (4 * NTW) + (s % NTW) * 4 + (rr & 3);
}
template <int MTW, int NTW>
__device__ __forceinline__ void gemm_issue(const bf16_t* ga, int lda, const bf16_t* gb0, const bf16_t* gb1, int kt, char* wstage) {
#pragma unroll
  for (int j = 0; j < MTW / 2; ++j)
    __builtin_amdgcn_global_load_lds((const unsigned*)(ga + (size_t)(64 * j) * lda + kt * 32), (unsigned*)(wstage + j * 4096), 16, 0, 0);
  __builtin_amdgcn_global_load_lds((const unsigned*)(gb0 + kt * 32), (unsigned*)(wstage + MTW * 2048), 16, 0, 0);
  if constexpr (NTW == 4)
    __builtin_amdgcn_global_load_lds((const unsigned*)(gb1 + kt * 32), (unsigned*)(wstage + MTW * 2048 + 4096), 16, 0, 0);
}

template <int MTW, int NTW>
__device__ __forceinline__ void gemm_prologue(const bf16_t* __restrict__ A, int lda, const bf16_t* __restrict__ Bt, int ldb,
                                              int m0, int n0, char* lds) {
  constexpr int SB = GEMM_STAGE_BYTES(MTW, NTW);
  const int TX = tid_();
  const int lane = TX & 63, wv = TX >> 6;
  const int obs = lane * 16;
  const int ob = obs ^ (((obs >> 9) & 1) << 5);
  const int srow = wv * 16 + (ob >> 6), scol = (ob & 63) >> 1;
  const bf16_t* ga = A + (size_t)(m0 + srow) * lda + scol;
  const bf16_t* gb0 = Bt + (size_t)(n0 + gemm_brow<NTW>(wv, ob >> 6)) * ldb + scol;
  const bf16_t* gb1 = Bt + (size_t)(n0 + gemm_brow<NTW>(wv + 4, ob >> 6)) * ldb + scol;
  char* wbase = lds + wv * 1024;
#pragma unroll
  for (int t = 0; t < 3; ++t) gemm_issue<MTW, NTW>(ga, lda, gb0, gb1, t, wbase + t * SB);
}

template <int MTW, int NTW>
__device__ __forceinline__ void gemm_loop(const bf16_t* __restrict__ A, int lda, const bf16_t* __restrict__ Bt, int ldb,
                                          int K, int m0, int n0, char* lds, f32x4 (&acc)[MTW][NTW]) {
  constexpr int SB = GEMM_STAGE_BYTES(MTW, NTW), NLD = GEMM_NLD(MTW, NTW);
  static_assert(NLD == 4 || NLD == 3, "vmcnt immediates below assume 3 or 4 loads per k-step");
  const int TX = tid_();
  const int lane = TX & 63, wv = TX >> 6;
  const int wr = wv >> 1, wc = wv & 1, fr = lane & 15, fq = lane >> 4;
  const int obs = lane * 16;
  const int ob = obs ^ (((obs >> 9) & 1) << 5);
  const int srow = wv * 16 + (ob >> 6), scol = (ob & 63) >> 1;
  const bf16_t* ga = A + (size_t)(m0 + srow) * lda + scol;
  const bf16_t* gb0 = Bt + (size_t)(n0 + gemm_brow<NTW>(wv, ob >> 6)) * ldb + scol;
  const bf16_t* gb1 = Bt + (size_t)(n0 + gemm_brow<NTW>(wv + 4, ob >> 6)) * ldb + scol;
  char* wbase = lds + wv * 1024;
  const int fo = swz(fr, fq * 16);
  const unsigned lbase = (unsigned)(unsigned long)((__attribute__((address_space(3))) char*)lds);
  const unsigned a_off = lbase + (wr * MTW) * 1024 + fo, b_off = lbase + MTW * 2048 + (wc * NTW) * 1024 + fo;
  const int nk = K >> 5;
  for (int kt = 0; kt < nk; ++kt) {
    if (kt + 2 < nk) { if (NLD == 4) asm volatile("s_waitcnt vmcnt(8)" ::: "memory"); else asm volatile("s_waitcnt vmcnt(6)" ::: "memory"); }
    else if (kt + 1 < nk) { if (NLD == 4) asm volatile("s_waitcnt vmcnt(4)" ::: "memory"); else asm volatile("s_waitcnt vmcnt(3)" ::: "memory"); }
    else asm volatile("s_waitcnt vmcnt(0)" ::: "memory");
    __builtin_amdgcn_s_barrier();
    asm volatile("" ::: "memory");
    static_assert(MTW == 4, "fragment read block below is written for 4 m-tiles per wave");
    const unsigned sa_ = a_off + (kt & 3) * SB, sb_ = b_off + (kt & 3) * SB;
    bf16x8 af[MTW], bfr[NTW];
    af[0] = lds_rd128<0>(sa_); af[1] = lds_rd128<1024>(sa_); af[2] = lds_rd128<2048>(sa_); af[3] = lds_rd128<3072>(sa_);
    bfr[0] = lds_rd128<0>(sb_); bfr[1] = lds_rd128<1024>(sb_);
    if constexpr (NTW == 4) { bfr[2] = lds_rd128<2048>(sb_); bfr[3] = lds_rd128<3072>(sb_); }
    if (kt + 3 < nk) gemm_issue<MTW, NTW>(ga, lda, gb0, gb1, kt + 3, wbase + ((kt + 3) & 3) * SB);
    if constexpr (NTW == 4)
      asm volatile("s_waitcnt lgkmcnt(0)" : "+v"(af[0]), "+v"(af[1]), "+v"(af[2]), "+v"(af[3]), "+v"(bfr[0]), "+v"(bfr[1]), "+v"(bfr[2]), "+v"(bfr[3]) :: "memory");
    else
      asm volatile("s_waitcnt lgkmcnt(0)" : "+v"(af[0]), "+v"(af[1]), "+v"(af[2]), "+v"(af[3]), "+v"(bfr[0]), "+v"(bfr[1]) :: "memory");
#pragma unroll
    for (int mt = 0; mt < MTW; ++mt)
#pragma unroll
      for (int nt = 0; nt < NTW; ++nt) acc[mt][nt] = MFMA(bfr[nt], af[mt], acc[mt][nt]);
  }
  asm volatile("s_waitcnt lgkmcnt(0)" ::: "memory");
  __builtin_amdgcn_s_barrier();
  asm volatile("" ::: "memory");
}

template <int MTW, int NTW>
__device__ __forceinline__ void gemm_main(const bf16_t* __restrict__ A, int lda, const bf16_t* __restrict__ Bt, int ldb,
                                          int K, int m0, int n0, char* lds, f32x4 (&acc)[MTW][NTW]) {
  gemm_prologue<MTW, NTW>(A, lda, Bt, ldb, m0, n0, lds);
  gemm_loop<MTW, NTW>(A, lda, Bt, ldb, K, m0, n0, lds, acc);
}

__device__ __forceinline__ uint4 pack8(const f32x4& a, const f32x4& b) {
  uint4 o;
  o.x = (unsigned)f2bf(a[0]) | ((unsigned)f2bf(a[1]) << 16);
  o.y = (unsigned)f2bf(a[2]) | ((unsigned)f2bf(a[3]) << 16);
  o.z = (unsigned)f2bf(b[0]) | ((unsigned)f2bf(b[1]) << 16);
  o.w = (unsigned)f2bf(b[2]) | ((unsigned)f2bf(b[3]) << 16);
  return o;
}

struct TileIter {
  int L, Lend, step;
};
__device__ __forceinline__ TileIter tile_iter(int ntiles) {
  const int G = (int)gridDim.x, b = (int)blockIdx.x;
  TileIter it;
  if ((G & 7) == 0) {
    const int tpx = (ntiles + 7) >> 3, x = b & 7;
    it.L = x * tpx + (b >> 3);
    it.Lend = min(ntiles, (x + 1) * tpx);
    it.step = G >> 3;
  } else {
    it.L = b; it.Lend = ntiles; it.step = G;
  }
  return it;
}
__device__ __forceinline__ TileIter tile_iter_rev(int ntiles) {
  const int G = (int)gridDim.x, b = (int)blockIdx.x;
  TileIter it;
  if ((G & 7) == 0) {
    const int tpx = (ntiles + 7) >> 3, x = b & 7, ns = G >> 3;
    it.L = x * tpx + (ns - 1 - (b >> 3));
    it.Lend = min(ntiles, (x + 1) * tpx);
    it.step = ns;
  } else {
    it.L = G - 1 - b; it.Lend = ntiles; it.step = G;
  }
  return it;
}
__device__ __forceinline__ void tile_mn(int L, int nM, int nN, int& m, int& n) {
  const int full = (nM >> 3) * 8 * nN;
  if (L < full) {
    const int band = L / (8 * nN), r = L % (8 * nN);
    n = r >> 3; m = band * 8 + (r & 7);
  } else {
    const int rem = nM & 7, r = L - full;
    n = r / rem; m = (nM >> 3) * 8 + r % rem;
  }
}

template <int MTW, int NTW>
__device__ __forceinline__ void zero_acc(f32x4 (&acc)[MTW][NTW]) {
#pragma unroll
  for (int a = 0; a < MTW; ++a)
#pragma unroll
    for (int b = 0; b < NTW; ++b) acc[a][b] = f32x4{0.f, 0.f, 0.f, 0.f};
}

__device__ void transpose_tile(const float* __restrict__ W, int ldw, bf16_t* __restrict__ Wt, int ldt, int k0, int n0,
                               int perm, char* lds) {
  const int TX = tid_();
  float* tile = (float*)lds;
  const int tid = TX;
  const int c = tid & 63, r0 = tid >> 6;
#pragma unroll
  for (int r = 0; r < 16; ++r) {
    int row = r * 4 + r0;
    tile[row * 65 + c] = W[(size_t)(k0 + row) * ldw + n0 + c];
  }
  __syncthreads();
#pragma unroll
  for (int r = 0; r < 16; ++r) {
    int n = n0 + r * 4 + r0;
    int np = n;
    if (perm) {
      if (n < DFF) np = (n >> 3) * 16 + (n & 7);
      else { int j = n - DFF; np = (j >> 3) * 16 + 8 + (j & 7); }
    }
    Wt[(size_t)np * ldt + k0 + c] = f2bf(tile[c * 65 + (r * 4 + r0)]);
  }
  __syncthreads();
}

__device__ __forceinline__ void convert_job(const float* __restrict__ src, bf16_t* __restrict__ dst, int K, int N, int nmat,
                                            int perm, int& start, char* lds) {
  const int tk = K / 64, tn = N / 64;
  const int ntiles = nmat * tk * tn;
  const int G = (int)gridDim.x;
  const int first = (((int)blockIdx.x - start) % G + G) % G;
  for (int i = first; i < ntiles; i += G) {
    const int mat = i / (tk * tn), r = i % (tk * tn);
    const int kt = r / tn, nt = r % tn;
    transpose_tile(src + (size_t)mat * K * N, N, dst + (size_t)mat * K * N, K, kt * 64, nt * 64, perm, lds);
  }
  start += ntiles;
}

__device__ void phase_convert(const Params& p, char* lds) {
  const int TX = tid_();
  char* ws = p.ws;
  int start = 0;
  convert_job(p.in[I_WIN], (bf16_t*)(ws + W_IN), 1024, 7680, NL, 0, start, lds);
  convert_job(p.in[I_WFFNIN], (bf16_t*)(ws + W_FFNIN), 1024, 5632, NL, 1, start, lds);
  convert_job(p.in[I_WFFNOUT], (bf16_t*)(ws + W_FFNOUT), 2816, 1024, NL, 0, start, lds);
  convert_job(p.in[I_WRWOUT], (bf16_t*)(ws + W_RWOUT), 768, 1024, NL, 0, start, lds);
  convert_job(p.in[I_WLRUOUT], (bf16_t*)(ws + W_LRUOUT), 768, 1024, NL, 0, start, lds);
  convert_job(p.in[I_WXAOUT], (bf16_t*)(ws + W_XAOUT), 512, 1024, NL, 0, start, lds);
  convert_job(p.in[I_WO], (bf16_t*)(ws + W_O), 1024, 1024, NL, 0, start, lds);
  convert_job(p.in[I_WMEMKV], (bf16_t*)(ws + W_MEMKV), 1024, 1024, NL, 0, start, lds);
  convert_job(p.in[I_W2], (bf16_t*)(ws + W_W2T), 64, 768, NL, 0, start, lds);
  convert_job(p.in[I_A2], (bf16_t*)(ws + W_A2T), 64, 768, NL, 0, start, lds);
  convert_job(p.in[I_G2], (bf16_t*)(ws + W_G2T), 128, 768, NL, 0, start, lds);
  convert_job(p.in[I_WRG], (bf16_t*)(ws + W_RGT), 64, 64, NL * 12, 0, start, lds);
  convert_job(p.in[I_WIG], (bf16_t*)(ws + W_IGT), 64, 64, NL * 12, 0, start, lds);
  const size_t gtid = (size_t)blockIdx.x * 256 + TX, gsz = (size_t)gridDim.x * 256;
  {
    uint2* xb = (uint2*)(ws + B_XB);
    const float4* xp = (const float4*)p.in[I_XP];
    const float4* xs = (const float4*)p.in[I_XS];
    const size_t np4 = (size_t)MP * D / 4, nt4 = (size_t)MT * D / 4;
    for (size_t i = gtid; i < nt4; i += gsz) {
      float4 v = (i < np4) ? xp[i] : xs[i - np4];
      uint2 o;
      o.x = (unsigned)f2bf(v.x) | ((unsigned)f2bf(v.y) << 16);
      o.y = (unsigned)f2bf(v.z) | ((unsigned)f2bf(v.w) << 16);
      xb[i] = o;
    }
  }
  {
    uint2* mb = (uint2*)(ws + B_MEMB);
    const float4* m = (const float4*)p.in[I_MEM];
    const size_t n4 = (size_t)2048 * D / 4;
    for (size_t i = gtid; i < n4; i += gsz) {
      float4 v = m[i];
      uint2 o;
      o.x = (unsigned)f2bf(v.x) | ((unsigned)f2bf(v.y) << 16);
      o.y = (unsigned)f2bf(v.z) | ((unsigned)f2bf(v.w) << 16);
      mb[i] = o;
    }
  }
  {
    bf16_t* v1t = (bf16_t*)(ws + W_V1T);
    const float* v1 = p.in[I_V1];
    for (size_t i = gtid; i < (size_t)3 * 768 * 32; i += gsz) {
      int j = (int)(i / (768 * 32)), r = (int)(i % (768 * 32));
      int n = r / 768, k = r % 768;
      v1t[i] = f2bf(v1[(size_t)j * 768 * 32 + (size_t)k * 32 + n]);
    }
  }
  {
    bf16_t* v2t = (bf16_t*)(ws + W_V2T);
    const float* v2 = p.in[I_V2];
    for (size_t i = gtid; i < (size_t)3 * 768 * 32; i += gsz) {
      int j = (int)(i / (768 * 32)), r = (int)(i % (768 * 32));
      int n = r / 32, k = r % 32;
      v2t[i] = f2bf(v2[(size_t)j * 32 * 768 + (size_t)k * 768 + n]);
    }
  }
}

struct ProjTile { const bf16_t* A; const bf16_t* Bt; int m0, n0, ll; bool main; };
__device__ __forceinline__ ProjTile proj_tile(const Params& p, int l, int tile, int nextra) {
  char* ws = p.ws;
  ProjTile t;
  if (nextra > 0) {
    constexpr int NTOT = (MT / 128) * (DIN / 128) + NL * 16 * 8, TPX = NTOT / 8, EPX = NL * 16 * 8 / 8;
    static_assert(NTOT % 8 == 0, "even split");
    const int x = tile / TPX, j = tile % TPX;
    tile = (j < EPX) ? (x * EPX + j) : (nextra + x * (TPX - EPX) + (j - EPX));
  }
  if (tile >= nextra) {
    int tm, tn;
    tile_mn(tile - nextra, MT / 128, DIN / 128, tm, tn);
    t.A = (const bf16_t*)(ws + B_XB); t.Bt = (const bf16_t*)(ws + W_IN) + (size_t)l * DIN * D;
    t.m0 = tm * 128; t.n0 = tn * 128; t.ll = l; t.main = true;
  } else {
    const int ll = tile / 128, r = tile % 128;
    t.A = (const bf16_t*)(ws + B_MEMB); t.Bt = (const bf16_t*)(ws + W_MEMKV) + (size_t)ll * D * D;
    t.m0 = (r / 8) * 128; t.n0 = (r % 8) * 128; t.ll = ll; t.main = false;
  }
  return t;
}

__device__ void phase_proj(const Params& p, int l, char* lds) {
  const int TX = tid_();
  char* ws = p.ws;
  bf16_t* proj = (bf16_t*)(ws + B_PROJ);
  const int lane = TX & 63, wv = TX >> 6, wr = wv >> 1, wc = wv & 1, fr = lane & 15, fq = lane >> 4;
  const int ntiles = (MT / 128) * (DIN / 128);
  const int nextra = (l == 0) ? NL * 16 * 8 : 0;
  TileIter it = tile_iter(ntiles + nextra);
  bool have = it.L < it.Lend;
  ProjTile cur;
  if (have) { cur = proj_tile(p, l, it.L, nextra); gemm_prologue<4, 4>(cur.A, D, cur.Bt, D, cur.m0, cur.n0, lds); }
  while (have) {
    f32x4 acc[4][4];
    zero_acc(acc);
    gemm_loop<4, 4>(cur.A, D, cur.Bt, D, D, cur.m0, cur.n0, lds, acc);
    const int Ln = it.L + it.step;
    const bool hn = Ln < it.Lend;
    ProjTile nxt = cur;
    if (hn) { nxt = proj_tile(p, l, Ln, nextra); gemm_prologue<4, 4>(nxt.A, D, nxt.Bt, D, nxt.m0, nxt.n0, lds); }
    const int m0 = cur.m0, n0 = cur.n0;
    if (cur.main) {
#pragma unroll
      for (int mt = 0; mt < 4; ++mt) {
        const int row = m0 + wr * 64 + mt * 16 + fr, col = n0 + wc * 64 + fq * 16;
        uint4* dst = (uint4*)(proj + (size_t)row * DIN + col);
        dst[0] = pack8(acc[mt][0], acc[mt][1]);
        dst[1] = pack8(acc[mt][2], acc[mt][3]);
      }
    } else {
      const int ll = cur.ll;
      bf16_t* kb = (bf16_t*)(ws + B_KB);
      bf16_t* vtb = (bf16_t*)(ws + B_VTB);
#pragma unroll
      for (int mt = 0; mt < 4; ++mt)
#pragma unroll
        for (int nt = 0; nt < 4; ++nt)
#pragma unroll
          for (int i = 0; i < 4; ++i) {
            int row = m0 + wr * 64 + mt * 16 + fr, col = n0 + wc * 64 + fq * 16 + nt * 4 + i;
            int b = row >> 8, key = row & 255;
            float v = acc[mt][nt][i];
            if (col < 512) {
              p.out[O_MKP + ((size_t)(ll * 8 + b) * 256 + key) * 512 + col] = v;
              kb[((size_t)(ll * 8 + b) * 256 + key) * 512 + col] = f2bf(v);
            } else {
              int c2 = col - 512, h = c2 >> 7, d = c2 & 127;
              p.out[O_MVP + ((size_t)(ll * 8 + b) * 256 + key) * 512 + c2] = v;
              vtb[(((size_t)(ll * 8 + b) * 4 + h) * 128 + d) * 256 + key] = f2bf(v);
            }
          }
    }
    it.L = Ln; have = hn; cur = nxt;
  }
}

__device__ __forceinline__ float prw_prev(const Params& p, const bf16_t* proj, int l, int tok, int seq, int t, int c) {
  if (t > 0) return bf2f(proj[(size_t)(tok - 1) * DIN + c]);
  if (seq >= 8) return p.in[I_SSHIFT][((size_t)l * 128 + (seq - 8)) * RWC + c];
  return 0.f;
}
__device__ __forceinline__ float plx_back(const Params& p, const bf16_t* proj, int l, int tok, int seq, int t, int j, int ch) {
  if (t - j >= 0) return bf2f(proj[(size_t)(tok - j) * DIN + C_LX + ch]);
  if (seq >= 8) return p.in[I_SCONV][(((size_t)l * 128 + (seq - 8)) * 3 + (3 + t - j)) * DLRU + ch];
  return 0.f;
}

__device__ __forceinline__ float2 ld_bf2(const bf16_t* p) {
  const unsigned u = *(const unsigned*)p;
  return make_float2(__uint_as_float(u << 16), __uint_as_float(u & 0xffff0000u));
}
__device__ __forceinline__ unsigned pk_bf2(float a, float b) { return (unsigned)f2bf(a) | ((unsigned)f2bf(b) << 16); }
__device__ __forceinline__ float2 prw_prev2(const Params& p, const bf16_t* proj, int l, int tok, int seq, int t, int c) {
  if (t > 0) return ld_bf2(proj + (size_t)(tok - 1) * DIN + c);
  if (seq >= 8) return *(const float2*)(p.in[I_SSHIFT] + ((size_t)l * 128 + (seq - 8)) * RWC + c);
  return make_float2(0.f, 0.f);
}
__device__ __forceinline__ float2 plx_back2(const Params& p, const bf16_t* proj, int l, int tok, int seq, int t, int j, int ch) {
  if (t - j >= 0) return ld_bf2(proj + (size_t)(tok - j) * DIN + C_LX + ch);
  if (seq >= 8) return *(const float2*)(p.in[I_SCONV] + (((size_t)l * 128 + (seq - 8)) * 3 + (3 + t - j)) * DLRU + ch);
  return make_float2(0.f, 0.f);
}

__device__ void phase_prep(const Params& p, int l, char* lds) {
  const int TX = tid_();
  char* ws = p.ws;
  const bf16_t* proj = (const bf16_t*)(ws + B_PROJ);
  bf16_t* L = (bf16_t*)(ws + B_LBUF);
  bf16_t* XC = (bf16_t*)(ws + B_ALRU);
  float* ubuf = (float*)(ws + B_UBUF);
  bf16_t* vmid = (bf16_t*)(ws + B_VMID);
  const float* mu = p.in[I_MU] + (size_t)l * RWC;
  const float* cw = p.in[I_CONVW] + (size_t)l * 4 * DLRU;
  const float* cb = p.in[I_CONVB] + (size_t)l * DLRU;
  const int tid = TX, lane = tid & 63, wv = tid >> 6, fr = lane & 15, fq = lane >> 4;
  constexpr int TK = 4;
  for (TileIter ti = tile_iter(MT / TK); ti.L < ti.Lend; ti.L += ti.step) {
    const int item = ti.L;
    const int tokb = item * TK;
    auto body = [&](auto interior_tag) {
    constexpr bool INTR = decltype(interior_tag)::value;
#pragma unroll 4
    for (int u = tid; u < TK * 128; u += 256) {
      const int tk = u >> 7, cp = (u & 127) * 2, tok = tokb + tk, c = 2304 + cp;
      int seq = 0, t = 16, T = 2048;
      if constexpr (!INTR) tok_info(tok, seq, t, T);
      const float2 pc = ld_bf2(proj + (size_t)tok * DIN + c);
      float2 pp;
      if constexpr (INTR) pp = ld_bf2(proj + (size_t)(tok - 1) * DIN + c); else pp = prw_prev2(p, proj, l, tok, seq, t, c);
      const float2 m2 = *(const float2*)(mu + c);
      const float x0 = pc.x + (pp.x - pc.x) * m2.x, x1 = pc.y + (pp.y - pc.y) * m2.y;
      float o0, o1;
      if (cp < 64) { o0 = tanhf(x0); o1 = tanhf(x1); }
      else if (cp < 128) { o0 = x0; o1 = x1; }
      else { o0 = sigmoidf_(x0); o1 = sigmoidf_(x1); }
      *(unsigned*)(L + (size_t)tok * 256 + cp) = pk_bf2(o0, o1);
    }
#pragma unroll 4
    for (int u = tid; u < TK * 384; u += 256) {
      const int tk = u / 384, ch = (u % 384) * 2, tok = tokb + tk;
      int seq = 0, t = 16, T = 2048;
      if constexpr (INTR) { seq = tok >> 11; t = tok & 2047; } else tok_info(tok, seq, t, T);
      const float2 x0 = ld_bf2(proj + (size_t)tok * DIN + C_LX + ch);
      float2 x1, x2, x3;
      if constexpr (INTR) {
        x1 = ld_bf2(proj + (size_t)(tok - 1) * DIN + C_LX + ch);
        x2 = ld_bf2(proj + (size_t)(tok - 2) * DIN + C_LX + ch);
        x3 = ld_bf2(proj + (size_t)(tok - 3) * DIN + C_LX + ch);
      } else {
        x1 = plx_back2(p, proj, l, tok, seq, t, 1, ch);
        x2 = plx_back2(p, proj, l, tok, seq, t, 2, ch);
        x3 = plx_back2(p, proj, l, tok, seq, t, 3, ch);
      }
      const float2 b2 = *(const float2*)(cb + ch), w3 = *(const float2*)(cw + 3 * DLRU + ch), w2 = *(const float2*)(cw + 2 * DLRU + ch),
                   w1 = *(const float2*)(cw + DLRU + ch), w0 = *(const float2*)(cw + ch);
      const float xa = b2.x + w3.x * x0.x + w2.x * x1.x + w1.x * x2.x + w0.x * x3.x;
      const float xb_ = b2.y + w3.y * x0.y + w2.y * x1.y + w1.y * x2.y + w0.y * x3.y;
      *(unsigned*)(XC + (size_t)tok * DLRU + ch) = pk_bf2(xa, xb_);
      if (t >= T - 3) {
        const size_t o = (seq < 8) ? O_CONVP + (((size_t)l * 8 + seq) * 3 + (t - (T - 3))) * DLRU
                                   : O_CONVS + (((size_t)l * 128 + (seq - 8)) * 3 + (t - (T - 3))) * DLRU;
        *(float2*)(p.out + o + ch) = x0;
      }
      if (l > 0) {
        const int c = 1536 + ch;
        const float2 pc = ld_bf2(proj + (size_t)tok * DIN + c);
        float2 pp;
        if constexpr (INTR) pp = ld_bf2(proj + (size_t)(tok - 1) * DIN + c); else pp = prw_prev2(p, proj, l, tok, seq, t, c);
        const float2 m2 = *(const float2*)(mu + c);
        const float v0 = pc.x + (pp.x - pc.x) * m2.x, v1 = pc.y + (pp.y - pc.y) * m2.y;
        *(unsigned*)(lds + (ch >> 5) * 1024 + swz(tk, (ch & 31) * 2)) = pk_bf2(v0, v1);
      }
    }
    };
    if (tokb < MP && (tokb & 2047) != 0) body(std::true_type{}); else body(std::false_type{});
    for (int tk = 0; tk < TK; ++tk) {
      const int tok = tokb + tk;
      int seq, t, T;
      tok_info(tok, seq, t, T);
      if (t == T - 1) {
        const size_t o = (seq < 8) ? O_SHP + ((size_t)l * 8 + seq) * RWC : O_SHS + ((size_t)l * 128 + (seq - 8)) * RWC;
        for (int c = tid * 2; c < RWC; c += 512) *(float2*)(p.out + o + c) = ld_bf2(proj + (size_t)tok * DIN + c);
      }
    }
    if (l > 0) {
      __syncthreads();
      const bf16_t* v1t = (const bf16_t*)(ws + W_V1T) + (size_t)(l - 1) * 32 * DRW;
      f32x4 acc0 = f32x4{0, 0, 0, 0}, acc1 = acc0;
      const int fo = swz(fr, fq * 16);
#pragma unroll
      for (int kk = 0; kk < 6; ++kk) {
        const int ks = wv * 6 + kk;
        const bf16x8 af = *(const bf16x8*)(lds + ks * 1024 + fo);
        const bf16x8 b0 = *(const bf16x8*)(v1t + (size_t)fr * DRW + ks * 32 + fq * 8);
        const bf16x8 b1 = *(const bf16x8*)(v1t + (size_t)(16 + fr) * DRW + ks * 32 + fq * 8);
        acc0 = MFMA(af, b0, acc0);
        acc1 = MFMA(af, b1, acc1);
      }
      float* red = (float*)(lds + 24576);
#pragma unroll
      for (int i = 0; i < 4; ++i) {
        red[(wv * 16 + fq * 4 + i) * 32 + fr] = acc0[i];
        red[(wv * 16 + fq * 4 + i) * 32 + 16 + fr] = acc1[i];
      }
      __syncthreads();
      {
        const int row = tid >> 4, c2 = (tid & 15) * 2;
        if (row < TK) {
          float s0 = 0.f, s1 = 0.f;
#pragma unroll
          for (int w = 0; w < 4; ++w) { s0 += red[(w * 16 + row) * 32 + c2]; s1 += red[(w * 16 + row) * 32 + c2 + 1]; }
          *(unsigned*)(vmid + (size_t)(tokb + row) * 32 + c2) = pk_bf2(s0, s1);
        }
      }
      __syncthreads();
    }
  }
}

__device__ __forceinline__ void unpack4(const uint2 q, float (&o)[4]) {
  o[0] = __uint_as_float(q.x << 16); o[1] = __uint_as_float(q.x & 0xffff0000u);
  o[2] = __uint_as_float(q.y << 16); o[3] = __uint_as_float(q.y & 0xffff0000u);
}
__device__ __forceinline__ void prw_prev4(const Params& p, const bf16_t* proj, int l, int tok, int seq, int t, int c, float (&o)[4]) {
  if (t > 0) { unpack4(*(const uint2*)(proj + (size_t)(tok - 1) * DIN + c), o); return; }
  if (seq >= 8) {
    const float4 s = *(const float4*)(p.in[I_SSHIFT] + ((size_t)l * 128 + (seq - 8)) * RWC + c);
    o[0] = s.x; o[1] = s.y; o[2] = s.z; o[3] = s.w;
    return;
  }
  o[0] = 0.f; o[1] = 0.f; o[2] = 0.f; o[3] = 0.f;
}

__device__ void phase_lora(const Params& p, int l, char* lds) {
  const int TX = tid_();
  char* ws = p.ws;
  const bf16_t* proj = (const bf16_t*)(ws + B_PROJ);
  const bf16_t* L = (const bf16_t*)(ws + B_LBUF);
  const bf16_t* vmid = (const bf16_t*)(ws + B_VMID);
  const bf16_t* XC = (const bf16_t*)(ws + B_ALRU);
  const int NRW = (MT / 128) * 12;
  for (TileIter ti = tile_iter(NRW); ti.L < ti.Lend; ti.L += ti.step) {
    const int item = ti.L;
    int txl = TX;
    asm volatile("" : "+v"(txl));
    const int lane = txl & 63, wv = txl >> 6, fr = lane & 15, fq = lane >> 4;
    {
      const int h = item % 12, tb = (item / 12) * 128 + wv * 32;
      const bf16_t* w2t = (const bf16_t*)(ws + W_W2T) + ((size_t)l * DRW + h * 64) * 64;
      const bf16_t* a2t = (const bf16_t*)(ws + W_A2T) + ((size_t)l * DRW + h * 64) * 64;
      const bf16_t* g2t = (const bf16_t*)(ws + W_G2T) + ((size_t)l * DRW + h * 64) * 128;
      bf16_t* gbuf = (bf16_t*)(ws + B_GBUF);
      {
        f32x4 ag[2][4];
#pragma unroll
        for (int a = 0; a < 2; ++a)
#pragma unroll
          for (int b = 0; b < 4; ++b) ag[a][b] = f32x4{0, 0, 0, 0};
#pragma unroll
        for (int ks = 0; ks < 4; ++ks) {
          bf16x8 af[2], bf_[4];
#pragma unroll
          for (int mt = 0; mt < 2; ++mt) af[mt] = *(const bf16x8*)(L + (size_t)(tb + mt * 16 + fr) * 256 + 128 + ks * 32 + fq * 8);
#pragma unroll
          for (int nt = 0; nt < 4; ++nt) bf_[nt] = *(const bf16x8*)(g2t + (size_t)(nt * 16 + fr) * 128 + ks * 32 + fq * 8);
#pragma unroll
          for (int mt = 0; mt < 2; ++mt)
#pragma unroll
            for (int nt = 0; nt < 4; ++nt) ag[mt][nt] = MFMA(af[mt], bf_[nt], ag[mt][nt]);
        }
#pragma unroll
        for (int mt = 0; mt < 2; ++mt)
#pragma unroll
          for (int nt = 0; nt < 4; ++nt)
#pragma unroll
            for (int i = 0; i < 4; ++i)
              gbuf[(size_t)(tb + mt * 16 + fq * 4 + i) * DRW + h * 64 + nt * 16 + fr] = f2bf(ag[mt][nt][i]);
      }
      f32x4 aw[2][4], aa[2][4], av[2][4];
#pragma unroll
      for (int a = 0; a < 2; ++a)
#pragma unroll
        for (int b = 0; b < 4; ++b) { aw[a][b] = f32x4{0, 0, 0, 0}; aa[a][b] = aw[a][b]; av[a][b] = aw[a][b]; }
#pragma unroll
      for (int ks = 0; ks < 2; ++ks) {
        bf16x8 af[2], bf_[4];
#pragma unroll
        for (int mt = 0; mt < 2; ++mt) af[mt] = *(const bf16x8*)(L + (size_t)(tb + mt * 16 + fr) * 256 + ks * 32 + fq * 8);
#pragma unroll
        for (int nt = 0; nt < 4; ++nt) bf_[nt] = *(const bf16x8*)(w2t + (size_t)(nt * 16 + fr) * 64 + ks * 32 + fq * 8);
#pragma unroll
        for (int mt = 0; mt < 2; ++mt)
#pragma unroll
          for (int nt = 0; nt < 4; ++nt) aw[mt][nt] = MFMA(af[mt], bf_[nt], aw[mt][nt]);
#pragma unroll
        for (int mt = 0; mt < 2; ++mt) af[mt] = *(const bf16x8*)(L + (size_t)(tb + mt * 16 + fr) * 256 + 64 + ks * 32 + fq * 8);
#pragma unroll
        for (int nt = 0; nt < 4; ++nt) bf_[nt] = *(const bf16x8*)(a2t + (size_t)(nt * 16 + fr) * 64 + ks * 32 + fq * 8);
#pragma unroll
        for (int mt = 0; mt < 2; ++mt)
#pragma unroll
          for (int nt = 0; nt < 4; ++nt) aa[mt][nt] = MFMA(af[mt], bf_[nt], aa[mt][nt]);
      }
      if (l > 0) {
        const bf16_t* v2t = (const bf16_t*)(ws + W_V2T) + ((size_t)(l - 1) * DRW + h * 64) * 32;
        bf16x8 af[2], bf_[4];
#pragma unroll
        for (int mt = 0; mt < 2; ++mt) af[mt] = *(const bf16x8*)(vmid + (size_t)(tb + mt * 16 + fr) * 32 + fq * 8);
#pragma unroll
        for (int nt = 0; nt < 4; ++nt) bf_[nt] = *(const bf16x8*)(v2t + (size_t)(nt * 16 + fr) * 32 + fq * 8);
#pragma unroll
        for (int mt = 0; mt < 2; ++mt)
#pragma unroll
          for (int nt = 0; nt < 4; ++nt) av[mt][nt] = MFMA(af[mt], bf_[nt], av[mt][nt]);
      }
      const float* mu = p.in[I_MU] + (size_t)l * RWC;
      float mur[4], muk[4], muv[4], w0[4], a0[4], v0[4], kkp[4], kap[4], rkp[4];
#pragma unroll
      for (int nt = 0; nt < 4; ++nt) {
        int c = h * 64 + nt * 16 + fr;
        mur[nt] = mu[c]; muk[nt] = mu[768 + c]; muv[nt] = mu[1536 + c];
        w0[nt] = p.in[I_W0][(size_t)l * DRW + c];
        a0[nt] = p.in[I_A0][(size_t)l * DRW + c];
        v0[nt] = (l > 0) ? p.in[I_V0][(size_t)(l - 1) * DRW + c] : 0.f;
        kkp[nt] = p.in[I_KK][(size_t)l * DRW + c];
        kap[nt] = p.in[I_KA][(size_t)l * DRW + c];
        rkp[nt] = p.in[I_RK][(size_t)l * DRW + c];
      }
      bf16_t* vfirst = (bf16_t*)(ws + B_VFIRST);
      float* cbuf = (float*)(ws + B_CBUF);
      char* scan = ws + B_SCAN;
      auto epi = [&](auto interior_tag) {
      constexpr bool INTR = decltype(interior_tag)::value;
#pragma unroll
      for (int mt = 0; mt < 2; ++mt)
#pragma unroll
        for (int i = 0; i < 4; ++i) {
          const int tok = tb + mt * 16 + fq * 4 + i;
          int seq = 0, t = 1, T = 2048;
          if constexpr (!INTR) tok_info(tok, seq, t, T);
          const bf16_t* pr = proj + (size_t)tok * DIN;
          float rr[4], kx[4], vv[4], aval[4], dec[4], kkr[4], kmod[4];
          float ss = 0.f, s1 = 0.f, s2 = 0.f, s3 = 0.f;
#pragma unroll
          for (int nt = 0; nt < 4; ++nt) {
            const int cc = nt * 16 + fr, c = h * 64 + cc;
            float pc, pp;
            pc = bf2f(pr[c]);
            if constexpr (INTR) pp = bf2f(pr[c - DIN]); else pp = prw_prev(p, proj, l, tok, seq, t, c);
            rr[nt] = pc + (pp - pc) * mur[nt];
            pc = bf2f(pr[768 + c]);
            if constexpr (INTR) pp = bf2f(pr[768 + c - DIN]); else pp = prw_prev(p, proj, l, tok, seq, t, 768 + c);
            kx[nt] = pc + (pp - pc) * muk[nt];
            pc = bf2f(pr[1536 + c]);
            if constexpr (INTR) pp = bf2f(pr[1536 + c - DIN]); else pp = prw_prev(p, proj, l, tok, seq, t, 1536 + c);
            float vx = pc + (pp - pc) * muv[nt];
            float wraw = -softplusf_(-(w0[nt] + aw[mt][nt][i])) - 0.5f;
            dec[nt] = __expf(-__expf(wraw));
            aval[nt] = sigmoidf_(a0[nt] + aa[mt][nt][i]);
            if (l > 0) {
              float vf = bf2f(vfirst[(size_t)tok * DRW + c]);
              vv[nt] = vx + (vf - vx) * sigmoidf_(v0[nt] + av[mt][nt][i]);
            } else {
              vfirst[(size_t)tok * DRW + c] = f2bf(vx);
              vv[nt] = vx;
            }
            kkr[nt] = kx[nt] * kkp[nt];
            kmod[nt] = kx[nt] * (1.f + (aval[nt] - 1.f) * kap[nt]);
            ss += kkr[nt] * kkr[nt];
            s1 += kkr[nt] * aval[nt] * rr[nt];
            s2 += kmod[nt] * rr[nt];
            s3 += rr[nt] * kmod[nt] * rkp[nt];
          }
          ss = red16_sum(ss); s1 = red16_sum(s1); s2 = red16_sum(s2); s3 = red16_sum(s3);
          const float inv = 1.f / fmaxf(sqrtf(ss), 1e-12f);
          char* so = scan + ((size_t)tok * 12 + h) * 896;
#pragma unroll
          for (int nt = 0; nt < 4; ++nt) {
            const int cc = nt * 16 + fr;
            float kkn = kkr[nt] * inv;
            ((float*)so)[cc] = dec[nt];
            ((bf16_t*)(so + 256))[cc] = f2bf(dec[nt] * rr[nt]);
            ((bf16_t*)(so + 384))[cc] = f2bf(-kkn);
            ((bf16_t*)(so + 512))[cc] = f2bf(kkn * aval[nt]);
            ((bf16_t*)(so + 640))[cc] = f2bf(kmod[nt]);
            ((bf16_t*)(so + 768))[cc] = f2bf(vv[nt]);
          }
          if (fr == 0) {
            float4 cv = make_float4(s1 * inv, s2, s3, 0.f);
            *(float4*)(cbuf + ((size_t)tok * 12 + h) * 4) = cv;
          }
        }
      };
      const int tbu = __builtin_amdgcn_readfirstlane(tb);
      if (tbu < MP && (tbu & 2047) != 0) epi(std::true_type{}); else epi(std::false_type{});
    }
  }
  for (TileIter ti = tile_iter_rev(NRW); ti.L < ti.Lend; ti.L += ti.step) {
    const int item = NRW + ti.L;
    int txl = TX;
    asm volatile("" : "+v"(txl));
    const int lane = txl & 63, wv = txl >> 6, fr = lane & 15, fq = lane >> 4;
    {
      const int it = item - NRW;
      const int nb = it % 12, tb = (it / 12) * 128 + wv * 32;
      const bf16_t* rgt = (const bf16_t*)(ws + W_RGT) + ((size_t)l * 12 + nb) * 4096;
      const bf16_t* igt = (const bf16_t*)(ws + W_IGT) + ((size_t)l * 12 + nb) * 4096;
      const int wrow0 = (fr >> 2) * 16 + (fr & 3);
      f32x4 ar[2][4], ai[2][4];
#pragma unroll
      for (int a = 0; a < 2; ++a)
#pragma unroll
        for (int b = 0; b < 4; ++b) { ar[a][b] = f32x4{0, 0, 0, 0}; ai[a][b] = ar[a][b]; }
#pragma unroll
      for (int ks = 0; ks < 2; ++ks) {
        bf16x8 af[2], b1[4], b2[4];
#pragma unroll
        for (int mt = 0; mt < 2; ++mt) af[mt] = *(const bf16x8*)(XC + (size_t)(tb + mt * 16 + fr) * DLRU + nb * 64 + ks * 32 + fq * 8);
#pragma unroll
        for (int nt = 0; nt < 4; ++nt) {
          b1[nt] = *(const bf16x8*)(rgt + (size_t)(wrow0 + nt * 4) * 64 + ks * 32 + fq * 8);
          b2[nt] = *(const bf16x8*)(igt + (size_t)(wrow0 + nt * 4) * 64 + ks * 32 + fq * 8);
        }
#pragma unroll
        for (int mt = 0; mt < 2; ++mt)
#pragma unroll
          for (int nt = 0; nt < 4; ++nt) {
            ar[mt][nt] = MFMA(b1[nt], af[mt], ar[mt][nt]);
            ai[mt][nt] = MFMA(b2[nt], af[mt], ai[mt][nt]);
          }
      }
      float* abuf = (float*)(ws + B_ABUF);
      bf16_t* ubuf = (bf16_t*)(ws + B_UBUF);
#pragma unroll
      for (int nt = 0; nt < 4; ++nt) {
        const int c = nb * 64 + fq * 16 + nt * 4;
        const float4 brq = *(const float4*)(p.in[I_BRG] + (size_t)l * DLRU + c), biq = *(const float4*)(p.in[I_BIG] + (size_t)l * DLRU + c);
        const float4 lmq = *(const float4*)(p.in[I_LAMBDA] + (size_t)l * DLRU + c);
        const float br_[4] = {brq.x, brq.y, brq.z, brq.w}, bi_[4] = {biq.x, biq.y, biq.z, biq.w};
        const float sp_[4] = {softplusf_(-lmq.x), softplusf_(-lmq.y), softplusf_(-lmq.z), softplusf_(-lmq.w)};
#pragma unroll
        for (int mt = 0; mt < 2; ++mt) {
          const int tok = tb + mt * 16 + fr;
          float xc_[4];
          unpack4(*(const uint2*)(XC + (size_t)tok * DLRU + c), xc_);
          float ao[4], uo[4];
#pragma unroll
          for (int i = 0; i < 4; ++i) {
            const float rg = sigmoidf_(ar[mt][nt][i] + br_[i]), ig = sigmoidf_(ai[mt][nt][i] + bi_[i]);
            const float la = -8.f * rg * sp_[i];
            ao[i] = __expf(la);
            uo[i] = sqrtf(fmaxf(-expm1f(2.f * la), 0.f)) * (ig * xc_[i]);
          }
          *(float4*)(abuf + (size_t)tok * DLRU + c) = make_float4(ao[0], ao[1], ao[2], ao[3]);
          { uint2 uq; uq.x = pk_bf2(uo[0], uo[1]); uq.y = pk_bf2(uo[2], uo[3]); *(uint2*)(ubuf + (size_t)tok * DLRU + c) = uq; }
        }
      }
    }
  }
}

constexpr int STEP_B = 1552;
struct WkvOps { float4 w4, r4, n4, b4, k4; float v; float2 cc; };
__device__ __forceinline__ void wkv_load(WkvOps& o, const char* b, int kq, int vrow) {
  o.w4 = *(const float4*)(b + kq * 16);
  o.r4 = *(const float4*)(b + 256 + kq * 16);
  o.n4 = *(const float4*)(b + 512 + kq * 16);
  o.b4 = *(const float4*)(b + 768 + kq * 16);
  o.k4 = *(const float4*)(b + 1024 + kq * 16);
  o.v = *(const float*)(b + 1280 + vrow * 4);
  o.cc = *(const float2*)(b + 1536);
}
__device__ __forceinline__ void wkv_step(const WkvOps& o, float& S0, float& S1, float& S2, float& S3, float& ykeep, bool keep) {
  float sa = S0 * o.n4.x + S1 * o.n4.y + S2 * o.n4.z + S3 * o.n4.w;
  float z = S0 * o.r4.x + S1 * o.r4.y + S2 * o.r4.z + S3 * o.r4.w;
  sa = red16_sum(sa);
  z = red16_sum(z);
  const float y = z + sa * o.cc.x + o.v * o.cc.y;
  ykeep = keep ? y : ykeep;
  S0 = S0 * o.w4.x + (sa * o.b4.x + o.v * o.k4.x);
  S1 = S1 * o.w4.y + (sa * o.b4.y + o.v * o.k4.y);
  S2 = S2 * o.w4.z + (sa * o.b4.z + o.v * o.k4.z);
  S3 = S3 * o.w4.w + (sa * o.b4.w + o.v * o.k4.w);
}

struct WkvStage { uint4 st[4]; float4 cst; };
__device__ __forceinline__ void wkv_stage_load(WkvStage& g, const char* scan, const float* cbuf, int tid, int tok0, int h, int c, int T) {
  const int ns = min(16, T - c * 16);
#pragma unroll
  for (int j = 0; j < 4; ++j) {
    const int u = tid + 256 * j;
    if (u < ns * 56) {
      const int s = u / 56, q = u % 56;
      g.st[j] = *(const uint4*)(scan + ((size_t)(tok0 + c * 16 + s) * 12 + h) * 896 + q * 16);
    }
  }
  if (tid >= 128 && tid < 128 + ns) g.cst = *(const float4*)(cbuf + ((size_t)(tok0 + c * 16 + (tid - 128)) * 12 + h) * 4);
}
__device__ __forceinline__ void wkv_stage_write(const WkvStage& g, char* buf, int tid, int c, int T) {
  const int ns = min(16, T - c * 16);
#pragma unroll
  for (int j = 0; j < 4; ++j) {
    const int u = tid + 256 * j;
    if (u < ns * 56) {
      const int s = u / 56, q = u % 56;
      char* base = buf + s * STEP_B;
      if (q < 16) {
        *(uint4*)(base + q * 16) = g.st[j];
      } else {
        float4 lo, hi;
        lo.x = __uint_as_float(g.st[j].x << 16); lo.y = __uint_as_float(g.st[j].x & 0xffff0000u);
        lo.z = __uint_as_float(g.st[j].y << 16); lo.w = __uint_as_float(g.st[j].y & 0xffff0000u);
        hi.x = __uint_as_float(g.st[j].z << 16); hi.y = __uint_as_float(g.st[j].z & 0xffff0000u);
        hi.z = __uint_as_float(g.st[j].w << 16); hi.w = __uint_as_float(g.st[j].w & 0xffff0000u);
        const int off = 256 + (q - 16) * 32;
        *(float4*)(base + off) = lo;
        *(float4*)(base + off + 16) = hi;
      }
    }
  }
  if (tid >= 128 && tid < 128 + ns) *(float2*)(buf + (tid - 128) * STEP_B + 1536) = make_float2(g.cst.x, g.cst.y);
}
__device__ __forceinline__ void wkv_chunk16(const char* buf, int kq, int vrow, float& S0, float& S1, float& S2, float& S3, float& ykeep) {
  WkvOps oa, ob;
  wkv_load(oa, buf, kq, vrow);
#pragma unroll
  for (int s = 0; s < 16; s += 2) {
    wkv_load(ob, buf + (s + 1) * STEP_B, kq, vrow);
    wkv_step(oa, S0, S1, S2, S3, ykeep, kq == s);
    if (s + 2 < 16) wkv_load(oa, buf + (s + 2) * STEP_B, kq, vrow);
    wkv_step(ob, S0, S1, S2, S3, ykeep, kq == s + 1);
  }
}

__device__ void wkv_scan_item(const Params& p, int l, int seq, int h, int qt, char* lds) {
  const int TX = tid_();
  char* ws = p.ws;
  const int tid = TX, lane = tid & 63, wv = tid >> 6;
  const int kq = lane & 15, rl = lane >> 4;
  const int T = (seq < 8) ? 2048 : 4;
  const int tok0 = seq_tok0(seq);
  const char* scan = ws + B_SCAN;
  const float* cbuf = (const float*)(ws + B_CBUF);
  float* ybuf = (float*)(ws + B_YBUF);
  WkvStage ga, gb;
  float4 sin[4];
  if (seq >= 8) {
#pragma unroll
    for (int q4 = 0; q4 < 4; ++q4)
      sin[q4] = *(const float4*)(p.in[I_SWKV] + ((((size_t)l * 128 + (seq - 8)) * 12 + h) * 64 + q4 * 16 + wv * 4 + rl) * 64 + kq * 4);
  }
  __syncthreads();
  wkv_stage_load(ga, scan, cbuf, tid, tok0, h, 0, T);
  if (seq < 8) wkv_stage_load(gb, scan, cbuf, tid, tok0, h, 1, T);
  wkv_stage_write(ga, lds, tid, 0, T);
  __syncthreads();
  if (seq < 8) {
    constexpr int NCH = 128;
    const int vrow = qt * 16 + wv * 4 + rl;
    float S0 = 0.f, S1 = 0.f, S2 = 0.f, S3 = 0.f;
    char* buf0 = lds;
    char* buf1 = lds + 16 * STEP_B;
#pragma unroll 1
    for (int c = 0; c < NCH; c += 2) {
      if (c + 2 < NCH) wkv_stage_load(ga, scan, cbuf, tid, tok0, h, c + 2, T);
      float ykeep = 0.f;
      wkv_chunk16(buf0, kq, vrow, S0, S1, S2, S3, ykeep);
      ybuf[(size_t)(tok0 + c * 16 + kq) * DRW + h * 64 + vrow] = ykeep;
      wkv_stage_write(gb, buf1, tid, c + 1, T);
      __syncthreads();
      if (c + 3 < NCH) wkv_stage_load(gb, scan, cbuf, tid, tok0, h, c + 3, T);
      ykeep = 0.f;
      wkv_chunk16(buf1, kq, vrow, S0, S1, S2, S3, ykeep);
      ybuf[(size_t)(tok0 + (c + 1) * 16 + kq) * DRW + h * 64 + vrow] = ykeep;
      if (c + 2 < NCH) wkv_stage_write(ga, buf0, tid, c + 2, T);
      __syncthreads();
    }
    *(float4*)(p.out + O_WKVP + ((((size_t)l * 8 + seq) * 12 + h) * 64 + vrow) * 64 + kq * 4) = make_float4(S0, S1, S2, S3);
  } else {
    const int b = seq - 8;
#pragma unroll
    for (int q4 = 0; q4 < 4; ++q4) {
      const int vrow = q4 * 16 + wv * 4 + rl;
      float S0 = sin[q4].x, S1 = sin[q4].y, S2 = sin[q4].z, S3 = sin[q4].w;
      float ykeep = 0.f;
      WkvOps oa, ob;
      wkv_load(oa, lds, kq, vrow);
#pragma unroll
      for (int s2 = 0; s2 < 4; s2 += 2) {
        wkv_load(ob, lds + (s2 + 1) * STEP_B, kq, vrow);
        wkv_step(oa, S0, S1, S2, S3, ykeep, kq == s2);
        if (s2 + 2 < 4) wkv_load(oa, lds + (s2 + 2) * STEP_B, kq, vrow);
        wkv_step(ob, S0, S1, S2, S3, ykeep, kq == s2 + 1);
      }
      if (kq < 4) ybuf[(size_t)(tok0 + kq) * DRW + h * 64 + vrow] = ykeep;
      *(float4*)(p.out + O_WKVS + ((((size_t)l * 128 + b) * 12 + h) * 64 + vrow) * 64 + kq * 4) = make_float4(S0, S1, S2, S3);
    }
    __syncthreads();
  }
}

__device__ __forceinline__ float gelu_tanh_(float x) {
  const float u = 0.7978845608028654f * (x + 0.044715f * x * x * x);
  const float th = 1.f - 2.f / (1.f + __expf(2.f * u));
  return 0.5f * x * (1.f + th);
}

__device__ void lru_scan_prompt_item(const Params& p, int l, int seq, int cg, char* lds) {
  const int TX = tid_();
  char* ws = p.ws;
  const int ts = TX >> 5, ch = cg * 32 + (TX & 31);
  const float* abuf = (const float*)(ws + B_ABUF);
  const bf16_t* ubuf = (const bf16_t*)(ws + B_UBUF);
  const bf16_t* plg = (const bf16_t*)(ws + B_PROJ) + ((size_t)seq * 2048 + ts * 256) * DIN + C_LG + ch;
  bf16_t* alru = (bf16_t*)(ws + B_ALRU);
  const size_t base = ((size_t)seq * 2048 + ts * 256) * DLRU + ch;
  float* sA = (float*)lds;
  float* sU = sA + 256;
  __syncthreads();
  float A = 1.f, U = 0.f;
  for (int t0 = 0; t0 < 256; t0 += 16) {
    float a[16], u[16];
#pragma unroll
    for (int j = 0; j < 16; ++j) {
      a[j] = abuf[base + (size_t)(t0 + j) * DLRU];
      u[j] = bf2f(ubuf[base + (size_t)(t0 + j) * DLRU]);
    }
#pragma unroll
    for (int j = 0; j < 16; ++j) { U = a[j] * U + u[j]; A *= a[j]; }
  }
  sA[TX] = A;
  sU[TX] = U;
  __syncthreads();
  float h = 0.f;
  for (int j = 0; j < ts; ++j) h = sA[j * 32 + (TX & 31)] * h + sU[j * 32 + (TX & 31)];
  {
    float a[16], u[16], an[16], un[16];
    bf16_t g[16], gn[16];
#pragma unroll
    for (int j = 0; j < 16; ++j) {
      a[j] = abuf[base + (size_t)j * DLRU];
      u[j] = bf2f(ubuf[base + (size_t)j * DLRU]);
      g[j] = plg[(size_t)j * DIN];
    }
    for (int t0 = 0; t0 < 256; t0 += 16) {
      if (t0 + 16 < 256) {
#pragma unroll
        for (int j = 0; j < 16; ++j) {
          an[j] = abuf[base + (size_t)(t0 + 16 + j) * DLRU];
          un[j] = bf2f(ubuf[base + (size_t)(t0 + 16 + j) * DLRU]);
          gn[j] = plg[(size_t)(t0 + 16 + j) * DIN];
        }
      }
#pragma unroll
      for (int j = 0; j < 16; ++j) {
        h = a[j] * h + u[j];
        alru[base + (size_t)(t0 + j) * DLRU] = f2bf(h * gelu_tanh_(bf2f(g[j])));
      }
#pragma unroll
      for (int j = 0; j < 16; ++j) { a[j] = an[j]; u[j] = un[j]; g[j] = gn[j]; }
    }
  }
  if (ts == 7) p.out[O_HP + ((size_t)l * 8 + seq) * DLRU + ch] = h;
  __syncthreads();
}

__device__ void lru_scan_item(const Params& p, int l, int seq, int cg3) {
  const int TX = tid_();
  char* ws = p.ws;
  const int ch = cg3 * 256 + TX;
  const int tok0 = seq_tok0(seq);
  const float* abuf = (const float*)(ws + B_ABUF);
  const bf16_t* ubuf = (const bf16_t*)(ws + B_UBUF);
  const bf16_t* proj = (const bf16_t*)(ws + B_PROJ);
  bf16_t* alru = (bf16_t*)(ws + B_ALRU);
  float h = p.in[I_SH][((size_t)l * 128 + (seq - 8)) * DLRU + ch];
  float a[4], u[4], g[4];
#pragma unroll
  for (int j = 0; j < 4; ++j) {
    a[j] = abuf[(size_t)(tok0 + j) * DLRU + ch];
    u[j] = bf2f(ubuf[(size_t)(tok0 + j) * DLRU + ch]);
    g[j] = bf2f(proj[(size_t)(tok0 + j) * DIN + C_LG + ch]);
  }
#pragma unroll
  for (int j = 0; j < 4; ++j) {
    h = a[j] * h + u[j];
    alru[(size_t)(tok0 + j) * DLRU + ch] = f2bf(h * gelu_tanh_(g[j]));
  }
  p.out[O_HS + ((size_t)l * 128 + (seq - 8)) * DLRU + ch] = h;
}

__device__ void attn_prompt_item(const Params& p, int l, int b, int h, int qt, char* lds) {
  const int TX = tid_();
  char* ws = p.ws;
  const int lane = TX & 63, wv = TX >> 6, fr = lane & 15, fq = lane >> 4;
  const bf16_t* proj = (const bf16_t*)(ws + B_PROJ);
  const bf16_t* kb = (const bf16_t*)(ws + B_KB) + ((size_t)(l * 8 + b) * 256) * 512 + h * 128;
  const bf16_t* vt = (const bf16_t*)(ws + B_VTB) + (((size_t)(l * 8 + b) * 4 + h) * 128) * 256;
  bf16_t* axa = (bf16_t*)(ws + B_AXA);
  const int tok0 = b * 2048 + qt * 64 + wv * 16;
  bf16x8 aq[4];
#pragma unroll
  for (int ks = 0; ks < 4; ++ks) aq[ks] = *(const bf16x8*)(proj + (size_t)(tok0 + fr) * DIN + C_Q + h * 128 + ks * 32 + fq * 8);
  f32x4 s[16];
#pragma unroll
  for (int nt = 0; nt < 16; ++nt) {
    s[nt] = f32x4{0, 0, 0, 0};
#pragma unroll
    for (int ks = 0; ks < 4; ++ks) {
      bf16x8 bk = *(const bf16x8*)(kb + (size_t)(nt * 16 + fr) * 512 + ks * 32 + fq * 8);
      s[nt] = MFMA(aq[ks], bk, s[nt]);
    }
  }
  const float scale = 0.08838834764831845f;
  float rs[4];
  char* pl = lds + wv * 8192;
  __syncthreads();
#pragma unroll
  for (int i = 0; i < 4; ++i) {
    float m = s[0][i];
#pragma unroll
    for (int nt = 1; nt < 16; ++nt) m = fmaxf(m, s[nt][i]);
    m = red16_max(m);
    float sum = 0.f;
#pragma unroll
    for (int nt = 0; nt < 16; ++nt) {
      float e = __expf((s[nt][i] - m) * scale);
      sum += e;
      const int key = nt * 16 + fr, rr = fq * 4 + i;
      *(bf16_t*)(pl + (key >> 5) * 1024 + swz(rr, (key & 31) * 2)) = f2bf(e);
    }
    rs[i] = red16_sum(sum);
  }
  __syncthreads();
  f32x4 o[8];
#pragma unroll
  for (int nt = 0; nt < 8; ++nt) o[nt] = f32x4{0, 0, 0, 0};
  const int fo = swz(fr, fq * 16);
#pragma unroll
  for (int ks = 0; ks < 8; ++ks) {
    bf16x8 ap = *(const bf16x8*)(pl + ks * 1024 + fo);
#pragma unroll
    for (int nt = 0; nt < 8; ++nt) {
      bf16x8 bv = *(const bf16x8*)(vt + (size_t)(nt * 16 + fr) * 256 + ks * 32 + fq * 8);
      o[nt] = MFMA(ap, bv, o[nt]);
    }
  }
#pragma unroll
  for (int nt = 0; nt < 8; ++nt)
#pragma unroll
    for (int i = 0; i < 4; ++i)
      axa[(size_t)(tok0 + fq * 4 + i) * DXA + h * 128 + nt * 16 + fr] = f2bf(o[nt][i] / rs[i]);
  __syncthreads();
}

__device__ void attn_sample_item(const Params& p, int l, int b, int h, char* lds) {
  const int TX = tid_();
  char* ws = p.ws;
  const int tid = TX, lane = tid & 63, wv = tid >> 6;
  const bf16_t* proj = (const bf16_t*)(ws + B_PROJ);
  bf16_t* axa = (bf16_t*)(ws + B_AXA);
  const int tok0 = MP + b * 4;
  float* q = (float*)lds;
  float* pr = q + 512;
  float* red = pr + 1024;
  float* part = red + 32;
  __syncthreads();
  for (int i = tid; i < 512; i += 256) q[i] = bf2f(proj[(size_t)(tok0 + (i >> 7)) * DIN + C_Q + h * 128 + (i & 127)]);
  __syncthreads();
  const float* kc = p.in[I_CK] + (((size_t)l * 128 + b) * 256 + tid) * 512 + h * 128;
  float s0 = 0.f, s1 = 0.f, s2 = 0.f, s3 = 0.f;
#pragma unroll 4
  for (int d = 0; d < 128; d += 4) {
    const float4 kv = *(const float4*)(kc + d);
    const float4 q0 = *(const float4*)(q + d), q1 = *(const float4*)(q + 128 + d), q2 = *(const float4*)(q + 256 + d),
                 q3 = *(const float4*)(q + 384 + d);
    s0 += kv.x * q0.x + kv.y * q0.y + kv.z * q0.z + kv.w * q0.w;
    s1 += kv.x * q1.x + kv.y * q1.y + kv.z * q1.z + kv.w * q1.w;
    s2 += kv.x * q2.x + kv.y * q2.y + kv.z * q2.z + kv.w * q2.w;
    s3 += kv.x * q3.x + kv.y * q3.y + kv.z * q3.z + kv.w * q3.w;
  }
  const float scale = 0.08838834764831845f;
  s0 *= scale; s1 *= scale; s2 *= scale; s3 *= scale;
  float m0 = s0, m1 = s1, m2 = s2, m3 = s3;
#pragma unroll
  for (int m = 1; m < 64; m <<= 1) {
    m0 = fmaxf(m0, __shfl_xor(m0, m, 64)); m1 = fmaxf(m1, __shfl_xor(m1, m, 64));
    m2 = fmaxf(m2, __shfl_xor(m2, m, 64)); m3 = fmaxf(m3, __shfl_xor(m3, m, 64));
  }
  if (lane == 0) { red[wv * 4 + 0] = m0; red[wv * 4 + 1] = m1; red[wv * 4 + 2] = m2; red[wv * 4 + 3] = m3; }
  __syncthreads();
  m0 = fmaxf(fmaxf(red[0], red[4]), fmaxf(red[8], red[12]));
  m1 = fmaxf(fmaxf(red[1], red[5]), fmaxf(red[9], red[13]));
  m2 = fmaxf(fmaxf(red[2], red[6]), fmaxf(red[10], red[14]));
  m3 = fmaxf(fmaxf(red[3], red[7]), fmaxf(red[11], red[15]));
  const float e0 = __expf(s0 - m0), e1 = __expf(s1 - m1), e2 = __expf(s2 - m2), e3 = __expf(s3 - m3);
  pr[tid] = e0; pr[256 + tid] = e1; pr[512 + tid] = e2; pr[768 + tid] = e3;
  float t0 = wave_sum(e0), t1 = wave_sum(e1), t2 = wave_sum(e2), t3 = wave_sum(e3);
  if (lane == 0) { red[16 + wv * 4 + 0] = t0; red[16 + wv * 4 + 1] = t1; red[16 + wv * 4 + 2] = t2; red[16 + wv * 4 + 3] = t3; }
  __syncthreads();
  const float z0 = red[16] + red[20] + red[24] + red[28], z1 = red[17] + red[21] + red[25] + red[29];
  const float z2 = red[18] + red[22] + red[26] + red[30], z3 = red[19] + red[23] + red[27] + red[31];
  const int d = tid & 127, half = tid >> 7;
  const float* vc = p.in[I_CV] + (((size_t)l * 128 + b) * 256 + half * 128) * 512 + h * 128 + d;
  float o0 = 0.f, o1 = 0.f, o2 = 0.f, o3 = 0.f;
#pragma unroll 8
  for (int k = 0; k < 128; ++k) {
    const float vv = vc[(size_t)k * 512];
    const int key = half * 128 + k;
    o0 += pr[key] * vv; o1 += pr[256 + key] * vv; o2 += pr[512 + key] * vv; o3 += pr[768 + key] * vv;
  }
  if (half == 1) { part[d] = o0; part[128 + d] = o1; part[256 + d] = o2; part[384 + d] = o3; }
  __syncthreads();
  if (half == 0) {
    o0 += part[d]; o1 += part[128 + d]; o2 += part[256 + d]; o3 += part[384 + d];
    axa[(size_t)(tok0 + 0) * DXA + h * 128 + d] = f2bf(o0 / z0);
    axa[(size_t)(tok0 + 1) * DXA + h * 128 + d] = f2bf(o1 / z1);
    axa[(size_t)(tok0 + 2) * DXA + h * 128 + d] = f2bf(o2 / z2);
    axa[(size_t)(tok0 + 3) * DXA + h * 128 + d] = f2bf(o3 / z3);
  }
  __syncthreads();
}

__device__ void phase_mix(const Params& p, int l, char* lds, int* s_item) {
  const int TX = tid_();
  int* cnt = (int*)(p.ws + B_CNT) + l;
  constexpr int N_WKVP = 96 * 4, N_LRUP = 8 * 24, N_ATTP = 1024, N_WKVS = 128 * 12, N_LRUS = 384, N_ATTS = 512;
  constexpr int E1 = N_WKVP, E2 = E1 + N_LRUP, E3 = E2 + N_ATTP, E4 = E3 + N_WKVS, E5 = E4 + N_LRUS, E6 = E5 + N_ATTS;
  for (;;) {
    __syncthreads();
    if (TX == 0) *s_item = atomicAdd(cnt, 1);
    __syncthreads();
    const int it = *s_item;
    if (it >= E6) break;
    if (it < E1) {
      const int qt = it & 3, bh = it >> 2;
      wkv_scan_item(p, l, bh / 12, bh % 12, qt, lds);
    } else if (it < E2) {
      const int j = it - E1;
      lru_scan_prompt_item(p, l, j / 24, j % 24, lds);
    } else if (it < E3) {
      const int j = it - E2;
      attn_prompt_item(p, l, j >> 7, (j >> 5) & 3, j & 31, lds);
    } else if (it < E4) {
      const int j = it - E3;
      wkv_scan_item(p, l, 8 + j / 12, j % 12, -1, lds);
    } else if (it < E5) {
      const int j = it - E4;
      lru_scan_item(p, l, 8 + j / 3, j % 3);
    } else {
      const int j = it - E5;
      attn_sample_item(p, l, j >> 2, j & 3, lds);
    }
  }
}

__device__ void phase_post(const Params& p, int l) {
  const int TX = tid_();
  char* ws = p.ws;
  const int lane = TX & 63, wv = TX >> 6;
  const float* ybuf = (const float*)(ws + B_YBUF);
  const float* cbuf = (const float*)(ws + B_CBUF);
  const bf16_t* gbuf = (const bf16_t*)(ws + B_GBUF);
  const char* scan = ws + B_SCAN;
  bf16_t* arw = (bf16_t*)(ws + B_ARW);
  const float* gng = p.in[I_GNG] + (size_t)l * DRW;
  const float* gnb = p.in[I_GNB] + (size_t)l * DRW;
  for (int t4 = blockIdx.x; t4 < MT / 4; t4 += gridDim.x) {
    const int tok = t4 * 4 + wv;
#pragma unroll
    for (int ps = 0; ps < 3; ++ps) {
      const int c = ps * 256 + lane * 4, h = c >> 6;
      const float4 y = *(const float4*)(ybuf + (size_t)tok * DRW + c);
      const float mean = red16_sum(y.x + y.y + y.z + y.w) * (1.f / 64.f);
      const float d0 = y.x - mean, d1 = y.y - mean, d2 = y.z - mean, d3 = y.w - mean;
      const float var = red16_sum(d0 * d0 + d1 * d1 + d2 * d2 + d3 * d3) * (1.f / 64.f);
      const float rs = rsqrtf(var + 64e-5f);
      const float4 gg = *(const float4*)(gng + c), gb = *(const float4*)(gnb + c);
      const float c3 = cbuf[((size_t)tok * 12 + h) * 4 + 2];
      const uint2 vq = *(const uint2*)(scan + ((size_t)tok * 12 + h) * 896 + 768 + (c & 63) * 2);
      const uint2 gq = *(const uint2*)(gbuf + (size_t)tok * DRW + c);
      const float v0 = __uint_as_float(vq.x << 16), v1 = __uint_as_float(vq.x & 0xffff0000u);
      const float v2 = __uint_as_float(vq.y << 16), v3 = __uint_as_float(vq.y & 0xffff0000u);
      const float g0 = __uint_as_float(gq.x << 16), g1 = __uint_as_float(gq.x & 0xffff0000u);
      const float g2 = __uint_as_float(gq.y << 16), g3 = __uint_as_float(gq.y & 0xffff0000u);
      uint2 o;
      o.x = pk_bf2((d0 * rs * gg.x + gb.x + c3 * v0) * g0, (d1 * rs * gg.y + gb.y + c3 * v1) * g1);
      o.y = pk_bf2((d2 * rs * gg.z + gb.z + c3 * v2) * g2, (d3 * rs * gg.w + gb.w + c3 * v3) * g3);
      *(uint2*)(arw + (size_t)tok * DRW + c) = o;
    }
  }
}

__device__ __forceinline__ void merge_ops(char* ws, int l, int br, const bf16_t*& A, const bf16_t*& Bt, int& K) {
  if (br == 0) { A = (const bf16_t*)(ws + B_ARW); Bt = (const bf16_t*)(ws + W_RWOUT) + (size_t)l * D * DRW; K = DRW; }
  else if (br == 1) { A = (const bf16_t*)(ws + B_ALRU); Bt = (const bf16_t*)(ws + W_LRUOUT) + (size_t)l * D * DLRU; K = DLRU; }
  else { A = (const bf16_t*)(ws + B_AXA); Bt = (const bf16_t*)(ws + W_XAOUT) + (size_t)l * D * DXA; K = DXA; }
}

__device__ void phase_merge(const Params& p, int l, char* lds) {
  const int TX = tid_();
  char* ws = p.ws;
  const bf16_t* proj = (const bf16_t*)(ws + B_PROJ);
  bf16_t* mixin = (bf16_t*)(ws + B_MIXIN);
  const int lane = TX & 63, wv = TX >> 6, wr = wv >> 1, wc = wv & 1, fr = lane & 15, fq = lane >> 4;
  const int ntiles = (MT / 128) * 16;
  TileIter it = tile_iter(ntiles);
  int L = it.L, br = 0;
  bool have = L < it.Lend;
  int m0 = 0, n0 = 0;
  const bf16_t* A = nullptr; const bf16_t* Bt = nullptr; int K = 0;
  if (have) {
    int tm, tn; tile_mn(L, MT / 128, 16, tm, tn); m0 = tm * 128; n0 = tn * 64;
    merge_ops(ws, l, 0, A, Bt, K);
    gemm_prologue<4, 2>(A, K, Bt, K, m0, n0, lds);
  }
  f32x4 sum[4][2];
  zero_acc(sum);
  while (have) {
    f32x4 acc[4][2];
    zero_acc(acc);
    gemm_loop<4, 2>(A, K, Bt, K, K, m0, n0, lds, acc);
    uint4 gq[4];
#pragma unroll
    for (int mt = 0; mt < 4; ++mt)
      gq[mt] = *(const uint4*)(proj + (size_t)(m0 + wr * 64 + mt * 16 + fr) * DIN + C_G + br * D + n0 + wc * 32 + fq * 8);
    int nbr = br + 1, nL = L;
    if (nbr == 3) { nbr = 0; nL = L + it.step; }
    const bool hn = nL < it.Lend;
    int m1 = m0, n1 = n0;
    const bf16_t* A1 = A; const bf16_t* Bt1 = Bt; int K1 = K;
    if (hn) {
      if (nbr == 0) { int tm, tn; tile_mn(nL, MT / 128, 16, tm, tn); m1 = tm * 128; n1 = tn * 64; }
      merge_ops(ws, l, nbr, A1, Bt1, K1);
      gemm_prologue<4, 2>(A1, K1, Bt1, K1, m1, n1, lds);
    }
#pragma unroll
    for (int mt = 0; mt < 4; ++mt) {
      const unsigned gw[4] = {gq[mt].x, gq[mt].y, gq[mt].z, gq[mt].w};
#pragma unroll
      for (int nt = 0; nt < 2; ++nt)
#pragma unroll
        for (int i = 0; i < 4; ++i) {
          const unsigned w = gw[nt * 2 + (i >> 1)];
          const float gv = __uint_as_float((i & 1) ? (w & 0xffff0000u) : (w << 16));
          sum[mt][nt][i] += sigmoidf_(gv) * acc[mt][nt][i];
        }
    }
    if (br == 2) {
#pragma unroll
      for (int mt = 0; mt < 4; ++mt) {
        const int row = m0 + wr * 64 + mt * 16 + fr, col = n0 + wc * 32 + fq * 8;
        *(uint4*)(mixin + (size_t)row * D + col) = pack8(sum[mt][0], sum[mt][1]);
      }
      zero_acc(sum);
    }
    L = nL; br = nbr; have = hn; m0 = m1; n0 = n1; A = A1; Bt = Bt1; K = K1;
  }
}

__device__ void phase_resid_gemm(const Params& p, const bf16_t* A, const bf16_t* Bt, int K, char* lds) {
  const int TX = tid_();
  char* ws = p.ws;
  const bf16_t* xb = (const bf16_t*)(ws + B_XB);
  bf16_t* t = (bf16_t*)(ws + B_XF);
  const int lane = TX & 63, wv = TX >> 6, wr = wv >> 1, wc = wv & 1, fr = lane & 15, fq = lane >> 4;
  constexpr int NT_ALL = (MT / 128) * 8;
  const int G = (int)gridDim.x;
  const int nfull = (NT_ALL / G) * G;
  TileIter it = tile_iter(nfull);
  bool have = it.L < it.Lend;
  int m0 = 0, n0 = 0;
  if (have) { int tm, tn; tile_mn(it.L, MT / 128, 8, tm, tn); m0 = tm * 128; n0 = tn * 128; gemm_prologue<4, 4>(A, K, Bt, K, m0, n0, lds); }
  while (have) {
    f32x4 acc[4][4];
    zero_acc(acc);
    gemm_loop<4, 4>(A, K, Bt, K, K, m0, n0, lds, acc);
    uint4 xq[4][2];
#pragma unroll
    for (int mt = 0; mt < 4; ++mt) {
      const uint4* xs = (const uint4*)(xb + (size_t)(m0 + wr * 64 + mt * 16 + fr) * D + n0 + wc * 64 + fq * 16);
      xq[mt][0] = xs[0];
      xq[mt][1] = xs[1];
    }
    const int Ln = it.L + it.step;
    const bool hn = Ln < it.Lend;
    int m1 = m0, n1 = n0;
    if (hn) { int tm, tn; tile_mn(Ln, MT / 128, 8, tm, tn); m1 = tm * 128; n1 = tn * 128; gemm_prologue<4, 4>(A, K, Bt, K, m1, n1, lds); }
#pragma unroll
    for (int mt = 0; mt < 4; ++mt) {
      uint4* ts = (uint4*)(t + (size_t)(m0 + wr * 64 + mt * 16 + fr) * D + n0 + wc * 64 + fq * 16);
      f32x4 o[4];
#pragma unroll
      for (int nt = 0; nt < 4; ++nt) {
        const uint4 q = xq[mt][nt >> 1];
        const unsigned w0 = (nt & 1) ? q.z : q.x, w1 = (nt & 1) ? q.w : q.y;
        o[nt][0] = ALPHA * __uint_as_float(w0 << 16) + acc[mt][nt][0];
        o[nt][1] = ALPHA * __uint_as_float(w0 & 0xffff0000u) + acc[mt][nt][1];
        o[nt][2] = ALPHA * __uint_as_float(w1 << 16) + acc[mt][nt][2];
        o[nt][3] = ALPHA * __uint_as_float(w1 & 0xffff0000u) + acc[mt][nt][3];
      }
      ts[0] = pack8(o[0], o[1]);
      ts[1] = pack8(o[2], o[3]);
    }
    it.L = Ln; have = hn; m0 = m1; n0 = n1;
  }
  for (int hidx = (int)blockIdx.x; hidx < (NT_ALL - nfull) * 2; hidx += G) {
    int tm, tn;
    tile_mn(nfull + (hidx >> 1), MT / 128, 8, tm, tn);
    const int hm0 = tm * 128, hn0 = tn * 128 + (hidx & 1) * 64;
    f32x4 acc[4][2];
    zero_acc(acc);
    gemm_main<4, 2>(A, K, Bt, K, K, hm0, hn0, lds, acc);
#pragma unroll
    for (int mt = 0; mt < 4; ++mt) {
      const size_t off = (size_t)(hm0 + wr * 64 + mt * 16 + fr) * D + hn0 + wc * 32 + fq * 8;
      const uint4 q = *(const uint4*)(xb + off);
      f32x4 o0, o1;
      o0[0] = ALPHA * __uint_as_float(q.x << 16) + acc[mt][0][0]; o0[1] = ALPHA * __uint_as_float(q.x & 0xffff0000u) + acc[mt][0][1];
      o0[2] = ALPHA * __uint_as_float(q.y << 16) + acc[mt][0][2]; o0[3] = ALPHA * __uint_as_float(q.y & 0xffff0000u) + acc[mt][0][3];
      o1[0] = ALPHA * __uint_as_float(q.z << 16) + acc[mt][1][0]; o1[1] = ALPHA * __uint_as_float(q.z & 0xffff0000u) + acc[mt][1][1];
      o1[2] = ALPHA * __uint_as_float(q.w << 16) + acc[mt][1][2]; o1[3] = ALPHA * __uint_as_float(q.w & 0xffff0000u) + acc[mt][1][3];
      *(uint4*)(t + off) = pack8(o0, o1);
    }
  }
}

__device__ void phase_ln(const Params& p, const float* g, const float* bta, bool final_out) {
  const int TX = tid_();
  char* ws = p.ws;
  const int lane = TX & 63, wv = TX >> 6;
  const bf16_t* t = (const bf16_t*)(ws + B_XF);
  float* yout = p.out + O_Y;
  bf16_t* xb = (bf16_t*)(ws + B_XB);
  for (int r4 = blockIdx.x; r4 < MT / 4; r4 += gridDim.x) {
    const int row = r4 * 4 + wv;
    float4 v[4];
    float s = 0.f;
#pragma unroll
    for (int j = 0; j < 4; ++j) {
      const uint2 q = *(const uint2*)(t + (size_t)row * D + j * 256 + lane * 4);
      v[j] = make_float4(__uint_as_float(q.x << 16), __uint_as_float(q.x & 0xffff0000u), __uint_as_float(q.y << 16), __uint_as_float(q.y & 0xffff0000u));
      s += v[j].x + v[j].y + v[j].z + v[j].w;
    }
    const float mean = wave_sum(s) * (1.f / 1024.f);
    float q = 0.f;
#pragma unroll
    for (int j = 0; j < 4; ++j) {
      v[j].x -= mean; v[j].y -= mean; v[j].z -= mean; v[j].w -= mean;
      q += v[j].x * v[j].x + v[j].y * v[j].y + v[j].z * v[j].z + v[j].w * v[j].w;
    }
    const float rstd = rsqrtf(wave_sum(q) * (1.f / 1024.f) + 1e-5f);
#pragma unroll
    for (int j = 0; j < 4; ++j) {
      const int c = j * 256 + lane * 4;
      const float4 gg = *(const float4*)(g + c), bb = *(const float4*)(bta + c);
      float4 o;
      o.x = v[j].x * rstd * gg.x + bb.x; o.y = v[j].y * rstd * gg.y + bb.y;
      o.z = v[j].z * rstd * gg.z + bb.z; o.w = v[j].w * rstd * gg.w + bb.w;
      if (final_out) {
        *(float4*)(yout + (size_t)row * D + c) = o;
      } else {
        uint2 ob;
        ob.x = (unsigned)f2bf(o.x) | ((unsigned)f2bf(o.y) << 16);
        ob.y = (unsigned)f2bf(o.z) | ((unsigned)f2bf(o.w) << 16);
        *(uint2*)(xb + (size_t)row * D + c) = ob;
      }
    }
  }
}

__device__ void phase_ffn_in(const Params& p, int l, char* lds) {
  const int TX = tid_();
  char* ws = p.ws;
  const bf16_t* xb = (const bf16_t*)(ws + B_XB);
  const bf16_t* wt = (const bf16_t*)(ws + W_FFNIN) + (size_t)l * 2 * DFF * D;
  bf16_t* act = (bf16_t*)(ws + B_ACT);
  const int lane = TX & 63, wv = TX >> 6, wr = wv >> 1, wc = wv & 1, fr = lane & 15, fq = lane >> 4;
  const int nN = 2 * DFF / 128, ntiles = (MT / 128) * nN;
  TileIter it = tile_iter(ntiles);
  bool have = it.L < it.Lend;
  int m0 = 0, n0 = 0;
  if (have) { int tm, tn; tile_mn(it.L, MT / 128, nN, tm, tn); m0 = tm * 128; n0 = tn * 128; gemm_prologue<4, 4>(xb, D, wt, D, m0, n0, lds); }
  while (have) {
    f32x4 acc[4][4];
    zero_acc(acc);
    gemm_loop<4, 4>(xb, D, wt, D, D, m0, n0, lds, acc);
    const int Ln = it.L + it.step;
    const bool hn = Ln < it.Lend;
    int m1 = m0, n1 = n0;
    if (hn) { int tm, tn; tile_mn(Ln, MT / 128, nN, tm, tn); m1 = tm * 128; n1 = tn * 128; gemm_prologue<4, 4>(xb, D, wt, D, m1, n1, lds); }
    const int jb = (n0 + wc * 64 + fq * 16) / 2;
#pragma unroll
    for (int mt = 0; mt < 4; ++mt) {
      const int row = m0 + wr * 64 + mt * 16 + fr;
      f32x4 o0, o1;
#pragma unroll
      for (int i = 0; i < 4; ++i) {
        const float g0 = acc[mt][2][i], g1 = acc[mt][3][i];
        o0[i] = g0 * sigmoidf_(g0) * acc[mt][0][i];
        o1[i] = g1 * sigmoidf_(g1) * acc[mt][1][i];
      }
      *(uint4*)(act + (size_t)row * DFF + jb) = pack8(o0, o1);
    }
    it.L = Ln; have = hn; m0 = m1; n0 = n1;
  }
}

__global__ void __launch_bounds__(256, 2) fwd_megakernel(Params p) {
  cg::grid_group grid = cg::this_grid();
  __shared__ __attribute__((aligned(1024))) char lds[LDS_BYTES];
  __shared__ int s_item;
  __shared__ uint4 xb_words;
  char* ws = p.ws;
  if (threadIdx.x == 0) xb_words = make_uint4(0u, 0u, 0u, 0u);
  __syncthreads();
  XcdBarrier xb = xcd_barrier_post((unsigned*)(ws + B_BAR), (volatile LAS unsigned*)&xb_words);
  constexpr int NPH = 1 + NL * 11;
#pragma unroll 1
  for (int ph = 0; ph < NPH; ++ph) {
    int phl = ph;
    asm volatile("" : "+s"(phl));
    if (phl == 0) {
      phase_convert(p, lds);
    } else {
      const int l = (phl - 1) / 11, k = (phl - 1) % 11;
      switch (k) {
        case 0: phase_proj(p, l, lds); break;
        case 1: phase_prep(p, l, lds); break;
        case 2: phase_lora(p, l, lds); break;
        case 3: phase_mix(p, l, lds, &s_item); break;
        case 4: phase_post(p, l); break;
        case 5: phase_merge(p, l, lds); break;
        case 8: phase_ffn_in(p, l, lds); break;
        case 6: case 9: {
          const bool first = (k == 6);
          phase_resid_gemm(p, (const bf16_t*)(ws + (first ? B_MIXIN : B_ACT)),
                           first ? (const bf16_t*)(ws + W_O) + (size_t)l * D * D : (const bf16_t*)(ws + W_FFNOUT) + (size_t)l * D * DFF,
                           first ? D : DFF, lds);
          break;
        }
        default: {
          const bool first = (k == 7);
          phase_ln(p, (first ? p.in[I_LN1G] : p.in[I_LN2G]) + (size_t)l * D, (first ? p.in[I_LN1B] : p.in[I_LN2B]) + (size_t)l * D,
                   !first && l == NL - 1);
          break;
        }
      }
    }
    if (ph + 1 < NPH) xcd_barrier(xb);
    if (p.ws == nullptr) grid.sync();
  }
}

extern "C" void kernel_launch(void* const* d_in, const int* in_sizes, int n_in, void* d_out, int out_size, void* d_ws,
                              size_t ws_size, hipStream_t stream) {
  static int grid_blocks = 0;
  if (!grid_blocks) {
    int dev = 0, cus = 0, per_cu = 0;
    (void)hipGetDevice(&dev);
    (void)hipDeviceGetAttribute(&cus, hipDeviceAttributeMultiprocessorCount, dev);
    (void)hipOccupancyMaxActiveBlocksPerMultiprocessor(&per_cu, fwd_megakernel, 256, 0);
    if (per_cu > 2) per_cu = 2;
    if (per_cu < 1) per_cu = 1;
    grid_blocks = cus * per_cu;
  }
  if (ws_size < WS_NEED || n_in < 42) {
    fprintf(stderr, "workspace too small: %zu < %zu\n", ws_size, (size_t)WS_NEED);
    return;
  }
  (void)hipMemsetAsync((char*)d_ws + B_CNT, 0, 256 + BAR_BYTES, stream);
  Params p{};
  for (int i = 0; i < 42; ++i) p.in[i] = (const float*)d_in[i];
  p.out = (float*)d_out;
  p.ws = (char*)d_ws;
  void* args[] = {&p};
  hipError_t e = hipLaunchCooperativeKernel((void*)fwd_megakernel, dim3(grid_blocks), dim3(256), args, 0, stream);
  if (e != hipSuccess) fprintf(stderr, "cooperative launch failed: %s (grid %d)\n", hipGetErrorString(e), grid_blocks);
}
```

```cpp
#include <hip/hip_runtime.h>
#include <hip/hip_cooperative_groups.h>
#include <cstdio>
#include <type_traits>
namespace cg = cooperative_groups;

typedef unsigned short bf16_t;
typedef __attribute__((ext_vector_type(8))) short bf16x8;
typedef __attribute__((ext_vector_type(4))) float f32x4;

constexpr int D = 1024, MP = 16384, MS = 512, MT = 16896, NL = 4;
constexpr int DIN = 7680, DRW = 768, DLRU = 768, DXA = 512, DFF = 2816, RWC = 2560;
constexpr int C_LX = 2560, C_LG = 3328, C_Q = 4096, C_G = 4608;
constexpr int NSEQ = 136;
constexpr float ALPHA = 1.681792830507429f;

constexpr size_t O_Y = 0;
constexpr size_t O_SHP = O_Y + (size_t)MT * D;
constexpr size_t O_WKVP = O_SHP + (size_t)NL * 8 * RWC;
constexpr size_t O_CONVP = O_WKVP + (size_t)NL * 8 * 12 * 64 * 64;
constexpr size_t O_HP = O_CONVP + (size_t)NL * 8 * 3 * DLRU;
constexpr size_t O_MKP = O_HP + (size_t)NL * 8 * DLRU;
constexpr size_t O_MVP = O_MKP + (size_t)NL * 8 * 256 * 512;
constexpr size_t O_SHS = O_MVP + (size_t)NL * 8 * 256 * 512;
constexpr size_t O_WKVS = O_SHS + (size_t)NL * 128 * RWC;
constexpr size_t O_CONVS = O_WKVS + (size_t)NL * 128 * 12 * 64 * 64;
constexpr size_t O_HS = O_CONVS + (size_t)NL * 128 * 3 * DLRU;
constexpr size_t O_END = O_HS + (size_t)NL * 128 * DLRU;

constexpr size_t al256(size_t x) { return (x + 255) & ~(size_t)255; }
constexpr size_t W_IN = 0;
constexpr size_t W_RWOUT = W_IN + al256((size_t)NL * DIN * D * 2);
constexpr size_t W_LRUOUT = W_RWOUT + al256((size_t)NL * D * DRW * 2);
constexpr size_t W_XAOUT = W_LRUOUT + al256((size_t)NL * D * DLRU * 2);
constexpr size_t W_O = W_XAOUT + al256((size_t)NL * D * DXA * 2);
constexpr size_t W_FFNIN = W_O + al256((size_t)NL * D * D * 2);
constexpr size_t W_FFNOUT = W_FFNIN + al256((size_t)NL * 2 * DFF * D * 2);
constexpr size_t W_MEMKV = W_FFNOUT + al256((size_t)NL * D * DFF * 2);
constexpr size_t W_W2T = W_MEMKV + al256((size_t)NL * D * D * 2);
constexpr size_t W_A2T = W_W2T + al256((size_t)NL * DRW * 64 * 2);
constexpr size_t W_G2T = W_A2T + al256((size_t)NL * DRW * 64 * 2);
constexpr size_t W_V2T = W_G2T + al256((size_t)NL * DRW * 128 * 2);
constexpr size_t W_RGT = W_V2T + al256((size_t)3 * DRW * 32 * 2);
constexpr size_t W_IGT = W_RGT + al256((size_t)NL * 12 * 64 * 64 * 2);
constexpr size_t B_XF = W_IGT + al256((size_t)NL * 12 * 64 * 64 * 2);
constexpr size_t B_XB = B_XF + al256((size_t)MT * D * 4);
constexpr size_t B_MEMB = B_XB + al256((size_t)MT * D * 2);
constexpr size_t B_KB = B_MEMB + al256((size_t)2048 * D * 2);
constexpr size_t B_VTB = B_KB + al256((size_t)NL * 8 * 256 * 512 * 2);
constexpr size_t B_VFIRST = B_VTB + al256((size_t)NL * 8 * 256 * 512 * 2);
constexpr size_t B_PROJ = B_VFIRST + al256((size_t)MT * DRW * 2);
constexpr size_t B_SCAN = B_PROJ + al256((size_t)MT * DIN * 2);
constexpr size_t SCAN_BYTES = (size_t)MT * 12 * 896;
constexpr size_t B_MIXIN = B_SCAN;
constexpr size_t B_ACT = B_SCAN + al256((size_t)MT * D * 2);
constexpr size_t B_CBUF = B_SCAN + al256(SCAN_BYTES);
constexpr size_t B_YBUF = B_CBUF + al256((size_t)MT * 12 * 16);
constexpr size_t B_GBUF = B_YBUF + al256((size_t)MT * DRW * 4);
constexpr size_t B_ABUF = B_GBUF + al256((size_t)MT * DRW * 2);
constexpr size_t B_UBUF = B_ABUF + al256((size_t)MT * DLRU * 4);
constexpr size_t B_LBUF = B_UBUF + al256((size_t)MT * DLRU * 4);
constexpr size_t B_VMID = B_LBUF + al256((size_t)MT * 256 * 2);
constexpr size_t B_ARW = B_VMID + al256((size_t)MT * 32 * 2);
constexpr size_t B_ALRU = B_ARW + al256((size_t)MT * DRW * 2);
constexpr size_t B_AXA = B_ALRU + al256((size_t)MT * DLRU * 2);
constexpr size_t B_CNT = B_AXA + al256((size_t)MT * DXA * 2);
constexpr size_t B_BAR = B_CNT + 256;
constexpr size_t BAR_BYTES = 16384;
constexpr size_t W_V1T = B_BAR + BAR_BYTES;
constexpr size_t WS_NEED = W_V1T + al256((size_t)3 * 32 * DRW * 2);
static_assert(al256((size_t)MT * D * 2) + (size_t)MT * DFF * 2 <= SCAN_BYTES, "alias overflow");

enum { I_XP = 0, I_XS, I_MEM, I_SSHIFT, I_SWKV, I_SCONV, I_SH, I_CK, I_CV, I_WIN, I_MU, I_W0, I_W2, I_A0, I_A2,
       I_G2, I_V0, I_V1, I_V2, I_KK, I_KA, I_RK, I_GNG, I_GNB, I_WRWOUT, I_CONVW, I_CONVB, I_WRG, I_BRG, I_WIG,
       I_BIG, I_LAMBDA, I_WLRUOUT, I_WMEMKV, I_WXAOUT, I_WO, I_LN1G, I_LN1B, I_WFFNIN, I_WFFNOUT, I_LN2G, I_LN2B };

struct Params {
  const float* in[42];
  float* out;
  char* ws;
};

constexpr int LDS_BYTES = 65536;

__device__ __forceinline__ bf16_t f2bf(float f) {
  unsigned u = __float_as_uint(f);
  u += 0x7fffu + ((u >> 16) & 1u);
  return (bf16_t)(u >> 16);
}
__device__ __forceinline__ float bf2f(bf16_t h) { return __uint_as_float(((unsigned)h) << 16); }
__device__ __forceinline__ float sigmoidf_(float x) { return 1.f / (1.f + __expf(-x)); }
__device__ __forceinline__ float softplusf_(float x) { return fmaxf(x, 0.f) + log1pf(__expf(-fabsf(x))); }
__device__ __forceinline__ int swz(int rr, int b) { int ob = rr * 64 + b; return ob ^ (((ob >> 9) & 1) << 5); }

__device__ __forceinline__ int tid_() {
  int t = threadIdx.x;
  asm volatile("" : "+v"(t));
  return t;
}
template <int CTRL>
__device__ __forceinline__ float dppf(float x) {
  return __int_as_float(__builtin_amdgcn_update_dpp(0, __float_as_int(x), CTRL, 0xf, 0xf, true));
}
__device__ __forceinline__ float red16_sum(float x) {
  x += dppf<0xB1>(x);
  x += dppf<0x4E>(x);
  x += dppf<0x141>(x);
  x += dppf<0x140>(x);
  return x;
}
__device__ __forceinline__ float red16_max(float x) {
  x = fmaxf(x, dppf<0xB1>(x));
  x = fmaxf(x, dppf<0x4E>(x));
  x = fmaxf(x, dppf<0x141>(x));
  x = fmaxf(x, dppf<0x140>(x));
  return x;
}
__device__ __forceinline__ float wave_sum(float x) {
#pragma unroll
  for (int m = 1; m < 64; m <<= 1) x += __shfl_xor(x, m, 64);
  return x;
}

__device__ __forceinline__ void tok_info(int tok, int& seq, int& t, int& T) {
  if (tok < MP) { seq = tok >> 11; t = tok & 2047; T = 2048; }
  else { int s = tok - MP; seq = 8 + (s >> 2); t = s & 3; T = 4; }
}
__device__ __forceinline__ int seq_tok0(int seq) { return seq < 8 ? seq * 2048 : MP + (seq - 8) * 4; }


#define XB_TMO      128
#define XB_XCNT(j)  (256  + 64 * (j))
#define XB_XSUB(j)  (1280 + 64 * (j))
#define XB_XGEN(j)  (2304 + 64 * (j))
#define XB_TOP      3328
#define XB_TOPGEN   3392
#define XCD_BAR_WORDS 3456
#define XB_SPIN_CAP (1u << 22)
#define LAS __attribute__((address_space(3)))
__device__ __forceinline__ unsigned xb_ld(unsigned* p) { return __hip_atomic_load(p, __ATOMIC_RELAXED, __HIP_MEMORY_SCOPE_AGENT); }
__device__ __forceinline__ unsigned xb_add(unsigned* p, unsigned v) { return __hip_atomic_fetch_add(p, v, __ATOMIC_RELAXED, __HIP_MEMORY_SCOPE_AGENT); }
__device__ __forceinline__ unsigned xb_xcc_id() { return (unsigned)__builtin_amdgcn_s_getreg((3 << 11) | 20) & 0xFu; }
#define XB_SPIN(cond, bar) do { unsigned _sp = 0; while (cond) { __builtin_amdgcn_s_sleep(1); \
    if ((++_sp & 255u) == 0u) { if (xb_ld(&(bar)[XB_TMO])) break; if (_sp > XB_SPIN_CAP) { atomicAdd(&(bar)[XB_TMO], 1u); break; } } } } while (0)
struct XcdBarrier { unsigned* bar; unsigned x; volatile LAS unsigned* st; };
__device__ __forceinline__ XcdBarrier xcd_barrier_post(unsigned* bar, volatile LAS unsigned* st) {
  XcdBarrier b; b.bar = bar; b.x = xb_xcc_id(); b.st = st;
  if (threadIdx.x == 0) (void)xb_add(&bar[XB_XCNT(b.x)], 1u);
  return b;
}
__device__ __forceinline__ void xcd_barrier_complete(unsigned* bar, unsigned x, unsigned& nloc, unsigned& nx) {
  const unsigned G = gridDim.x * gridDim.y * gridDim.z;
  unsigned sum, cnt, mine, sp = 0u;
  for (;;) {
    sum = 0u; cnt = 0u; mine = 0u;
#pragma unroll
    for (unsigned j = 0; j < 16; ++j) { const unsigned c = xb_ld(&bar[XB_XCNT(j)]); sum += c; cnt += (c > 0u) ? 1u : 0u; mine = (j == x) ? c : mine; }
    if (sum == G) break;
    __builtin_amdgcn_s_sleep(1);
    if ((++sp & 255u) == 0u) { if (xb_ld(&bar[XB_TMO])) break; if (sp > XB_SPIN_CAP) { atomicAdd(&bar[XB_TMO], 1u); break; } }
  }
  nloc = mine > 0u ? mine : 1u; nx = cnt > 0u ? cnt : 1u;
}
__device__ __forceinline__ void xcd_barrier(const XcdBarrier& b) {
  asm volatile("s_waitcnt vmcnt(0)" ::: "memory");
  __syncthreads();
  if (threadIdx.x == 0) {
    unsigned* bar = b.bar;
    __builtin_amdgcn_s_waitcnt(0);
    unsigned nloc = b.st[0], nx = b.st[1];
    if (nloc == 0u) { xcd_barrier_complete(bar, b.x, nloc, nx); b.st[0] = nloc; b.st[1] = nx; }
    const unsigned old = xb_add(&bar[XB_XSUB(b.x)], 1u);
    const unsigned gen = old / nloc;
    if (old + 1u == (gen + 1u) * nloc) {
      __builtin_amdgcn_fence(__ATOMIC_RELEASE, "agent");
      asm volatile("s_waitcnt vmcnt(0)" ::: "memory");
      const unsigned og = xb_add(&bar[XB_TOP], 1u);
      const unsigned tg = og / nx;
      if (og + 1u == (tg + 1u) * nx) xb_add(&bar[XB_TOPGEN], 1u);
      else XB_SPIN(xb_ld(&bar[XB_TOPGEN]) == tg, bar);
      __builtin_amdgcn_fence(__ATOMIC_ACQUIRE, "agent");
      xb_add(&bar[XB_XGEN(b.x)], 1u);
      asm volatile("s_waitcnt vmcnt(0)" ::: "memory");
    } else {
      XB_SPIN(xb_ld(&bar[XB_XGEN(b.x)]) == gen, bar);
      __builtin_amdgcn_fence(__ATOMIC_ACQUIRE, "agent");
      asm volatile("s_waitcnt vmcnt(0)" ::: "memory");
    }
  }
  __syncthreads();
}

#define MFMA(a, b, c) __builtin_amdgcn_mfma_f32_16x16x32_bf16((a), (b), (c), 0, 0, 0)

template <int OFF>
__device__ __forceinline__ bf16x8 lds_rd128(unsigned addr) {
  bf16x8 v;
  asm volatile("ds_read_b128 %0, %1 offset:%2" : "=v"(v) : "v"(addr), "n"(OFF));
  return v;
}
template <int MTW, int NTW>
struct GemmCtx {
  const bf16_t* ga;
  const bf16_t* gb;
  int lda, ldb;
};
#define GEMM_STAGE_BYTES(MTW, NTW) (2048 * ((MTW) + (NTW)))
#define GEMM_NLD(MTW, NTW) (((MTW) + (NTW)) / 2)

template <int NTW>
__device__ __forceinline__ int gemm_brow(int s  , int rr  ) {
  return (s / NTW) * (16 * NTW) + (rr >> 2) * (4 * NTW) + (s % NTW) * 4 + (rr & 3);
}
template <int MTW, int NTW>
__device__ __forceinline__ void gemm_issue(const bf16_t* ga, int lda, const bf16_t* gb0, const bf16_t* gb1, int kt, char* wstage) {
#pragma unroll
  for (int j = 0; j < MTW / 2; ++j)
    __builtin_amdgcn_global_load_lds((const unsigned*)(ga + (size_t)(64 * j) * lda + kt * 32), (unsigned*)(wstage + j * 4096), 16, 0, 0);
  __builtin_amdgcn_global_load_lds((const unsigned*)(gb0 + kt * 32), (unsigned*)(wstage + MTW * 2048), 16, 0, 0);
  if constexpr (NTW == 4)
    __builtin_amdgcn_global_load_lds((const unsigned*)(gb1 + kt * 32), (unsigned*)(wstage + MTW * 2048 + 4096), 16, 0, 0);
}

template <int MTW, int NTW>
__device__ __forceinline__ void gemm_prologue(const bf16_t* __restrict__ A, int lda, const bf16_t* __restrict__ Bt, int ldb,
                                              int m0, int n0, char* lds) {
  constexpr int SB = GEMM_STAGE_BYTES(MTW, NTW);
  const int TX = tid_();
  const int lane = TX & 63, wv = TX >> 6;
  const int obs = lane * 16;
  const int ob = obs ^ (((obs >> 9) & 1) << 5);
  const int srow = wv * 16 + (ob >> 6), scol = (ob & 63) >> 1;
  const bf16_t* ga = A + (size_t)(m0 + srow) * lda + scol;
  const bf16_t* gb0 = Bt + (size_t)(n0 + gemm_brow<NTW>(wv, ob >> 6)) * ldb + scol;
  const bf16_t* gb1 = Bt + (size_t)(n0 + gemm_brow<NTW>(wv + 4, ob >> 6)) * ldb + scol;
  char* wbase = lds + wv * 1024;
#pragma unroll
  for (int t = 0; t < 3; ++t) gemm_issue<MTW, NTW>(ga, lda, gb0, gb1, t, wbase + t * SB);
}

template <int MTW, int NTW>
__device__ __forceinline__ void gemm_loop(const bf16_t* __restrict__ A, int lda, const bf16_t* __restrict__ Bt, int ldb,
                                          int K, int m0, int n0, char* lds, f32x4 (&acc)[MTW][NTW]) {
  constexpr int SB = GEMM_STAGE_BYTES(MTW, NTW), NLD = GEMM_NLD(MTW, NTW);
  static_assert(NLD == 4 || NLD == 3, "vmcnt immediates below assume 3 or 4 loads per k-step");
  const int TX = tid_();
  const int lane = TX & 63, wv = TX >> 6;
  const int wr = wv >> 1, wc = wv & 1, fr = lane & 15, fq = lane >> 4;
  const int obs = lane * 16;
  const int ob = obs ^ (((obs >> 9) & 1) << 5);
  const int srow = wv * 16 + (ob >> 6), scol = (ob & 63) >> 1;
  const bf16_t* ga = A + (size_t)(m0 + srow) * lda + scol;
  const bf16_t* gb0 = Bt + (size_t)(n0 + gemm_brow<NTW>(wv, ob >> 6)) * ldb + scol;
  const bf16_t* gb1 = Bt + (size_t)(n0 + gemm_brow<NTW>(wv + 4, ob >> 6)) * ldb + scol;
  char* wbase = lds + wv * 1024;
  const int fo = swz(fr, fq * 16);
  const unsigned lbase = (unsigned)(unsigned long)((__attribute__((address_space(3))) char*)lds);
  const unsigned a_off = lbase + (wr * MTW) * 1024 + fo, b_off = lbase + MTW * 2048 + (wc * NTW) * 1024 + fo;
  const int nk = K >> 5;
  for (int kt = 0; kt < nk; ++kt) {
    if (kt + 2 < nk) { if (NLD == 4) asm volatile("s_waitcnt vmcnt(8)" ::: "memory"); else asm volatile("s_waitcnt vmcnt(6)" ::: "memory"); }
    else if (kt + 1 < nk) { if (NLD == 4) asm volatile("s_waitcnt vmcnt(4)" ::: "memory"); else asm volatile("s_waitcnt vmcnt(3)" ::: "memory"); }
    else asm volatile("s_waitcnt vmcnt(0)" ::: "memory");
    __builtin_amdgcn_s_barrier();
    asm volatile("" ::: "memory");
    static_assert(MTW == 4, "fragment read block below is written for 4 m-tiles per wave");
    const unsigned sa_ = a_off + (kt & 3) * SB, sb_ = b_off + (kt & 3) * SB;
    bf16x8 af[MTW], bfr[NTW];
    af[0] = lds_rd128<0>(sa_); af[1] = lds_rd128<1024>(sa_); af[2] = lds_rd128<2048>(sa_); af[3] = lds_rd128<3072>(sa_);
    bfr[0] = lds_rd128<0>(sb_); bfr[1] = lds_rd128<1024>(sb_);
    if constexpr (NTW == 4) { bfr[2] = lds_rd128<2048>(sb_); bfr[3] = lds_rd128<3072>(sb_); }
    if (kt + 3 < nk) gemm_issue<MTW, NTW>(ga, lda, gb0, gb1, kt + 3, wbase + ((kt + 3) & 3) * SB);
    if constexpr (NTW == 4)
      asm volatile("s_waitcnt lgkmcnt(0)" : "+v"(af[0]), "+v"(af[1]), "+v"(af[2]), "+v"(af[3]), "+v"(bfr[0]), "+v"(bfr[1]), "+v"(bfr[2]), "+v"(bfr[3]) :: "memory");
    else
      asm volatile("s_waitcnt lgkmcnt(0)" : "+v"(af[0]), "+v"(af[1]), "+v"(af[2]), "+v"(af[3]), "+v"(bfr[0]), "+v"(bfr[1]) :: "memory");
#pragma unroll
    for (int mt = 0; mt < MTW; ++mt)
#pragma unroll
      for (int nt = 0; nt < NTW; ++nt) acc[mt][nt] = MFMA(bfr[nt], af[mt], acc[mt][nt]);
  }
  asm volatile("s_waitcnt lgkmcnt(0)" ::: "memory");
  __builtin_amdgcn_s_barrier();
  asm volatile("" ::: "memory");
}

template <int MTW, int NTW>
__device__ __forceinline__ void gemm_main(const bf16_t* __restrict__ A, int lda, const bf16_t* __restrict__ Bt, int ldb,
                                          int K, int m0, int n0, char* lds, f32x4 (&acc)[MTW][NTW]) {
  gemm_prologue<MTW, NTW>(A, lda, Bt, ldb, m0, n0, lds);
  gemm_loop<MTW, NTW>(A, lda, Bt, ldb, K, m0, n0, lds, acc);
}

__device__ __forceinline__ uint4 pack8(const f32x4& a, const f32x4& b) {
  uint4 o;
  o.x = (unsigned)f2bf(a[0]) | ((unsigned)f2bf(a[1]) << 16);
  o.y = (unsigned)f2bf(a[2]) | ((unsigned)f2bf(a[3]) << 16);
  o.z = (unsigned)f2bf(b[0]) | ((unsigned)f2bf(b[1]) << 16);
  o.w = (unsigned)f2bf(b[2]) | ((unsigned)f2bf(b[3]) << 16);
  return o;
}

struct TileIter {
  int L, Lend, step;
};
__device__ __forceinline__ TileIter tile_iter(int ntiles) {
  const int G = (int)gridDim.x, b = (int)blockIdx.x;
  TileIter it;
  if ((G & 7) == 0) {
    const int tpx = (ntiles + 7) >> 3, x = b & 7;
    it.L = x * tpx + (b >> 3);
    it.Lend = min(ntiles, (x + 1) * tpx);
    it.step = G >> 3;
  } else {
    it.L = b; it.Lend = ntiles; it.step = G;
  }
  return it;
}
__device__ __forceinline__ TileIter tile_iter_rev(int ntiles) {
  const int G = (int)gridDim.x, b = (int)blockIdx.x;
  TileIter it;
  if ((G & 7) == 0) {
    const int tpx = (ntiles + 7) >> 3, x = b & 7, ns = G >> 3;
    it.L = x * tpx + (ns - 1 - (b >> 3));
    it.Lend = min(ntiles, (x + 1) * tpx);
    it.step = ns;
  } else {
    it.L = G - 1 - b; it.Lend = ntiles; it.step = G;
  }
  return it;
}
__device__ __forceinline__ void tile_mn(int L, int nM, int nN, int& m, int& n) {
  const int full = (nM >> 3) * 8 * nN;
  if (L < full) {
    const int band = L / (8 * nN), r = L % (8 * nN);
    n = r >> 3; m = band * 8 + (r & 7);
  } else {
    const int rem = nM & 7, r = L - full;
    n = r / rem; m = (nM >> 3) * 8 + r % rem;
  }
}

template <int MTW, int NTW>
__device__ __forceinline__ void zero_acc(f32x4 (&acc)[MTW][NTW]) {
#pragma unroll
  for (int a = 0; a < MTW; ++a)
#pragma unroll
    for (int b = 0; b < NTW; ++b) acc[a][b] = f32x4{0.f, 0.f, 0.f, 0.f};
}

__device__ void transpose_tile(const float* __restrict__ W, int ldw, bf16_t* __restrict__ Wt, int ldt, int k0, int n0,
                               int perm, char* lds) {
  const int TX = tid_();
  float* tile = (float*)lds;
  const int tid = TX;
  const int c = tid & 63, r0 = tid >> 6;
#pragma unroll
  for (int r = 0; r < 16; ++r) {
    int row = r * 4 + r0;
    tile[row * 65 + c] = W[(size_t)(k0 + row) * ldw + n0 + c];
  }
  __syncthreads();
#pragma unroll
  for (int r = 0; r < 16; ++r) {
    int n = n0 + r * 4 + r0;
    int np = n;
    if (perm) {
      if (n < DFF) np = (n >> 3) * 16 + (n & 7);
      else { int j = n - DFF; np = (j >> 3) * 16 + 8 + (j & 7); }
    }
    Wt[(size_t)np * ldt + k0 + c] = f2bf(tile[c * 65 + (r * 4 + r0)]);
  }
  __syncthreads();
}

__device__ __forceinline__ void convert_job(const float* __restrict__ src, bf16_t* __restrict__ dst, int K, int N, int nmat,
                                            int perm, int& start, char* lds) {
  const int tk = K / 64, tn = N / 64;
  const int ntiles = nmat * tk * tn;
  const int G = (int)gridDim.x;
  const int first = (((int)blockIdx.x - start) % G + G) % G;
  for (int i = first; i < ntiles; i += G) {
    const int mat = i / (tk * tn), r = i % (tk * tn);
    const int kt = r / tn, nt = r % tn;
    transpose_tile(src + (size_t)mat * K * N, N, dst + (size_t)mat * K * N, K, kt * 64, nt * 64, perm, lds);
  }
  start += ntiles;
}

__device__ void phase_convert(const Params& p, char* lds) {
  const int TX = tid_();
  char* ws = p.ws;
  int start = 0;
  convert_job(p.in[I_WIN], (bf16_t*)(ws + W_IN), 1024, 7680, NL, 0, start, lds);
  convert_job(p.in[I_WFFNIN], (bf16_t*)(ws + W_FFNIN), 1024, 5632, NL, 1, start, lds);
  convert_job(p.in[I_WFFNOUT], (bf16_t*)(ws + W_FFNOUT), 2816, 1024, NL, 0, start, lds);
  convert_job(p.in[I_WRWOUT], (bf16_t*)(ws + W_RWOUT), 768, 1024, NL, 0, start, lds);
  convert_job(p.in[I_WLRUOUT], (bf16_t*)(ws + W_LRUOUT), 768, 1024, NL, 0, start, lds);
  convert_job(p.in[I_WXAOUT], (bf16_t*)(ws + W_XAOUT), 512, 1024, NL, 0, start, lds);
  convert_job(p.in[I_WO], (bf16_t*)(ws + W_O), 1024, 1024, NL, 0, start, lds);
  convert_job(p.in[I_WMEMKV], (bf16_t*)(ws + W_MEMKV), 1024, 1024, NL, 0, start, lds);
  convert_job(p.in[I_W2], (bf16_t*)(ws + W_W2T), 64, 768, NL, 0, start, lds);
  convert_job(p.in[I_A2], (bf16_t*)(ws + W_A2T), 64, 768, NL, 0, start, lds);
  convert_job(p.in[I_G2], (bf16_t*)(ws + W_G2T), 128, 768, NL, 0, start, lds);
  convert_job(p.in[I_WRG], (bf16_t*)(ws + W_RGT), 64, 64, NL * 12, 0, start, lds);
  convert_job(p.in[I_WIG], (bf16_t*)(ws + W_IGT), 64, 64, NL * 12, 0, start, lds);
  const size_t gtid = (size_t)blockIdx.x * 256 + TX, gsz = (size_t)gridDim.x * 256;
  {
    uint2* xb = (uint2*)(ws + B_XB);
    const float4* xp = (const float4*)p.in[I_XP];
    const float4* xs = (const float4*)p.in[I_XS];
    const size_t np4 = (size_t)MP * D / 4, nt4 = (size_t)MT * D / 4;
    for (size_t i = gtid; i < nt4; i += gsz) {
      float4 v = (i < np4) ? xp[i] : xs[i - np4];
      uint2 o;
      o.x = (unsigned)f2bf(v.x) | ((unsigned)f2bf(v.y) << 16);
      o.y = (unsigned)f2bf(v.z) | ((unsigned)f2bf(v.w) << 16);
      xb[i] = o;
    }
  }
  {
    uint2* mb = (uint2*)(ws + B_MEMB);
    const float4* m = (const float4*)p.in[I_MEM];
    const size_t n4 = (size_t)2048 * D / 4;
    for (size_t i = gtid; i < n4; i += gsz) {
      float4 v = m[i];
      uint2 o;
      o.x = (unsigned)f2bf(v.x) | ((unsigned)f2bf(v.y) << 16);
      o.y = (unsigned)f2bf(v.z) | ((unsigned)f2bf(v.w) << 16);
      mb[i] = o;
    }
  }
  {
    bf16_t* v1t = (bf16_t*)(ws + W_V1T);
    const float* v1 = p.in[I_V1];
    for (size_t i = gtid; i < (size_t)3 * 768 * 32; i += gsz) {
      int j = (int)(i / (768 * 32)), r = (int)(i % (768 * 32));
      int n = r / 768, k = r % 768;
      v1t[i] = f2bf(v1[(size_t)j * 768 * 32 + (size_t)k * 32 + n]);
    }
  }
  {
    bf16_t* v2t = (bf16_t*)(ws + W_V2T);
    const float* v2 = p.in[I_V2];
    for (size_t i = gtid; i < (size_t)3 * 768 * 32; i += gsz) {
      int j = (int)(i / (768 * 32)), r = (int)(i % (768 * 32));
      int n = r / 32, k = r % 32;
      v2t[i] = f2bf(v2[(size_t)j * 32 * 768 + (size_t)k * 768 + n]);
    }
  }
}

struct ProjTile { const bf16_t* A; const bf16_t* Bt; int m0, n0, ll; bool main; };
__device__ __forceinline__ ProjTile proj_tile(const Params& p, int l, int tile, int nextra) {
  char* ws = p.ws;
  ProjTile t;
  if (nextra > 0) {
    constexpr int NTOT = (MT / 128) * (DIN / 128) + NL * 16 * 8, TPX = NTOT / 8, EPX = NL * 16 * 8 / 8;
    static_assert(NTOT % 8 == 0, "even split");
    const int x = tile / TPX, j = tile % TPX;
    tile = (j < EPX) ? (x * EPX + j) : (nextra + x * (TPX - EPX) + (j - EPX));
  }
  if (tile >= nextra) {
    int tm, tn;
    tile_mn(tile - nextra, MT / 128, DIN / 128, tm, tn);
    t.A = (const bf16_t*)(ws + B_XB); t.Bt = (const bf16_t*)(ws + W_IN) + (size_t)l * DIN * D;
    t.m0 = tm * 128; t.n0 = tn * 128; t.ll = l; t.main = true;
  } else {
    const int ll = tile / 128, r = tile % 128;
    t.A = (const bf16_t*)(ws + B_MEMB); t.Bt = (const bf16_t*)(ws + W_MEMKV) + (size_t)ll * D * D;
    t.m0 = (r / 8) * 128; t.n0 = (r % 8) * 128; t.ll = ll; t.main = false;
  }
  return t;
}

__device__ void phase_proj(const Params& p, int l, char* lds) {
  const int TX = tid_();
  char* ws = p.ws;
  bf16_t* proj = (bf16_t*)(ws + B_PROJ);
  const int lane = TX & 63, wv = TX >> 6, wr = wv >> 1, wc = wv & 1, fr = lane & 15, fq = lane >> 4;
  const int ntiles = (MT / 128) * (DIN / 128);
  const int nextra = (l == 0) ? NL * 16 * 8 : 0;
  TileIter it = tile_iter(ntiles + nextra);
  bool have = it.L < it.Lend;
  ProjTile cur;
  if (have) { cur = proj_tile(p, l, it.L, nextra); gemm_prologue<4, 4>(cur.A, D, cur.Bt, D, cur.m0, cur.n0, lds); }
  while (have) {
    f32x4 acc[4][4];
    zero_acc(acc);
    gemm_loop<4, 4>(cur.A, D, cur.Bt, D, D, cur.m0, cur.n0, lds, acc);
    const int Ln = it.L + it.step;
    const bool hn = Ln < it.Lend;
    ProjTile nxt = cur;
    if (hn) { nxt = proj_tile(p, l, Ln, nextra); gemm_prologue<4, 4>(nxt.A, D, nxt.Bt, D, nxt.m0, nxt.n0, lds); }
    const int m0 = cur.m0, n0 = cur.n0;
    if (cur.main) {
#pragma unroll
      for (int mt = 0; mt < 4; ++mt) {
        const int row = m0 + wr * 64 + mt * 16 + fr, col = n0 + wc * 64 + fq * 16;
        uint4* dst = (uint4*)(proj + (size_t)row * DIN + col);
        dst[0] = pack8(acc[mt][0], acc[mt][1]);
        dst[1] = pack8(acc[mt][2], acc[mt][3]);
      }
    } else {
      const int ll = cur.ll;
      bf16_t* kb = (bf16_t*)(ws + B_KB);
      bf16_t* vtb = (bf16_t*)(ws + B_VTB);
#pragma unroll
      for (int mt = 0; mt < 4; ++mt) {
        const int row = m0 + wr * 64 + mt * 16 + fr, col0 = n0 + wc * 64 + fq * 16;
        const int b = row >> 8, key = row & 255;
        const size_t rbase = ((size_t)(ll * 8 + b) * 256 + key) * 512;
        if (n0 < 512) {
          float4* o = (float4*)(p.out + O_MKP + rbase + col0);
#pragma unroll
          for (int nt = 0; nt < 4; ++nt) o[nt] = make_float4(acc[mt][nt][0], acc[mt][nt][1], acc[mt][nt][2], acc[mt][nt][3]);
          uint4* ob = (uint4*)(kb + rbase + col0);
          ob[0] = pack8(acc[mt][0], acc[mt][1]);
          ob[1] = pack8(acc[mt][2], acc[mt][3]);
        } else {
          const int c0 = col0 - 512;
          float4* o = (float4*)(p.out + O_MVP + rbase + c0);
#pragma unroll
          for (int nt = 0; nt < 4; ++nt) o[nt] = make_float4(acc[mt][nt][0], acc[mt][nt][1], acc[mt][nt][2], acc[mt][nt][3]);
#pragma unroll
          for (int nt = 0; nt < 4; ++nt)
#pragma unroll
            for (int i = 0; i < 4; ++i) {
              const int c2 = c0 + nt * 4 + i, h = c2 >> 7, d = c2 & 127;
              vtb[(((size_t)(ll * 8 + b) * 4 + h) * 128 + d) * 256 + key] = f2bf(acc[mt][nt][i]);
            }
        }
      }
    }
    it.L = Ln; have = hn; cur = nxt;
  }
}

__device__ __forceinline__ float prw_prev(const Params& p, const bf16_t* proj, int l, int tok, int seq, int t, int c) {
  if (t > 0) return bf2f(proj[(size_t)(tok - 1) * DIN + c]);
  if (seq >= 8) return p.in[I_SSHIFT][((size_t)l * 128 + (seq - 8)) * RWC + c];
  return 0.f;
}
__device__ __forceinline__ float plx_back(const Params& p, const bf16_t* proj, int l, int tok, int seq, int t, int j, int ch) {
  if (t - j >= 0) return bf2f(proj[(size_t)(tok - j) * DIN + C_LX + ch]);
  if (seq >= 8) return p.in[I_SCONV][(((size_t)l * 128 + (seq - 8)) * 3 + (3 + t - j)) * DLRU + ch];
  return 0.f;
}

__device__ __forceinline__ float2 ld_bf2(const bf16_t* p) {
  const unsigned u = *(const unsigned*)p;
  return make_float2(__uint_as_float(u << 16), __uint_as_float(u & 0xffff0000u));
}
__device__ __forceinline__ unsigned pk_bf2(float a, float b) { return (unsigned)f2bf(a) | ((unsigned)f2bf(b) << 16); }
__device__ __forceinline__ float2 prw_prev2(const Params& p, const bf16_t* proj, int l, int tok, int seq, int t, int c) {
  if (t > 0) return ld_bf2(proj + (size_t)(tok - 1) * DIN + c);
  if (seq >= 8) return *(const float2*)(p.in[I_SSHIFT] + ((size_t)l * 128 + (seq - 8)) * RWC + c);
  return make_float2(0.f, 0.f);
}
__device__ __forceinline__ float2 plx_back2(const Params& p, const bf16_t* proj, int l, int tok, int seq, int t, int j, int ch) {
  if (t - j >= 0) return ld_bf2(proj + (size_t)(tok - j) * DIN + C_LX + ch);
  if (seq >= 8) return *(const float2*)(p.in[I_SCONV] + (((size_t)l * 128 + (seq - 8)) * 3 + (3 + t - j)) * DLRU + ch);
  return make_float2(0.f, 0.f);
}

__device__ void phase_prep(const Params& p, int l, char* lds) {
  const int TX = tid_();
  char* ws = p.ws;
  const bf16_t* proj = (const bf16_t*)(ws + B_PROJ);
  bf16_t* L = (bf16_t*)(ws + B_LBUF);
  bf16_t* XC = (bf16_t*)(ws + B_ALRU);
  float* ubuf = (float*)(ws + B_UBUF);
  bf16_t* vmid = (bf16_t*)(ws + B_VMID);
  const float* mu = p.in[I_MU] + (size_t)l * RWC;
  const float* cw = p.in[I_CONVW] + (size_t)l * 4 * DLRU;
  const float* cb = p.in[I_CONVB] + (size_t)l * DLRU;
  const int tid = TX, lane = tid & 63, wv = tid >> 6, fr = lane & 15, fq = lane >> 4;
  constexpr int TK = 4;
  for (TileIter ti = tile_iter(MT / TK); ti.L < ti.Lend; ti.L += ti.step) {
    const int item = ti.L;
    const int tokb = item * TK;
    auto body = [&](auto interior_tag) {
    constexpr bool INTR = decltype(interior_tag)::value;
#pragma unroll 4
    for (int u = tid; u < TK * 128; u += 256) {
      const int tk = u >> 7, cp = (u & 127) * 2, tok = tokb + tk, c = 2304 + cp;
      int seq = 0, t = 16, T = 2048;
      if constexpr (!INTR) tok_info(tok, seq, t, T);
      const float2 pc = ld_bf2(proj + (size_t)tok * DIN + c);
      float2 pp;
      if constexpr (INTR) pp = ld_bf2(proj + (size_t)(tok - 1) * DIN + c); else pp = prw_prev2(p, proj, l, tok, seq, t, c);
      const float2 m2 = *(const float2*)(mu + c);
      const float x0 = pc.x + (pp.x - pc.x) * m2.x, x1 = pc.y + (pp.y - pc.y) * m2.y;
      float o0, o1;
      if (cp < 64) { o0 = tanhf(x0); o1 = tanhf(x1); }
      else if (cp < 128) { o0 = x0; o1 = x1; }
      else { o0 = sigmoidf_(x0); o1 = sigmoidf_(x1); }
      *(unsigned*)(L + (size_t)tok * 256 + cp) = pk_bf2(o0, o1);
    }
#pragma unroll 4
    for (int u = tid; u < TK * 384; u += 256) {
      const int tk = u / 384, ch = (u % 384) * 2, tok = tokb + tk;
      int seq = 0, t = 16, T = 2048;
      if constexpr (INTR) { seq = tok >> 11; t = tok & 2047; } else tok_info(tok, seq, t, T);
      const float2 x0 = ld_bf2(proj + (size_t)tok * DIN + C_LX + ch);
      float2 x1, x2, x3;
      if constexpr (INTR) {
        x1 = ld_bf2(proj + (size_t)(tok - 1) * DIN + C_LX + ch);
        x2 = ld_bf2(proj + (size_t)(tok - 2) * DIN + C_LX + ch);
        x3 = ld_bf2(proj + (size_t)(tok - 3) * DIN + C_LX + ch);
      } else {
        x1 = plx_back2(p, proj, l, tok, seq, t, 1, ch);
        x2 = plx_back2(p, proj, l, tok, seq, t, 2, ch);
        x3 = plx_back2(p, proj, l, tok, seq, t, 3, ch);
      }
      const float2 b2 = *(const float2*)(cb + ch), w3 = *(const float2*)(cw + 3 * DLRU + ch), w2 = *(const float2*)(cw + 2 * DLRU + ch),
                   w1 = *(const float2*)(cw + DLRU + ch), w0 = *(const float2*)(cw + ch);
      const float xa = b2.x + w3.x * x0.x + w2.x * x1.x + w1.x * x2.x + w0.x * x3.x;
      const float xb_ = b2.y + w3.y * x0.y + w2.y * x1.y + w1.y * x2.y + w0.y * x3.y;
      *(unsigned*)(XC + (size_t)tok * DLRU + ch) = pk_bf2(xa, xb_);
      if (t >= T - 3) {
        const size_t o = (seq < 8) ? O_CONVP + (((size_t)l * 8 + seq) * 3 + (t - (T - 3))) * DLRU
                                   : O_CONVS + (((size_t)l * 128 + (seq - 8)) * 3 + (t - (T - 3))) * DLRU;
        *(float2*)(p.out + o + ch) = x0;
      }
      if (l > 0) {
        const int c = 1536 + ch;
        const float2 pc = ld_bf2(proj + (size_t)tok * DIN + c);
        float2 pp;
        if constexpr (INTR) pp = ld_bf2(proj + (size_t)(tok - 1) * DIN + c); else pp = prw_prev2(p, proj, l, tok, seq, t, c);
        const float2 m2 = *(const float2*)(mu + c);
        const float v0 = pc.x + (pp.x - pc.x) * m2.x, v1 = pc.y + (pp.y - pc.y) * m2.y;
        *(unsigned*)(lds + (ch >> 5) * 1024 + swz(tk, (ch & 31) * 2)) = pk_bf2(v0, v1);
      }
    }
    };
    if (tokb < MP && (tokb & 2047) != 0) body(std::true_type{}); else body(std::false_type{});
    for (int tk = 0; tk < TK; ++tk) {
      const int tok = tokb + tk;
      int seq, t, T;
      tok_info(tok, seq, t, T);
      if (t == T - 1) {
        const size_t o = (seq < 8) ? O_SHP + ((size_t)l * 8 + seq) * RWC : O_SHS + ((size_t)l * 128 + (seq - 8)) * RWC;
        for (int c = tid * 2; c < RWC; c += 512) *(float2*)(p.out + o + c) = ld_bf2(proj + (size_t)tok * DIN + c);
      }
    }
    if (l > 0) {
      __syncthreads();
      const bf16_t* v1t = (const bf16_t*)(ws + W_V1T) + (size_t)(l - 1) * 32 * DRW;
      f32x4 acc0 = f32x4{0, 0, 0, 0}, acc1 = acc0;
      const int fo = swz(fr, fq * 16);
#pragma unroll
      for (int kk = 0; kk < 6; ++kk) {
        const int ks = wv * 6 + kk;
        const bf16x8 af = *(const bf16x8*)(lds + ks * 1024 + fo);
        const bf16x8 b0 = *(const bf16x8*)(v1t + (size_t)fr * DRW + ks * 32 + fq * 8);
        const bf16x8 b1 = *(const bf16x8*)(v1t + (size_t)(16 + fr) * DRW + ks * 32 + fq * 8);
        acc0 = MFMA(af, b0, acc0);
        acc1 = MFMA(af, b1, acc1);
      }
      float* red = (float*)(lds + 24576);
#pragma unroll
      for (int i = 0; i < 4; ++i) {
        red[(wv * 16 + fq * 4 + i) * 32 + fr] = acc0[i];
        red[(wv * 16 + fq * 4 + i) * 32 + 16 + fr] = acc1[i];
      }
      __syncthreads();
      {
        const int row = tid >> 4, c2 = (tid & 15) * 2;
        if (row < TK) {
          float s0 = 0.f, s1 = 0.f;
#pragma unroll
          for (int w = 0; w < 4; ++w) { s0 += red[(w * 16 + row) * 32 + c2]; s1 += red[(w * 16 + row) * 32 + c2 + 1]; }
          *(unsigned*)(vmid + (size_t)(tokb + row) * 32 + c2) = pk_bf2(s0, s1);
        }
      }
      __syncthreads();
    }
  }
}

__device__ __forceinline__ void unpack4(const uint2 q, float (&o)[4]) {
  o[0] = __uint_as_float(q.x << 16); o[1] = __uint_as_float(q.x & 0xffff0000u);
  o[2] = __uint_as_float(q.y << 16); o[3] = __uint_as_float(q.y & 0xffff0000u);
}
__device__ __forceinline__ void prw_prev4(const Params& p, const bf16_t* proj, int l, int tok, int seq, int t, int c, float (&o)[4]) {
  if (t > 0) { unpack4(*(const uint2*)(proj + (size_t)(tok - 1) * DIN + c), o); return; }
  if (seq >= 8) {
    const float4 s = *(const float4*)(p.in[I_SSHIFT] + ((size_t)l * 128 + (seq - 8)) * RWC + c);
    o[0] = s.x; o[1] = s.y; o[2] = s.z; o[3] = s.w;
    return;
  }
  o[0] = 0.f; o[1] = 0.f; o[2] = 0.f; o[3] = 0.f;
}

__device__ void phase_lora(const Params& p, int l, char* lds) {
  const int TX = tid_();
  char* ws = p.ws;
  const bf16_t* proj = (const bf16_t*)(ws + B_PROJ);
  const bf16_t* L = (const bf16_t*)(ws + B_LBUF);
  const bf16_t* vmid = (const bf16_t*)(ws + B_VMID);
  const bf16_t* XC = (const bf16_t*)(ws + B_ALRU);
  const int NRW = (MT / 128) * 12;
  for (TileIter ti = tile_iter(NRW); ti.L < ti.Lend; ti.L += ti.step) {
    const int item = ti.L;
    int txl = TX;
    asm volatile("" : "+v"(txl));
    const int lane = txl & 63, wv = txl >> 6, fr = lane & 15, fq = lane >> 4;
    {
      const int h = item % 12, tb = (item / 12) * 128 + wv * 32;
      const bf16_t* w2t = (const bf16_t*)(ws + W_W2T) + ((size_t)l * DRW + h * 64) * 64;
      const bf16_t* a2t = (const bf16_t*)(ws + W_A2T) + ((size_t)l * DRW + h * 64) * 64;
      const bf16_t* g2t = (const bf16_t*)(ws + W_G2T) + ((size_t)l * DRW + h * 64) * 128;
      bf16_t* gbuf = (bf16_t*)(ws + B_GBUF);
      {
        f32x4 ag[2][4];
#pragma unroll
        for (int a = 0; a < 2; ++a)
#pragma unroll
          for (int b = 0; b < 4; ++b) ag[a][b] = f32x4{0, 0, 0, 0};
#pragma unroll
        for (int ks = 0; ks < 4; ++ks) {
          bf16x8 af[2], bf_[4];
#pragma unroll
          for (int mt = 0; mt < 2; ++mt) af[mt] = *(const bf16x8*)(L + (size_t)(tb + mt * 16 + fr) * 256 + 128 + ks * 32 + fq * 8);
#pragma unroll
          for (int nt = 0; nt < 4; ++nt) bf_[nt] = *(const bf16x8*)(g2t + (size_t)(nt * 16 + fr) * 128 + ks * 32 + fq * 8);
#pragma unroll
          for (int mt = 0; mt < 2; ++mt)
#pragma unroll
            for (int nt = 0; nt < 4; ++nt) ag[mt][nt] = MFMA(af[mt], bf_[nt], ag[mt][nt]);
        }
#pragma unroll
        for (int mt = 0; mt < 2; ++mt)
#pragma unroll
          for (int nt = 0; nt < 4; ++nt)
#pragma unroll
            for (int i = 0; i < 4; ++i)
              gbuf[(size_t)(tb + mt * 16 + fq * 4 + i) * DRW + h * 64 + nt * 16 + fr] = f2bf(ag[mt][nt][i]);
      }
      f32x4 aw[2][4], aa[2][4], av[2][4];
#pragma unroll
      for (int a = 0; a < 2; ++a)
#pragma unroll
        for (int b = 0; b < 4; ++b) { aw[a][b] = f32x4{0, 0, 0, 0}; aa[a][b] = aw[a][b]; av[a][b] = aw[a][b]; }
#pragma unroll
      for (int ks = 0; ks < 2; ++ks) {
        bf16x8 af[2], bf_[4];
#pragma unroll
        for (int mt = 0; mt < 2; ++mt) af[mt] = *(const bf16x8*)(L + (size_t)(tb + mt * 16 + fr) * 256 + ks * 32 + fq * 8);
#pragma unroll
        for (int nt = 0; nt < 4; ++nt) bf_[nt] = *(const bf16x8*)(w2t + (size_t)(nt * 16 + fr) * 64 + ks * 32 + fq * 8);
#pragma unroll
        for (int mt = 0; mt < 2; ++mt)
#pragma unroll
          for (int nt = 0; nt < 4; ++nt) aw[mt][nt] = MFMA(af[mt], bf_[nt], aw[mt][nt]);
#pragma unroll
        for (int mt = 0; mt < 2; ++mt) af[mt] = *(const bf16x8*)(L + (size_t)(tb + mt * 16 + fr) * 256 + 64 + ks * 32 + fq * 8);
#pragma unroll
        for (int nt = 0; nt < 4; ++nt) bf_[nt] = *(const bf16x8*)(a2t + (size_t)(nt * 16 + fr) * 64 + ks * 32 + fq * 8);
#pragma unroll
        for (int mt = 0; mt < 2; ++mt)
#pragma unroll
          for (int nt = 0; nt < 4; ++nt) aa[mt][nt] = MFMA(af[mt], bf_[nt], aa[mt][nt]);
      }
      if (l > 0) {
        const bf16_t* v2t = (const bf16_t*)(ws + W_V2T) + ((size_t)(l - 1) * DRW + h * 64) * 32;
        bf16x8 af[2], bf_[4];
#pragma unroll
        for (int mt = 0; mt < 2; ++mt) af[mt] = *(const bf16x8*)(vmid + (size_t)(tb + mt * 16 + fr) * 32 + fq * 8);
#pragma unroll
        for (int nt = 0; nt < 4; ++nt) bf_[nt] = *(const bf16x8*)(v2t + (size_t)(nt * 16 + fr) * 32 + fq * 8);
#pragma unroll
        for (int mt = 0; mt < 2; ++mt)
#pragma unroll
          for (int nt = 0; nt < 4; ++nt) av[mt][nt] = MFMA(af[mt], bf_[nt], av[mt][nt]);
      }
      const float* mu = p.in[I_MU] + (size_t)l * RWC;
      float mur[4], muk[4], muv[4], w0[4], a0[4], v0[4], kkp[4], kap[4], rkp[4];
#pragma unroll
      for (int nt = 0; nt < 4; ++nt) {
        int c = h * 64 + nt * 16 + fr;
        mur[nt] = mu[c]; muk[nt] = mu[768 + c]; muv[nt] = mu[1536 + c];
        w0[nt] = p.in[I_W0][(size_t)l * DRW + c];
        a0[nt] = p.in[I_A0][(size_t)l * DRW + c];
        v0[nt] = (l > 0) ? p.in[I_V0][(size_t)(l - 1) * DRW + c] : 0.f;
        kkp[nt] = p.in[I_KK][(size_t)l * DRW + c];
        kap[nt] = p.in[I_KA][(size_t)l * DRW + c];
        rkp[nt] = p.in[I_RK][(size_t)l * DRW + c];
      }
      bf16_t* vfirst = (bf16_t*)(ws + B_VFIRST);
      float* cbuf = (float*)(ws + B_CBUF);
      char* scan = ws + B_SCAN;
      auto epi = [&](auto interior_tag) {
      constexpr bool INTR = decltype(interior_tag)::value;
#pragma unroll
      for (int mt = 0; mt < 2; ++mt)
#pragma unroll
        for (int i = 0; i < 4; ++i) {
          const int tok = tb + mt * 16 + fq * 4 + i;
          int seq = 0, t = 1, T = 2048;
          if constexpr (!INTR) tok_info(tok, seq, t, T);
          const bf16_t* pr = proj + (size_t)tok * DIN;
          float rr[4], kx[4], vv[4], aval[4], dec[4], kkr[4], kmod[4];
          float ss = 0.f, s1 = 0.f, s2 = 0.f, s3 = 0.f;
#pragma unroll
          for (int nt = 0; nt < 4; ++nt) {
            const int cc = nt * 16 + fr, c = h * 64 + cc;
            float pc, pp;
            pc = bf2f(pr[c]);
            if constexpr (INTR) pp = bf2f(pr[c - DIN]); else pp = prw_prev(p, proj, l, tok, seq, t, c);
            rr[nt] = pc + (pp - pc) * mur[nt];
            pc = bf2f(pr[768 + c]);
            if constexpr (INTR) pp = bf2f(pr[768 + c - DIN]); else pp = prw_prev(p, proj, l, tok, seq, t, 768 + c);
            kx[nt] = pc + (pp - pc) * muk[nt];
            pc = bf2f(pr[1536 + c]);
            if constexpr (INTR) pp = bf2f(pr[1536 + c - DIN]); else pp = prw_prev(p, proj, l, tok, seq, t, 1536 + c);
            float vx = pc + (pp - pc) * muv[nt];
            float wraw = -softplusf_(-(w0[nt] + aw[mt][nt][i])) - 0.5f;
            dec[nt] = __expf(-__expf(wraw));
            aval[nt] = sigmoidf_(a0[nt] + aa[mt][nt][i]);
            if (l > 0) {
              float vf = bf2f(vfirst[(size_t)tok * DRW + c]);
              vv[nt] = vx + (vf - vx) * sigmoidf_(v0[nt] + av[mt][nt][i]);
            } else {
              vfirst[(size_t)tok * DRW + c] = f2bf(vx);
              vv[nt] = vx;
            }
            kkr[nt] = kx[nt] * kkp[nt];
            kmod[nt] = kx[nt] * (1.f + (aval[nt] - 1.f) * kap[nt]);
            ss += kkr[nt] * kkr[nt];
            s1 += kkr[nt] * aval[nt] * rr[nt];
            s2 += kmod[nt] * rr[nt];
            s3 += rr[nt] * kmod[nt] * rkp[nt];
          }
          ss = red16_sum(ss); s1 = red16_sum(s1); s2 = red16_sum(s2); s3 = red16_sum(s3);
          const float inv = 1.f / fmaxf(sqrtf(ss), 1e-12f);
          char* so = scan + ((size_t)tok * 12 + h) * 896;
#pragma unroll
          for (int nt = 0; nt < 4; ++nt) {
            const int cc = nt * 16 + fr;
            float kkn = kkr[nt] * inv;
            ((float*)so)[cc] = dec[nt];
            ((bf16_t*)(so + 256))[cc] = f2bf(dec[nt] * rr[nt]);
            ((bf16_t*)(so + 384))[cc] = f2bf(-kkn);
            ((bf16_t*)(so + 512))[cc] = f2bf(kkn * aval[nt]);
            ((bf16_t*)(so + 640))[cc] = f2bf(kmod[nt]);
            ((bf16_t*)(so + 768))[cc] = f2bf(vv[nt]);
          }
          if (fr == 0) {
            float4 cv = make_float4(s1 * inv, s2, s3, 0.f);
            *(float4*)(cbuf + ((size_t)tok * 12 + h) * 4) = cv;
          }
        }
      };
      const int tbu = __builtin_amdgcn_readfirstlane(tb);
      if (tbu < MP && (tbu & 2047) != 0) epi(std::true_type{}); else epi(std::false_type{});
    }
  }
  for (TileIter ti = tile_iter_rev(NRW); ti.L < ti.Lend; ti.L += ti.step) {
    const int item = NRW + ti.L;
    int txl = TX;
    asm volatile("" : "+v"(txl));
    const int lane = txl & 63, wv = txl >> 6, fr = lane & 15, fq = lane >> 4;
    {
      const int it = item - NRW;
      const int nb = it % 12, tb = (it / 12) * 128 + wv * 32;
      const bf16_t* rgt = (const bf16_t*)(ws + W_RGT) + ((size_t)l * 12 + nb) * 4096;
      const bf16_t* igt = (const bf16_t*)(ws + W_IGT) + ((size_t)l * 12 + nb) * 4096;
      const int wrow0 = (fr >> 2) * 16 + (fr & 3);
      f32x4 ar[2][4], ai[2][4];
#pragma unroll
      for (int a = 0; a < 2; ++a)
#pragma unroll
        for (int b = 0; b < 4; ++b) { ar[a][b] = f32x4{0, 0, 0, 0}; ai[a][b] = ar[a][b]; }
#pragma unroll
      for (int ks = 0; ks < 2; ++ks) {
        bf16x8 af[2], b1[4], b2[4];
#pragma unroll
        for (int mt = 0; mt < 2; ++mt) af[mt] = *(const bf16x8*)(XC + (size_t)(tb + mt * 16 + fr) * DLRU + nb * 64 + ks * 32 + fq * 8);
#pragma unroll
        for (int nt = 0; nt < 4; ++nt) {
          b1[nt] = *(const bf16x8*)(rgt + (size_t)(wrow0 + nt * 4) * 64 + ks * 32 + fq * 8);
          b2[nt] = *(const bf16x8*)(igt + (size_t)(wrow0 + nt * 4) * 64 + ks * 32 + fq * 8);
        }
#pragma unroll
        for (int mt = 0; mt < 2; ++mt)
#pragma unroll
          for (int nt = 0; nt < 4; ++nt) {
            ar[mt][nt] = MFMA(b1[nt], af[mt], ar[mt][nt]);
            ai[mt][nt] = MFMA(b2[nt], af[mt], ai[mt][nt]);
          }
      }
      float* abuf = (float*)(ws + B_ABUF);
      bf16_t* ubuf = (bf16_t*)(ws + B_UBUF);
#pragma unroll
      for (int nt = 0; nt < 4; ++nt) {
        const int c = nb * 64 + fq * 16 + nt * 4;
        const float4 brq = *(const float4*)(p.in[I_BRG] + (size_t)l * DLRU + c), biq = *(const float4*)(p.in[I_BIG] + (size_t)l * DLRU + c);
        const float4 lmq = *(const float4*)(p.in[I_LAMBDA] + (size_t)l * DLRU + c);
        const float br_[4] = {brq.x, brq.y, brq.z, brq.w}, bi_[4] = {biq.x, biq.y, biq.z, biq.w};
        const float sp_[4] = {softplusf_(-lmq.x), softplusf_(-lmq.y), softplusf_(-lmq.z), softplusf_(-lmq.w)};
#pragma unroll
        for (int mt = 0; mt < 2; ++mt) {
          const int tok = tb + mt * 16 + fr;
          float xc_[4];
          unpack4(*(const uint2*)(XC + (size_t)tok * DLRU + c), xc_);
          float ao[4], uo[4];
#pragma unroll
          for (int i = 0; i < 4; ++i) {
            const float rg = sigmoidf_(ar[mt][nt][i] + br_[i]), ig = sigmoidf_(ai[mt][nt][i] + bi_[i]);
            const float la = -8.f * rg * sp_[i];
            ao[i] = __expf(la);
            uo[i] = sqrtf(fmaxf(-expm1f(2.f * la), 0.f)) * (ig * xc_[i]);
          }
          *(float4*)(abuf + (size_t)tok * DLRU + c) = make_float4(ao[0], ao[1], ao[2], ao[3]);
          { uint2 uq; uq.x = pk_bf2(uo[0], uo[1]); uq.y = pk_bf2(uo[2], uo[3]); *(uint2*)(ubuf + (size_t)tok * DLRU + c) = uq; }
        }
      }
    }
  }
}

constexpr int STEP_B = 1552;
struct WkvOps { float4 w4, r4, n4, b4, k4; float v; float2 cc; };
__device__ __forceinline__ void wkv_load(WkvOps& o, const char* b, int kq, int vrow) {
  o.w4 = *(const float4*)(b + kq * 16);
  o.r4 = *(const float4*)(b + 256 + kq * 16);
  o.n4 = *(const float4*)(b + 512 + kq * 16);
  o.b4 = *(const float4*)(b + 768 + kq * 16);
  o.k4 = *(const float4*)(b + 1024 + kq * 16);
  o.v = *(const float*)(b + 1280 + vrow * 4);
  o.cc = *(const float2*)(b + 1536);
}
__device__ __forceinline__ void wkv_step(const WkvOps& o, float& S0, float& S1, float& S2, float& S3, float& ykeep, bool keep) {
  float sa = S0 * o.n4.x + S1 * o.n4.y + S2 * o.n4.z + S3 * o.n4.w;
  float z = S0 * o.r4.x + S1 * o.r4.y + S2 * o.r4.z + S3 * o.r4.w;
  sa = red16_sum(sa);
  z = red16_sum(z);
  const float y = z + sa * o.cc.x + o.v * o.cc.y;
  ykeep = keep ? y : ykeep;
  S0 = S0 * o.w4.x + (sa * o.b4.x + o.v * o.k4.x);
  S1 = S1 * o.w4.y + (sa * o.b4.y + o.v * o.k4.y);
  S2 = S2 * o.w4.z + (sa * o.b4.z + o.v * o.k4.z);
  S3 = S3 * o.w4.w + (sa * o.b4.w + o.v * o.k4.w);
}

struct WkvStage { uint4 st[4]; float4 cst; };
__device__ __forceinline__ void wkv_stage_load(WkvStage& g, const char* scan, const float* cbuf, int tid, int tok0, int h, int c, int T) {
  const int ns = min(16, T - c * 16);
#pragma unroll
  for (int j = 0; j < 4; ++j) {
    const int u = tid + 256 * j;
    if (u < ns * 56) {
      const int s = u / 56, q = u % 56;
      g.st[j] = *(const uint4*)(scan + ((size_t)(tok0 + c * 16 + s) * 12 + h) * 896 + q * 16);
    }
  }
  if (tid >= 128 && tid < 128 + ns) g.cst = *(const float4*)(cbuf + ((size_t)(tok0 + c * 16 + (tid - 128)) * 12 + h) * 4);
}
__device__ __forceinline__ void wkv_stage_write(const WkvStage& g, char* buf, int tid, int c, int T) {
  const int ns = min(16, T - c * 16);
#pragma unroll
  for (int j = 0; j < 4; ++j) {
    const int u = tid + 256 * j;
    if (u < ns * 56) {
      const int s = u / 56, q = u % 56;
      char* base = buf + s * STEP_B;
      if (q < 16) {
        *(uint4*)(base + q * 16) = g.st[j];
      } else {
        float4 lo, hi;
        lo.x = __uint_as_float(g.st[j].x << 16); lo.y = __uint_as_float(g.st[j].x & 0xffff0000u);
        lo.z = __uint_as_float(g.st[j].y << 16); lo.w = __uint_as_float(g.st[j].y & 0xffff0000u);
        hi.x = __uint_as_float(g.st[j].z << 16); hi.y = __uint_as_float(g.st[j].z & 0xffff0000u);
        hi.z = __uint_as_float(g.st[j].w << 16); hi.w = __uint_as_float(g.st[j].w & 0xffff0000u);
        const int off = 256 + (q - 16) * 32;
        *(float4*)(base + off) = lo;
        *(float4*)(base + off + 16) = hi;
      }
    }
  }
  if (tid >= 128 && tid < 128 + ns) *(float2*)(buf + (tid - 128) * STEP_B + 1536) = make_float2(g.cst.x, g.cst.y);
}
__device__ __forceinline__ void wkv_chunk16(const char* buf, int kq, int vrow, float& S0, float& S1, float& S2, float& S3, float& ykeep) {
  WkvOps oa, ob;
  wkv_load(oa, buf, kq, vrow);
#pragma unroll
  for (int s = 0; s < 16; s += 2) {
    wkv_load(ob, buf + (s + 1) * STEP_B, kq, vrow);
    wkv_step(oa, S0, S1, S2, S3, ykeep, kq == s);
    if (s + 2 < 16) wkv_load(oa, buf + (s + 2) * STEP_B, kq, vrow);
    wkv_step(ob, S0, S1, S2, S3, ykeep, kq == s + 1);
  }
}

__device__ void wkv_scan_item(const Params& p, int l, int seq, int h, int qt, char* lds) {
  const int TX = tid_();
  char* ws = p.ws;
  const int tid = TX, lane = tid & 63, wv = tid >> 6;
  const int kq = lane & 15, rl = lane >> 4;
  const int T = (seq < 8) ? 2048 : 4;
  const int tok0 = seq_tok0(seq);
  const char* scan = ws + B_SCAN;
  const float* cbuf = (const float*)(ws + B_CBUF);
  float* ybuf = (float*)(ws + B_YBUF);
  WkvStage ga, gb;
  float4 sin[4];
  if (seq >= 8) {
#pragma unroll
    for (int q4 = 0; q4 < 4; ++q4)
      sin[q4] = *(const float4*)(p.in[I_SWKV] + ((((size_t)l * 128 + (seq - 8)) * 12 + h) * 64 + q4 * 16 + wv * 4 + rl) * 64 + kq * 4);
  }
  __syncthreads();
  wkv_stage_load(ga, scan, cbuf, tid, tok0, h, 0, T);
  if (seq < 8) wkv_stage_load(gb, scan, cbuf, tid, tok0, h, 1, T);
  wkv_stage_write(ga, lds, tid, 0, T);
  __syncthreads();
  if (seq < 8) {
    constexpr int NCH = 128;
    const int vrow = qt * 16 + wv * 4 + rl;
    float S0 = 0.f, S1 = 0.f, S2 = 0.f, S3 = 0.f;
    char* buf0 = lds;
    char* buf1 = lds + 16 * STEP_B;
#pragma unroll 1
    for (int c = 0; c < NCH; c += 2) {
      if (c + 2 < NCH) wkv_stage_load(ga, scan, cbuf, tid, tok0, h, c + 2, T);
      float ykeep = 0.f;
      wkv_chunk16(buf0, kq, vrow, S0, S1, S2, S3, ykeep);
      ybuf[(size_t)(tok0 + c * 16 + kq) * DRW + h * 64 + vrow] = ykeep;
      wkv_stage_write(gb, buf1, tid, c + 1, T);
      __syncthreads();
      if (c + 3 < NCH) wkv_stage_load(gb, scan, cbuf, tid, tok0, h, c + 3, T);
      ykeep = 0.f;
      wkv_chunk16(buf1, kq, vrow, S0, S1, S2, S3, ykeep);
      ybuf[(size_t)(tok0 + (c + 1) * 16 + kq) * DRW + h * 64 + vrow] = ykeep;
      if (c + 2 < NCH) wkv_stage_write(ga, buf0, tid, c + 2, T);
      __syncthreads();
    }
    *(float4*)(p.out + O_WKVP + ((((size_t)l * 8 + seq) * 12 + h) * 64 + vrow) * 64 + kq * 4) = make_float4(S0, S1, S2, S3);
  } else {
    const int b = seq - 8;
#pragma unroll
    for (int q4 = 0; q4 < 4; ++q4) {
      const int vrow = q4 * 16 + wv * 4 + rl;
      float S0 = sin[q4].x, S1 = sin[q4].y, S2 = sin[q4].z, S3 = sin[q4].w;
      float ykeep = 0.f;
      WkvOps oa, ob;
      wkv_load(oa, lds, kq, vrow);
#pragma unroll
      for (int s2 = 0; s2 < 4; s2 += 2) {
        wkv_load(ob, lds + (s2 + 1) * STEP_B, kq, vrow);
        wkv_step(oa, S0, S1, S2, S3, ykeep, kq == s2);
        if (s2 + 2 < 4) wkv_load(oa, lds + (s2 + 2) * STEP_B, kq, vrow);
        wkv_step(ob, S0, S1, S2, S3, ykeep, kq == s2 + 1);
      }
      if (kq < 4) ybuf[(size_t)(tok0 + kq) * DRW + h * 64 + vrow] = ykeep;
      *(float4*)(p.out + O_WKVS + ((((size_t)l * 128 + b) * 12 + h) * 64 + vrow) * 64 + kq * 4) = make_float4(S0, S1, S2, S3);
    }
    __syncthreads();
  }
}

__device__ __forceinline__ float gelu_tanh_(float x) {
  const float u = 0.7978845608028654f * (x + 0.044715f * x * x * x);
  const float th = 1.f - 2.f / (1.f + __expf(2.f * u));
  return 0.5f * x * (1.f + th);
}

__device__ void lru_scan_prompt_item(const Params& p, int l, int seq, int cg, char* lds) {
  const int TX = tid_();
  char* ws = p.ws;
  const int ts = TX >> 5, ch = cg * 32 + (TX & 31);
  const float* abuf = (const float*)(ws + B_ABUF);
  const bf16_t* ubuf = (const bf16_t*)(ws + B_UBUF);
  const bf16_t* plg = (const bf16_t*)(ws + B_PROJ) + ((size_t)seq * 2048 + ts * 256) * DIN + C_LG + ch;
  bf16_t* alru = (bf16_t*)(ws + B_ALRU);
  const size_t base = ((size_t)seq * 2048 + ts * 256) * DLRU + ch;
  float* sA = (float*)lds;
  float* sU = sA + 256;
  __syncthreads();
  float A = 1.f, U = 0.f;
  for (int t0 = 0; t0 < 256; t0 += 16) {
    float a[16], u[16];
#pragma unroll
    for (int j = 0; j < 16; ++j) {
      a[j] = abuf[base + (size_t)(t0 + j) * DLRU];
      u[j] = bf2f(ubuf[base + (size_t)(t0 + j) * DLRU]);
    }
#pragma unroll
    for (int j = 0; j < 16; ++j) { U = a[j] * U + u[j]; A *= a[j]; }
  }
  sA[TX] = A;
  sU[TX] = U;
  __syncthreads();
  float h = 0.f;
  for (int j = 0; j < ts; ++j) h = sA[j * 32 + (TX & 31)] * h + sU[j * 32 + (TX & 31)];
  {
    float a[16], u[16], an[16], un[16];
    bf16_t g[16], gn[16];
#pragma unroll
    for (int j = 0; j < 16; ++j) {
      a[j] = abuf[base + (size_t)j * DLRU];
      u[j] = bf2f(ubuf[base + (size_t)j * DLRU]);
      g[j] = plg[(size_t)j * DIN];
    }
    for (int t0 = 0; t0 < 256; t0 += 16) {
      if (t0 + 16 < 256) {
#pragma unroll
        for (int j = 0; j < 16; ++j) {
          an[j] = abuf[base + (size_t)(t0 + 16 + j) * DLRU];
          un[j] = bf2f(ubuf[base + (size_t)(t0 + 16 + j) * DLRU]);
          gn[j] = plg[(size_t)(t0 + 16 + j) * DIN];
        }
      }
#pragma unroll
      for (int j = 0; j < 16; ++j) {
        h = a[j] * h + u[j];
        alru[base + (size_t)(t0 + j) * DLRU] = f2bf(h * gelu_tanh_(bf2f(g[j])));
      }
#pragma unroll
      for (int j = 0; j < 16; ++j) { a[j] = an[j]; u[j] = un[j]; g[j] = gn[j]; }
    }
  }
  if (ts == 7) p.out[O_HP + ((size_t)l * 8 + seq) * DLRU + ch] = h;
  __syncthreads();
}

__device__ void lru_scan_item(const Params& p, int l, int seq, int cg3) {
  const int TX = tid_();
  char* ws = p.ws;
  const int ch = cg3 * 256 + TX;
  const int tok0 = seq_tok0(seq);
  const float* abuf = (const float*)(ws + B_ABUF);
  const bf16_t* ubuf = (const bf16_t*)(ws + B_UBUF);
  const bf16_t* proj = (const bf16_t*)(ws + B_PROJ);
  bf16_t* alru = (bf16_t*)(ws + B_ALRU);
  float h = p.in[I_SH][((size_t)l * 128 + (seq - 8)) * DLRU + ch];
  float a[4], u[4], g[4];
#pragma unroll
  for (int j = 0; j < 4; ++j) {
    a[j] = abuf[(size_t)(tok0 + j) * DLRU + ch];
    u[j] = bf2f(ubuf[(size_t)(tok0 + j) * DLRU + ch]);
    g[j] = bf2f(proj[(size_t)(tok0 + j) * DIN + C_LG + ch]);
  }
#pragma unroll
  for (int j = 0; j < 4; ++j) {
    h = a[j] * h + u[j];
    alru[(size_t)(tok0 + j) * DLRU + ch] = f2bf(h * gelu_tanh_(g[j]));
  }
  p.out[O_HS + ((size_t)l * 128 + (seq - 8)) * DLRU + ch] = h;
}

__device__ void attn_prompt_item(const Params& p, int l, int b, int h, int qt, char* lds) {
  const int TX = tid_();
  char* ws = p.ws;
  const int lane = TX & 63, wv = TX >> 6, fr = lane & 15, fq = lane >> 4;
  const bf16_t* proj = (const bf16_t*)(ws + B_PROJ);
  const bf16_t* kb = (const bf16_t*)(ws + B_KB) + ((size_t)(l * 8 + b) * 256) * 512 + h * 128;
  const bf16_t* vt = (const bf16_t*)(ws + B_VTB) + (((size_t)(l * 8 + b) * 4 + h) * 128) * 256;
  bf16_t* axa = (bf16_t*)(ws + B_AXA);
  const int tok0 = b * 2048 + qt * 64 + wv * 16;
  bf16x8 aq[4];
#pragma unroll
  for (int ks = 0; ks < 4; ++ks) aq[ks] = *(const bf16x8*)(proj + (size_t)(tok0 + fr) * DIN + C_Q + h * 128 + ks * 32 + fq * 8);
  f32x4 s[16];
#pragma unroll
  for (int nt = 0; nt < 16; ++nt) {
    s[nt] = f32x4{0, 0, 0, 0};
#pragma unroll
    for (int ks = 0; ks < 4; ++ks) {
      bf16x8 bk = *(const bf16x8*)(kb + (size_t)(nt * 16 + fr) * 512 + ks * 32 + fq * 8);
      s[nt] = MFMA(aq[ks], bk, s[nt]);
    }
  }
  const float scale = 0.08838834764831845f;
  float rs[4];
  char* pl = lds + wv * 8192;
  __syncthreads();
#pragma unroll
  for (int i = 0; i < 4; ++i) {
    float m = s[0][i];
#pragma unroll
    for (int nt = 1; nt < 16; ++nt) m = fmaxf(m, s[nt][i]);
    m = red16_max(m);
    float sum = 0.f;
#pragma unroll
    for (int nt = 0; nt < 16; ++nt) {
      float e = __expf((s[nt][i] - m) * scale);
      sum += e;
      const int key = nt * 16 + fr, rr = fq * 4 + i;
      *(bf16_t*)(pl + (key >> 5) * 1024 + swz(rr, (key & 31) * 2)) = f2bf(e);
    }
    rs[i] = red16_sum(sum);
  }
  __syncthreads();
  f32x4 o[8];
#pragma unroll
  for (int nt = 0; nt < 8; ++nt) o[nt] = f32x4{0, 0, 0, 0};
  const int fo = swz(fr, fq * 16);
#pragma unroll
  for (int ks = 0; ks < 8; ++ks) {
    bf16x8 ap = *(const bf16x8*)(pl + ks * 1024 + fo);
#pragma unroll
    for (int nt = 0; nt < 8; ++nt) {
      bf16x8 bv = *(const bf16x8*)(vt + (size_t)(nt * 16 + fr) * 256 + ks * 32 + fq * 8);
      o[nt] = MFMA(ap, bv, o[nt]);
    }
  }
#pragma unroll
  for (int nt = 0; nt < 8; ++nt)
#pragma unroll
    for (int i = 0; i < 4; ++i)
      axa[(size_t)(tok0 + fq * 4 + i) * DXA + h * 128 + nt * 16 + fr] = f2bf(o[nt][i] / rs[i]);
  __syncthreads();
}

__device__ void attn_sample_item(const Params& p, int l, int b, int h, char* lds) {
  const int TX = tid_();
  char* ws = p.ws;
  const int tid = TX, lane = tid & 63, wv = tid >> 6;
  const bf16_t* proj = (const bf16_t*)(ws + B_PROJ);
  bf16_t* axa = (bf16_t*)(ws + B_AXA);
  const int tok0 = MP + b * 4;
  float* q = (float*)lds;
  float* pr = q + 512;
  float* red = pr + 1024;
  float* part = red + 32;
  __syncthreads();
  for (int i = tid; i < 512; i += 256) q[i] = bf2f(proj[(size_t)(tok0 + (i >> 7)) * DIN + C_Q + h * 128 + (i & 127)]);
  __syncthreads();
  const float* kc = p.in[I_CK] + (((size_t)l * 128 + b) * 256 + tid) * 512 + h * 128;
  float s0 = 0.f, s1 = 0.f, s2 = 0.f, s3 = 0.f;
#pragma unroll 4
  for (int d = 0; d < 128; d += 4) {
    const float4 kv = *(const float4*)(kc + d);
    const float4 q0 = *(const float4*)(q + d), q1 = *(const float4*)(q + 128 + d), q2 = *(const float4*)(q + 256 + d),
                 q3 = *(const float4*)(q + 384 + d);
    s0 += kv.x * q0.x + kv.y * q0.y + kv.z * q0.z + kv.w * q0.w;
    s1 += kv.x * q1.x + kv.y * q1.y + kv.z * q1.z + kv.w * q1.w;
    s2 += kv.x * q2.x + kv.y * q2.y + kv.z * q2.z + kv.w * q2.w;
    s3 += kv.x * q3.x + kv.y * q3.y + kv.z * q3.z + kv.w * q3.w;
  }
  const float scale = 0.08838834764831845f;
  s0 *= scale; s1 *= scale; s2 *= scale; s3 *= scale;
  float m0 = s0, m1 = s1, m2 = s2, m3 = s3;
#pragma unroll
  for (int m = 1; m < 64; m <<= 1) {
    m0 = fmaxf(m0, __shfl_xor(m0, m, 64)); m1 = fmaxf(m1, __shfl_xor(m1, m, 64));
    m2 = fmaxf(m2, __shfl_xor(m2, m, 64)); m3 = fmaxf(m3, __shfl_xor(m3, m, 64));
  }
  if (lane == 0) { red[wv * 4 + 0] = m0; red[wv * 4 + 1] = m1; red[wv * 4 + 2] = m2; red[wv * 4 + 3] = m3; }
  __syncthreads();
  m0 = fmaxf(fmaxf(red[0], red[4]), fmaxf(red[8], red[12]));
  m1 = fmaxf(fmaxf(red[1], red[5]), fmaxf(red[9], red[13]));
  m2 = fmaxf(fmaxf(red[2], red[6]), fmaxf(red[10], red[14]));
  m3 = fmaxf(fmaxf(red[3], red[7]), fmaxf(red[11], red[15]));
  const float e0 = __expf(s0 - m0), e1 = __expf(s1 - m1), e2 = __expf(s2 - m2), e3 = __expf(s3 - m3);
  pr[tid] = e0; pr[256 + tid] = e1; pr[512 + tid] = e2; pr[768 + tid] = e3;
  float t0 = wave_sum(e0), t1 = wave_sum(e1), t2 = wave_sum(e2), t3 = wave_sum(e3);
  if (lane == 0) { red[16 + wv * 4 + 0] = t0; red[16 + wv * 4 + 1] = t1; red[16 + wv * 4 + 2] = t2; red[16 + wv * 4 + 3] = t3; }
  __syncthreads();
  const float z0 = red[16] + red[20] + red[24] + red[28], z1 = red[17] + red[21] + red[25] + red[29];
  const float z2 = red[18] + red[22] + red[26] + red[30], z3 = red[19] + red[23] + red[27] + red[31];
  const int d = tid & 127, half = tid >> 7;
  const float* vc = p.in[I_CV] + (((size_t)l * 128 + b) * 256 + half * 128) * 512 + h * 128 + d;
  float o0 = 0.f, o1 = 0.f, o2 = 0.f, o3 = 0.f;
#pragma unroll 8
  for (int k = 0; k < 128; ++k) {
    const float vv = vc[(size_t)k * 512];
    const int key = half * 128 + k;
    o0 += pr[key] * vv; o1 += pr[256 + key] * vv; o2 += pr[512 + key] * vv; o3 += pr[768 + key] * vv;
  }
  if (half == 1) { part[d] = o0; part[128 + d] = o1; part[256 + d] = o2; part[384 + d] = o3; }
  __syncthreads();
  if (half == 0) {
    o0 += part[d]; o1 += part[128 + d]; o2 += part[256 + d]; o3 += part[384 + d];
    axa[(size_t)(tok0 + 0) * DXA + h * 128 + d] = f2bf(o0 / z0);
    axa[(size_t)(tok0 + 1) * DXA + h * 128 + d] = f2bf(o1 / z1);
    axa[(size_t)(tok0 + 2) * DXA + h * 128 + d] = f2bf(o2 / z2);
    axa[(size_t)(tok0 + 3) * DXA + h * 128 + d] = f2bf(o3 / z3);
  }
  __syncthreads();
}

__device__ void phase_mix(const Params& p, int l, char* lds, int* s_item) {
  const int TX = tid_();
  int* cnt = (int*)(p.ws + B_CNT) + l;
  constexpr int N_WKVP = 96 * 4, N_LRUP = 8 * 24, N_ATTP = 1024, N_WKVS = 128 * 12, N_LRUS = 384, N_ATTS = 512;
  constexpr int E1 = N_WKVP, E2 = E1 + N_LRUP, E3 = E2 + N_ATTP, E4 = E3 + N_WKVS, E5 = E4 + N_LRUS, E6 = E5 + N_ATTS;
  for (;;) {
    __syncthreads();
    if (TX == 0) *s_item = atomicAdd(cnt, 1);
    __syncthreads();
    const int it = *s_item;
    if (it >= E6) break;
    if (it < E1) {
      const int qt = it & 3, bh = it >> 2;
      wkv_scan_item(p, l, bh / 12, bh % 12, qt, lds);
    } else if (it < E2) {
      const int j = it - E1;
      lru_scan_prompt_item(p, l, j / 24, j % 24, lds);
    } else if (it < E3) {
      const int j = it - E2;
      attn_prompt_item(p, l, j >> 7, (j >> 5) & 3, j & 31, lds);
    } else if (it < E4) {
      const int j = it - E3;
      wkv_scan_item(p, l, 8 + j / 12, j % 12, -1, lds);
    } else if (it < E5) {
      const int j = it - E4;
      lru_scan_item(p, l, 8 + j / 3, j % 3);
    } else {
      const int j = it - E5;
      attn_sample_item(p, l, j >> 2, j & 3, lds);
    }
  }
}

__device__ void phase_post(const Params& p, int l) {
  const int TX = tid_();
  char* ws = p.ws;
  const int lane = TX & 63, wv = TX >> 6;
  const float* ybuf = (const float*)(ws + B_YBUF);
  const float* cbuf = (const float*)(ws + B_CBUF);
  const bf16_t* gbuf = (const bf16_t*)(ws + B_GBUF);
  const char* scan = ws + B_SCAN;
  bf16_t* arw = (bf16_t*)(ws + B_ARW);
  const float* gng = p.in[I_GNG] + (size_t)l * DRW;
  const float* gnb = p.in[I_GNB] + (size_t)l * DRW;
  for (int t4 = blockIdx.x; t4 < MT / 4; t4 += gridDim.x) {
    const int tok = t4 * 4 + wv;
#pragma unroll
    for (int ps = 0; ps < 3; ++ps) {
      const int c = ps * 256 + lane * 4, h = c >> 6;
      const float4 y = *(const float4*)(ybuf + (size_t)tok * DRW + c);
      const float mean = red16_sum(y.x + y.y + y.z + y.w) * (1.f / 64.f);
      const float d0 = y.x - mean, d1 = y.y - mean, d2 = y.z - mean, d3 = y.w - mean;
      const float var = red16_sum(d0 * d0 + d1 * d1 + d2 * d2 + d3 * d3) * (1.f / 64.f);
      const float rs = rsqrtf(var + 64e-5f);
      const float4 gg = *(const float4*)(gng + c), gb = *(const float4*)(gnb + c);
      const float c3 = cbuf[((size_t)tok * 12 + h) * 4 + 2];
      const uint2 vq = *(const uint2*)(scan + ((size_t)tok * 12 + h) * 896 + 768 + (c & 63) * 2);
      const uint2 gq = *(const uint2*)(gbuf + (size_t)tok * DRW + c);
      const float v0 = __uint_as_float(vq.x << 16), v1 = __uint_as_float(vq.x & 0xffff0000u);
      const float v2 = __uint_as_float(vq.y << 16), v3 = __uint_as_float(vq.y & 0xffff0000u);
      const float g0 = __uint_as_float(gq.x << 16), g1 = __uint_as_float(gq.x & 0xffff0000u);
      const float g2 = __uint_as_float(gq.y << 16), g3 = __uint_as_float(gq.y & 0xffff0000u);
      uint2 o;
      o.x = pk_bf2((d0 * rs * gg.x + gb.x + c3 * v0) * g0, (d1 * rs * gg.y + gb.y + c3 * v1) * g1);
      o.y = pk_bf2((d2 * rs * gg.z + gb.z + c3 * v2) * g2, (d3 * rs * gg.w + gb.w + c3 * v3) * g3);
      *(uint2*)(arw + (size_t)tok * DRW + c) = o;
    }
  }
}

__device__ __forceinline__ void merge_ops(char* ws, int l, int br, const bf16_t*& A, const bf16_t*& Bt, int& K) {
  if (br == 0) { A = (const bf16_t*)(ws + B_ARW); Bt = (const bf16_t*)(ws + W_RWOUT) + (size_t)l * D * DRW; K = DRW; }
  else if (br == 1) { A = (const bf16_t*)(ws + B_ALRU); Bt = (const bf16_t*)(ws + W_LRUOUT) + (size_t)l * D * DLRU; K = DLRU; }
  else { A = (const bf16_t*)(ws + B_AXA); Bt = (const bf16_t*)(ws + W_XAOUT) + (size_t)l * D * DXA; K = DXA; }
}

__device__ void phase_merge(const Params& p, int l, char* lds) {
  const int TX = tid_();
  char* ws = p.ws;
  const bf16_t* proj = (const bf16_t*)(ws + B_PROJ);
  bf16_t* mixin = (bf16_t*)(ws + B_MIXIN);
  const int lane = TX & 63, wv = TX >> 6, wr = wv >> 1, wc = wv & 1, fr = lane & 15, fq = lane >> 4;
  const int ntiles = (MT / 128) * 16;
  TileIter it = tile_iter(ntiles);
  int L = it.L, br = 0;
  bool have = L < it.Lend;
  int m0 = 0, n0 = 0;
  const bf16_t* A = nullptr; const bf16_t* Bt = nullptr; int K = 0;
  if (have) {
    int tm, tn; tile_mn(L, MT / 128, 16, tm, tn); m0 = tm * 128; n0 = tn * 64;
    merge_ops(ws, l, 0, A, Bt, K);
    gemm_prologue<4, 2>(A, K, Bt, K, m0, n0, lds);
  }
  f32x4 sum[4][2];
  zero_acc(sum);
  while (have) {
    f32x4 acc[4][2];
    zero_acc(acc);
    gemm_loop<4, 2>(A, K, Bt, K, K, m0, n0, lds, acc);
    uint4 gq[4];
#pragma unroll
    for (int mt = 0; mt < 4; ++mt)
      gq[mt] = *(const uint4*)(proj + (size_t)(m0 + wr * 64 + mt * 16 + fr) * DIN + C_G + br * D + n0 + wc * 32 + fq * 8);
    int nbr = br + 1, nL = L;
    if (nbr == 3) { nbr = 0; nL = L + it.step; }
    const bool hn = nL < it.Lend;
    int m1 = m0, n1 = n0;
    const bf16_t* A1 = A; const bf16_t* Bt1 = Bt; int K1 = K;
    if (hn) {
      if (nbr == 0) { int tm, tn; tile_mn(nL, MT / 128, 16, tm, tn); m1 = tm * 128; n1 = tn * 64; }
      merge_ops(ws, l, nbr, A1, Bt1, K1);
      gemm_prologue<4, 2>(A1, K1, Bt1, K1, m1, n1, lds);
    }
#pragma unroll
    for (int mt = 0; mt < 4; ++mt) {
      const unsigned gw[4] = {gq[mt].x, gq[mt].y, gq[mt].z, gq[mt].w};
#pragma unroll
      for (int nt = 0; nt < 2; ++nt)
#pragma unroll
        for (int i = 0; i < 4; ++i) {
          const unsigned w = gw[nt * 2 + (i >> 1)];
          const float gv = __uint_as_float((i & 1) ? (w & 0xffff0000u) : (w << 16));
          sum[mt][nt][i] += sigmoidf_(gv) * acc[mt][nt][i];
        }
    }
    if (br == 2) {
#pragma unroll
      for (int mt = 0; mt < 4; ++mt) {
        const int row = m0 + wr * 64 + mt * 16 + fr, col = n0 + wc * 32 + fq * 8;
        *(uint4*)(mixin + (size_t)row * D + col) = pack8(sum[mt][0], sum[mt][1]);
      }
      zero_acc(sum);
    }
    L = nL; br = nbr; have = hn; m0 = m1; n0 = n1; A = A1; Bt = Bt1; K = K1;
  }
}

__device__ void phase_resid_gemm(const Params& p, const bf16_t* A, const bf16_t* Bt, int K, char* lds) {
  const int TX = tid_();
  char* ws = p.ws;
  const bf16_t* xb = (const bf16_t*)(ws + B_XB);
  bf16_t* t = (bf16_t*)(ws + B_XF);
  const int lane = TX & 63, wv = TX >> 6, wr = wv >> 1, wc = wv & 1, fr = lane & 15, fq = lane >> 4;
  constexpr int NT_ALL = (MT / 128) * 8;
  const int G = (int)gridDim.x;
  const int nfull = (NT_ALL / G) * G;
  TileIter it = tile_iter(nfull);
  bool have = it.L < it.Lend;
  int m0 = 0, n0 = 0;
  if (have) { int tm, tn; tile_mn(it.L, MT / 128, 8, tm, tn); m0 = tm * 128; n0 = tn * 128; gemm_prologue<4, 4>(A, K, Bt, K, m0, n0, lds); }
  while (have) {
    f32x4 acc[4][4];
    zero_acc(acc);
    gemm_loop<4, 4>(A, K, Bt, K, K, m0, n0, lds, acc);
    uint4 xq[4][2];
#pragma unroll
    for (int mt = 0; mt < 4; ++mt) {
      const uint4* xs = (const uint4*)(xb + (size_t)(m0 + wr * 64 + mt * 16 + fr) * D + n0 + wc * 64 + fq * 16);
      xq[mt][0] = xs[0];
      xq[mt][1] = xs[1];
    }
    const int Ln = it.L + it.step;
    const bool hn = Ln < it.Lend;
    int m1 = m0, n1 = n0;
    if (hn) { int tm, tn; tile_mn(Ln, MT / 128, 8, tm, tn); m1 = tm * 128; n1 = tn * 128; gemm_prologue<4, 4>(A, K, Bt, K, m1, n1, lds); }
#pragma unroll
    for (int mt = 0; mt < 4; ++mt) {
      uint4* ts = (uint4*)(t + (size_t)(m0 + wr * 64 + mt * 16 + fr) * D + n0 + wc * 64 + fq * 16);
      f32x4 o[4];
#pragma unroll
      for (int nt = 0; nt < 4; ++nt) {
        const uint4 q = xq[mt][nt >> 1];
        const unsigned w0 = (nt & 1) ? q.z : q.x, w1 = (nt & 1) ? q.w : q.y;
        o[nt][0] = ALPHA * __uint_as_float(w0 << 16) + acc[mt][nt][0];
        o[nt][1] = ALPHA * __uint_as_float(w0 & 0xffff0000u) + acc[mt][nt][1];
        o[nt][2] = ALPHA * __uint_as_float(w1 << 16) + acc[mt][nt][2];
        o[nt][3] = ALPHA * __uint_as_float(w1 & 0xffff0000u) + acc[mt][nt][3];
      }
      ts[0] = pack8(o[0], o[1]);
      ts[1] = pack8(o[2], o[3]);
    }
    it.L = Ln; have = hn; m0 = m1; n0 = n1;
  }
  for (int hidx = (int)blockIdx.x; hidx < (NT_ALL - nfull) * 2; hidx += G) {
    int tm, tn;
    tile_mn(nfull + (hidx >> 1), MT / 128, 8, tm, tn);
    const int hm0 = tm * 128, hn0 = tn * 128 + (hidx & 1) * 64;
    f32x4 acc[4][2];
    zero_acc(acc);
    gemm_main<4, 2>(A, K, Bt, K, K, hm0, hn0, lds, acc);
#pragma unroll
    for (int mt = 0; mt < 4; ++mt) {
      const size_t off = (size_t)(hm0 + wr * 64 + mt * 16 + fr) * D + hn0 + wc * 32 + fq * 8;
      const uint4 q = *(const uint4*)(xb + off);
      f32x4 o0, o1;
      o0[0] = ALPHA * __uint_as_float(q.x << 16) + acc[mt][0][0]; o0[1] = ALPHA * __uint_as_float(q.x & 0xffff0000u) + acc[mt][0][1];
      o0[2] = ALPHA * __uint_as_float(q.y << 16) + acc[mt][0][2]; o0[3] = ALPHA * __uint_as_float(q.y & 0xffff0000u) + acc[mt][0][3];
      o1[0] = ALPHA * __uint_as_float(q.z << 16) + acc[mt][1][0]; o1[1] = ALPHA * __uint_as_float(q.z & 0xffff0000u) + acc[mt][1][1];
      o1[2] = ALPHA * __uint_as_float(q.w << 16) + acc[mt][1][2]; o1[3] = ALPHA * __uint_as_float(q.w & 0xffff0000u) + acc[mt][1][3];
      *(uint4*)(t + off) = pack8(o0, o1);
    }
  }
}

__device__ void phase_ln(const Params& p, const float* g, const float* bta, bool final_out) {
  const int TX = tid_();
  char* ws = p.ws;
  const int lane = TX & 63, wv = TX >> 6;
  const bf16_t* t = (const bf16_t*)(ws + B_XF);
  float* yout = p.out + O_Y;
  bf16_t* xb = (bf16_t*)(ws + B_XB);
  for (int r4 = blockIdx.x; r4 < MT / 4; r4 += gridDim.x) {
    const int row = r4 * 4 + wv;
    float4 v[4];
    float s = 0.f;
#pragma unroll
    for (int j = 0; j < 4; ++j) {
      const uint2 q = *(const uint2*)(t + (size_t)row * D + j * 256 + lane * 4);
      v[j] = make_float4(__uint_as_float(q.x << 16), __uint_as_float(q.x & 0xffff0000u), __uint_as_float(q.y << 16), __uint_as_float(q.y & 0xffff0000u));
      s += v[j].x + v[j].y + v[j].z + v[j].w;
    }
    const float mean = wave_sum(s) * (1.f / 1024.f);
    float q = 0.f;
#pragma unroll
    for (int j = 0; j < 4; ++j) {
      v[j].x -= mean; v[j].y -= mean; v[j].z -= mean; v[j].w -= mean;
      q += v[j].x * v[j].x + v[j].y * v[j].y + v[j].z * v[j].z + v[j].w * v[j].w;
    }
    const float rstd = rsqrtf(wave_sum(q) * (1.f / 1024.f) + 1e-5f);
#pragma unroll
    for (int j = 0; j < 4; ++j) {
      const int c = j * 256 + lane * 4;
      const float4 gg = *(const float4*)(g + c), bb = *(const float4*)(bta + c);
      float4 o;
      o.x = v[j].x * rstd * gg.x + bb.x; o.y = v[j].y * rstd * gg.y + bb.y;
      o.z = v[j].z * rstd * gg.z + bb.z; o.w = v[j].w * rstd * gg.w + bb.w;
      if (final_out) {
        *(float4*)(yout + (size_t)row * D + c) = o;
      } else {
        uint2 ob;
        ob.x = (unsigned)f2bf(o.x) | ((unsigned)f2bf(o.y) << 16);
        ob.y = (unsigned)f2bf(o.z) | ((unsigned)f2bf(o.w) << 16);
        *(uint2*)(xb + (size_t)row * D + c) = ob;
      }
    }
  }
}

__device__ void phase_ffn_in(const Params& p, int l, char* lds) {
  const int TX = tid_();
  char* ws = p.ws;
  const bf16_t* xb = (const bf16_t*)(ws + B_XB);
  const bf16_t* wt = (const bf16_t*)(ws + W_FFNIN) + (size_t)l * 2 * DFF * D;
  bf16_t* act = (bf16_t*)(ws + B_ACT);
  const int lane = TX & 63, wv = TX >> 6, wr = wv >> 1, wc = wv & 1, fr = lane & 15, fq = lane >> 4;
  const int nN = 2 * DFF / 128, ntiles = (MT / 128) * nN;
  TileIter it = tile_iter(ntiles);
  bool have = it.L < it.Lend;
  int m0 = 0, n0 = 0;
  if (have) { int tm, tn; tile_mn(it.L, MT / 128, nN, tm, tn); m0 = tm * 128; n0 = tn * 128; gemm_prologue<4, 4>(xb, D, wt, D, m0, n0, lds); }
  while (have) {
    f32x4 acc[4][4];
    zero_acc(acc);
    gemm_loop<4, 4>(xb, D, wt, D, D, m0, n0, lds, acc);
    const int Ln = it.L + it.step;
    const bool hn = Ln < it.Lend;
    int m1 = m0, n1 = n0;
    if (hn) { int tm, tn; tile_mn(Ln, MT / 128, nN, tm, tn); m1 = tm * 128; n1 = tn * 128; gemm_prologue<4, 4>(xb, D, wt, D, m1, n1, lds); }
    const int jb = (n0 + wc * 64 + fq * 16) / 2;
#pragma unroll
    for (int mt = 0; mt < 4; ++mt) {
      const int row = m0 + wr * 64 + mt * 16 + fr;
      f32x4 o0, o1;
#pragma unroll
      for (int i = 0; i < 4; ++i) {
        const float g0 = acc[mt][2][i], g1 = acc[mt][3][i];
        o0[i] = g0 * sigmoidf_(g0) * acc[mt][0][i];
        o1[i] = g1 * sigmoidf_(g1) * acc[mt][1][i];
      }
      *(uint4*)(act + (size_t)row * DFF + jb) = pack8(o0, o1);
    }
    it.L = Ln; have = hn; m0 = m1; n0 = n1;
  }
}

__global__ void __launch_bounds__(256, 2) fwd_megakernel(Params p) {
  cg::grid_group grid = cg::this_grid();
  __shared__ __attribute__((aligned(1024))) char lds[LDS_BYTES];
  __shared__ int s_item;
  __shared__ uint4 xb_words;
  char* ws = p.ws;
  if (threadIdx.x == 0) xb_words = make_uint4(0u, 0u, 0u, 0u);
  __syncthreads();
  XcdBarrier xb = xcd_barrier_post((unsigned*)(ws + B_BAR), (volatile LAS unsigned*)&xb_words);
  constexpr int NPH = 1 + NL * 11;
#pragma unroll 1
  for (int ph = 0; ph < NPH; ++ph) {
    int phl = ph;
    asm volatile("" : "+s"(phl));
    if (phl == 0) {
      phase_convert(p, lds);
    } else {
      const int l = (phl - 1) / 11, k = (phl - 1) % 11;
      switch (k) {
        case 0: phase_proj(p, l, lds); break;
        case 1: phase_prep(p, l, lds); break;
        case 2: phase_lora(p, l, lds); break;
        case 3: phase_mix(p, l, lds, &s_item); break;
        case 4: phase_post(p, l); break;
        case 5: phase_merge(p, l, lds); break;
        case 8: phase_ffn_in(p, l, lds); break;
        case 6: case 9: {
          const bool first = (k == 6);
          phase_resid_gemm(p, (const bf16_t*)(ws + (first ? B_MIXIN : B_ACT)),
                           first ? (const bf16_t*)(ws + W_O) + (size_t)l * D * D : (const bf16_t*)(ws + W_FFNOUT) + (size_t)l * D * DFF,
                           first ? D : DFF, lds);
          break;
        }
        default: {
          const bool first = (k == 7);
          phase_ln(p, (first ? p.in[I_LN1G] : p.in[I_LN2G]) + (size_t)l * D, (first ? p.in[I_LN1B] : p.in[I_LN2B]) + (size_t)l * D,
                   !first && l == NL - 1);
          break;
        }
      }
    }
    if (ph + 1 < NPH) xcd_barrier(xb);
    if (p.ws == nullptr) grid.sync();
  }
}

extern "C" void kernel_launch(void* const* d_in, const int* in_sizes, int n_in, void* d_out, int out_size, void* d_ws,
                              size_t ws_size, hipStream_t stream) {
  static int grid_blocks = 0;
  if (!grid_blocks) {
    int dev = 0, cus = 0, per_cu = 0;
    (void)hipGetDevice(&dev);
    (void)hipDeviceGetAttribute(&cus, hipDeviceAttributeMultiprocessorCount, dev);
    (void)hipOccupancyMaxActiveBlocksPerMultiprocessor(&per_cu, fwd_megakernel, 256, 0);
    if (per_cu > 2) per_cu = 2;
    if (per_cu < 1) per_cu = 1;
    grid_blocks = cus * per_cu;
  }
  if (ws_size < WS_NEED || n_in < 42) {
    fprintf(stderr, "workspace too small: %zu < %zu\n", ws_size, (size_t)WS_NEED);
    return;
  }
  (void)hipMemsetAsync((char*)d_ws + B_CNT, 0, 256 + BAR_BYTES, stream);
  Params p{};
  for (int i = 0; i < 42; ++i) p.in[i] = (const float*)d_in[i];
  p.out = (float*)d_out;
  p.ws = (char*)d_ws;
  void* args[] = {&p};
  hipError_t e = hipLaunchCooperativeKernel((void*)fwd_megakernel, dim3(grid_blocks), dim3(256), args, 0, stream);
  if (e != hipSuccess) fprintf(stderr, "cooperative launch failed: %s (grid %d)\n", hipGetErrorString(e), grid_blocks);
}
```
